# Optimizing an MI355X kernel written in HIP

```python
import jax, jax.numpy as jnp
from jax import lax
import numpy as np

D_MODEL = 1024
BATCH = 2
SEQ = 16384
DEPTH = 1
DEC_BATCH = 32
DEC_SEQ = 16
PAST_LEN = 1024

CHUNK = 64
H_RET = 8
DK_RET = 64
DV_RET = 128
H_FOX = 8
DH_FOX = 64
Q_BLOCK = 128
ROPE_BASE = 10000.0
PEER_HEADS = 8
PEER_N_KEYS = 128
PEER_N_EXPERTS = PEER_N_KEYS * PEER_N_KEYS
PEER_QUERY_DIM = 256
PEER_HALF = PEER_QUERY_DIM // 2
PEER_TOPK = 16
PEER_TOKEN_BLOCK = 128
FORGET_BIAS_INIT = 2.0
EPS = 1e-6

RET_QK = H_RET * DK_RET
RET_V = H_RET * DV_RET
FOX_W = H_FOX * DH_FOX
IN_SIZES = (RET_QK, RET_QK, RET_V, RET_V, FOX_W, FOX_W, FOX_W, H_FOX, D_MODEL, D_MODEL)
IN_WIDTH = 2 * RET_QK + 2 * RET_V + 3 * FOX_W + H_FOX + 2 * D_MODEL

kernel_name = 'hybrid_retention_fox_peer_stream_step'


def rms_norm(x, g):
    xf = x.astype(jnp.float32)
    y = xf * lax.rsqrt(jnp.mean(xf * xf, axis=-1, keepdims=True) + EPS)
    return (y * g.astype(jnp.float32)).astype(x.dtype)


def rotary(x, pos):
    half = x.shape[-1] // 2
    inv = ROPE_BASE ** (-jnp.arange(half, dtype=jnp.float32) / half)
    ang = pos.astype(jnp.float32)[:, None] * inv[None, :]
    cos = jnp.cos(ang)[None, :, None, :]
    sin = jnp.sin(ang)[None, :, None, :]
    xf = x.astype(jnp.float32)
    x1, x2 = xf[..., :half], xf[..., half:]
    return jnp.concatenate([x1 * cos - x2 * sin, x2 * cos + x1 * sin], axis=-1).astype(x.dtype)


def retention_log_gamma():
    return jnp.log1p(-jnp.exp2(-5.0 - jnp.arange(H_RET, dtype=jnp.float32)))


def project_inputs(xn, pos, p):
    B, T, _ = xn.shape
    h = xn @ p['w_in']
    splits = np.cumsum(IN_SIZES)[:-1].tolist()
    rq, rk, rv, rg, fq, fk, fv, fz, ga, gb = jnp.split(h, splits, axis=-1)
    rq = rotary(rq.reshape(B, T, H_RET, DK_RET), pos)
    rk = rotary(rk.reshape(B, T, H_RET, DK_RET), pos) * (DK_RET ** -0.5)
    rv = rv.reshape(B, T, H_RET, DV_RET)
    fq = rms_norm(fq.reshape(B, T, H_FOX, DH_FOX), p['fox_q_g'])
    fk = rms_norm(fk.reshape(B, T, H_FOX, DH_FOX), p['fox_k_g'])
    fv = fv.reshape(B, T, H_FOX, DH_FOX)
    logf = jax.nn.log_sigmoid((fz + p['b_f']).astype(jnp.float32))
    return rq, rk, rv, rg, fq, fk, fv, logf, ga, gb


def retention_chunk(S, q, k, v, log_gamma):
    L = q.shape[1]
    idx = jnp.arange(L, dtype=jnp.float32)
    diff = idx[:, None] - idx[None, :]
    decay = jnp.where(diff >= 0, jnp.exp(jnp.maximum(diff, 0.0)[None] * log_gamma[:, None, None]), 0.0)
    scores = jnp.einsum('blhd,bmhd->bhlm', q, k) * decay[None]
    inner = jnp.einsum('bhlm,bmhe->blhe', scores, v)
    q_dec = jnp.exp((idx + 1.0)[:, None] * log_gamma[None, :])[None, :, :, None]
    cross = jnp.einsum('blhd,bhde->blhe', q, S) * q_dec
    k_dec = k * jnp.exp((L - 1.0 - idx)[:, None] * log_gamma[None, :])[None, :, :, None]
    S_new = jnp.exp(L * log_gamma)[None, :, None, None] * S + jnp.einsum('blhd,blhe->bhde', k_dec, v)
    return S_new, inner + cross


def retention_prompt(q, k, v):
    B, T, H, dk = q.shape
    dv = v.shape[-1]
    nc = T // CHUNK
    log_gamma = retention_log_gamma()

    def to_chunks(a):
        return a.astype(jnp.float32).reshape(B, nc, CHUNK, *a.shape[2:]).swapaxes(0, 1)

    def step(S, qkv):
        qi, ki, vi = qkv
        return retention_chunk(S, qi, ki, vi, log_gamma)

    S0 = jnp.zeros((B, H, dk, dv), jnp.float32)
    S, o = lax.scan(step, S0, (to_chunks(q), to_chunks(k), to_chunks(v)))
    return o.swapaxes(0, 1).reshape(B, T, H, dv), S


def fox_prompt(q, k, v, logf):
    B, T, H, dh = q.shape
    c = jnp.cumsum(logf, axis=1)
    cT = c.transpose(0, 2, 1)
    nb = T // Q_BLOCK
    qb = q.reshape(B, nb, Q_BLOCK, H, dh).swapaxes(0, 1)
    cb = c.reshape(B, nb, Q_BLOCK, H).swapaxes(0, 1)
    kpos = jnp.arange(T)
    scale = dh ** -0.5

    def block(args):
        i, qi, ci = args
        s = jnp.einsum('bqhd,bkhd->bhqk', qi, k).astype(jnp.float32) * scale
        s = s + ci.transpose(0, 2, 1)[..., None] - cT[:, :, None, :]
        qpos = i * Q_BLOCK + jnp.arange(Q_BLOCK)
        s = jnp.where(kpos[None, :] <= qpos[:, None], s, -jnp.inf)
        pr = jax.nn.softmax(s, axis=-1).astype(v.dtype)
        return jnp.einsum('bhqk,bkhd->bqhd', pr, v)

    o = lax.map(block, (jnp.arange(nb), qb, cb))
    return o.swapaxes(0, 1).reshape(B, T, H, dh)


def fox_sample(q, k_new, v_new, logf_new, k_c, v_c, logf_c):
    P = k_c.shape[1]
    L = q.shape[1]
    dh = q.shape[-1]
    k = jnp.concatenate([k_c, k_new], axis=1)
    v = jnp.concatenate([v_c, v_new], axis=1)
    c = jnp.cumsum(jnp.concatenate([logf_c.astype(jnp.float32), logf_new], axis=1), axis=1)
    cT = c.transpose(0, 2, 1)
    s = jnp.einsum('bqhd,bkhd->bhqk', q, k).astype(jnp.float32) * (dh ** -0.5)
    s = s + cT[:, :, P:, None] - cT[:, :, None, :]
    kpos = jnp.arange(P + L)
    qpos = P + jnp.arange(L)
    s = jnp.where(kpos[None, :] <= qpos[:, None], s, -jnp.inf)
    pr = jax.nn.softmax(s, axis=-1).astype(v.dtype)
    return jnp.einsum('bhqk,bkhd->bqhd', pr, v)


def merge_branches(ret_o, rg, fox_o, ga, gb, p):
    B, T = rg.shape[:2]
    ret_o = rms_norm(ret_o, p['ret_gn_g'])
    ret_y = (jax.nn.silu(rg) * ret_o.reshape(B, T, RET_V)) @ p['w_ret_out']
    fox_y = fox_o.reshape(B, T, FOX_W) @ p['w_fox_out']
    mixed = jax.nn.sigmoid(ga) * ret_y + jax.nn.sigmoid(gb) * fox_y
    return mixed @ p['w_o']


def token_mixer_prompt(xn, p):
    T = xn.shape[1]
    pos = jnp.arange(T)
    rq, rk, rv, rg, fq, fk, fv, logf, ga, gb = project_inputs(xn, pos, p)
    ret_o, S = retention_prompt(rq, rk, rv)
    fox_o = fox_prompt(fq, fk, fv, logf)
    y = merge_branches(ret_o.astype(xn.dtype), rg, fox_o, ga, gb, p)
    return y, S, fk, fv, logf


def token_mixer_sample(xn, S, k_c, v_c, logf_c, p):
    L = xn.shape[1]
    P = k_c.shape[1]
    pos = P + jnp.arange(L)
    rq, rk, rv, rg, fq, fk, fv, logf, ga, gb = project_inputs(xn, pos, p)
    S_new, ret_o = retention_chunk(S.astype(jnp.float32), rq.astype(jnp.float32), rk.astype(jnp.float32),
                                   rv.astype(jnp.float32), retention_log_gamma())
    fox_o = fox_sample(fq, fk, fv, logf, k_c.astype(fk.dtype), v_c.astype(fv.dtype), logf_c)
    y = merge_branches(ret_o.astype(xn.dtype), rg, fox_o, ga, gb, p)
    return y, S_new, fk, fv, logf


def peer_ffn(x, p):
    shp = x.shape
    xt = x.reshape(-1, D_MODEL)
    n = xt.shape[0]
    nb = -(-n // PEER_TOKEN_BLOCK)
    pad = nb * PEER_TOKEN_BLOCK - n
    xt = jnp.pad(xt, ((0, pad), (0, 0))).reshape(nb, PEER_TOKEN_BLOCK, D_MODEL)
    w_q, k1, k2, u_tab, v_tab = p['peer_w_q'], p['peer_sub_k1'], p['peer_sub_k2'], p['peer_u'], p['peer_v']

    def block(xb):
        t = xb.shape[0]
        q = (xb @ w_q).reshape(t, PEER_HEADS, 2, PEER_HALF)
        s1 = jnp.einsum('thc,kc->thk', q[:, :, 0], k1).astype(jnp.float32)
        s2 = jnp.einsum('thc,kc->thk', q[:, :, 1], k2).astype(jnp.float32)
        v1, i1 = lax.top_k(s1, PEER_TOPK)
        v2, i2 = lax.top_k(s2, PEER_TOPK)
        cand = (v1[..., :, None] + v2[..., None, :]).reshape(t, PEER_HEADS, PEER_TOPK * PEER_TOPK)
        cidx = (i1[..., :, None] * PEER_N_KEYS + i2[..., None, :]).reshape(t, PEER_HEADS, PEER_TOPK * PEER_TOPK)
        top_s, sel = lax.top_k(cand, PEER_TOPK)
        eidx = jnp.take_along_axis(cidx, sel, axis=-1)
        g = jax.nn.softmax(top_s, axis=-1)
        act = jax.nn.gelu(jnp.einsum('thkd,td->thk', u_tab[eidx], xb), approximate=False)
        w = (g * act.astype(jnp.float32)).astype(xb.dtype)
        return jnp.einsum('thk,thkd->td', w, v_tab[eidx])

    y = lax.map(block, xt).reshape(-1, D_MODEL)[:n]
    return y.reshape(shp)


def setup_inputs(seed: int = 0) -> dict:
    key = jax.random.key(seed)
    ks = jax.random.split(key, 24)
    f32 = jnp.float32

    def nrm(k, shape, scale):
        return jax.random.normal(k, shape, f32) * scale

    L = DEPTH
    return {
        'x_prompt': nrm(ks[0], (BATCH, SEQ, D_MODEL), 1.0),
        'x_sample': nrm(ks[1], (DEC_BATCH, DEC_SEQ, D_MODEL), 1.0),
        'state_ret': nrm(ks[2], (L, DEC_BATCH, H_RET, DK_RET, DV_RET), 0.5),
        'cache_fox_k': nrm(ks[3], (L, DEC_BATCH, PAST_LEN, H_FOX, DH_FOX), 1.0),
        'cache_fox_v': nrm(ks[4], (L, DEC_BATCH, PAST_LEN, H_FOX, DH_FOX), 1.0),
        'cache_fox_logf': jax.nn.log_sigmoid(FORGET_BIAS_INIT + nrm(ks[5], (L, DEC_BATCH, PAST_LEN, H_FOX), 0.5)),
        'norm1_g': 1.0 + nrm(ks[6], (L, D_MODEL), 0.02),
        'w_in': nrm(ks[7], (L, D_MODEL, IN_WIDTH), D_MODEL ** -0.5),
        'b_f': FORGET_BIAS_INIT + nrm(ks[8], (L, H_FOX), 0.1),
        'fox_q_g': 1.0 + nrm(ks[9], (L, DH_FOX), 0.02),
        'fox_k_g': 1.0 + nrm(ks[10], (L, DH_FOX), 0.02),
        'ret_gn_g': 1.0 + nrm(ks[11], (L, H_RET, DV_RET), 0.02),
        'w_ret_out': nrm(ks[12], (L, RET_V, D_MODEL), RET_V ** -0.5),
        'w_fox_out': nrm(ks[13], (L, FOX_W, D_MODEL), FOX_W ** -0.5),
        'w_o': nrm(ks[14], (L, D_MODEL, D_MODEL), D_MODEL ** -0.5),
        'norm2_g': 1.0 + nrm(ks[15], (L, D_MODEL), 0.02),
        'peer_w_q': nrm(ks[16], (L, D_MODEL, PEER_HEADS * PEER_QUERY_DIM), D_MODEL ** -0.5),
        'peer_sub_k1': nrm(ks[17], (L, PEER_N_KEYS, PEER_HALF), PEER_HALF ** -0.5),
        'peer_sub_k2': nrm(ks[18], (L, PEER_N_KEYS, PEER_HALF), PEER_HALF ** -0.5),
        'peer_u': nrm(ks[19], (L, PEER_N_EXPERTS, D_MODEL), D_MODEL ** -0.5),
        'peer_v': nrm(ks[20], (L, PEER_N_EXPERTS, D_MODEL), D_MODEL ** -0.5),
    }


def reference(x_prompt, x_sample, state_ret, cache_fox_k, cache_fox_v, cache_fox_logf,
              norm1_g, w_in, b_f, fox_q_g, fox_k_g, ret_gn_g, w_ret_out, w_fox_out, w_o,
              norm2_g, peer_w_q, peer_sub_k1, peer_sub_k2, peer_u, peer_v):
    xp = x_prompt
    xs = x_sample
    sp_l, kp_l, vp_l, lp_l = [], [], [], []
    ss_l, ks_l, vs_l, ls_l = [], [], [], []
    for l in range(DEPTH):
        p = {
            'w_in': w_in[l], 'b_f': b_f[l], 'fox_q_g': fox_q_g[l], 'fox_k_g': fox_k_g[l],
            'ret_gn_g': ret_gn_g[l], 'w_ret_out': w_ret_out[l], 'w_fox_out': w_fox_out[l], 'w_o': w_o[l],
            'peer_w_q': peer_w_q[l], 'peer_sub_k1': peer_sub_k1[l], 'peer_sub_k2': peer_sub_k2[l],
            'peer_u': peer_u[l], 'peer_v': peer_v[l],
        }
        mix_p, S_p, k_p, v_p, lf_p = token_mixer_prompt(rms_norm(xp, norm1_g[l]), p)
        xp = xp + mix_p
        xp = xp + peer_ffn(rms_norm(xp, norm2_g[l]), p)
        mix_s, S_s, k_s, v_s, lf_s = token_mixer_sample(rms_norm(xs, norm1_g[l]), state_ret[l], cache_fox_k[l],
                                                        cache_fox_v[l], cache_fox_logf[l], p)
        xs = xs + mix_s
        xs = xs + peer_ffn(rms_norm(xs, norm2_g[l]), p)
        sp_l.append(S_p.astype(state_ret.dtype))
        kp_l.append(k_p.astype(cache_fox_k.dtype))
        vp_l.append(v_p.astype(cache_fox_v.dtype))
        lp_l.append(lf_p.astype(cache_fox_logf.dtype))
        ss_l.append(S_s.astype(state_ret.dtype))
        ks_l.append(k_s.astype(cache_fox_k.dtype))
        vs_l.append(v_s.astype(cache_fox_v.dtype))
        ls_l.append(lf_s.astype(cache_fox_logf.dtype))
    ret_state_prompt = jnp.stack(sp_l, axis=0)
    fox_k_prompt = jnp.stack(kp_l, axis=0)
    fox_v_prompt = jnp.stack(vp_l, axis=0)
    fox_logf_prompt = jnp.stack(lp_l, axis=0)
    ret_state_sample = jnp.stack(ss_l, axis=0)
    fox_k_sample = jnp.stack(ks_l, axis=0)
    fox_v_sample = jnp.stack(vs_l, axis=0)
    fox_logf_sample = jnp.stack(ls_l, axis=0)
    return (xp, xs, ret_state_prompt, fox_k_prompt, fox_v_prompt, fox_logf_prompt,
            ret_state_sample, fox_k_sample, fox_v_sample, fox_logf_sample)
```

```cpp
#include <hip/hip_runtime.h>
#include <hip/hip_cooperative_groups.h>
#include <stdint.h>
#include <stdio.h>
namespace cg = cooperative_groups;

#define DEV __device__ __forceinline__
typedef unsigned short bfu;
typedef __attribute__((ext_vector_type(8))) short bf16x8;
typedef __attribute__((ext_vector_type(4))) short bf16x4;
typedef __attribute__((ext_vector_type(4))) float f32x4;
typedef __attribute__((ext_vector_type(16))) float f32x16;
typedef __attribute__((ext_vector_type(4))) unsigned u32x4;

constexpr int DM = 1024, SEQ = 16384, TP = 32768, TS = 512, TT = 33280;
constexpr int NWP = 6784;
constexpr int RC = 128;
constexpr int NCH = SEQ / RC;
constexpr float LOG2E = 1.4426950408889634f;
constexpr float EPSN = 1e-6f;

constexpr size_t O_YP = 0, O_YS = 33554432, O_SP = 34078720, O_FKP = 34209792, O_FVP = 50987008,
                 O_LFP = 67764224, O_SS = 68026368, O_FKS = 70123520, O_FVS = 70385664, O_LFS = 70647808;
constexpr size_t MiB = 1u << 20;
constexpr size_t OFF_XB = 0;
constexpr size_t OFF_WINT = 66 * MiB, OFF_WRT = 80 * MiB, OFF_WFT = 82 * MiB, OFF_WOT = 83 * MiB, OFF_MT = 85 * MiB;
constexpr size_t OFF_RSTD1 = 89 * MiB, OFF_C2 = 90 * MiB, OFF_HS = 91 * MiB;
constexpr size_t OFF_QT = 105 * MiB, OFF_KT = 137 * MiB, OFF_KTT = 169 * MiB, OFF_VT = 201 * MiB;
constexpr size_t OFF_X1B = OFF_QT, OFF_ROUTE = 171 * MiB, OFF_SSQ2 = 204 * MiB;
constexpr size_t OFF_RG = 265 * MiB, OFF_FQ = 331 * MiB, OFF_FKB = 364 * MiB, OFF_FVT = 396 * MiB;
constexpr size_t OFF_PUB = OFF_FKB, OFF_PVB = OFF_FVT, OFF_SST = 428 * MiB;
constexpr size_t WS_NEED = 460 * MiB;

constexpr int SMEM_BYTES = 75776;

struct Params {
  const float *x_p, *x_s, *state_ret, *ck, *cv, *clogf, *norm1_g, *w_in, *b_f, *fq_g, *fk_g, *gn_g,
      *w_ret_out, *w_fox_out, *w_o, *norm2_g, *peer_wq, *k1, *k2, *peer_u, *peer_v;
  float* out;
  char* ws;
};

DEV bfu f2bf(float f) { unsigned u = __float_as_uint(f); u += 0x7fffu + ((u >> 16) & 1u); return (bfu)(u >> 16); }
DEV float bf2f(bfu b) { return __uint_as_float(((unsigned)b) << 16); }
DEV unsigned pack2(float a, float b) { return (unsigned)f2bf(a) | ((unsigned)f2bf(b) << 16); }
DEV float bflo(unsigned u) { return __uint_as_float(u << 16); }
DEV float bfhi(unsigned u) { return __uint_as_float(u & 0xffff0000u); }
DEV float sigmoidf_(float z) { return 1.f / (1.f + __expf(-z)); }
DEV float l2gamma(int h) { return log2f(1.f - exp2f(-5.f - (float)h)); }
DEV float wave_sum(float v) {
#pragma unroll
  for (int o = 32; o >= 1; o >>= 1) v += __shfl_xor(v, o);
  return v;
}
DEV float sum16(float v) {
  v += __shfl_xor(v, 1); v += __shfl_xor(v, 2); v += __shfl_xor(v, 4); v += __shfl_xor(v, 8);
  return v;
}

template <int ROWS>
DEV void g2r(const bfu* g, int ld, u32x4 (&r)[ROWS / 32]) {
#pragma unroll
  for (int i = 0; i < ROWS / 32; i++) {
    int id = threadIdx.x + i * 256; int row = id >> 3, ch = id & 7;
    r[i] = *(const u32x4*)(g + (size_t)row * ld + ch * 8);
  }
}
template <int ROWS>
DEV void r2s(bfu* s, const u32x4 (&r)[ROWS / 32]) {
#pragma unroll
  for (int i = 0; i < ROWS / 32; i++) {
    int id = threadIdx.x + i * 256; int row = id >> 3, ch = id & 7;
    *(u32x4*)(s + row * 72 + ch * 8) = r[i];
  }
}
template <int MI, int NI>
DEV void mma64(const bfu* sA, int sldA, const bfu* sB, int sldB, f32x4 (&acc)[MI][NI]) {
  const int lane = threadIdx.x & 63, w = threadIdx.x >> 6, wr = w >> 1, wc = w & 1, l16 = lane & 15, quad = lane >> 4;
#pragma unroll
  for (int kk = 0; kk < 2; kk++) {
    bf16x8 a[MI], b[NI];
#pragma unroll
    for (int mi = 0; mi < MI; mi++) a[mi] = *(const bf16x8*)(sA + (wr * MI * 16 + mi * 16 + l16) * sldA + kk * 32 + quad * 8);
#pragma unroll
    for (int ni = 0; ni < NI; ni++) b[ni] = *(const bf16x8*)(sB + (wc * NI * 16 + ni * 16 + l16) * sldB + kk * 32 + quad * 8);
#pragma unroll
    for (int mi = 0; mi < MI; mi++)
#pragma unroll
      for (int ni = 0; ni < NI; ni++) acc[mi][ni] = __builtin_amdgcn_mfma_f32_16x16x32_bf16(a[mi], b[ni], acc[mi][ni], 0, 0, 0);
  }
}
template <int MI, int NI>
DEV void gemm_loop(const bfu* A, int lda, const bfu* B, int ldb, int K, f32x4 (&acc)[MI][NI], bfu* sA, bfu* sB) {
  constexpr int BM = 32 * MI, BN = 32 * NI;
  u32x4 ra[BM / 32], rb[BN / 32];
  g2r<BM>(A, lda, ra); g2r<BN>(B, ldb, rb);
  for (int k0 = 0; k0 < K; k0 += 64) {
    __syncthreads();
    r2s<BM>(sA, ra); r2s<BN>(sB, rb);
    __syncthreads();
    if (k0 + 64 < K) { g2r<BM>(A + k0 + 64, lda, ra); g2r<BN>(B + k0 + 64, ldb, rb); }
    mma64<MI, NI>(sA, 72, sB, 72, acc);
  }
}

DEV void transpose_tile(const float* src, int ldsrc, int srccol0, int validcols, const float* scale,
                        bfu* dst, int lddst, int n0, int k0, float* sT) {
  const int tid = threadIdx.x;
  __syncthreads();
#pragma unroll
  for (int i = 0; i < 4; i++) {
    int kk = (tid >> 4) + i * 16, c = (tid & 15) * 4;
    float4 v = make_float4(0.f, 0.f, 0.f, 0.f);
    if (c < validcols) v = *(const float4*)(src + (size_t)(k0 + kk) * ldsrc + srccol0 + c);
    float s = scale ? scale[k0 + kk] : 1.f;
    sT[kk * 65 + c] = v.x * s; sT[kk * 65 + c + 1] = v.y * s; sT[kk * 65 + c + 2] = v.z * s; sT[kk * 65 + c + 3] = v.w * s;
  }
  __syncthreads();
  int n = tid >> 2, kc = (tid & 3) * 16;
  unsigned o[8];
#pragma unroll
  for (int e = 0; e < 8; e++) o[e] = pack2(sT[(kc + 2 * e) * 65 + n], sT[(kc + 2 * e + 1) * 65 + n]);
  uint4* d = (uint4*)(dst + (size_t)(n0 + n) * lddst + k0 + kc);
  d[0] = make_uint4(o[0], o[1], o[2], o[3]); d[1] = make_uint4(o[4], o[5], o[6], o[7]);
}

DEV void phase0(const Params& p, int bid, int nb, char* smem) {
  const int tid = threadIdx.x, lane = tid & 63, w = tid >> 6;
  constexpr int N_X = TT / 4, N_TW = 106 * 16, N_TR = 256, N_TF = 128, N_TO = 256, N_MT = 512;
  constexpr int B1 = N_X, B2 = B1 + N_TW, B3 = B2 + N_TR, B4 = B3 + N_TF, B5 = B4 + N_TO, TOT = B5 + N_MT;
  bfu* xb = (bfu*)(p.ws + OFF_XB); float* rstd1 = (float*)(p.ws + OFF_RSTD1);
  for (int it = bid; it < TOT; it += nb) {
    if (it < B1) {
      int row = it * 4 + w;
      const float* src = row < TP ? p.x_p + (size_t)row * DM : p.x_s + (size_t)(row - TP) * DM;
      float4 a0 = *(const float4*)(src + lane * 8), a1 = *(const float4*)(src + lane * 8 + 4);
      float4 b0 = *(const float4*)(src + 512 + lane * 8), b1 = *(const float4*)(src + 512 + lane * 8 + 4);
      float ss = a0.x * a0.x + a0.y * a0.y + a0.z * a0.z + a0.w * a0.w + a1.x * a1.x + a1.y * a1.y + a1.z * a1.z + a1.w * a1.w +
                 b0.x * b0.x + b0.y * b0.y + b0.z * b0.z + b0.w * b0.w + b1.x * b1.x + b1.y * b1.y + b1.z * b1.z + b1.w * b1.w;
      ss = wave_sum(ss);
      if (lane == 0) rstd1[row] = rsqrtf(ss * (1.f / DM) + EPSN);
      *(uint4*)(xb + (size_t)row * DM + lane * 8) = make_uint4(pack2(a0.x, a0.y), pack2(a0.z, a0.w), pack2(a1.x, a1.y), pack2(a1.z, a1.w));
      *(uint4*)(xb + (size_t)row * DM + 512 + lane * 8) = make_uint4(pack2(b0.x, b0.y), pack2(b0.z, b0.w), pack2(b1.x, b1.y), pack2(b1.z, b1.w));
    } else if (it < B2) {
      int j = it - B1; int nt = j >> 4, kt = j & 15; int n0 = nt * 64;
      int sc0, vc;
      if (n0 < 4608) { sc0 = n0; vc = 64; } else if (n0 < 6656) { sc0 = n0 + 8; vc = 64; } else if (n0 == 6656) { sc0 = 4608; vc = 8; } else { sc0 = 0; vc = 0; }
      transpose_tile(p.w_in, 6664, sc0, vc, p.norm1_g, (bfu*)(p.ws + OFF_WINT), DM, n0, kt * 64, (float*)smem);
    } else if (it < B3) {
      int j = it - B2; transpose_tile(p.w_ret_out, 1024, (j >> 4) * 64, 64, nullptr, (bfu*)(p.ws + OFF_WRT), 1024, (j >> 4) * 64, (j & 15) * 64, (float*)smem);
    } else if (it < B4) {
      int j = it - B3; transpose_tile(p.w_fox_out, 1024, (j >> 3) * 64, 64, nullptr, (bfu*)(p.ws + OFF_WFT), 512, (j >> 3) * 64, (j & 7) * 64, (float*)smem);
    } else if (it < B5) {
      int j = it - B4; transpose_tile(p.w_o, 1024, (j >> 4) * 64, 64, nullptr, (bfu*)(p.ws + OFF_WOT), 1024, (j >> 4) * 64, (j & 15) * 64, (float*)smem);
    } else {
      int j = it - B5; int hh = j >> 5, kt = (j >> 4) & 1, dt = j & 15;
      float* sW = (float*)smem; float* sK = sW + 64 * 129;
      const float* ksub = (hh & 1) ? p.k2 : p.k1;
      __syncthreads();
#pragma unroll
      for (int i = 0; i < 8; i++) {
        int id = tid + i * 256; int row = id >> 5, c4 = (id & 31) * 4;
        float4 v = *(const float4*)(p.peer_wq + (size_t)(dt * 64 + row) * 2048 + hh * 128 + c4);
        sW[row * 129 + c4] = v.x; sW[row * 129 + c4 + 1] = v.y; sW[row * 129 + c4 + 2] = v.z; sW[row * 129 + c4 + 3] = v.w;
        float4 u = *(const float4*)(ksub + (size_t)(kt * 64 + row) * 128 + c4);
        sK[row * 129 + c4] = u.x; sK[row * 129 + c4 + 1] = u.y; sK[row * 129 + c4 + 2] = u.z; sK[row * 129 + c4 + 3] = u.w;
      }
      __syncthreads();
      int ky = (tid >> 4) * 4, dd = (tid & 15) * 4;
      float a[4][4];
#pragma unroll
      for (int i = 0; i < 4; i++)
#pragma unroll
        for (int jj = 0; jj < 4; jj++) a[i][jj] = 0.f;
      for (int c = 0; c < 128; c++) {
        float kv[4], wv[4];
#pragma unroll
        for (int i = 0; i < 4; i++) { kv[i] = sK[(ky + i) * 129 + c]; wv[i] = sW[(dd + i) * 129 + c]; }
#pragma unroll
        for (int i = 0; i < 4; i++)
#pragma unroll
          for (int jj = 0; jj < 4; jj++) a[i][jj] += kv[i] * wv[jj];
      }
      bfu* MT = (bfu*)(p.ws + OFF_MT);
      float g0 = p.norm2_g[dt * 64 + dd], g1 = p.norm2_g[dt * 64 + dd + 1], g2 = p.norm2_g[dt * 64 + dd + 2], g3 = p.norm2_g[dt * 64 + dd + 3];
#pragma unroll
      for (int i = 0; i < 4; i++)
        *(uint2*)(MT + (size_t)(hh * 128 + kt * 64 + ky + i) * DM + dt * 64 + dd) = make_uint2(pack2(a[i][0] * g0, a[i][1] * g1), pack2(a[i][2] * g2, a[i][3] * g3));
    }
  }
}

DEV void rot_angle(int pos, int d, float& cs, float& sn) {
  float inv = exp2f(-(float)d * (13.287712379549449f / 32.f));
  float ang = (float)pos * inv;
  float rev = ang * 0.15915494309189535f;
  rev = rev - floorf(rev);
  sn = __builtin_amdgcn_sinf(rev); cs = __builtin_amdgcn_cosf(rev);
}

DEV void phase1(const Params& p, int bid, int nb, char* smem) {
  const int tid = threadIdx.x, lane = tid & 63, w = tid >> 6, wr = w >> 1, wc = w & 1, l16 = lane & 15, quad = lane >> 4;
  bfu* sA = (bfu*)smem; bfu* sB = sA + 128 * 72;
  const bfu* XB = (const bfu*)(p.ws + OFF_XB); const bfu* WT = (const bfu*)(p.ws + OFF_WINT);
  const float* rstd1 = (const float*)(p.ws + OFF_RSTD1);
  constexpr int NT = NWP / 128, MT_ = TT / 128;
  for (int it = bid; it < NT * MT_; it += nb) {
    int mt = it / NT, nt = it - mt * NT;
    int m0 = mt * 128, n0 = nt * 128;
    f32x4 acc[4][4];
#pragma unroll
    for (int i = 0; i < 4; i++)
#pragma unroll
      for (int j = 0; j < 4; j++) acc[i][j] = f32x4{0.f, 0.f, 0.f, 0.f};
    gemm_loop<4, 4>(XB + (size_t)m0 * DM, DM, WT + (size_t)n0 * DM, DM, DM, acc, sA, sB);
    const int rbase = m0 + wr * 64 + quad * 4;
    const int cbase = n0 + wc * 64 + l16;
    if (m0 >= TP) {
      float* hs = (float*)(p.ws + OFF_HS);
      bfu* gaS = (bfu*)(p.out + O_YS); bfu* gbS = gaS + (size_t)TS * DM;
#pragma unroll
      for (int mi = 0; mi < 4; mi++)
#pragma unroll
        for (int j = 0; j < 4; j++) {
          int row = rbase + mi * 16 + j; float rs = rstd1[row]; int sr = row - TP;
#pragma unroll
          for (int ni = 0; ni < 4; ni++) {
            int col = cbase + ni * 16; float v = acc[mi][ni][j] * rs;
            if (n0 >= 4608 && n0 < 5632) gaS[(size_t)sr * DM + col - 4608] = f2bf(v);
            else if (n0 >= 5632 && n0 < 6656) gbS[(size_t)sr * DM + col - 5632] = f2bf(v);
            else hs[(size_t)sr * NWP + col] = v;
          }
        }
      continue;
    }
    const int b = m0 >> 14;
    if (n0 < 1024) {
      const int isK = n0 >= 512; const int head = ((n0 & 511) >> 6) + wc;
      const float l2g = l2gamma(head);
      bfu* dst = (bfu*)(p.ws + (isK ? OFF_KT : OFF_QT));
      bfu* ktT = (bfu*)(p.ws + OFF_KTT);
#pragma unroll
      for (int mi = 0; mi < 4; mi++) {
#pragma unroll
        for (int ni = 0; ni < 2; ni++) {
          int d = ni * 16 + l16;
          float y1[4], y2[4];
#pragma unroll
          for (int j = 0; j < 4; j++) {
            int row = rbase + mi * 16 + j; int t = row & (SEQ - 1); int l = t & (RC - 1);
            float rs = rstd1[row];
            float dec = exp2f((float)(l + 1) * l2g);
            float sc = isK ? 0.125f / dec : dec;
            float cs, sn; rot_angle(t, d, cs, sn);
            float x1 = acc[mi][ni][j] * rs, x2 = acc[mi][ni + 2][j] * rs;
            y1[j] = (x1 * cs - x2 * sn) * sc; y2[j] = (x2 * cs + x1 * sn) * sc;
            dst[(size_t)row * 512 + head * 64 + d] = f2bf(y1[j]);
            dst[(size_t)row * 512 + head * 64 + d + 32] = f2bf(y2[j]);
          }
          if (isK) {
            int t0 = (rbase + mi * 16) & (SEQ - 1);
            *(uint2*)(ktT + ((size_t)((b * 8 + head) * 64 + d)) * SEQ + t0) = make_uint2(pack2(y1[0], y1[1]), pack2(y1[2], y1[3]));
            *(uint2*)(ktT + ((size_t)((b * 8 + head) * 64 + d + 32)) * SEQ + t0) = make_uint2(pack2(y2[0], y2[1]), pack2(y2[2], y2[3]));
          }
        }
      }
    } else if (n0 < 2048) {
      const int head = (n0 - 1024) >> 7;
      bfu* vT = (bfu*)(p.ws + OFF_VT);
#pragma unroll
      for (int mi = 0; mi < 4; mi++) {
        int row0 = rbase + mi * 16; int t0 = row0 & (SEQ - 1);
        float r0 = rstd1[row0], r1 = rstd1[row0 + 1], r2 = rstd1[row0 + 2], r3 = rstd1[row0 + 3];
#pragma unroll
        for (int ni = 0; ni < 4; ni++) {
          int dv = wc * 64 + ni * 16 + l16;
          *(uint2*)(vT + ((size_t)((b * 8 + head) * 128 + dv)) * SEQ + t0) =
              make_uint2(pack2(acc[mi][ni][0] * r0, acc[mi][ni][1] * r1), pack2(acc[mi][ni][2] * r2, acc[mi][ni][3] * r3));
        }
      }
    } else if (n0 < 3072 || (n0 >= 4608 && n0 < 6656)) {
      bfu* dst; int c0;
      if (n0 < 3072) { dst = (bfu*)(p.ws + OFF_RG); c0 = 2048; }
      else if (n0 < 5632) { dst = (bfu*)(p.out + O_YP); c0 = 4608; }
      else { dst = (bfu*)(p.out + O_YP) + (size_t)TP * DM; c0 = 5632; }
#pragma unroll
      for (int mi = 0; mi < 4; mi++)
#pragma unroll
        for (int j = 0; j < 4; j++) {
          int row = rbase + mi * 16 + j; float rs = rstd1[row];
#pragma unroll
          for (int ni = 0; ni < 4; ni++) dst[(size_t)row * DM + cbase + ni * 16 - c0] = f2bf(acc[mi][ni][j] * rs);
        }
    } else if (n0 < 4096) {
      const int isK = n0 >= 3584; const int head = (((n0 - 3072) & 511) >> 6) + wc;
      const float* g = isK ? p.fk_g : p.fq_g;
      float gv[4];
#pragma unroll
      for (int ni = 0; ni < 4; ni++) gv[ni] = g[ni * 16 + l16];
      bfu* fq = (bfu*)(p.ws + OFF_FQ); bfu* fkb = (bfu*)(p.ws + OFF_FKB);
#pragma unroll
      for (int mi = 0; mi < 4; mi++)
#pragma unroll
        for (int j = 0; j < 4; j++) {
          int row = rbase + mi * 16 + j; float rs = rstd1[row];
          float v[4]; float ss = 0.f;
#pragma unroll
          for (int ni = 0; ni < 4; ni++) { v[ni] = acc[mi][ni][j] * rs; ss += v[ni] * v[ni]; }
          ss = sum16(ss);
          float r = rsqrtf(ss * (1.f / 64.f) + EPSN);
#pragma unroll
          for (int ni = 0; ni < 4; ni++) {
            float y = v[ni] * r * gv[ni]; size_t o = (size_t)row * 512 + head * 64 + ni * 16 + l16;
            if (isK) { p.out[O_FKP + o] = y; fkb[o] = f2bf(y); }
            else fq[o] = f2bf(y * (0.125f * LOG2E));
          }
        }
    } else if (n0 < 4608) {
      const int head = ((n0 - 4096) >> 6) + wc;
      bfu* fvT = (bfu*)(p.ws + OFF_FVT);
#pragma unroll
      for (int mi = 0; mi < 4; mi++) {
        int row0 = rbase + mi * 16; int t0 = row0 & (SEQ - 1);
        float r[4] = {rstd1[row0], rstd1[row0 + 1], rstd1[row0 + 2], rstd1[row0 + 3]};
#pragma unroll
        for (int ni = 0; ni < 4; ni++) {
          int d = ni * 16 + l16; float v[4];
#pragma unroll
          for (int j = 0; j < 4; j++) { v[j] = acc[mi][ni][j] * r[j]; p.out[O_FVP + (size_t)(row0 + j) * 512 + head * 64 + d] = v[j]; }
          *(uint2*)(fvT + ((size_t)((b * 8 + head) * 64 + d)) * SEQ + t0) = make_uint2(pack2(v[0], v[1]), pack2(v[2], v[3]));
        }
      }
    } else {
      if (wc == 0 && l16 < 8) {
        float bf = p.b_f[l16];
#pragma unroll
        for (int mi = 0; mi < 4; mi++)
#pragma unroll
          for (int j = 0; j < 4; j++) {
            int row = rbase + mi * 16 + j;
            float z = acc[mi][0][j] * rstd1[row] + bf;
            p.out[O_LFP + (size_t)row * 8 + l16] = fminf(z, 0.f) - log1pf(__expf(-fabsf(z)));
          }
      }
    }
  }
}

DEV void phase2(const Params& p, int bid, int nb, char* smem) {
  const int tid = threadIdx.x, lane = tid & 63, w = tid >> 6, wr = w >> 1, wc = w & 1, l16 = lane & 15, quad = lane >> 4;
  bfu* sA = (bfu*)smem; bfu* sB = sA + 128 * 72;
  const bfu* vT = (const bfu*)(p.ws + OFF_VT); const bfu* ktT = (const bfu*)(p.ws + OFF_KTT);
  float* U = (float*)(p.ws + OFF_XB);
  constexpr int NR1 = 16 * NCH;
  for (int it = bid; it < NR1 + 16; it += nb) {
    if (it < 16) {
      int bh = it, b = bh >> 3, h = bh & 7;
      double* sd = (double*)smem;
      const float* lf = p.out + O_LFP + (size_t)b * SEQ * 8 + h;
      float part = 0.f;
      for (int i = 0; i < 64; i++) part += lf[(size_t)(tid * 64 + i) * 8];
      __syncthreads();
      sd[tid] = (double)part;
      __syncthreads();
      if (tid == 0) { double run = 0.0; for (int i = 0; i < 256; i++) { double v = sd[i]; sd[i] = run; run += v; } }
      __syncthreads();
      double run = sd[tid];
      float* c2 = (float*)(p.ws + OFF_C2) + (size_t)bh * SEQ;
      for (int i = 0; i < 64; i++) { run += (double)lf[(size_t)(tid * 64 + i) * 8]; c2[tid * 64 + i] = (float)(run * (double)LOG2E); }
      __syncthreads();
    } else {
      int j = it - 16; int bh = j / NCH, c = j - bh * NCH;
      f32x4 acc[4][2];
#pragma unroll
      for (int i = 0; i < 4; i++) { acc[i][0] = f32x4{0.f, 0.f, 0.f, 0.f}; acc[i][1] = f32x4{0.f, 0.f, 0.f, 0.f}; }
      gemm_loop<4, 2>(vT + (size_t)bh * 128 * SEQ + c * RC, SEQ, ktT + (size_t)bh * 64 * SEQ + c * RC, SEQ, RC, acc, sA, sB);
      float gC = exp2f((float)RC * l2gamma(bh & 7));
      float* Uo = U + (size_t)j * 8192;
#pragma unroll
      for (int mi = 0; mi < 4; mi++)
#pragma unroll
        for (int ni = 0; ni < 2; ni++)
#pragma unroll
          for (int jj = 0; jj < 4; jj++) {
            int dv = wr * 64 + mi * 16 + quad * 4 + jj, dk = wc * 32 + ni * 16 + l16;
            Uo[dv * 64 + dk] = acc[mi][ni][jj] * gC;
          }
    }
  }
}

DEV void sample_item(const Params& p, int item, char* smem) {
  const int tid = threadIdx.x;
  const int b = item >> 3, h = item & 7;
  float* sq = (float*)smem;
  float* sk = sq + 1024;
  float* sv = sk + 1024;
  float* sP = sv + 2048;
  float* so = sP + 256;
  float* sr = so + 2048;
  float* sc = (float*)smem;
  float* fq = (float*)(smem + 34816);
  float* fk = fq + 1024;
  float* cn = fk + 1024;
  float* suf = cn + 16;
  float* red = suf + 1024;
  float* sL = red + 256;
  const float* hs = (const float*)(p.ws + OFF_HS) + (size_t)b * 16 * NWP;
  const float l2g = l2gamma(h);
  __syncthreads();
  for (int i = tid; i < 512; i += 256) {
    int l = i >> 5, d = i & 31; float cs, sn; rot_angle(1024 + l, d, cs, sn);
    float dec = exp2f((float)(l + 1) * l2g);
    const float* r = hs + (size_t)l * NWP;
    float x1 = r[h * 64 + d], x2 = r[h * 64 + d + 32];
    sq[l * 64 + d] = (x1 * cs - x2 * sn) * dec; sq[l * 64 + d + 32] = (x2 * cs + x1 * sn) * dec;
    x1 = r[512 + h * 64 + d]; x2 = r[512 + h * 64 + d + 32];
    float sc_ = 0.125f / dec;
    sk[l * 64 + d] = (x1 * cs - x2 * sn) * sc_; sk[l * 64 + d + 32] = (x2 * cs + x1 * sn) * sc_;
  }
  for (int i = tid; i < 2048; i += 256) { int l = i >> 7, dv = i & 127; sv[i] = hs[(size_t)l * NWP + 1024 + h * 128 + dv]; }
  __syncthreads();
  { int l = tid >> 4, m = tid & 15; float a = 0.f;
    if (l >= m) for (int d = 0; d < 64; d++) a += sq[l * 64 + d] * sk[m * 64 + d];
    sP[tid] = a; }
  __syncthreads();
  const float* S = p.state_ret + (size_t)(b * 8 + h) * 8192;
  { int dv = tid & 127, lh = tid >> 7; float o[8];
#pragma unroll
    for (int i = 0; i < 8; i++) o[i] = 0.f;
    for (int dk = 0; dk < 64; dk++) { float s = S[dk * 128 + dv];
#pragma unroll
      for (int i = 0; i < 8; i++) o[i] += sq[(lh * 8 + i) * 64 + dk] * s; }
    for (int m = 0; m < 16; m++) { float v = sv[m * 128 + dv];
#pragma unroll
      for (int i = 0; i < 8; i++) o[i] += sP[(lh * 8 + i) * 16 + m] * v; }
#pragma unroll
    for (int i = 0; i < 8; i++) so[(lh * 8 + i) * 128 + dv] = o[i];
    float g16 = exp2f(16.f * l2g);
    float* So = p.out + O_SS + (size_t)(b * 8 + h) * 8192;
    for (int i = 0; i < 32; i++) { int dk = lh * 32 + i; float a = S[dk * 128 + dv];
      for (int m = 0; m < 16; m++) a += sk[m * 64 + dk] * sv[m * 128 + dv];
      So[dk * 128 + dv] = a * g16; }
  }
  __syncthreads();
  if (tid < 16) { float ss = 0.f; for (int i = 0; i < 128; i++) { float v = so[tid * 128 + i]; ss += v * v; } sr[tid] = rsqrtf(ss * (1.f / 128.f) + EPSN); }
  __syncthreads();
  { int dv = tid & 127, lh = tid >> 7; bfu* gated = (bfu*)(p.ws + OFF_RG);
    float gg = p.gn_g[h * 128 + dv];
    for (int i = 0; i < 8; i++) { int l = lh * 8 + i; float rgv = hs[(size_t)l * NWP + 2048 + h * 128 + dv];
      float v = so[l * 128 + dv] * sr[l] * gg * (rgv * sigmoidf_(rgv));
      gated[(size_t)(TP + b * 16 + l) * DM + h * 128 + dv] = f2bf(v); } }
  {
    int l = tid >> 4, dl = tid & 15; const float* r = hs + (size_t)l * NWP;
    float qv[4], kv[4]; float sq_ = 0.f, sk_ = 0.f;
#pragma unroll
    for (int i = 0; i < 4; i++) { qv[i] = r[3072 + h * 64 + dl * 4 + i]; kv[i] = r[3584 + h * 64 + dl * 4 + i]; sq_ += qv[i] * qv[i]; sk_ += kv[i] * kv[i]; }
    sq_ = sum16(sq_); sk_ = sum16(sk_);
    float rq = rsqrtf(sq_ * (1.f / 64.f) + EPSN), rk = rsqrtf(sk_ * (1.f / 64.f) + EPSN);
#pragma unroll
    for (int i = 0; i < 4; i++) { int d = dl * 4 + i;
      fq[l * 64 + d] = qv[i] * rq * p.fq_g[d] * 0.125f;
      float kk = kv[i] * rk * p.fk_g[d]; fk[l * 64 + d] = kk;
      p.out[O_FKS + (size_t)((b * 16 + l) * 8 + h) * 64 + d] = kk;
      p.out[O_FVS + (size_t)((b * 16 + l) * 8 + h) * 64 + d] = r[4096 + h * 64 + d]; }
  }
  if (tid < 16) { float z = hs[(size_t)tid * NWP + 6656 + h] + p.b_f[h]; float lf = fminf(z, 0.f) - log1pf(__expf(-fabsf(z)));
    p.out[O_LFS + (size_t)(b * 16 + tid) * 8 + h] = lf; cn[tid] = lf; }
  { const float* cl = p.clogf + (size_t)b * 1024 * 8 + h; float v[4]; float part = 0.f;
#pragma unroll
    for (int i = 0; i < 4; i++) { v[i] = cl[(size_t)(tid * 4 + i) * 8]; part += v[i]; }
    red[tid] = part;
    __syncthreads();
    if (tid == 0) { float run = 0.f; for (int i = 255; i >= 0; i--) { float t = red[i]; red[i] = run; run += t; }
      float c = 0.f; for (int i = 0; i < 16; i++) { c += cn[i]; cn[i] = c; } }
    __syncthreads();
    float run = red[tid];
    for (int i = 3; i >= 0; i--) { suf[tid * 4 + i] = run; run += v[i]; }
  }
  __syncthreads();
  const float* CK = p.ck + (size_t)b * 1024 * 512 + h * 64; const float* CV = p.cv + (size_t)b * 1024 * 512 + h * 64;
  for (int pass = 0; pass < 2; pass++) {
    __syncthreads();
    for (int j = tid; j < 1040; j += 256) {
      float a[8];
#pragma unroll
      for (int qi = 0; qi < 8; qi++) a[qi] = 0.f;
      if (j < 1024) {
        const float4* kp = (const float4*)(CK + (size_t)j * 512);
#pragma unroll 4
        for (int i = 0; i < 16; i++) { float4 t = kp[i];
#pragma unroll
          for (int qi = 0; qi < 8; qi++) { const float* qq = fq + (pass * 8 + qi) * 64 + i * 4; a[qi] += qq[0] * t.x + qq[1] * t.y + qq[2] * t.z + qq[3] * t.w; } }
      } else {
        const float* kp = fk + (j - 1024) * 64;
#pragma unroll 4
        for (int i = 0; i < 64; i++) { float t = kp[i];
#pragma unroll
          for (int qi = 0; qi < 8; qi++) a[qi] += fq[(pass * 8 + qi) * 64 + i] * t; }
      }
#pragma unroll
      for (int qi = 0; qi < 8; qi++) { int q = pass * 8 + qi;
        float bias;
        if (j < 1024) bias = suf[j] + cn[q]; else { int m = j - 1024; bias = (m <= q) ? (cn[q] - cn[m]) : -INFINITY; }
        sc[qi * 1040 + j] = a[qi] + bias; }
    }
    __syncthreads();
    { int qi = tid >> 5, l32 = tid & 31; float m = -INFINITY;
      for (int j = l32; j < 1040; j += 32) m = fmaxf(m, sc[qi * 1040 + j]);
#pragma unroll
      for (int o = 16; o >= 1; o >>= 1) m = fmaxf(m, __shfl_xor(m, o));
      float s = 0.f;
      for (int j = l32; j < 1040; j += 32) { float e = __expf(sc[qi * 1040 + j] - m); sc[qi * 1040 + j] = e; s += e; }
#pragma unroll
      for (int o = 16; o >= 1; o >>= 1) s += __shfl_xor(s, o);
      if (l32 == 0) sL[qi] = s; }
    __syncthreads();
    { int qi = tid >> 5, d2 = (tid & 31) * 2; float a0 = 0.f, a1 = 0.f;
      for (int j = 0; j < 1024; j++) { float pj = sc[qi * 1040 + j]; float2 v = *(const float2*)(CV + (size_t)j * 512 + d2); a0 += pj * v.x; a1 += pj * v.y; }
      for (int m = 0; m < 16; m++) { float pj = sc[qi * 1040 + 1024 + m]; const float* r = hs + (size_t)m * NWP + 4096 + h * 64 + d2; a0 += pj * r[0]; a1 += pj * r[1]; }
      float inv = 1.f / sL[qi]; bfu* fo = (bfu*)(p.ws + OFF_FQ);
      *(unsigned*)(fo + (size_t)(TP + b * 16 + pass * 8 + qi) * 512 + h * 64 + d2) = pack2(a0 * inv, a1 * inv); }
  }
  __syncthreads();
}

DEV void phase3(const Params& p, int bid, int nb, char* smem) {
  const int tid = threadIdx.x;
  const float* U = (const float*)(p.ws + OFF_XB); bfu* SST = (bfu*)(p.ws + OFF_SST);
  for (int it = bid; it < 256 + 512; it += nb) {
    if (it < 256) { sample_item(p, it, smem); continue; }
    int g = (it - 256) * 256 + tid; int bh = g >> 13, e = g & 8191;
    float G = exp2f((float)RC * l2gamma(bh & 7));
    float s = 0.f;
    const float* Up = U + (size_t)bh * NCH * 8192 + e; bfu* Sp = SST + (size_t)bh * NCH * 8192 + e;
    Sp[0] = 0;
    for (int c0 = 0; c0 < NCH; c0 += 8) {
      float u[8];
#pragma unroll
      for (int i = 0; i < 8; i++) u[i] = Up[(size_t)(c0 + i) * 8192];
#pragma unroll
      for (int i = 0; i < 8; i++) { s = s * G + u[i]; if (c0 + i + 1 < NCH) Sp[(size_t)(c0 + i + 1) * 8192] = f2bf(s); }
    }
    int dv = e >> 6, dk = e & 63;
    p.out[O_SP + (size_t)bh * 8192 + dk * 128 + dv] = s;
  }
}

DEV void attn_item(const Params& p, int item, char* smem, float thr) {
  const int tid = threadIdx.x, lane = tid & 63, w = tid >> 6, r32 = lane & 31, hi = lane >> 5;
  const int bh = item >> 7, qt = 127 - (item & 127);
  const int b = bh >> 3, h = bh & 7;
  const int q0 = qt * 128;
  bfu* sK = (bfu*)smem;
  bfu* sV = sK + 64 * 72;
  float* sC = (float*)(sV + 64 * 72);
  const float* c2 = (const float*)(p.ws + OFF_C2) + (size_t)bh * SEQ;
  bfu* FQ = (bfu*)(p.ws + OFF_FQ);
  const bfu* FKB = (const bfu*)(p.ws + OFF_FKB) + (size_t)b * SEQ * 512 + h * 64;
  const bfu* FVT = (const bfu*)(p.ws + OFF_FVT) + (size_t)bh * 64 * SEQ;
  const int jd0 = q0 >> 6;
  int pred = 0;
  if (tid < jd0) pred = (c2[q0] - c2[tid * 64 + 63]) < -thr;
  const int jstart = __syncthreads_count(pred);
  const int qrow = q0 + w * 32 + r32;
  bf16x8 qf[4];
  const bfu* qp = FQ + (size_t)(b * SEQ + qrow) * 512 + h * 64 + hi * 8;
#pragma unroll
  for (int d0 = 0; d0 < 4; d0++) qf[d0] = *(const bf16x8*)(qp + d0 * 16);
  const float cq = c2[qrow];
  float m = -INFINITY, lsum = 0.f;
  f32x16 o0, o1;
#pragma unroll
  for (int r = 0; r < 16; r++) { o0[r] = 0.f; o1[r] = 0.f; }
  u32x4 rk0, rk1, rv0, rv1; float rc = 0.f;
  const int srow = tid >> 3, sch = tid & 7;
#define ATT_GLOAD(j_) do { \
    rk0 = *(const u32x4*)(FKB + (size_t)((j_) * 64 + srow) * 512 + sch * 8); \
    rk1 = *(const u32x4*)(FKB + (size_t)((j_) * 64 + srow + 32) * 512 + sch * 8); \
    rv0 = *(const u32x4*)(FVT + (size_t)srow * SEQ + (j_) * 64 + sch * 8); \
    rv1 = *(const u32x4*)(FVT + (size_t)(srow + 32) * SEQ + (j_) * 64 + sch * 8); \
    if (tid < 64) rc = c2[(j_) * 64 + tid]; } while (0)
  ATT_GLOAD(jstart);
  for (int j = jstart; j <= jd0 + 1; j++) {
    __syncthreads();
    *(u32x4*)(sK + srow * 72 + sch * 8) = rk0; *(u32x4*)(sK + (srow + 32) * 72 + sch * 8) = rk1;
    *(u32x4*)(sV + srow * 72 + sch * 8) = rv0; *(u32x4*)(sV + (srow + 32) * 72 + sch * 8) = rv1;
    if (tid < 64) sC[tid] = rc;
    __syncthreads();
    if (j < jd0 + 1) ATT_GLOAD(j + 1);
    if (j * 64 > q0 + w * 32 + 31) continue;
    f32x16 s0, s1;
#pragma unroll
    for (int r = 0; r < 16; r++) { s0[r] = 0.f; s1[r] = 0.f; }
#pragma unroll
    for (int d0 = 0; d0 < 4; d0++) {
      bf16x8 k0 = *(const bf16x8*)(sK + r32 * 72 + d0 * 16 + hi * 8);
      bf16x8 k1 = *(const bf16x8*)(sK + (32 + r32) * 72 + d0 * 16 + hi * 8);
      s0 = __builtin_amdgcn_mfma_f32_32x32x16_bf16(k0, qf[d0], s0, 0, 0, 0);
      s1 = __builtin_amdgcn_mfma_f32_32x32x16_bf16(k1, qf[d0], s1, 0, 0, 0);
    }
    const bool diag = (j >= jd0);
    const int kbase = j * 64 + 4 * hi;
    float mloc = -INFINITY;
#pragma unroll
    for (int g = 0; g < 4; g++) {
      float4 c0 = *(const float4*)(sC + 8 * g + 4 * hi), c1 = *(const float4*)(sC + 32 + 8 * g + 4 * hi);
      float cc0[4] = {c0.x, c0.y, c0.z, c0.w}, cc1[4] = {c1.x, c1.y, c1.z, c1.w};
#pragma unroll
      for (int e = 0; e < 4; e++) {
        int r = g * 4 + e;
        float a = s0[r] + (cq - cc0[e]), bb = s1[r] + (cq - cc1[e]);
        if (diag) { int key = kbase + 8 * g + e; if (key > qrow) a = -INFINITY; if (key + 32 > qrow) bb = -INFINITY; }
        s0[r] = a; s1[r] = bb; mloc = fmaxf(mloc, fmaxf(a, bb));
      }
    }
    mloc = fmaxf(mloc, __shfl_xor(mloc, 32));
    float mn = fmaxf(m, mloc);
    float alpha = __builtin_amdgcn_exp2f(m - mn);
    m = mn;
    float ps = 0.f;
#pragma unroll
    for (int r = 0; r < 16; r++) { s0[r] = __builtin_amdgcn_exp2f(s0[r] - mn); s1[r] = __builtin_amdgcn_exp2f(s1[r] - mn); ps += s0[r] + s1[r]; }
    lsum = lsum * alpha + ps;
#pragma unroll
    for (int r = 0; r < 16; r++) { o0[r] *= alpha; o1[r] *= alpha; }
#pragma unroll
    for (int ks = 0; ks < 4; ks++) {
      union { bf16x8 v; unsigned u[4]; } pf;
#pragma unroll
      for (int e = 0; e < 4; e++) {
        int r = (ks & 1) * 8 + 2 * e;
        pf.u[e] = (ks < 2) ? pack2(s0[r], s0[r + 1]) : pack2(s1[r], s1[r + 1]);
      }
#pragma unroll
      for (int db = 0; db < 2; db++) {
        const bfu* vp = sV + (db * 32 + r32) * 72 + ks * 16 + 4 * hi;
        union { bf16x8 v; uint2 u[2]; } vf;
        vf.u[0] = *(const uint2*)vp; vf.u[1] = *(const uint2*)(vp + 8);
        if (db == 0) o0 = __builtin_amdgcn_mfma_f32_32x32x16_bf16(vf.v, pf.v, o0, 0, 0, 0);
        else o1 = __builtin_amdgcn_mfma_f32_32x32x16_bf16(vf.v, pf.v, o1, 0, 0, 0);
      }
    }
  }
  float lt = lsum + __shfl_xor(lsum, 32);
  float inv = 1.f / lt;
  bfu* op = FQ + (size_t)(b * SEQ + qrow) * 512 + h * 64;
#pragma unroll
  for (int g = 0; g < 4; g++) {
    *(uint2*)(op + 8 * g + 4 * hi) = make_uint2(pack2(o0[g * 4] * inv, o0[g * 4 + 1] * inv), pack2(o0[g * 4 + 2] * inv, o0[g * 4 + 3] * inv));
    *(uint2*)(op + 32 + 8 * g + 4 * hi) = make_uint2(pack2(o1[g * 4] * inv, o1[g * 4 + 1] * inv), pack2(o1[g * 4 + 2] * inv, o1[g * 4 + 3] * inv));
  }
  __syncthreads();
}

DEV void r3_item(const Params& p, int item, char* smem) {
  const int tid = threadIdx.x, lane = tid & 63, w = tid >> 6, wr = w >> 1, wc = w & 1, l16 = lane & 15, quad = lane >> 4;
  const int bh = item / NCH, c = item - bh * NCH; const int b = bh >> 3, h = bh & 7;
  bfu* sQ = (bfu*)smem; bfu* sK = sQ + 128 * 72; bfu* sP = sK + 128 * 72; float* sRed = (float*)(sP + 128 * 136);
  const size_t row0 = (size_t)b * SEQ + c * RC;
  const bfu* Q = (const bfu*)(p.ws + OFF_QT) + row0 * 512 + h * 64;
  const bfu* Kk = (const bfu*)(p.ws + OFF_KT) + row0 * 512 + h * 64;
  const bfu* vT = (const bfu*)(p.ws + OFF_VT) + (size_t)bh * 128 * SEQ + c * RC;
  const bfu* ST = (const bfu*)(p.ws + OFF_SST) + (size_t)item * 8192;
  u32x4 ra[4], rb[4];
  g2r<128>(Q, 512, ra); g2r<128>(Kk, 512, rb);
  __syncthreads();
  r2s<128>(sQ, ra); r2s<128>(sK, rb);
  __syncthreads();
  g2r<128>(vT, SEQ, rb);
  f32x4 acc[4][4];
#pragma unroll
  for (int i = 0; i < 4; i++)
#pragma unroll
    for (int j = 0; j < 4; j++) acc[i][j] = f32x4{0.f, 0.f, 0.f, 0.f};
  mma64<4, 4>(sQ, 72, sK, 72, acc);
#pragma unroll
  for (int mi = 0; mi < 4; mi++)
#pragma unroll
    for (int ni = 0; ni < 4; ni++)
#pragma unroll
      for (int j = 0; j < 4; j++) {
        int row = wr * 64 + mi * 16 + quad * 4 + j, col = wc * 64 + ni * 16 + l16;
        sP[row * 136 + col] = (col <= row) ? f2bf(acc[mi][ni][j]) : (bfu)0;
      }
#pragma unroll
  for (int i = 0; i < 4; i++)
#pragma unroll
    for (int j = 0; j < 4; j++) acc[i][j] = f32x4{0.f, 0.f, 0.f, 0.f};
  __syncthreads();
  r2s<128>(sK, rb);
  __syncthreads();
  g2r<128>(vT + 64, SEQ, rb);
  mma64<4, 4>(sP, 136, sK, 72, acc);
  __syncthreads();
  r2s<128>(sK, rb);
  __syncthreads();
  g2r<128>(ST, 64, rb);
  mma64<4, 4>(sP + 64, 136, sK, 72, acc);
  __syncthreads();
  r2s<128>(sK, rb);
  __syncthreads();
  mma64<4, 4>(sQ, 72, sK, 72, acc);
  float ssq[4][4];
#pragma unroll
  for (int mi = 0; mi < 4; mi++)
#pragma unroll
    for (int j = 0; j < 4; j++) { float s = 0.f;
#pragma unroll
      for (int ni = 0; ni < 4; ni++) s += acc[mi][ni][j] * acc[mi][ni][j];
      s = sum16(s); ssq[mi][j] = s;
      if (l16 == 0) sRed[(wr * 64 + mi * 16 + quad * 4 + j) * 2 + wc] = s; }
  __syncthreads();
  bfu* RG = (bfu*)(p.ws + OFF_RG);
  float gg[4];
#pragma unroll
  for (int ni = 0; ni < 4; ni++) gg[ni] = p.gn_g[h * 128 + wc * 64 + ni * 16 + l16];
#pragma unroll
  for (int mi = 0; mi < 4; mi++)
#pragma unroll
    for (int j = 0; j < 4; j++) {
      int row = wr * 64 + mi * 16 + quad * 4 + j;
      float tot = sRed[row * 2] + sRed[row * 2 + 1];
      float r = rsqrtf(tot * (1.f / 128.f) + EPSN);
#pragma unroll
      for (int ni = 0; ni < 4; ni++) {
        size_t o = (row0 + row) * DM + h * 128 + wc * 64 + ni * 16 + l16;
        float rgv = bf2f(RG[o]);
        RG[o] = f2bf(acc[mi][ni][j] * r * gg[ni] * (rgv * sigmoidf_(rgv)));
      }
    }
  __syncthreads();
}

DEV void phase4(const Params& p, int bid, int nb, char* smem) {
  float gq = 0.f, gk = 0.f;
  for (int i = 0; i < 64; i++) { gq = fmaxf(gq, fabsf(p.fq_g[i])); gk = fmaxf(gk, fabsf(p.fk_g[i])); }
  const float thr = 2.f * (8.f * gq * gk * 1.03f * LOG2E) + 44.f;
  for (int it = bid; it < 2048 + 16 * NCH; it += nb) {
    if (it < 2048) attn_item(p, it, smem, thr); else r3_item(p, it - 2048, smem);
  }
}

DEV void phase5(const Params& p, int bid, int nb, char* smem) {
  const int tid = threadIdx.x, lane = tid & 63, w = tid >> 6, wr = w >> 1, wc = w & 1, l16 = lane & 15, quad = lane >> 4;
  bfu* sA = (bfu*)smem; bfu* sB = sA + 128 * 72;
  const bfu* G = (const bfu*)(p.ws + OFF_RG); const bfu* FO = (const bfu*)(p.ws + OFF_FQ);
  const bfu* WR = (const bfu*)(p.ws + OFF_WRT); const bfu* WF = (const bfu*)(p.ws + OFF_WFT);
  bfu* MX = (bfu*)(p.ws + OFF_XB);
  constexpr int NG = (TT / 128) * 8, NCV = 4096;
  for (int it = bid; it < NG + NCV; it += nb) {
    if (it >= NG) {
      int j = it - NG;
#pragma unroll
      for (int i = 0; i < 8; i++) {
        size_t q = (size_t)j * 2048 + i * 256 + tid;
        const float* src = q < 4194304 ? p.peer_u + q * 4 : p.peer_v + (q - 4194304) * 4;
        bfu* dst = q < 4194304 ? (bfu*)(p.ws + OFF_PUB) + q * 4 : (bfu*)(p.ws + OFF_PVB) + (q - 4194304) * 4;
        float4 v = *(const float4*)src;
        *(uint2*)dst = make_uint2(pack2(v.x, v.y), pack2(v.z, v.w));
      }
      continue;
    }
    int mt = it >> 3, nt = it & 7; int m0 = mt * 128, n0 = nt * 128;
    f32x4 a1[4][4];
#pragma unroll
    for (int i = 0; i < 4; i++)
#pragma unroll
      for (int j = 0; j < 4; j++) a1[i][j] = f32x4{0.f, 0.f, 0.f, 0.f};
    gemm_loop<4, 4>(G + (size_t)m0 * DM, DM, WR + (size_t)n0 * DM, DM, DM, a1, sA, sB);
    const bfu *ga, *gb;
    if (m0 < TP) { ga = (const bfu*)(p.out + O_YP) + (size_t)m0 * DM + n0; gb = ga + (size_t)TP * DM; }
    else { ga = (const bfu*)(p.out + O_YS) + (size_t)(m0 - TP) * DM + n0; gb = ga + (size_t)TS * DM; }
    bfu* mxT = MX + (size_t)m0 * DM + n0;
    const unsigned loff = (unsigned)((wr * 64 + quad * 4) * DM + wc * 64 + l16);
#pragma unroll
    for (int mi = 0; mi < 4; mi++)
#pragma unroll
      for (int ni = 0; ni < 4; ni++) {
#pragma unroll
        for (int j = 0; j < 4; j++) { unsigned o = loff + (unsigned)((mi * 16 + j) * DM + ni * 16);
          mxT[o] = f2bf(sigmoidf_(bf2f(ga[o])) * a1[mi][ni][j]); }
        a1[mi][ni] = f32x4{0.f, 0.f, 0.f, 0.f};
      }
    gemm_loop<4, 4>(FO + (size_t)m0 * 512, 512, WF + (size_t)n0 * 512, 512, 512, a1, sA, sB);
    unsigned loff2 = loff; asm volatile("" : "+v"(loff2));
#pragma unroll
    for (int mi = 0; mi < 4; mi++)
#pragma unroll
      for (int ni = 0; ni < 4; ni++) {
#pragma unroll
        for (int j = 0; j < 4; j++) { unsigned o = loff2 + (unsigned)((mi * 16 + j) * DM + ni * 16);
          mxT[o] = f2bf(bf2f(mxT[o]) + sigmoidf_(bf2f(gb[o])) * a1[mi][ni][j]); }
      }
  }
}

DEV void phase6(const Params& p, int bid, int nb, char* smem) {
  const int tid = threadIdx.x, lane = tid & 63, w = tid >> 6, wr = w >> 1, wc = w & 1, l16 = lane & 15, quad = lane >> 4;
  bfu* sA = (bfu*)smem; bfu* sB = sA + 128 * 72;
  const bfu* MX = (const bfu*)(p.ws + OFF_XB); const bfu* WO = (const bfu*)(p.ws + OFF_WOT);
  bfu* X1B = (bfu*)(p.ws + OFF_X1B); float* SSQ2 = (float*)(p.ws + OFF_SSQ2);
  constexpr int NG = (TT / 128) * 8;
  for (int it = bid; it < NG; it += nb) {
    int mt = it >> 3, nt = it & 7; int m0 = mt * 128, n0 = nt * 128;
    f32x4 acc[4][4];
#pragma unroll
    for (int i = 0; i < 4; i++)
#pragma unroll
      for (int j = 0; j < 4; j++) acc[i][j] = f32x4{0.f, 0.f, 0.f, 0.f};
    gemm_loop<4, 4>(MX + (size_t)m0 * DM, DM, WO + (size_t)n0 * DM, DM, DM, acc, sA, sB);
    const float* xin = m0 < TP ? p.x_p + (size_t)m0 * DM : p.x_s + (size_t)(m0 - TP) * DM;
    float* y = m0 < TP ? p.out + O_YP + (size_t)m0 * DM : p.out + O_YS + (size_t)(m0 - TP) * DM;
#pragma unroll
    for (int mi = 0; mi < 4; mi++)
#pragma unroll
      for (int j = 0; j < 4; j++) {
        int lr = wr * 64 + mi * 16 + quad * 4 + j; float ss = 0.f;
#pragma unroll
        for (int ni = 0; ni < 4; ni++) {
          int col = n0 + wc * 64 + ni * 16 + l16;
          float v = xin[(size_t)lr * DM + col] + acc[mi][ni][j];
          y[(size_t)lr * DM + col] = v; X1B[(size_t)(m0 + lr) * DM + col] = f2bf(v); ss += v * v;
        }
        ss = sum16(ss);
        if (l16 == 0) SSQ2[(size_t)(m0 + lr) * 16 + nt * 2 + wc] = ss;
      }
  }
}

DEV int fkey(float x, int idx, int mask) { int b = __float_as_int(x); b ^= (b >> 31) & 0x7fffffff; return (b & ~mask) | idx; }
DEV void ins16(int (&t)[16], int v) {
#pragma unroll
  for (int s = 0; s < 16; s++) { int hi = max(t[s], v); v = min(t[s], v); t[s] = hi; }
}

DEV void phase7(const Params& p, int bid, int nb, char* smem) {
  const int tid = threadIdx.x, lane = tid & 63, w = tid >> 6, wr = w >> 1, wc = w & 1, l16 = lane & 15, quad = lane >> 4;
  bfu* sA = (bfu*)smem; bfu* sB = sA + 64 * 72;
  float* sS = (float*)smem;
  int* sL = (int*)(smem + 33024);
  float* sTV = (float*)(smem + 33024 + 16640);
  int* sTI = (int*)(sTV + 2 * 64 * 17);
  const bfu* X1B = (const bfu*)(p.ws + OFF_X1B); const bfu* MT = (const bfu*)(p.ws + OFF_MT);
  const float* SSQ2 = (const float*)(p.ws + OFF_SSQ2);
  int2* ROUTE = (int2*)(p.ws + OFF_ROUTE);
  constexpr int NI7 = (TT / 64) * 8;
  for (int it = bid; it < NI7; it += nb) {
    int mt = it >> 3, h = it & 7; int m0 = mt * 64;
    for (int half = 0; half < 2; half++) {
      f32x4 acc[2][4];
#pragma unroll
      for (int i = 0; i < 2; i++)
#pragma unroll
        for (int j = 0; j < 4; j++) acc[i][j] = f32x4{0.f, 0.f, 0.f, 0.f};
      gemm_loop<2, 4>(X1B + (size_t)m0 * DM, DM, MT + (size_t)(h * 256 + half * 128) * DM, DM, DM, acc, sA, sB);
      __syncthreads();
#pragma unroll
      for (int mi = 0; mi < 2; mi++)
#pragma unroll
        for (int j = 0; j < 4; j++) {
          int lr = wr * 32 + mi * 16 + quad * 4 + j;
          const float* sp = SSQ2 + (size_t)(m0 + lr) * 16; float tot = 0.f;
#pragma unroll
          for (int i = 0; i < 16; i++) tot += sp[i];
          float rs = rsqrtf(tot * (1.f / DM) + EPSN);
#pragma unroll
          for (int ni = 0; ni < 4; ni++) sS[lr * 129 + wc * 64 + ni * 16 + l16] = acc[mi][ni][j] * rs;
        }
      __syncthreads();
      { int row = tid & 63, q = tid >> 6; int t[16];
#pragma unroll
        for (int s = 0; s < 16; s++) t[s] = (int)0x80000000;
        for (int i = 0; i < 32; i++) { int idx = q * 32 + i; ins16(t, fkey(sS[row * 129 + idx], idx, 127)); }
#pragma unroll
        for (int s = 0; s < 16; s++) sL[row * 65 + q * 16 + s] = t[s]; }
      __syncthreads();
      if (tid < 64) { int row = tid; int p0 = 0, p1 = 0, p2 = 0, p3 = 0; const int* L = sL + row * 65;
        for (int r = 0; r < 16; r++) {
          int a0 = L[p0], a1 = L[16 + p1], a2 = L[32 + p2], a3 = L[48 + p3];
          int mx = max(max(a0, a1), max(a2, a3));
          if (mx == a0) p0++; else if (mx == a1) p1++; else if (mx == a2) p2++; else p3++;
          int idx = mx & 127;
          sTV[(half * 64 + row) * 17 + r] = sS[row * 129 + idx]; sTI[(half * 64 + row) * 17 + r] = idx; } }
      __syncthreads();
    }
    if (tid < 64) {
      int row = tid; float v1[16], v2[16];
#pragma unroll
      for (int i = 0; i < 16; i++) { v1[i] = sTV[row * 17 + i]; v2[i] = sTV[(64 + row) * 17 + i]; }
      int t[16];
#pragma unroll
      for (int s = 0; s < 16; s++) t[s] = (int)0x80000000;
#pragma unroll
      for (int i = 0; i < 16; i++)
#pragma unroll
        for (int j = 0; j < 16; j++)
          if ((i + 1) * (j + 1) <= 16) ins16(t, fkey(v1[i] + v2[j], i * 16 + j, 255));
      float es[16]; int ei[16]; float mx = 0.f, sum = 0.f;
#pragma unroll
      for (int r = 0; r < 16; r++) { int c = t[r] & 255; int i = c >> 4, j = c & 15;
        float s = sTV[row * 17 + i] + sTV[(64 + row) * 17 + j];
        ei[r] = sTI[row * 17 + i] * 128 + sTI[(64 + row) * 17 + j];
        if (r == 0) mx = s;
        es[r] = __expf(s - mx); sum += es[r]; }
      float inv = 1.f / sum;
      int2* ro = ROUTE + ((size_t)(m0 + row) * 8 + h) * 16;
#pragma unroll
      for (int r = 0; r < 16; r++) ro[r] = make_int2(ei[r], __float_as_int(es[r] * inv));
    }
    __syncthreads();
  }
}

DEV void phase8(const Params& p, int bid, int nb, char* smem) {
  const int tid = threadIdx.x, lane = tid & 63, w = tid >> 6;
  const uint4* PUB = (const uint4*)(p.ws + OFF_PUB); const uint4* PVB = (const uint4*)(p.ws + OFF_PVB);
  const float* SSQ2 = (const float*)(p.ws + OFF_SSQ2); const int2* ROUTE = (const int2*)(p.ws + OFF_ROUTE);
  for (int it = bid; it < TT / 4; it += nb) {
    int tok = it * 4 + w;
    float* y = tok < TP ? p.out + O_YP + (size_t)tok * DM : p.out + O_YS + (size_t)(tok - TP) * DM;
    float x[16], xn[16];
    { float4 a0 = *(const float4*)(y + lane * 8), a1 = *(const float4*)(y + lane * 8 + 4), b0 = *(const float4*)(y + 512 + lane * 8), b1 = *(const float4*)(y + 512 + lane * 8 + 4);
      x[0] = a0.x; x[1] = a0.y; x[2] = a0.z; x[3] = a0.w; x[4] = a1.x; x[5] = a1.y; x[6] = a1.z; x[7] = a1.w;
      x[8] = b0.x; x[9] = b0.y; x[10] = b0.z; x[11] = b0.w; x[12] = b1.x; x[13] = b1.y; x[14] = b1.z; x[15] = b1.w; }
    float tot = 0.f;
    { const float* sp = SSQ2 + (size_t)tok * 16;
#pragma unroll
      for (int i = 0; i < 16; i++) tot += sp[i]; }
    float rs = rsqrtf(tot * (1.f / DM) + EPSN);
#pragma unroll
    for (int i = 0; i < 8; i++) { xn[i] = x[i] * rs * p.norm2_g[lane * 8 + i]; xn[8 + i] = x[8 + i] * rs * p.norm2_g[512 + lane * 8 + i]; }
    const int2* rt = ROUTE + (size_t)tok * 128;
    int2 r0 = rt[lane], r1 = rt[lane + 64];
    float w0 = 0.f, w1 = 0.f;
#pragma unroll 4
    for (int j = 0; j < 128; j++) {
      int e = (j < 64) ? __builtin_amdgcn_readlane(r0.x, j & 63) : __builtin_amdgcn_readlane(r1.x, j & 63);
      uint4 u0 = PUB[(size_t)e * 128 + lane], u1 = PUB[(size_t)e * 128 + 64 + lane];
      float d = bflo(u0.x) * xn[0] + bfhi(u0.x) * xn[1] + bflo(u0.y) * xn[2] + bfhi(u0.y) * xn[3] + bflo(u0.z) * xn[4] + bfhi(u0.z) * xn[5] + bflo(u0.w) * xn[6] + bfhi(u0.w) * xn[7] +
                bflo(u1.x) * xn[8] + bfhi(u1.x) * xn[9] + bflo(u1.y) * xn[10] + bfhi(u1.y) * xn[11] + bflo(u1.z) * xn[12] + bfhi(u1.z) * xn[13] + bflo(u1.w) * xn[14] + bfhi(u1.w) * xn[15];
      d = wave_sum(d);
      float act = 0.5f * d * (1.f + erff(d * 0.70710678118654752f));
      if (j < 64) { if (lane == j) w0 = act * __int_as_float(r0.y); } else { if (lane == j - 64) w1 = act * __int_as_float(r1.y); }
    }
    float acc[16];
#pragma unroll
    for (int i = 0; i < 16; i++) acc[i] = 0.f;
#pragma unroll 4
    for (int j = 0; j < 128; j++) {
      int e = (j < 64) ? __builtin_amdgcn_readlane(r0.x, j & 63) : __builtin_amdgcn_readlane(r1.x, j & 63);
      float wj = (j < 64) ? __builtin_amdgcn_readlane(__float_as_int(w0), j & 63) == 0 ? 0.f : 0.f : 0.f;
      wj = __int_as_float((j < 64) ? __builtin_amdgcn_readlane(__float_as_int(w0), j & 63) : __builtin_amdgcn_readlane(__float_as_int(w1), j & 63));
      uint4 u0 = PVB[(size_t)e * 128 + lane], u1 = PVB[(size_t)e * 128 + 64 + lane];
      acc[0] += wj * bflo(u0.x); acc[1] += wj * bfhi(u0.x); acc[2] += wj * bflo(u0.y); acc[3] += wj * bfhi(u0.y);
      acc[4] += wj * bflo(u0.z); acc[5] += wj * bfhi(u0.z); acc[6] += wj * bflo(u0.w); acc[7] += wj * bfhi(u0.w);
      acc[8] += wj * bflo(u1.x); acc[9] += wj * bfhi(u1.x); acc[10] += wj * bflo(u1.y); acc[11] += wj * bfhi(u1.y);
      acc[12] += wj * bflo(u1.z); acc[13] += wj * bfhi(u1.z); acc[14] += wj * bflo(u1.w); acc[15] += wj * bfhi(u1.w);
    }
    *(float4*)(y + lane * 8) = make_float4(x[0] + acc[0], x[1] + acc[1], x[2] + acc[2], x[3] + acc[3]);
    *(float4*)(y + lane * 8 + 4) = make_float4(x[4] + acc[4], x[5] + acc[5], x[6] + acc[6], x[7] + acc[7]);
    *(float4*)(y + 512 + lane * 8) = make_float4(x[8] + acc[8], x[9] + acc[9], x[10] + acc[10], x[11] + acc[11]);
    *(float4*)(y + 512 + lane * 8 + 4) = make_float4(x[12] + acc[12], x[13] + acc[13], x[14] + acc[14], x[15] + acc[15]);
  }
}

__global__ void __launch_bounds__(256, 2) fwd_kernel(Params p, int ph_lo, int ph_hi, int coop) {
  __shared__ __attribute__((aligned(16))) char smem[SMEM_BYTES];
  const int bid = blockIdx.x, nb = gridDim.x;
#define RUN_PHASE(N) if (ph_lo <= N && N <= ph_hi) { phase##N(p, bid, nb, smem); if (coop && N < ph_hi) cg::this_grid().sync(); }
  RUN_PHASE(0) RUN_PHASE(1) RUN_PHASE(2) RUN_PHASE(3) RUN_PHASE(4) RUN_PHASE(5) RUN_PHASE(6) RUN_PHASE(7) RUN_PHASE(8)
}

extern "C" void kernel_launch(void* const* d_in, const int* in_sizes, int n_in, void* d_out, int out_size,
                              void* d_ws, size_t ws_size, hipStream_t stream) {
  if (ws_size < WS_NEED) { fprintf(stderr, "workspace too small\n"); return; }
  static int grid_blocks = 0;
  if (!grid_blocks) {
    int dev = 0, cus = 0, per_cu = 0;
    hipGetDevice(&dev);
    hipDeviceGetAttribute(&cus, hipDeviceAttributeMultiprocessorCount, dev);
    hipOccupancyMaxActiveBlocksPerMultiprocessor(&per_cu, fwd_kernel, 256, 0);
    if (per_cu < 1) per_cu = 1;
    if (per_cu > 2) per_cu = 2;
    grid_blocks = cus * per_cu;
  }
  Params p{};
  const float* const* in = (const float* const*)d_in;
  p.x_p = in[0]; p.x_s = in[1]; p.state_ret = in[2]; p.ck = in[3]; p.cv = in[4]; p.clogf = in[5]; p.norm1_g = in[6];
  p.w_in = in[7]; p.b_f = in[8]; p.fq_g = in[9]; p.fk_g = in[10]; p.gn_g = in[11]; p.w_ret_out = in[12]; p.w_fox_out = in[13];
  p.w_o = in[14]; p.norm2_g = in[15]; p.peer_wq = in[16]; p.k1 = in[17]; p.k2 = in[18]; p.peer_u = in[19]; p.peer_v = in[20];
  p.out = (float*)d_out; p.ws = (char*)d_ws;
#ifndef MULTI_LAUNCH
#define MULTI_LAUNCH 0
#endif
#if MULTI_LAUNCH
  for (int ph = 0; ph <= 8; ph++) fwd_kernel<<<grid_blocks, 256, 0, stream>>>(p, ph, ph, 0);
#else
  int lo = 0, hi = 8, coop = 1;
  void* args[] = {&p, &lo, &hi, &coop};
  hipError_t e = hipLaunchCooperativeKernel((void*)fwd_kernel, dim3(grid_blocks), dim3(256), args, 0, stream);
  if (e != hipSuccess) fprintf(stderr, "cooperative launch failed: %s (grid %d)\n", hipGetErrorString(e), grid_blocks);
#endif
}
```

```cpp
#include <hip/hip_runtime.h>
#include <hip/hip_cooperative_groups.h>
#include <stdint.h>
#include <stdio.h>
namespace cg = cooperative_groups;

#define DEV __device__ __forceinline__
typedef unsigned short bfu;
typedef __attribute__((ext_vector_type(8))) short bf16x8;
typedef __attribute__((ext_vector_type(4))) short bf16x4;
typedef __attribute__((ext_vector_type(4))) float f32x4;
typedef __attribute__((ext_vector_type(16))) float f32x16;
typedef __attribute__((ext_vector_type(4))) unsigned u32x4;
typedef __attribute__((ext_vector_type(2))) float f32x2;

constexpr int DM = 1024, SEQ = 16384, TP = 32768, TS = 512, TT = 33280;
constexpr int NWP = 6784;
constexpr int RC = 128;
constexpr int NCH = SEQ / RC;
constexpr float LOG2E = 1.4426950408889634f;
constexpr float EPSN = 1e-6f;

constexpr size_t O_YP = 0, O_YS = 33554432, O_SP = 34078720, O_FKP = 34209792, O_FVP = 50987008,
                 O_LFP = 67764224, O_SS = 68026368, O_FKS = 70123520, O_FVS = 70385664, O_LFS = 70647808;
constexpr size_t MiB = 1u << 20;
constexpr size_t OFF_XB = 0;
constexpr size_t OFF_WINT = 66 * MiB, OFF_WRT = 80 * MiB, OFF_WFT = 82 * MiB, OFF_WOT = 83 * MiB, OFF_MT = 85 * MiB;
constexpr size_t OFF_RSTD1 = 89 * MiB, OFF_C2 = 90 * MiB, OFF_HS = 91 * MiB;
constexpr size_t OFF_QT = 105 * MiB, OFF_KT = 137 * MiB, OFF_KTT = 169 * MiB, OFF_VT = 201 * MiB;
constexpr size_t OFF_X1B = OFF_QT, OFF_ROUTE = 171 * MiB, OFF_SSQ2 = 204 * MiB, OFF_PSC = 208 * MiB;
constexpr size_t OFF_RG = 265 * MiB, OFF_FQ = 331 * MiB, OFF_FKB = 364 * MiB, OFF_FVT = 396 * MiB;
constexpr size_t OFF_PUB = OFF_FKB, OFF_PVB = OFF_FVT, OFF_SST = 428 * MiB;
constexpr size_t WS_NEED = 460 * MiB;

constexpr int SMEM_BYTES = 75776;

struct Params {
  const float *x_p, *x_s, *state_ret, *ck, *cv, *clogf, *norm1_g, *w_in, *b_f, *fq_g, *fk_g, *gn_g,
      *w_ret_out, *w_fox_out, *w_o, *norm2_g, *peer_wq, *k1, *k2, *peer_u, *peer_v;
  float* out;
  char* ws;
};

DEV bfu f2bf(float f) { unsigned u = __float_as_uint(f); u += 0x7fffu + ((u >> 16) & 1u); return (bfu)(u >> 16); }
DEV float bf2f(bfu b) { return __uint_as_float(((unsigned)b) << 16); }
DEV unsigned pack2(float a, float b) { return (unsigned)f2bf(a) | ((unsigned)f2bf(b) << 16); }
DEV float bflo(unsigned u) { return __uint_as_float(u << 16); }
DEV float bfhi(unsigned u) { return __uint_as_float(u & 0xffff0000u); }
DEV float sigmoidf_(float z) { return 1.f / (1.f + __expf(-z)); }
DEV float l2gamma(int h) { return log2f(1.f - exp2f(-5.f - (float)h)); }
DEV float wave_sum(float v) {
#pragma unroll
  for (int o = 32; o >= 1; o >>= 1) v += __shfl_xor(v, o);
  return v;
}
DEV float sum16(float v) {
  v += __shfl_xor(v, 1); v += __shfl_xor(v, 2); v += __shfl_xor(v, 4); v += __shfl_xor(v, 8);
  return v;
}

template <int ROWS>
DEV void g2r(const bfu* g, int ld, u32x4 (&r)[ROWS / 32]) {
#pragma unroll
  for (int i = 0; i < ROWS / 32; i++) {
    int id = threadIdx.x + i * 256; int row = id >> 3, ch = id & 7;
    const unsigned off = (unsigned)(row * ld + ch * 8);
    r[i] = *(const u32x4*)(g + off);
  }
}
template <int ROWS>
DEV void r2s(bfu* s, const u32x4 (&r)[ROWS / 32]) {
#pragma unroll
  for (int i = 0; i < ROWS / 32; i++) {
    int id = threadIdx.x + i * 256; int row = id >> 3, ch = id & 7;
    *(u32x4*)(s + row * 72 + ch * 8) = r[i];
  }
}
template <int MI, int NI>
DEV void mma64(const bfu* sA, int sldA, const bfu* sB, int sldB, f32x4 (&acc)[MI][NI]) {
  const int lane = threadIdx.x & 63, w = threadIdx.x >> 6, wr = w >> 1, wc = w & 1, l16 = lane & 15, quad = lane >> 4;
#pragma unroll
  for (int kk = 0; kk < 2; kk++) {
    bf16x8 a[MI], b[NI];
#pragma unroll
    for (int mi = 0; mi < MI; mi++) a[mi] = *(const bf16x8*)(sA + (wr * MI * 16 + mi * 16 + l16) * sldA + kk * 32 + quad * 8);
#pragma unroll
    for (int ni = 0; ni < NI; ni++) b[ni] = *(const bf16x8*)(sB + (wc * NI * 16 + ni * 16 + l16) * sldB + kk * 32 + quad * 8);
#pragma unroll
    for (int mi = 0; mi < MI; mi++)
#pragma unroll
      for (int ni = 0; ni < NI; ni++) acc[mi][ni] = __builtin_amdgcn_mfma_f32_16x16x32_bf16(a[mi], b[ni], acc[mi][ni], 0, 0, 0);
  }
}
template <int MI, int NI>
DEV void gemm_loop(const bfu* A, int lda, const bfu* B, int ldb, int K, f32x4 (&acc)[MI][NI], bfu* sbuf) {
  constexpr int BM = 32 * MI, BN = 32 * NI;
  bfu* sA0 = sbuf; bfu* sB0 = sA0 + BM * 72; bfu* sA1 = sB0 + BN * 72; bfu* sB1 = sA1 + BM * 72;
  const int nk = K >> 6;
  u32x4 ra[BM / 32], rb[BN / 32];
  g2r<BM>(A, lda, ra); g2r<BN>(B, ldb, rb);
  __syncthreads();
  r2s<BM>(sA0, ra); r2s<BN>(sB0, rb);
  if (nk > 1) { g2r<BM>(A + 64, lda, ra); g2r<BN>(B + 64, ldb, rb); }
  __syncthreads();
  for (int k = 0; k < nk; k += 2) {
    if (k + 1 < nk) { r2s<BM>(sA1, ra); r2s<BN>(sB1, rb); }
    if (k + 2 < nk) { g2r<BM>(A + (k + 2) * 64, lda, ra); g2r<BN>(B + (k + 2) * 64, ldb, rb); }
    mma64<MI, NI>(sA0, 72, sB0, 72, acc);
    __syncthreads();
    if (k + 1 >= nk) break;
    if (k + 2 < nk) { r2s<BM>(sA0, ra); r2s<BN>(sB0, rb); }
    if (k + 3 < nk) { g2r<BM>(A + (k + 3) * 64, lda, ra); g2r<BN>(B + (k + 3) * 64, ldb, rb); }
    mma64<MI, NI>(sA1, 72, sB1, 72, acc);
    __syncthreads();
  }
}

DEV void transpose_tile(const float* src, int ldsrc, int srccol0, int validcols, const float* scale,
                        bfu* dst, int lddst, int n0, int k0, float* sT) {
  const int tid = threadIdx.x;
  __syncthreads();
#pragma unroll
  for (int i = 0; i < 4; i++) {
    int kk = (tid >> 4) + i * 16, c = (tid & 15) * 4;
    float4 v = make_float4(0.f, 0.f, 0.f, 0.f);
    if (c < validcols) v = *(const float4*)(src + (size_t)(k0 + kk) * ldsrc + srccol0 + c);
    float s = scale ? scale[k0 + kk] : 1.f;
    sT[kk * 65 + c] = v.x * s; sT[kk * 65 + c + 1] = v.y * s; sT[kk * 65 + c + 2] = v.z * s; sT[kk * 65 + c + 3] = v.w * s;
  }
  __syncthreads();
  int n = tid >> 2, kc = (tid & 3) * 16;
  unsigned o[8];
#pragma unroll
  for (int e = 0; e < 8; e++) o[e] = pack2(sT[(kc + 2 * e) * 65 + n], sT[(kc + 2 * e + 1) * 65 + n]);
  uint4* d = (uint4*)(dst + (size_t)(n0 + n) * lddst + k0 + kc);
  d[0] = make_uint4(o[0], o[1], o[2], o[3]); d[1] = make_uint4(o[4], o[5], o[6], o[7]);
}

DEV void phase0(const Params& p, int bid, int nb, char* smem) {
  const int tid = threadIdx.x, lane = tid & 63, w = tid >> 6;
  constexpr int N_X = TT / 4, N_TW = 106 * 16, N_TR = 256, N_TF = 128, N_TO = 256, N_MT = 512;
  constexpr int B1 = N_X, B2 = B1 + N_TW, B3 = B2 + N_TR, B4 = B3 + N_TF, B5 = B4 + N_TO, TOT = B5 + N_MT;
  bfu* xb = (bfu*)(p.ws + OFF_XB); float* rstd1 = (float*)(p.ws + OFF_RSTD1);
  for (int it = bid; it < TOT; it += nb) {
    if (it < B1) {
      int row = it * 4 + w;
      const float* src = row < TP ? p.x_p + (size_t)row * DM : p.x_s + (size_t)(row - TP) * DM;
      float4 a0 = *(const float4*)(src + lane * 8), a1 = *(const float4*)(src + lane * 8 + 4);
      float4 b0 = *(const float4*)(src + 512 + lane * 8), b1 = *(const float4*)(src + 512 + lane * 8 + 4);
      float ss = a0.x * a0.x + a0.y * a0.y + a0.z * a0.z + a0.w * a0.w + a1.x * a1.x + a1.y * a1.y + a1.z * a1.z + a1.w * a1.w +
                 b0.x * b0.x + b0.y * b0.y + b0.z * b0.z + b0.w * b0.w + b1.x * b1.x + b1.y * b1.y + b1.z * b1.z + b1.w * b1.w;
      ss = wave_sum(ss);
      if (lane == 0) rstd1[row] = rsqrtf(ss * (1.f / DM) + EPSN);
      *(uint4*)(xb + (size_t)row * DM + lane * 8) = make_uint4(pack2(a0.x, a0.y), pack2(a0.z, a0.w), pack2(a1.x, a1.y), pack2(a1.z, a1.w));
      *(uint4*)(xb + (size_t)row * DM + 512 + lane * 8) = make_uint4(pack2(b0.x, b0.y), pack2(b0.z, b0.w), pack2(b1.x, b1.y), pack2(b1.z, b1.w));
    } else if (it < B2) {
      int j = it - B1; int nt = j >> 4, kt = j & 15; int n0 = nt * 64;
      int sc0, vc;
      if (n0 < 4608) { sc0 = n0; vc = 64; } else if (n0 < 6656) { sc0 = n0 + 8; vc = 64; } else if (n0 == 6656) { sc0 = 4608; vc = 8; } else { sc0 = 0; vc = 0; }
      transpose_tile(p.w_in, 6664, sc0, vc, p.norm1_g, (bfu*)(p.ws + OFF_WINT), DM, n0, kt * 64, (float*)smem);
    } else if (it < B3) {
      int j = it - B2; transpose_tile(p.w_ret_out, 1024, (j >> 4) * 64, 64, nullptr, (bfu*)(p.ws + OFF_WRT), 1024, (j >> 4) * 64, (j & 15) * 64, (float*)smem);
    } else if (it < B4) {
      int j = it - B3; transpose_tile(p.w_fox_out, 1024, (j >> 3) * 64, 64, nullptr, (bfu*)(p.ws + OFF_WFT), 512, (j >> 3) * 64, (j & 7) * 64, (float*)smem);
    } else if (it < B5) {
      int j = it - B4; transpose_tile(p.w_o, 1024, (j >> 4) * 64, 64, nullptr, (bfu*)(p.ws + OFF_WOT), 1024, (j >> 4) * 64, (j & 15) * 64, (float*)smem);
    } else {
      int j = it - B5; int hh = j >> 5, kt = (j >> 4) & 1, dt = j & 15;
      float* sW = (float*)smem; float* sK = sW + 64 * 129;
      const float* ksub = (hh & 1) ? p.k2 : p.k1;
      __syncthreads();
#pragma unroll
      for (int i = 0; i < 8; i++) {
        int id = tid + i * 256; int row = id >> 5, c4 = (id & 31) * 4;
        float4 v = *(const float4*)(p.peer_wq + (size_t)(dt * 64 + row) * 2048 + hh * 128 + c4);
        sW[row * 129 + c4] = v.x; sW[row * 129 + c4 + 1] = v.y; sW[row * 129 + c4 + 2] = v.z; sW[row * 129 + c4 + 3] = v.w;
        float4 u = *(const float4*)(ksub + (size_t)(kt * 64 + row) * 128 + c4);
        sK[row * 129 + c4] = u.x; sK[row * 129 + c4 + 1] = u.y; sK[row * 129 + c4 + 2] = u.z; sK[row * 129 + c4 + 3] = u.w;
      }
      __syncthreads();
      int ky = (tid >> 4) * 4, dd = (tid & 15) * 4;
      float a[4][4];
#pragma unroll
      for (int i = 0; i < 4; i++)
#pragma unroll
        for (int jj = 0; jj < 4; jj++) a[i][jj] = 0.f;
      for (int c = 0; c < 128; c++) {
        float kv[4], wv[4];
#pragma unroll
        for (int i = 0; i < 4; i++) { kv[i] = sK[(ky + i) * 129 + c]; wv[i] = sW[(dd + i) * 129 + c]; }
#pragma unroll
        for (int i = 0; i < 4; i++)
#pragma unroll
          for (int jj = 0; jj < 4; jj++) a[i][jj] += kv[i] * wv[jj];
      }
      bfu* MT = (bfu*)(p.ws + OFF_MT);
      float g0 = p.norm2_g[dt * 64 + dd], g1 = p.norm2_g[dt * 64 + dd + 1], g2 = p.norm2_g[dt * 64 + dd + 2], g3 = p.norm2_g[dt * 64 + dd + 3];
#pragma unroll
      for (int i = 0; i < 4; i++)
        *(uint2*)(MT + (size_t)(hh * 128 + kt * 64 + ky + i) * DM + dt * 64 + dd) = make_uint2(pack2(a[i][0] * g0, a[i][1] * g1), pack2(a[i][2] * g2, a[i][3] * g3));
    }
  }
}

DEV void rot_angle(int pos, int d, float& cs, float& sn) {
  float inv = exp2f(-(float)d * (13.287712379549449f / 32.f));
  float ang = (float)pos * inv;
  float rev = ang * 0.15915494309189535f;
  rev = rev - floorf(rev);
  sn = __builtin_amdgcn_sinf(rev); cs = __builtin_amdgcn_cosf(rev);
}

DEV void phase1(const Params& p, int bid, int nb, char* smem) {
  const int tid = threadIdx.x, lane = tid & 63, w = tid >> 6, wr = w >> 1, wc = w & 1, l16 = lane & 15, quad = lane >> 4;
  bfu* sA = (bfu*)smem; bfu* sB = sA + 128 * 72;
  const bfu* XB = (const bfu*)(p.ws + OFF_XB); const bfu* WT = (const bfu*)(p.ws + OFF_WINT);
  const float* rstd1 = (const float*)(p.ws + OFF_RSTD1);
  constexpr int NT = NWP / 128, MT_ = TT / 128;
  for (int it = bid; it < NT * MT_; it += nb) {
    int mt = it / NT, nt = it - mt * NT;
    int m0 = mt * 128, n0 = nt * 128;
    f32x4 acc[4][4];
#pragma unroll
    for (int i = 0; i < 4; i++)
#pragma unroll
      for (int j = 0; j < 4; j++) acc[i][j] = f32x4{0.f, 0.f, 0.f, 0.f};
    gemm_loop<4, 4>(XB + (size_t)m0 * DM, DM, WT + (size_t)n0 * DM, DM, DM, acc, sA);
    const int rbase = m0 + wr * 64 + quad * 4;
    const int cbase = n0 + wc * 64 + l16;
    if (m0 >= TP) {
      float* hs = (float*)(p.ws + OFF_HS);
      bfu* gaS = (bfu*)(p.out + O_YS); bfu* gbS = gaS + (size_t)TS * DM;
#pragma unroll
      for (int mi = 0; mi < 4; mi++)
#pragma unroll
        for (int j = 0; j < 4; j++) {
          int row = rbase + mi * 16 + j; float rs = rstd1[row]; int sr = row - TP;
#pragma unroll
          for (int ni = 0; ni < 4; ni++) {
            int col = cbase + ni * 16; float v = acc[mi][ni][j] * rs;
            if (n0 >= 4608 && n0 < 5632) gaS[(size_t)sr * DM + col - 4608] = f2bf(v);
            else if (n0 >= 5632 && n0 < 6656) gbS[(size_t)sr * DM + col - 5632] = f2bf(v);
            else hs[(size_t)sr * NWP + col] = v;
          }
        }
      continue;
    }
    const int b = m0 >> 14;
    if (n0 < 1024) {
      const int isK = n0 >= 512; const int head = ((n0 & 511) >> 6) + wc;
      const float l2g = l2gamma(head);
      bfu* dst = (bfu*)(p.ws + (isK ? OFF_KT : OFF_QT));
      bfu* ktT = (bfu*)(p.ws + OFF_KTT);
#pragma unroll
      for (int mi = 0; mi < 4; mi++) {
#pragma unroll
        for (int ni = 0; ni < 2; ni++) {
          int d = ni * 16 + l16;
          float y1[4], y2[4];
#pragma unroll
          for (int j = 0; j < 4; j++) {
            int row = rbase + mi * 16 + j; int t = row & (SEQ - 1); int l = t & (RC - 1);
            float rs = rstd1[row];
            float dec = exp2f((float)(l + 1) * l2g);
            float sc = isK ? 0.125f / dec : dec;
            float cs, sn; rot_angle(t, d, cs, sn);
            float x1 = acc[mi][ni][j] * rs, x2 = acc[mi][ni + 2][j] * rs;
            y1[j] = (x1 * cs - x2 * sn) * sc; y2[j] = (x2 * cs + x1 * sn) * sc;
            dst[(size_t)row * 512 + head * 64 + d] = f2bf(y1[j]);
            dst[(size_t)row * 512 + head * 64 + d + 32] = f2bf(y2[j]);
          }
          if (isK) {
            int t0 = (rbase + mi * 16) & (SEQ - 1);
            *(uint2*)(ktT + ((size_t)((b * 8 + head) * 64 + d)) * SEQ + t0) = make_uint2(pack2(y1[0], y1[1]), pack2(y1[2], y1[3]));
            *(uint2*)(ktT + ((size_t)((b * 8 + head) * 64 + d + 32)) * SEQ + t0) = make_uint2(pack2(y2[0], y2[1]), pack2(y2[2], y2[3]));
          }
        }
      }
    } else if (n0 < 2048) {
      const int head = (n0 - 1024) >> 7;
      bfu* vT = (bfu*)(p.ws + OFF_VT);
#pragma unroll
      for (int mi = 0; mi < 4; mi++) {
        int row0 = rbase + mi * 16; int t0 = row0 & (SEQ - 1);
        float r0 = rstd1[row0], r1 = rstd1[row0 + 1], r2 = rstd1[row0 + 2], r3 = rstd1[row0 + 3];
#pragma unroll
        for (int ni = 0; ni < 4; ni++) {
          int dv = wc * 64 + ni * 16 + l16;
          *(uint2*)(vT + ((size_t)((b * 8 + head) * 128 + dv)) * SEQ + t0) =
              make_uint2(pack2(acc[mi][ni][0] * r0, acc[mi][ni][1] * r1), pack2(acc[mi][ni][2] * r2, acc[mi][ni][3] * r3));
        }
      }
    } else if (n0 < 3072 || (n0 >= 4608 && n0 < 6656)) {
      bfu* dst; int c0;
      if (n0 < 3072) { dst = (bfu*)(p.ws + OFF_RG); c0 = 2048; }
      else if (n0 < 5632) { dst = (bfu*)(p.out + O_YP); c0 = 4608; }
      else { dst = (bfu*)(p.out + O_YP) + (size_t)TP * DM; c0 = 5632; }
#pragma unroll
      for (int mi = 0; mi < 4; mi++)
#pragma unroll
        for (int j = 0; j < 4; j++) {
          int row = rbase + mi * 16 + j; float rs = rstd1[row];
#pragma unroll
          for (int ni = 0; ni < 4; ni++) dst[(size_t)row * DM + cbase + ni * 16 - c0] = f2bf(acc[mi][ni][j] * rs);
        }
    } else if (n0 < 4096) {
      const int isK = n0 >= 3584; const int head = (((n0 - 3072) & 511) >> 6) + wc;
      const float* g = isK ? p.fk_g : p.fq_g;
      float gv[4];
#pragma unroll
      for (int ni = 0; ni < 4; ni++) gv[ni] = g[ni * 16 + l16];
      bfu* fq = (bfu*)(p.ws + OFF_FQ); bfu* fkb = (bfu*)(p.ws + OFF_FKB);
#pragma unroll
      for (int mi = 0; mi < 4; mi++)
#pragma unroll
        for (int j = 0; j < 4; j++) {
          int row = rbase + mi * 16 + j; float rs = rstd1[row];
          float v[4]; float ss = 0.f;
#pragma unroll
          for (int ni = 0; ni < 4; ni++) { v[ni] = acc[mi][ni][j] * rs; ss += v[ni] * v[ni]; }
          ss = sum16(ss);
          float r = rsqrtf(ss * (1.f / 64.f) + EPSN);
#pragma unroll
          for (int ni = 0; ni < 4; ni++) {
            float y = v[ni] * r * gv[ni]; size_t o = (size_t)row * 512 + head * 64 + ni * 16 + l16;
            if (isK) { p.out[O_FKP + o] = y; fkb[o] = f2bf(y); }
            else fq[o] = f2bf(y * (0.125f * LOG2E));
          }
        }
    } else if (n0 < 4608) {
      const int head = ((n0 - 4096) >> 6) + wc;
      bfu* fvT = (bfu*)(p.ws + OFF_FVT);
#pragma unroll
      for (int mi = 0; mi < 4; mi++) {
        int row0 = rbase + mi * 16; int t0 = row0 & (SEQ - 1);
        float r[4] = {rstd1[row0], rstd1[row0 + 1], rstd1[row0 + 2], rstd1[row0 + 3]};
#pragma unroll
        for (int ni = 0; ni < 4; ni++) {
          int d = ni * 16 + l16; float v[4];
#pragma unroll
          for (int j = 0; j < 4; j++) { v[j] = acc[mi][ni][j] * r[j]; p.out[O_FVP + (size_t)(row0 + j) * 512 + head * 64 + d] = v[j]; }
          *(uint2*)(fvT + ((size_t)((b * 8 + head) * 64 + d)) * SEQ + t0) = make_uint2(pack2(v[0], v[1]), pack2(v[2], v[3]));
        }
      }
    } else {
      if (wc == 0 && l16 < 8) {
        float bf = p.b_f[l16];
#pragma unroll
        for (int mi = 0; mi < 4; mi++)
#pragma unroll
          for (int j = 0; j < 4; j++) {
            int row = rbase + mi * 16 + j;
            float z = acc[mi][0][j] * rstd1[row] + bf;
            p.out[O_LFP + (size_t)row * 8 + l16] = fminf(z, 0.f) - log1pf(__expf(-fabsf(z)));
          }
      }
    }
  }
}

DEV void phase2(const Params& p, int bid, int nb, char* smem) {
  const int tid = threadIdx.x, lane = tid & 63, w = tid >> 6, wr = w >> 1, wc = w & 1, l16 = lane & 15, quad = lane >> 4;
  bfu* sA = (bfu*)smem; bfu* sB = sA + 128 * 72;
  const bfu* vT = (const bfu*)(p.ws + OFF_VT); const bfu* ktT = (const bfu*)(p.ws + OFF_KTT);
  float* U = (float*)(p.ws + OFF_XB);
  constexpr int NR1 = 16 * NCH;
  for (int it = bid; it < NR1 + 16; it += nb) {
    if (it < 16) {
      int bh = it, b = bh >> 3, h = bh & 7;
      double* sd = (double*)smem;
      const float* lf = p.out + O_LFP + (size_t)b * SEQ * 8 + h;
      float part = 0.f;
      for (int i = 0; i < 64; i++) part += lf[(size_t)(tid * 64 + i) * 8];
      __syncthreads();
      sd[tid] = (double)part;
      __syncthreads();
      if (tid == 0) { double run = 0.0; for (int i = 0; i < 256; i++) { double v = sd[i]; sd[i] = run; run += v; } }
      __syncthreads();
      double run = sd[tid];
      float* c2 = (float*)(p.ws + OFF_C2) + (size_t)bh * SEQ;
      for (int i = 0; i < 64; i++) { run += (double)lf[(size_t)(tid * 64 + i) * 8]; c2[tid * 64 + i] = (float)(run * (double)LOG2E); }
      __syncthreads();
    } else {
      int j = it - 16; int bh = j / NCH, c = j - bh * NCH;
      f32x4 acc[4][2];
#pragma unroll
      for (int i = 0; i < 4; i++) { acc[i][0] = f32x4{0.f, 0.f, 0.f, 0.f}; acc[i][1] = f32x4{0.f, 0.f, 0.f, 0.f}; }
      gemm_loop<4, 2>(vT + (size_t)bh * 128 * SEQ + c * RC, SEQ, ktT + (size_t)bh * 64 * SEQ + c * RC, SEQ, RC, acc, sA);
      float gC = exp2f((float)RC * l2gamma(bh & 7));
      float* Uo = U + (size_t)j * 8192;
#pragma unroll
      for (int mi = 0; mi < 4; mi++)
#pragma unroll
        for (int ni = 0; ni < 2; ni++)
#pragma unroll
          for (int jj = 0; jj < 4; jj++) {
            int dv = wr * 64 + mi * 16 + quad * 4 + jj, dk = wc * 32 + ni * 16 + l16;
            Uo[dv * 64 + dk] = acc[mi][ni][jj] * gC;
          }
    }
  }
}

DEV void sample_item(const Params& p, int item, char* smem) {
  const int tid = threadIdx.x;
  const int b = item >> 3, h = item & 7;
  float* sq = (float*)smem;
  float* sk = sq + 1024;
  float* sv = sk + 1024;
  float* sP = sv + 2048;
  float* so = sP + 256;
  float* sr = so + 2048;
  float* sc = (float*)smem;
  float* fq = (float*)(smem + 34816);
  float* fk = fq + 1024;
  float* cn = fk + 1024;
  float* suf = cn + 16;
  float* red = suf + 1024;
  float* sL = red + 256;
  const float* hs = (const float*)(p.ws + OFF_HS) + (size_t)b * 16 * NWP;
  const float l2g = l2gamma(h);
  __syncthreads();
  for (int i = tid; i < 512; i += 256) {
    int l = i >> 5, d = i & 31; float cs, sn; rot_angle(1024 + l, d, cs, sn);
    float dec = exp2f((float)(l + 1) * l2g);
    const float* r = hs + (size_t)l * NWP;
    float x1 = r[h * 64 + d], x2 = r[h * 64 + d + 32];
    sq[l * 64 + d] = (x1 * cs - x2 * sn) * dec; sq[l * 64 + d + 32] = (x2 * cs + x1 * sn) * dec;
    x1 = r[512 + h * 64 + d]; x2 = r[512 + h * 64 + d + 32];
    float sc_ = 0.125f / dec;
    sk[l * 64 + d] = (x1 * cs - x2 * sn) * sc_; sk[l * 64 + d + 32] = (x2 * cs + x1 * sn) * sc_;
  }
  for (int i = tid; i < 2048; i += 256) { int l = i >> 7, dv = i & 127; sv[i] = hs[(size_t)l * NWP + 1024 + h * 128 + dv]; }
  __syncthreads();
  { int l = tid >> 4, m = tid & 15; float a = 0.f;
    if (l >= m) for (int d = 0; d < 64; d++) a += sq[l * 64 + d] * sk[m * 64 + d];
    sP[tid] = a; }
  __syncthreads();
  const float* S = p.state_ret + (size_t)(b * 8 + h) * 8192;
  { int dv = tid & 127, lh = tid >> 7; float o[8];
#pragma unroll
    for (int i = 0; i < 8; i++) o[i] = 0.f;
    for (int dk = 0; dk < 64; dk++) { float s = S[dk * 128 + dv];
#pragma unroll
      for (int i = 0; i < 8; i++) o[i] += sq[(lh * 8 + i) * 64 + dk] * s; }
    for (int m = 0; m < 16; m++) { float v = sv[m * 128 + dv];
#pragma unroll
      for (int i = 0; i < 8; i++) o[i] += sP[(lh * 8 + i) * 16 + m] * v; }
#pragma unroll
    for (int i = 0; i < 8; i++) so[(lh * 8 + i) * 128 + dv] = o[i];
    float g16 = exp2f(16.f * l2g);
    float* So = p.out + O_SS + (size_t)(b * 8 + h) * 8192;
    for (int i = 0; i < 32; i++) { int dk = lh * 32 + i; float a = S[dk * 128 + dv];
      for (int m = 0; m < 16; m++) a += sk[m * 64 + dk] * sv[m * 128 + dv];
      So[dk * 128 + dv] = a * g16; }
  }
  __syncthreads();
  if (tid < 16) { float ss = 0.f; for (int i = 0; i < 128; i++) { float v = so[tid * 128 + i]; ss += v * v; } sr[tid] = rsqrtf(ss * (1.f / 128.f) + EPSN); }
  __syncthreads();
  { int dv = tid & 127, lh = tid >> 7; bfu* gated = (bfu*)(p.ws + OFF_RG);
    float gg = p.gn_g[h * 128 + dv];
    for (int i = 0; i < 8; i++) { int l = lh * 8 + i; float rgv = hs[(size_t)l * NWP + 2048 + h * 128 + dv];
      float v = so[l * 128 + dv] * sr[l] * gg * (rgv * sigmoidf_(rgv));
      gated[(size_t)(TP + b * 16 + l) * DM + h * 128 + dv] = f2bf(v); } }
  {
    int l = tid >> 4, dl = tid & 15; const float* r = hs + (size_t)l * NWP;
    float qv[4], kv[4]; float sq_ = 0.f, sk_ = 0.f;
#pragma unroll
    for (int i = 0; i < 4; i++) { qv[i] = r[3072 + h * 64 + dl * 4 + i]; kv[i] = r[3584 + h * 64 + dl * 4 + i]; sq_ += qv[i] * qv[i]; sk_ += kv[i] * kv[i]; }
    sq_ = sum16(sq_); sk_ = sum16(sk_);
    float rq = rsqrtf(sq_ * (1.f / 64.f) + EPSN), rk = rsqrtf(sk_ * (1.f / 64.f) + EPSN);
#pragma unroll
    for (int i = 0; i < 4; i++) { int d = dl * 4 + i;
      fq[l * 64 + d] = qv[i] * rq * p.fq_g[d] * 0.125f;
      float kk = kv[i] * rk * p.fk_g[d]; fk[l * 64 + d] = kk;
      p.out[O_FKS + (size_t)((b * 16 + l) * 8 + h) * 64 + d] = kk;
      p.out[O_FVS + (size_t)((b * 16 + l) * 8 + h) * 64 + d] = r[4096 + h * 64 + d]; }
  }
  if (tid < 16) { float z = hs[(size_t)tid * NWP + 6656 + h] + p.b_f[h]; float lf = fminf(z, 0.f) - log1pf(__expf(-fabsf(z)));
    p.out[O_LFS + (size_t)(b * 16 + tid) * 8 + h] = lf; cn[tid] = lf; }
  { const float* cl = p.clogf + (size_t)b * 1024 * 8 + h; float v[4]; float part = 0.f;
#pragma unroll
    for (int i = 0; i < 4; i++) { v[i] = cl[(size_t)(tid * 4 + i) * 8]; part += v[i]; }
    red[tid] = part;
    __syncthreads();
    if (tid == 0) { float run = 0.f; for (int i = 255; i >= 0; i--) { float t = red[i]; red[i] = run; run += t; }
      float c = 0.f; for (int i = 0; i < 16; i++) { c += cn[i]; cn[i] = c; } }
    __syncthreads();
    float run = red[tid];
    for (int i = 3; i >= 0; i--) { suf[tid * 4 + i] = run; run += v[i]; }
  }
  __syncthreads();
  const float* CK = p.ck + (size_t)b * 1024 * 512 + h * 64; const float* CV = p.cv + (size_t)b * 1024 * 512 + h * 64;
  for (int pass = 0; pass < 2; pass++) {
    __syncthreads();
    for (int j = tid; j < 1040; j += 256) {
      float a[8];
#pragma unroll
      for (int qi = 0; qi < 8; qi++) a[qi] = 0.f;
      if (j < 1024) {
        const float4* kp = (const float4*)(CK + (size_t)j * 512);
#pragma unroll 4
        for (int i = 0; i < 16; i++) { float4 t = kp[i];
#pragma unroll
          for (int qi = 0; qi < 8; qi++) { const float* qq = fq + (pass * 8 + qi) * 64 + i * 4; a[qi] += qq[0] * t.x + qq[1] * t.y + qq[2] * t.z + qq[3] * t.w; } }
      } else {
        const float* kp = fk + (j - 1024) * 64;
#pragma unroll 4
        for (int i = 0; i < 64; i++) { float t = kp[i];
#pragma unroll
          for (int qi = 0; qi < 8; qi++) a[qi] += fq[(pass * 8 + qi) * 64 + i] * t; }
      }
#pragma unroll
      for (int qi = 0; qi < 8; qi++) { int q = pass * 8 + qi;
        float bias;
        if (j < 1024) bias = suf[j] + cn[q]; else { int m = j - 1024; bias = (m <= q) ? (cn[q] - cn[m]) : -INFINITY; }
        sc[qi * 1040 + j] = a[qi] + bias; }
    }
    __syncthreads();
    { int qi = tid >> 5, l32 = tid & 31; float m = -INFINITY;
      for (int j = l32; j < 1040; j += 32) m = fmaxf(m, sc[qi * 1040 + j]);
#pragma unroll
      for (int o = 16; o >= 1; o >>= 1) m = fmaxf(m, __shfl_xor(m, o));
      float s = 0.f;
      for (int j = l32; j < 1040; j += 32) { float e = __expf(sc[qi * 1040 + j] - m); sc[qi * 1040 + j] = e; s += e; }
#pragma unroll
      for (int o = 16; o >= 1; o >>= 1) s += __shfl_xor(s, o);
      if (l32 == 0) sL[qi] = s; }
    __syncthreads();
    { int qi = tid >> 5, d2 = (tid & 31) * 2; float a0 = 0.f, a1 = 0.f;
      for (int j = 0; j < 1024; j++) { float pj = sc[qi * 1040 + j]; float2 v = *(const float2*)(CV + (size_t)j * 512 + d2); a0 += pj * v.x; a1 += pj * v.y; }
      for (int m = 0; m < 16; m++) { float pj = sc[qi * 1040 + 1024 + m]; const float* r = hs + (size_t)m * NWP + 4096 + h * 64 + d2; a0 += pj * r[0]; a1 += pj * r[1]; }
      float inv = 1.f / sL[qi]; bfu* fo = (bfu*)(p.ws + OFF_FQ);
      *(unsigned*)(fo + (size_t)(TP + b * 16 + pass * 8 + qi) * 512 + h * 64 + d2) = pack2(a0 * inv, a1 * inv); }
  }
  __syncthreads();
}

DEV void phase3(const Params& p, int bid, int nb, char* smem) {
  const int tid = threadIdx.x;
  const float* U = (const float*)(p.ws + OFF_XB); bfu* SST = (bfu*)(p.ws + OFF_SST);
  for (int it = bid; it < 256 + 512; it += nb) {
    if (it < 256) { sample_item(p, it, smem); continue; }
    int g = (it - 256) * 256 + tid; int bh = g >> 13, e = g & 8191;
    float G = exp2f((float)RC * l2gamma(bh & 7));
    float s = 0.f;
    const float* Up = U + (size_t)bh * NCH * 8192 + e; bfu* Sp = SST + (size_t)bh * NCH * 8192 + e;
    Sp[0] = 0;
    for (int c0 = 0; c0 < NCH; c0 += 8) {
      float u[8];
#pragma unroll
      for (int i = 0; i < 8; i++) u[i] = Up[(size_t)(c0 + i) * 8192];
#pragma unroll
      for (int i = 0; i < 8; i++) { s = s * G + u[i]; if (c0 + i + 1 < NCH) Sp[(size_t)(c0 + i + 1) * 8192] = f2bf(s); }
    }
    int dv = e >> 6, dk = e & 63;
    p.out[O_SP + (size_t)bh * 8192 + dk * 128 + dv] = s;
  }
}

DEV void attn_item(const Params& p, int item, char* smem, float thr) {
  const int tid = threadIdx.x, lane = tid & 63, w = tid >> 6, r32 = lane & 31, hi = lane >> 5;
  const int bh = item >> 7, qt = 127 - (item & 127);
  const int b = bh >> 3, h = bh & 7;
  const int q0 = qt * 128;
  bfu* sK = (bfu*)smem;
  bfu* sV = sK + 64 * 72;
  float* sC = (float*)(sV + 64 * 72);
  const float* c2 = (const float*)(p.ws + OFF_C2) + (size_t)bh * SEQ;
  bfu* FQ = (bfu*)(p.ws + OFF_FQ);
  const bfu* FKB = (const bfu*)(p.ws + OFF_FKB) + (size_t)b * SEQ * 512 + h * 64;
  const bfu* FVT = (const bfu*)(p.ws + OFF_FVT) + (size_t)bh * 64 * SEQ;
  const int jd0 = q0 >> 6;
  int pred = 0;
  if (tid < jd0) pred = (c2[q0] - c2[tid * 64 + 63]) < -thr;
  const int jstart = __syncthreads_count(pred);
  const int qrow = q0 + w * 32 + r32;
  bf16x8 qf[4];
  const bfu* qp = FQ + (size_t)(b * SEQ + qrow) * 512 + h * 64 + hi * 8;
#pragma unroll
  for (int d0 = 0; d0 < 4; d0++) qf[d0] = *(const bf16x8*)(qp + d0 * 16);
  const float cq = c2[qrow];
  float m = -INFINITY, lsum = 0.f;
  f32x16 o0, o1;
#pragma unroll
  for (int r = 0; r < 16; r++) { o0[r] = 0.f; o1[r] = 0.f; }
  u32x4 rk0, rk1, rv0, rv1; float rc = 0.f;
  const int srow = tid >> 3, sch = tid & 7;
#define ATT_GLOAD(j_) do { \
    rk0 = *(const u32x4*)(FKB + (size_t)((j_) * 64 + srow) * 512 + sch * 8); \
    rk1 = *(const u32x4*)(FKB + (size_t)((j_) * 64 + srow + 32) * 512 + sch * 8); \
    rv0 = *(const u32x4*)(FVT + (size_t)srow * SEQ + (j_) * 64 + sch * 8); \
    rv1 = *(const u32x4*)(FVT + (size_t)(srow + 32) * SEQ + (j_) * 64 + sch * 8); \
    if (tid < 64) rc = c2[(j_) * 64 + tid]; } while (0)
  ATT_GLOAD(jstart);
  for (int j = jstart; j <= jd0 + 1; j++) {
    __syncthreads();
    *(u32x4*)(sK + srow * 72 + sch * 8) = rk0; *(u32x4*)(sK + (srow + 32) * 72 + sch * 8) = rk1;
    *(u32x4*)(sV + srow * 72 + sch * 8) = rv0; *(u32x4*)(sV + (srow + 32) * 72 + sch * 8) = rv1;
    if (tid < 64) sC[tid] = rc;
    __syncthreads();
    if (j < jd0 + 1) ATT_GLOAD(j + 1);
    if (j * 64 > q0 + w * 32 + 31) continue;
    f32x16 s0, s1;
#pragma unroll
    for (int r = 0; r < 16; r++) { s0[r] = 0.f; s1[r] = 0.f; }
#pragma unroll
    for (int d0 = 0; d0 < 4; d0++) {
      bf16x8 k0 = *(const bf16x8*)(sK + r32 * 72 + d0 * 16 + hi * 8);
      bf16x8 k1 = *(const bf16x8*)(sK + (32 + r32) * 72 + d0 * 16 + hi * 8);
      s0 = __builtin_amdgcn_mfma_f32_32x32x16_bf16(k0, qf[d0], s0, 0, 0, 0);
      s1 = __builtin_amdgcn_mfma_f32_32x32x16_bf16(k1, qf[d0], s1, 0, 0, 0);
    }
    const bool diag = (j >= jd0);
    const int kbase = j * 64 + 4 * hi;
    float mloc = -INFINITY;
#pragma unroll
    for (int g = 0; g < 4; g++) {
      float4 c0 = *(const float4*)(sC + 8 * g + 4 * hi), c1 = *(const float4*)(sC + 32 + 8 * g + 4 * hi);
      float cc0[4] = {c0.x, c0.y, c0.z, c0.w}, cc1[4] = {c1.x, c1.y, c1.z, c1.w};
#pragma unroll
      for (int e = 0; e < 4; e++) {
        int r = g * 4 + e;
        float a = s0[r] + (cq - cc0[e]), bb = s1[r] + (cq - cc1[e]);
        if (diag) { int key = kbase + 8 * g + e; if (key > qrow) a = -INFINITY; if (key + 32 > qrow) bb = -INFINITY; }
        s0[r] = a; s1[r] = bb; mloc = fmaxf(mloc, fmaxf(a, bb));
      }
    }
    mloc = fmaxf(mloc, __shfl_xor(mloc, 32));
    float mn = fmaxf(m, mloc);
    float alpha = __builtin_amdgcn_exp2f(m - mn);
    m = mn;
    float ps = 0.f;
#pragma unroll
    for (int r = 0; r < 16; r++) { s0[r] = __builtin_amdgcn_exp2f(s0[r] - mn); s1[r] = __builtin_amdgcn_exp2f(s1[r] - mn); ps += s0[r] + s1[r]; }
    lsum = lsum * alpha + ps;
#pragma unroll
    for (int r = 0; r < 16; r++) { o0[r] *= alpha; o1[r] *= alpha; }
#pragma unroll
    for (int ks = 0; ks < 4; ks++) {
      union { bf16x8 v; unsigned u[4]; } pf;
#pragma unroll
      for (int e = 0; e < 4; e++) {
        int r = (ks & 1) * 8 + 2 * e;
        pf.u[e] = (ks < 2) ? pack2(s0[r], s0[r + 1]) : pack2(s1[r], s1[r + 1]);
      }
#pragma unroll
      for (int db = 0; db < 2; db++) {
        const bfu* vp = sV + (db * 32 + r32) * 72 + ks * 16 + 4 * hi;
        union { bf16x8 v; uint2 u[2]; } vf;
        vf.u[0] = *(const uint2*)vp; vf.u[1] = *(const uint2*)(vp + 8);
        if (db == 0) o0 = __builtin_amdgcn_mfma_f32_32x32x16_bf16(vf.v, pf.v, o0, 0, 0, 0);
        else o1 = __builtin_amdgcn_mfma_f32_32x32x16_bf16(vf.v, pf.v, o1, 0, 0, 0);
      }
    }
  }
  float lt = lsum + __shfl_xor(lsum, 32);
  float inv = 1.f / lt;
  bfu* op = FQ + (size_t)(b * SEQ + qrow) * 512 + h * 64;
#pragma unroll
  for (int g = 0; g < 4; g++) {
    *(uint2*)(op + 8 * g + 4 * hi) = make_uint2(pack2(o0[g * 4] * inv, o0[g * 4 + 1] * inv), pack2(o0[g * 4 + 2] * inv, o0[g * 4 + 3] * inv));
    *(uint2*)(op + 32 + 8 * g + 4 * hi) = make_uint2(pack2(o1[g * 4] * inv, o1[g * 4 + 1] * inv), pack2(o1[g * 4 + 2] * inv, o1[g * 4 + 3] * inv));
  }
  __syncthreads();
}

DEV void r3_item(const Params& p, int item, char* smem) {
  const int tid = threadIdx.x, lane = tid & 63, w = tid >> 6, wr = w >> 1, wc = w & 1, l16 = lane & 15, quad = lane >> 4;
  const int bh = item / NCH, c = item - bh * NCH; const int b = bh >> 3, h = bh & 7;
  bfu* sQ = (bfu*)smem; bfu* sK = sQ + 128 * 72; bfu* sP = sK + 128 * 72; float* sRed = (float*)(sP + 128 * 136);
  const size_t row0 = (size_t)b * SEQ + c * RC;
  const bfu* Q = (const bfu*)(p.ws + OFF_QT) + row0 * 512 + h * 64;
  const bfu* Kk = (const bfu*)(p.ws + OFF_KT) + row0 * 512 + h * 64;
  const bfu* vT = (const bfu*)(p.ws + OFF_VT) + (size_t)bh * 128 * SEQ + c * RC;
  const bfu* ST = (const bfu*)(p.ws + OFF_SST) + (size_t)item * 8192;
  u32x4 ra[4], rb[4];
  g2r<128>(Q, 512, ra); g2r<128>(Kk, 512, rb);
  __syncthreads();
  r2s<128>(sQ, ra); r2s<128>(sK, rb);
  __syncthreads();
  g2r<128>(vT, SEQ, rb);
  f32x4 acc[4][4];
#pragma unroll
  for (int i = 0; i < 4; i++)
#pragma unroll
    for (int j = 0; j < 4; j++) acc[i][j] = f32x4{0.f, 0.f, 0.f, 0.f};
  mma64<4, 4>(sQ, 72, sK, 72, acc);
#pragma unroll
  for (int mi = 0; mi < 4; mi++)
#pragma unroll
    for (int ni = 0; ni < 4; ni++)
#pragma unroll
      for (int j = 0; j < 4; j++) {
        int row = wr * 64 + mi * 16 + quad * 4 + j, col = wc * 64 + ni * 16 + l16;
        sP[row * 136 + col] = (col <= row) ? f2bf(acc[mi][ni][j]) : (bfu)0;
      }
#pragma unroll
  for (int i = 0; i < 4; i++)
#pragma unroll
    for (int j = 0; j < 4; j++) acc[i][j] = f32x4{0.f, 0.f, 0.f, 0.f};
  __syncthreads();
  r2s<128>(sK, rb);
  __syncthreads();
  g2r<128>(vT + 64, SEQ, rb);
  mma64<4, 4>(sP, 136, sK, 72, acc);
  __syncthreads();
  r2s<128>(sK, rb);
  __syncthreads();
  g2r<128>(ST, 64, rb);
  mma64<4, 4>(sP + 64, 136, sK, 72, acc);
  __syncthreads();
  r2s<128>(sK, rb);
  __syncthreads();
  mma64<4, 4>(sQ, 72, sK, 72, acc);
  float ssq[4][4];
#pragma unroll
  for (int mi = 0; mi < 4; mi++)
#pragma unroll
    for (int j = 0; j < 4; j++) { float s = 0.f;
#pragma unroll
      for (int ni = 0; ni < 4; ni++) s += acc[mi][ni][j] * acc[mi][ni][j];
      s = sum16(s); ssq[mi][j] = s;
      if (l16 == 0) sRed[(wr * 64 + mi * 16 + quad * 4 + j) * 2 + wc] = s; }
  __syncthreads();
  bfu* RG = (bfu*)(p.ws + OFF_RG);
  float gg[4];
#pragma unroll
  for (int ni = 0; ni < 4; ni++) gg[ni] = p.gn_g[h * 128 + wc * 64 + ni * 16 + l16];
#pragma unroll
  for (int mi = 0; mi < 4; mi++)
#pragma unroll
    for (int j = 0; j < 4; j++) {
      int row = wr * 64 + mi * 16 + quad * 4 + j;
      float tot = sRed[row * 2] + sRed[row * 2 + 1];
      float r = rsqrtf(tot * (1.f / 128.f) + EPSN);
#pragma unroll
      for (int ni = 0; ni < 4; ni++) {
        size_t o = (row0 + row) * DM + h * 128 + wc * 64 + ni * 16 + l16;
        float rgv = bf2f(RG[o]);
        RG[o] = f2bf(acc[mi][ni][j] * r * gg[ni] * (rgv * sigmoidf_(rgv)));
      }
    }
  __syncthreads();
}

DEV void phase4(const Params& p, int bid, int nb, char* smem) {
  float gq = 0.f, gk = 0.f;
  for (int i = 0; i < 64; i++) { gq = fmaxf(gq, fabsf(p.fq_g[i])); gk = fmaxf(gk, fabsf(p.fk_g[i])); }
  const float thr = 2.f * (8.f * gq * gk * 1.03f * LOG2E) + 44.f;
  for (int it = bid; it < 2048 + 16 * NCH; it += nb) {
    if (it < 2048) attn_item(p, it, smem, thr); else r3_item(p, it - 2048, smem);
  }
}

DEV void phase5(const Params& p, int bid, int nb, char* smem) {
  const int tid = threadIdx.x, lane = tid & 63, w = tid >> 6, wr = w >> 1, wc = w & 1, l16 = lane & 15, quad = lane >> 4;
  bfu* sA = (bfu*)smem; bfu* sB = sA + 128 * 72;
  const bfu* G = (const bfu*)(p.ws + OFF_RG); const bfu* FO = (const bfu*)(p.ws + OFF_FQ);
  const bfu* WR = (const bfu*)(p.ws + OFF_WRT); const bfu* WF = (const bfu*)(p.ws + OFF_WFT);
  bfu* MX = (bfu*)(p.ws + OFF_XB);
  constexpr int NG = (TT / 128) * 8, NCV = 8192;
  for (int it = NG + bid; it < NG + NCV; it += nb) {
    {
      int r = (it - NG) * 4 + w;
      const float* src = r < 16384 ? p.peer_u + (size_t)r * DM : p.peer_v + (size_t)(r - 16384) * DM;
      float4 v0 = *(const float4*)(src + lane * 16), v1 = *(const float4*)(src + lane * 16 + 4), v2 = *(const float4*)(src + lane * 16 + 8), v3 = *(const float4*)(src + lane * 16 + 12);
      float am = fmaxf(fmaxf(fmaxf(fabsf(v0.x), fabsf(v0.y)), fmaxf(fabsf(v0.z), fabsf(v0.w))), fmaxf(fmaxf(fabsf(v1.x), fabsf(v1.y)), fmaxf(fabsf(v1.z), fabsf(v1.w))));
      am = fmaxf(am, fmaxf(fmaxf(fmaxf(fabsf(v2.x), fabsf(v2.y)), fmaxf(fabsf(v2.z), fabsf(v2.w))), fmaxf(fmaxf(fabsf(v3.x), fabsf(v3.y)), fmaxf(fabsf(v3.z), fabsf(v3.w)))));
#pragma unroll
      for (int o = 32; o >= 1; o >>= 1) am = fmaxf(am, __shfl_xor(am, o));
      float sc = am > 0.f ? 440.f / am : 1.f;
      int w0 = __builtin_amdgcn_cvt_pk_fp8_f32(v0.x * sc, v0.y * sc, 0, false); w0 = __builtin_amdgcn_cvt_pk_fp8_f32(v0.z * sc, v0.w * sc, w0, true);
      int w1 = __builtin_amdgcn_cvt_pk_fp8_f32(v1.x * sc, v1.y * sc, 0, false); w1 = __builtin_amdgcn_cvt_pk_fp8_f32(v1.z * sc, v1.w * sc, w1, true);
      int w2 = __builtin_amdgcn_cvt_pk_fp8_f32(v2.x * sc, v2.y * sc, 0, false); w2 = __builtin_amdgcn_cvt_pk_fp8_f32(v2.z * sc, v2.w * sc, w2, true);
      int w3 = __builtin_amdgcn_cvt_pk_fp8_f32(v3.x * sc, v3.y * sc, 0, false); w3 = __builtin_amdgcn_cvt_pk_fp8_f32(v3.z * sc, v3.w * sc, w3, true);
      uint4* dst = (uint4*)(p.ws + (r < 16384 ? OFF_PUB : OFF_PVB)) + (size_t)(r & 16383) * 64 + lane;
      *dst = make_uint4((unsigned)w0, (unsigned)w1, (unsigned)w2, (unsigned)w3);
      if (lane == 0) ((float*)(p.ws + OFF_PSC))[r] = am > 0.f ? am / 440.f : 1.f;
    }
  }
  for (int it = bid; it < NG; it += nb) {
    int mt = it >> 3, nt = it & 7; int m0 = mt * 128, n0 = nt * 128;
    f32x4 a1[4][4];
#pragma unroll
    for (int i = 0; i < 4; i++)
#pragma unroll
      for (int j = 0; j < 4; j++) a1[i][j] = f32x4{0.f, 0.f, 0.f, 0.f};
    gemm_loop<4, 4>(G + (size_t)m0 * DM, DM, WR + (size_t)n0 * DM, DM, DM, a1, sA);
    const bfu *ga, *gb;
    if (m0 < TP) { ga = (const bfu*)(p.out + O_YP) + (size_t)m0 * DM + n0; gb = ga + (size_t)TP * DM; }
    else { ga = (const bfu*)(p.out + O_YS) + (size_t)(m0 - TP) * DM + n0; gb = ga + (size_t)TS * DM; }
    bfu* mxT = MX + (size_t)m0 * DM + n0;
    unsigned loff = (unsigned)((wr * 64 + quad * 4) * DM + wc * 64 + l16); asm volatile("" : "+v"(loff));
#pragma unroll
    for (int mi = 0; mi < 4; mi++)
#pragma unroll
      for (int ni = 0; ni < 4; ni++) {
#pragma unroll
        for (int j = 0; j < 4; j++) { unsigned o = loff + (unsigned)((mi * 16 + j) * DM + ni * 16);
          mxT[o] = f2bf(sigmoidf_(bf2f(ga[o])) * a1[mi][ni][j]); }
        a1[mi][ni] = f32x4{0.f, 0.f, 0.f, 0.f};
        __builtin_amdgcn_sched_barrier(0);
      }
    gemm_loop<4, 4>(FO + (size_t)m0 * 512, 512, WF + (size_t)n0 * 512, 512, 512, a1, sA);
    unsigned loff2 = loff; asm volatile("" : "+v"(loff2));
#pragma unroll
    for (int mi = 0; mi < 4; mi++)
#pragma unroll
      for (int ni = 0; ni < 4; ni++) {
#pragma unroll
        for (int j = 0; j < 4; j++) { unsigned o = loff2 + (unsigned)((mi * 16 + j) * DM + ni * 16);
          mxT[o] = f2bf(bf2f(mxT[o]) + sigmoidf_(bf2f(gb[o])) * a1[mi][ni][j]); }
        __builtin_amdgcn_sched_barrier(0);
      }
  }
}

DEV void phase6(const Params& p, int bid, int nb, char* smem) {
  const int tid = threadIdx.x, lane = tid & 63, w = tid >> 6, wr = w >> 1, wc = w & 1, l16 = lane & 15, quad = lane >> 4;
  bfu* sA = (bfu*)smem; bfu* sB = sA + 128 * 72;
  const bfu* MX = (const bfu*)(p.ws + OFF_XB); const bfu* WO = (const bfu*)(p.ws + OFF_WOT);
  bfu* X1B = (bfu*)(p.ws + OFF_X1B); float* SSQ2 = (float*)(p.ws + OFF_SSQ2);
  constexpr int NG = (TT / 128) * 8;
  for (int it = bid; it < NG; it += nb) {
    int mt = it >> 3, nt = it & 7; int m0 = mt * 128, n0 = nt * 128;
    f32x4 acc[4][4];
#pragma unroll
    for (int i = 0; i < 4; i++)
#pragma unroll
      for (int j = 0; j < 4; j++) acc[i][j] = f32x4{0.f, 0.f, 0.f, 0.f};
    gemm_loop<4, 4>(MX + (size_t)m0 * DM, DM, WO + (size_t)n0 * DM, DM, DM, acc, sA);
    const float* xin = (m0 < TP ? p.x_p + (size_t)m0 * DM : p.x_s + (size_t)(m0 - TP) * DM) + n0;
    float* y = (m0 < TP ? p.out + O_YP + (size_t)m0 * DM : p.out + O_YS + (size_t)(m0 - TP) * DM) + n0;
    bfu* xb1 = X1B + (size_t)m0 * DM + n0;
    unsigned loff = (unsigned)((wr * 64 + quad * 4) * DM + wc * 64 + l16); asm volatile("" : "+v"(loff));
#pragma unroll
    for (int mi = 0; mi < 4; mi++)
#pragma unroll
      for (int j = 0; j < 4; j++) {
        int lr = wr * 64 + mi * 16 + quad * 4 + j; float ss = 0.f;
#pragma unroll
        for (int ni = 0; ni < 4; ni++) {
          unsigned o = loff + (unsigned)((mi * 16 + j) * DM + ni * 16);
          float v = xin[o] + acc[mi][ni][j];
          y[o] = v; xb1[o] = f2bf(v); ss += v * v;
        }
        ss = sum16(ss);
        if (l16 == 0) SSQ2[(size_t)(m0 + lr) * 16 + nt * 2 + wc] = ss;
      }
  }
}

DEV int fkey(float x, int idx, int mask) { int b = __float_as_int(x); b ^= (b >> 31) & 0x7fffffff; return (b & ~mask) | idx; }
DEV void ins16(int (&t)[16], int v) {
#pragma unroll
  for (int s = 0; s < 16; s++) { int hi = max(t[s], v); v = min(t[s], v); t[s] = hi; }
}

DEV void phase7(const Params& p, int bid, int nb, char* smem) {
  const int tid = threadIdx.x, lane = tid & 63, w = tid >> 6, wr = w >> 1, wc = w & 1, l16 = lane & 15, quad = lane >> 4;
  bfu* sA = (bfu*)smem;
  float* sS = (float*)smem;
  int* sL = (int*)(smem + 33024);
  float* sTV = (float*)(smem + 55296);
  int* sTI = (int*)(sTV + 2 * 64 * 17);
  const bfu* X1B = (const bfu*)(p.ws + OFF_X1B); const bfu* MT = (const bfu*)(p.ws + OFF_MT);
  const float* SSQ2 = (const float*)(p.ws + OFF_SSQ2);
  int2* ROUTE = (int2*)(p.ws + OFF_ROUTE);
  constexpr int NI7 = (TT / 64) * 8;
  for (int it = bid; it < NI7; it += nb) {
    int mt = it >> 3, h = it & 7; int m0 = mt * 64;
    for (int half = 0; half < 2; half++) {
      f32x4 acc[2][4];
#pragma unroll
      for (int i = 0; i < 2; i++)
#pragma unroll
        for (int j = 0; j < 4; j++) acc[i][j] = f32x4{0.f, 0.f, 0.f, 0.f};
      gemm_loop<2, 4>(X1B + (size_t)m0 * DM, DM, MT + (size_t)(h * 256 + half * 128) * DM, DM, DM, acc, sA);
      __syncthreads();
#pragma unroll
      for (int mi = 0; mi < 2; mi++)
#pragma unroll
        for (int j = 0; j < 4; j++) {
          int lr = wr * 32 + mi * 16 + quad * 4 + j;
          const float* sp = SSQ2 + (size_t)(m0 + lr) * 16; float tot = 0.f;
#pragma unroll
          for (int i = 0; i < 16; i++) tot += sp[i];
          float rs = rsqrtf(tot * (1.f / DM) + EPSN);
#pragma unroll
          for (int ni = 0; ni < 4; ni++) sS[lr * 129 + wc * 64 + ni * 16 + l16] = acc[mi][ni][j] * rs;
        }
      __syncthreads();
      { int row = tid & 63, q = tid >> 6; int t[16];
#pragma unroll
        for (int s = 0; s < 16; s++) t[s] = (int)0x80000000;
        for (int i = 0; i < 32; i++) { int idx = q * 32 + i; ins16(t, fkey(sS[row * 129 + idx], idx, 127)); }
#pragma unroll
        for (int s = 0; s < 16; s++) sL[row * 65 + q * 16 + s] = t[s]; }
      __syncthreads();
      if (tid < 64) { int row = tid; int p0 = 0, p1 = 0, p2 = 0, p3 = 0; const int* L = sL + row * 65;
        for (int r = 0; r < 16; r++) {
          int a0 = L[p0], a1 = L[16 + p1], a2 = L[32 + p2], a3 = L[48 + p3];
          int mx = max(max(a0, a1), max(a2, a3));
          if (mx == a0) p0++; else if (mx == a1) p1++; else if (mx == a2) p2++; else p3++;
          int idx = mx & 127;
          sTV[(half * 64 + row) * 17 + r] = sS[row * 129 + idx]; sTI[(half * 64 + row) * 17 + r] = idx; } }
      __syncthreads();
    }
    if (tid < 64) {
      int row = tid; float v1[16], v2[16];
#pragma unroll
      for (int i = 0; i < 16; i++) { v1[i] = sTV[row * 17 + i]; v2[i] = sTV[(64 + row) * 17 + i]; }
      int t[16];
#pragma unroll
      for (int s = 0; s < 16; s++) t[s] = (int)0x80000000;
#pragma unroll
      for (int i = 0; i < 16; i++)
#pragma unroll
        for (int j = 0; j < 16; j++)
          if ((i + 1) * (j + 1) <= 16) ins16(t, fkey(v1[i] + v2[j], i * 16 + j, 255));
      float es[16]; int ei[16]; float mx = 0.f, sum = 0.f;
#pragma unroll
      for (int r = 0; r < 16; r++) { int c = t[r] & 255; int i = c >> 4, j = c & 15;
        float s = sTV[row * 17 + i] + sTV[(64 + row) * 17 + j];
        ei[r] = sTI[row * 17 + i] * 128 + sTI[(64 + row) * 17 + j];
        if (r == 0) mx = s;
        es[r] = __expf(s - mx); sum += es[r]; }
      float inv = 1.f / sum;
      int2* ro = ROUTE + ((size_t)(m0 + row) * 8 + h) * 16;
#pragma unroll
      for (int r = 0; r < 16; r++) ro[r] = make_int2(ei[r], __float_as_int(es[r] * inv));
    }
    __syncthreads();
  }
}

DEV float dot16_fp8(const u32x4& u, const float (&xn)[16]) {
  f32x2 a;
  float d;
  a = __builtin_amdgcn_cvt_pk_f32_fp8((int)u.x, false); d = a[0] * xn[0] + a[1] * xn[1];
  a = __builtin_amdgcn_cvt_pk_f32_fp8((int)u.x, true); d += a[0] * xn[2] + a[1] * xn[3];
  a = __builtin_amdgcn_cvt_pk_f32_fp8((int)u.y, false); d += a[0] * xn[4] + a[1] * xn[5];
  a = __builtin_amdgcn_cvt_pk_f32_fp8((int)u.y, true); d += a[0] * xn[6] + a[1] * xn[7];
  a = __builtin_amdgcn_cvt_pk_f32_fp8((int)u.z, false); d += a[0] * xn[8] + a[1] * xn[9];
  a = __builtin_amdgcn_cvt_pk_f32_fp8((int)u.z, true); d += a[0] * xn[10] + a[1] * xn[11];
  a = __builtin_amdgcn_cvt_pk_f32_fp8((int)u.w, false); d += a[0] * xn[12] + a[1] * xn[13];
  a = __builtin_amdgcn_cvt_pk_f32_fp8((int)u.w, true); d += a[0] * xn[14] + a[1] * xn[15];
  return d;
}
DEV void axpy16_fp8(const u32x4& u, float wj, float (&acc)[16]) {
  f32x2 a;
  a = __builtin_amdgcn_cvt_pk_f32_fp8((int)u.x, false); acc[0] += wj * a[0]; acc[1] += wj * a[1];
  a = __builtin_amdgcn_cvt_pk_f32_fp8((int)u.x, true); acc[2] += wj * a[0]; acc[3] += wj * a[1];
  a = __builtin_amdgcn_cvt_pk_f32_fp8((int)u.y, false); acc[4] += wj * a[0]; acc[5] += wj * a[1];
  a = __builtin_amdgcn_cvt_pk_f32_fp8((int)u.y, true); acc[6] += wj * a[0]; acc[7] += wj * a[1];
  a = __builtin_amdgcn_cvt_pk_f32_fp8((int)u.z, false); acc[8] += wj * a[0]; acc[9] += wj * a[1];
  a = __builtin_amdgcn_cvt_pk_f32_fp8((int)u.z, true); acc[10] += wj * a[0]; acc[11] += wj * a[1];
  a = __builtin_amdgcn_cvt_pk_f32_fp8((int)u.w, false); acc[12] += wj * a[0]; acc[13] += wj * a[1];
  a = __builtin_amdgcn_cvt_pk_f32_fp8((int)u.w, true); acc[14] += wj * a[0]; acc[15] += wj * a[1];
}
template <int S>
DEV void red_step(float (&pp)[16], int lane) {
  const bool up = (lane & S) != 0;
#pragma unroll
  for (int i = 0; i < S; i++) {
    float send = up ? pp[i] : pp[i + S];
    float keep = up ? pp[i + S] : pp[i];
    pp[i] = keep + __shfl_xor(send, S);
  }
}
DEV float reduce16(float (&pp)[16], int lane) {
  red_step<8>(pp, lane); red_step<4>(pp, lane); red_step<2>(pp, lane); red_step<1>(pp, lane);
  float v = pp[0];
  v += __shfl_xor(v, 16); v += __shfl_xor(v, 32);
  return v;
}

DEV void phase8(const Params& p, int bid, int nb, char* smem) {
  const int tid = threadIdx.x, lane = tid & 63, w = __builtin_amdgcn_readfirstlane(tid >> 6);
  const u32x4* PUB = (const u32x4*)(p.ws + OFF_PUB); const u32x4* PVB = (const u32x4*)(p.ws + OFF_PVB);
  const float* PSC = (const float*)(p.ws + OFF_PSC);
  const float* SSQ2 = (const float*)(p.ws + OFF_SSQ2); const int2* ROUTE = (const int2*)(p.ws + OFF_ROUTE);
  for (int it = bid; it < TT / 4; it += nb) {
    int tok = it * 4 + w;
    float* y = tok < TP ? p.out + O_YP + (size_t)tok * DM : p.out + O_YS + (size_t)(tok - TP) * DM;
    float x[16], xn[16];
    { float4 a0 = *(const float4*)(y + lane * 16), a1 = *(const float4*)(y + lane * 16 + 4), b0 = *(const float4*)(y + lane * 16 + 8), b1 = *(const float4*)(y + lane * 16 + 12);
      x[0] = a0.x; x[1] = a0.y; x[2] = a0.z; x[3] = a0.w; x[4] = a1.x; x[5] = a1.y; x[6] = a1.z; x[7] = a1.w;
      x[8] = b0.x; x[9] = b0.y; x[10] = b0.z; x[11] = b0.w; x[12] = b1.x; x[13] = b1.y; x[14] = b1.z; x[15] = b1.w; }
    float tot = 0.f;
    { const float* sp = SSQ2 + (size_t)tok * 16;
#pragma unroll
      for (int i = 0; i < 16; i++) tot += sp[i]; }
    float rs = rsqrtf(tot * (1.f / DM) + EPSN);
#pragma unroll
    for (int i = 0; i < 16; i++) xn[i] = x[i] * rs * p.norm2_g[lane * 16 + i];
    const int2* rt = ROUTE + (size_t)tok * 128;
    int2 r0 = rt[lane], r1 = rt[lane + 64];
    float d0 = 0.f, d1 = 0.f;
#pragma unroll 1
    for (int g = 0; g < 4; g++) {
      float pp[16]; u32x4 u[16];
#pragma unroll
      for (int jj = 0; jj < 16; jj++) { int e = __builtin_amdgcn_readlane(r0.x, g * 16 + jj); u[jj] = PUB[(size_t)e * 64 + lane]; }
      __builtin_amdgcn_sched_barrier(0);
#pragma unroll
      for (int jj = 0; jj < 16; jj++) pp[jj] = dot16_fp8(u[jj], xn);
      float v = reduce16(pp, lane);
      if ((lane >> 4) == g) d0 = v;
    }
#pragma unroll 1
    for (int g = 0; g < 4; g++) {
      float pp[16]; u32x4 u[16];
#pragma unroll
      for (int jj = 0; jj < 16; jj++) { int e = __builtin_amdgcn_readlane(r1.x, g * 16 + jj); u[jj] = PUB[(size_t)e * 64 + lane]; }
      __builtin_amdgcn_sched_barrier(0);
#pragma unroll
      for (int jj = 0; jj < 16; jj++) pp[jj] = dot16_fp8(u[jj], xn);
      float v = reduce16(pp, lane);
      if ((lane >> 4) == g) d1 = v;
    }
    d0 *= PSC[r0.x]; d1 *= PSC[r1.x];
    const float w0 = 0.5f * d0 * (1.f + erff(d0 * 0.70710678118654752f)) * __int_as_float(r0.y) * PSC[16384 + r0.x];
    const float w1 = 0.5f * d1 * (1.f + erff(d1 * 0.70710678118654752f)) * __int_as_float(r1.y) * PSC[16384 + r1.x];
    float acc[16];
#pragma unroll
    for (int i = 0; i < 16; i++) acc[i] = 0.f;
#pragma unroll 1
    for (int g = 0; g < 8; g++) {
      const int rx = g < 4 ? r0.x : r1.x; const int wx = __float_as_int(g < 4 ? w0 : w1);
      u32x4 u[16];
#pragma unroll
      for (int jj = 0; jj < 16; jj++) { int e = __builtin_amdgcn_readlane(rx, (g & 3) * 16 + jj); u[jj] = PVB[(size_t)e * 64 + lane]; }
      __builtin_amdgcn_sched_barrier(0);
#pragma unroll
      for (int jj = 0; jj < 16; jj++) { float wj = __int_as_float(__builtin_amdgcn_readlane(wx, (g & 3) * 16 + jj)); axpy16_fp8(u[jj], wj, acc); }
    }
    *(float4*)(y + lane * 16) = make_float4(x[0] + acc[0], x[1] + acc[1], x[2] + acc[2], x[3] + acc[3]);
    *(float4*)(y + lane * 16 + 4) = make_float4(x[4] + acc[4], x[5] + acc[5], x[6] + acc[6], x[7] + acc[7]);
    *(float4*)(y + lane * 16 + 8) = make_float4(x[8] + acc[8], x[9] + acc[9], x[10] + acc[10], x[11] + acc[11]);
    *(float4*)(y + lane * 16 + 12) = make_float4(x[12] + acc[12], x[13] + acc[13], x[14] + acc[14], x[15] + acc[15]);
  }
}

__global__ void __launch_bounds__(256, 2) fwd_kernel(Params p, int ph_lo, int ph_hi, int coop) {
  __shared__ __attribute__((aligned(16))) char smem[SMEM_BYTES];
  const int bid = blockIdx.x, nb = gridDim.x;
#ifndef REPS
#define REPS {1,1,1,1,1,1,1,1,1}
#endif
  constexpr int REP[9] = REPS;
#define RUN_PHASE(N) if (ph_lo <= N && N <= ph_hi) { for (int r_ = 0; r_ < REP[N]; r_++) phase##N(p, bid, nb, smem); if (coop && N < ph_hi) cg::this_grid().sync(); }
  RUN_PHASE(0) RUN_PHASE(1) RUN_PHASE(2) RUN_PHASE(3) RUN_PHASE(4) RUN_PHASE(5) RUN_PHASE(6) RUN_PHASE(7) RUN_PHASE(8)
}

extern "C" void kernel_launch(void* const* d_in, const int* in_sizes, int n_in, void* d_out, int out_size,
                              void* d_ws, size_t ws_size, hipStream_t stream) {
  if (ws_size < WS_NEED) { fprintf(stderr, "workspace too small\n"); return; }
  static int grid_blocks = 0;
  if (!grid_blocks) {
    int dev = 0, cus = 0, per_cu = 0;
    hipGetDevice(&dev);
    hipDeviceGetAttribute(&cus, hipDeviceAttributeMultiprocessorCount, dev);
    hipOccupancyMaxActiveBlocksPerMultiprocessor(&per_cu, fwd_kernel, 256, 0);
    if (per_cu < 1) per_cu = 1;
    if (per_cu > 2) per_cu = 2;
    grid_blocks = cus * per_cu;
  }
  Params p{};
  const float* const* in = (const float* const*)d_in;
  p.x_p = in[0]; p.x_s = in[1]; p.state_ret = in[2]; p.ck = in[3]; p.cv = in[4]; p.clogf = in[5]; p.norm1_g = in[6];
  p.w_in = in[7]; p.b_f = in[8]; p.fq_g = in[9]; p.fk_g = in[10]; p.gn_g = in[11]; p.w_ret_out = in[12]; p.w_fox_out = in[13];
  p.w_o = in[14]; p.norm2_g = in[15]; p.peer_wq = in[16]; p.k1 = in[17]; p.k2 = in[18]; p.peer_u = in[19]; p.peer_v = in[20];
  p.out = (float*)d_out; p.ws = (char*)d_ws;
#ifndef MULTI_LAUNCH
#define MULTI_LAUNCH 0
#endif
#if MULTI_LAUNCH
  for (int ph = 0; ph <= 8; ph++) fwd_kernel<<<grid_blocks, 256, 0, stream>>>(p, ph, ph, 0);
#else
  int lo = 0, hi = 8, coop = 1;
  void* args[] = {&p, &lo, &hi, &coop};
  hipError_t e = hipLaunchCooperativeKernel((void*)fwd_kernel, dim3(grid_blocks), dim3(256), args, 0, stream);
  if (e != hipSuccess) fprintf(stderr, "cooperative launch failed: %s (grid %d)\n", hipGetErrorString(e), grid_blocks);
#endif
}
```

```cpp
#include <hip/hip_runtime.h>
#include <hip/hip_cooperative_groups.h>
#include <stdint.h>
#include <stdio.h>
namespace cg = cooperative_groups;

#define DEV __device__ __forceinline__
typedef unsigned short bfu;
typedef __attribute__((ext_vector_type(8))) short bf16x8;
typedef __attribute__((ext_vector_type(4))) short bf16x4;
typedef __attribute__((ext_vector_type(4))) float f32x4;
typedef __attribute__((ext_vector_type(16))) float f32x16;
typedef __attribute__((ext_vector_type(4))) unsigned u32x4;
typedef __attribute__((ext_vector_type(2))) float f32x2;

constexpr int DM = 1024, SEQ = 16384, TP = 32768, TS = 512, TT = 33280;
constexpr int NWP = 6784;
constexpr int RC = 128;
constexpr int NCH = SEQ / RC;
constexpr float LOG2E = 1.4426950408889634f;
constexpr float EPSN = 1e-6f;

constexpr size_t O_YP = 0, O_YS = 33554432, O_SP = 34078720, O_FKP = 34209792, O_FVP = 50987008,
                 O_LFP = 67764224, O_SS = 68026368, O_FKS = 70123520, O_FVS = 70385664, O_LFS = 70647808;
constexpr size_t MiB = 1u << 20;
constexpr size_t OFF_XB = 0;
constexpr size_t OFF_WINT = 66 * MiB, OFF_WRT = 80 * MiB, OFF_WFT = 82 * MiB, OFF_WOT = 83 * MiB, OFF_MT = 85 * MiB;
constexpr size_t OFF_RSTD1 = 89 * MiB, OFF_C2 = 90 * MiB, OFF_HS = 91 * MiB;
constexpr size_t OFF_QT = 105 * MiB, OFF_KT = 137 * MiB, OFF_KTT = 169 * MiB, OFF_VT = 201 * MiB;
constexpr size_t OFF_X1B = OFF_QT, OFF_ROUTE = 171 * MiB, OFF_SSQ2 = 204 * MiB, OFF_PSC = 208 * MiB;
constexpr size_t OFF_RG = 265 * MiB, OFF_FQ = 331 * MiB, OFF_FKB = 364 * MiB, OFF_FVT = 396 * MiB;
constexpr size_t OFF_PUB = OFF_FKB, OFF_PVB = OFF_FVT, OFF_SST = 428 * MiB;
constexpr size_t WS_NEED = 460 * MiB;

constexpr int SMEM_BYTES = 75776;

struct Params {
  const float *x_p, *x_s, *state_ret, *ck, *cv, *clogf, *norm1_g, *w_in, *b_f, *fq_g, *fk_g, *gn_g,
      *w_ret_out, *w_fox_out, *w_o, *norm2_g, *peer_wq, *k1, *k2, *peer_u, *peer_v;
  float* out;
  char* ws;
};

DEV bfu f2bf(float f) { unsigned u = __float_as_uint(f); u += 0x7fffu + ((u >> 16) & 1u); return (bfu)(u >> 16); }
DEV float bf2f(bfu b) { return __uint_as_float(((unsigned)b) << 16); }
DEV unsigned pack2(float a, float b) { return (unsigned)f2bf(a) | ((unsigned)f2bf(b) << 16); }
DEV float bflo(unsigned u) { return __uint_as_float(u << 16); }
DEV float bfhi(unsigned u) { return __uint_as_float(u & 0xffff0000u); }
DEV float sigmoidf_(float z) { return 1.f / (1.f + __expf(-z)); }
DEV float l2gamma(int h) { return log2f(1.f - exp2f(-5.f - (float)h)); }
DEV float wave_sum(float v) {
#pragma unroll
  for (int o = 32; o >= 1; o >>= 1) v += __shfl_xor(v, o);
  return v;
}
DEV float sum16(float v) {
  v += __shfl_xor(v, 1); v += __shfl_xor(v, 2); v += __shfl_xor(v, 4); v += __shfl_xor(v, 8);
  return v;
}

template <int ROWS>
DEV void g2r(const bfu* g, int ld, u32x4 (&r)[ROWS / 32], int tid_ = threadIdx.x) {
#pragma unroll
  for (int i = 0; i < ROWS / 32; i++) {
    int id = tid_ + i * 256; int row = id >> 3, ch = id & 7;
    const unsigned off = (unsigned)(row * ld + ch * 8);
    r[i] = *(const u32x4*)(g + off);
  }
}
template <int ROWS>
DEV void r2s(bfu* s, const u32x4 (&r)[ROWS / 32], int tid_ = threadIdx.x) {
#pragma unroll
  for (int i = 0; i < ROWS / 32; i++) {
    int id = tid_ + i * 256; int row = id >> 3, ch = id & 7;
    *(u32x4*)(s + row * 72 + ch * 8) = r[i];
  }
}
template <int MI, int NI>
DEV void mma64(const bfu* sA, int sldA, const bfu* sB, int sldB, f32x4 (&acc)[MI][NI]) {
  const int lane = threadIdx.x & 63, w = threadIdx.x >> 6, wr = w >> 1, wc = w & 1, l16 = lane & 15, quad = lane >> 4;
#pragma unroll
  for (int kk = 0; kk < 2; kk++) {
    bf16x8 a[MI], b[NI];
#pragma unroll
    for (int mi = 0; mi < MI; mi++) a[mi] = *(const bf16x8*)(sA + (wr * MI * 16 + mi * 16 + l16) * sldA + kk * 32 + quad * 8);
#pragma unroll
    for (int ni = 0; ni < NI; ni++) b[ni] = *(const bf16x8*)(sB + (wc * NI * 16 + ni * 16 + l16) * sldB + kk * 32 + quad * 8);
#pragma unroll
    for (int mi = 0; mi < MI; mi++)
#pragma unroll
      for (int ni = 0; ni < NI; ni++) acc[mi][ni] = __builtin_amdgcn_mfma_f32_16x16x32_bf16(a[mi], b[ni], acc[mi][ni], 0, 0, 0);
  }
}
template <int ROWS>
DEV void r2sw(bfu* s, const u32x4 (&r)[ROWS / 32], int tid_) {
#pragma unroll
  for (int i = 0; i < ROWS / 32; i++) {
    int id = tid_ + i * 256; int row = id >> 3, ch = id & 7;
    int byte = (((row >> 4) * 2 + (ch >> 2)) << 10) + ((((row & 15) << 6) + ((ch & 3) << 4)) ^ (((row >> 3) & 1) << 5));
    *(u32x4*)((char*)s + byte) = r[i];
  }
}
template <int MI, int NI>
DEV void mma64w(const bfu* sA, const bfu* sB, f32x4 (&acc)[MI][NI]) {
  const int lane = threadIdx.x & 63, w = threadIdx.x >> 6, wr = w >> 1, wc = w & 1, l16 = lane & 15, quad = lane >> 4;
  const int lo = ((l16 << 6) + (quad << 4)) ^ (((l16 >> 3) & 1) << 5);
#pragma unroll
  for (int kk = 0; kk < 2; kk++) {
    bf16x8 a[MI], b[NI];
#pragma unroll
    for (int mi = 0; mi < MI; mi++) a[mi] = *(const bf16x8*)((const char*)sA + (((wr * MI + mi) * 2 + kk) << 10) + lo);
#pragma unroll
    for (int ni = 0; ni < NI; ni++) b[ni] = *(const bf16x8*)((const char*)sB + (((wc * NI + ni) * 2 + kk) << 10) + lo);
#pragma unroll
    for (int mi = 0; mi < MI; mi++)
#pragma unroll
      for (int ni = 0; ni < NI; ni++) acc[mi][ni] = __builtin_amdgcn_mfma_f32_16x16x32_bf16(a[mi], b[ni], acc[mi][ni], 0, 0, 0);
  }
}
template <int MI, int NI>
DEV void gemm_loop(const bfu* A, int lda, const bfu* B, int ldb, int K, f32x4 (&acc)[MI][NI], bfu* sbuf) {
  constexpr int BM = 32 * MI, BN = 32 * NI;
  bfu* sA0 = sbuf; bfu* sB0 = sA0 + BM * 64; bfu* sA1 = sB0 + BN * 64; bfu* sB1 = sA1 + BM * 64;
  const int nk = K >> 6;
  int t_ = threadIdx.x; asm volatile("" : "+v"(t_));
  u32x4 ra0[BM / 32], rb0[BN / 32], ra1[BM / 32], rb1[BN / 32];
  g2r<BM>(A, lda, ra0, t_); g2r<BN>(B, ldb, rb0, t_);
  if (nk > 1) { g2r<BM>(A + 64, lda, ra1, t_); g2r<BN>(B + 64, ldb, rb1, t_); }
  __syncthreads();
  r2sw<BM>(sA0, ra0, t_); r2sw<BN>(sB0, rb0, t_);
  if (nk > 2) { g2r<BM>(A + 128, lda, ra0, t_); g2r<BN>(B + 128, ldb, rb0, t_); }
  __syncthreads();
  for (int k = 0; k < nk; k += 2) {
    if (k + 1 < nk) { r2sw<BM>(sA1, ra1, t_); r2sw<BN>(sB1, rb1, t_); }
    if (k + 3 < nk) { g2r<BM>(A + (k + 3) * 64, lda, ra1, t_); g2r<BN>(B + (k + 3) * 64, ldb, rb1, t_); }
    mma64w<MI, NI>(sA0, sB0, acc);
    __syncthreads();
    if (k + 1 >= nk) break;
    if (k + 2 < nk) { r2sw<BM>(sA0, ra0, t_); r2sw<BN>(sB0, rb0, t_); }
    if (k + 4 < nk) { g2r<BM>(A + (k + 4) * 64, lda, ra0, t_); g2r<BN>(B + (k + 4) * 64, ldb, rb0, t_); }
    mma64w<MI, NI>(sA1, sB1, acc);
    __syncthreads();
  }
}

DEV void transpose_tile(const float* src, int ldsrc, int srccol0, int validcols, const float* scale,
                        bfu* dst, int lddst, int n0, int k0, float* sT) {
  const int tid = threadIdx.x;
  __syncthreads();
#pragma unroll
  for (int i = 0; i < 4; i++) {
    int kk = (tid >> 4) + i * 16, c = (tid & 15) * 4;
    float4 v = make_float4(0.f, 0.f, 0.f, 0.f);
    if (c < validcols) v = *(const float4*)(src + (size_t)(k0 + kk) * ldsrc + srccol0 + c);
    float s = scale ? scale[k0 + kk] : 1.f;
    sT[kk * 65 + c] = v.x * s; sT[kk * 65 + c + 1] = v.y * s; sT[kk * 65 + c + 2] = v.z * s; sT[kk * 65 + c + 3] = v.w * s;
  }
  __syncthreads();
  int n = tid >> 2, kc = (tid & 3) * 16;
  unsigned o[8];
#pragma unroll
  for (int e = 0; e < 8; e++) o[e] = pack2(sT[(kc + 2 * e) * 65 + n], sT[(kc + 2 * e + 1) * 65 + n]);
  uint4* d = (uint4*)(dst + (size_t)(n0 + n) * lddst + k0 + kc);
  d[0] = make_uint4(o[0], o[1], o[2], o[3]); d[1] = make_uint4(o[4], o[5], o[6], o[7]);
}

DEV void phase0(const Params& p, int bid, int nb, char* smem) {
  const int tid = threadIdx.x, lane = tid & 63, w = tid >> 6;
  constexpr int N_X = TT / 4, N_TW = 106 * 16, N_TR = 256, N_TF = 128, N_TO = 256, N_MT = 512;
  constexpr int B1 = N_X, B2 = B1 + N_TW, B3 = B2 + N_TR, B4 = B3 + N_TF, B5 = B4 + N_TO, TOT = B5 + N_MT;
  bfu* xb = (bfu*)(p.ws + OFF_XB); float* rstd1 = (float*)(p.ws + OFF_RSTD1);
  for (int it = bid; it < TOT; it += nb) {
    if (it < B1) {
      int row = it * 4 + w;
      const float* src = row < TP ? p.x_p + (size_t)row * DM : p.x_s + (size_t)(row - TP) * DM;
      float4 a0 = *(const float4*)(src + lane * 8), a1 = *(const float4*)(src + lane * 8 + 4);
      float4 b0 = *(const float4*)(src + 512 + lane * 8), b1 = *(const float4*)(src + 512 + lane * 8 + 4);
      float ss = a0.x * a0.x + a0.y * a0.y + a0.z * a0.z + a0.w * a0.w + a1.x * a1.x + a1.y * a1.y + a1.z * a1.z + a1.w * a1.w +
                 b0.x * b0.x + b0.y * b0.y + b0.z * b0.z + b0.w * b0.w + b1.x * b1.x + b1.y * b1.y + b1.z * b1.z + b1.w * b1.w;
      ss = wave_sum(ss);
      if (lane == 0) rstd1[row] = rsqrtf(ss * (1.f / DM) + EPSN);
      *(uint4*)(xb + (size_t)row * DM + lane * 8) = make_uint4(pack2(a0.x, a0.y), pack2(a0.z, a0.w), pack2(a1.x, a1.y), pack2(a1.z, a1.w));
      *(uint4*)(xb + (size_t)row * DM + 512 + lane * 8) = make_uint4(pack2(b0.x, b0.y), pack2(b0.z, b0.w), pack2(b1.x, b1.y), pack2(b1.z, b1.w));
    } else if (it < B2) {
      int j = it - B1; int nt = j >> 4, kt = j & 15; int n0 = nt * 64;
      int sc0, vc;
      if (n0 < 4608) { sc0 = n0; vc = 64; } else if (n0 < 6656) { sc0 = n0 + 8; vc = 64; } else if (n0 == 6656) { sc0 = 4608; vc = 8; } else { sc0 = 0; vc = 0; }
      transpose_tile(p.w_in, 6664, sc0, vc, p.norm1_g, (bfu*)(p.ws + OFF_WINT), DM, n0, kt * 64, (float*)smem);
    } else if (it < B3) {
      int j = it - B2; transpose_tile(p.w_ret_out, 1024, (j >> 4) * 64, 64, nullptr, (bfu*)(p.ws + OFF_WRT), 1024, (j >> 4) * 64, (j & 15) * 64, (float*)smem);
    } else if (it < B4) {
      int j = it - B3; transpose_tile(p.w_fox_out, 1024, (j >> 3) * 64, 64, nullptr, (bfu*)(p.ws + OFF_WFT), 512, (j >> 3) * 64, (j & 7) * 64, (float*)smem);
    } else if (it < B5) {
      int j = it - B4; transpose_tile(p.w_o, 1024, (j >> 4) * 64, 64, nullptr, (bfu*)(p.ws + OFF_WOT), 1024, (j >> 4) * 64, (j & 15) * 64, (float*)smem);
    } else {
      int j = it - B5; int hh = j >> 5, kt = (j >> 4) & 1, dt = j & 15;
      float* sW = (float*)smem; float* sK = sW + 64 * 129;
      const float* ksub = (hh & 1) ? p.k2 : p.k1;
      __syncthreads();
#pragma unroll
      for (int i = 0; i < 8; i++) {
        int id = tid + i * 256; int row = id >> 5, c4 = (id & 31) * 4;
        float4 v = *(const float4*)(p.peer_wq + (size_t)(dt * 64 + row) * 2048 + hh * 128 + c4);
        sW[row * 129 + c4] = v.x; sW[row * 129 + c4 + 1] = v.y; sW[row * 129 + c4 + 2] = v.z; sW[row * 129 + c4 + 3] = v.w;
        float4 u = *(const float4*)(ksub + (size_t)(kt * 64 + row) * 128 + c4);
        sK[row * 129 + c4] = u.x; sK[row * 129 + c4 + 1] = u.y; sK[row * 129 + c4 + 2] = u.z; sK[row * 129 + c4 + 3] = u.w;
      }
      __syncthreads();
      int ky = (tid >> 4) * 4, dd = (tid & 15) * 4;
      float a[4][4];
#pragma unroll
      for (int i = 0; i < 4; i++)
#pragma unroll
        for (int jj = 0; jj < 4; jj++) a[i][jj] = 0.f;
      for (int c = 0; c < 128; c++) {
        float kv[4], wv[4];
#pragma unroll
        for (int i = 0; i < 4; i++) { kv[i] = sK[(ky + i) * 129 + c]; wv[i] = sW[(dd + i) * 129 + c]; }
#pragma unroll
        for (int i = 0; i < 4; i++)
#pragma unroll
          for (int jj = 0; jj < 4; jj++) a[i][jj] += kv[i] * wv[jj];
      }
      bfu* MT = (bfu*)(p.ws + OFF_MT);
      float g0 = p.norm2_g[dt * 64 + dd], g1 = p.norm2_g[dt * 64 + dd + 1], g2 = p.norm2_g[dt * 64 + dd + 2], g3 = p.norm2_g[dt * 64 + dd + 3];
#pragma unroll
      for (int i = 0; i < 4; i++)
        *(uint2*)(MT + (size_t)(hh * 128 + kt * 64 + ky + i) * DM + dt * 64 + dd) = make_uint2(pack2(a[i][0] * g0, a[i][1] * g1), pack2(a[i][2] * g2, a[i][3] * g3));
    }
  }
}

DEV void rot_angle(int pos, int d, float& cs, float& sn) {
  float inv = exp2f(-(float)d * (13.287712379549449f / 32.f));
  float ang = (float)pos * inv;
  float rev = ang * 0.15915494309189535f;
  rev = rev - floorf(rev);
  sn = __builtin_amdgcn_sinf(rev); cs = __builtin_amdgcn_cosf(rev);
}

DEV void phase1(const Params& p, int bid, int nb, char* smem) {
  const int tid = threadIdx.x, lane = tid & 63, w = tid >> 6, wr = w >> 1, wc = w & 1, l16 = lane & 15, quad = lane >> 4;
  bfu* sA = (bfu*)smem; bfu* sB = sA + 128 * 72;
  const bfu* XB = (const bfu*)(p.ws + OFF_XB); const bfu* WT = (const bfu*)(p.ws + OFF_WINT);
  const float* rstd1 = (const float*)(p.ws + OFF_RSTD1);
  constexpr int NT = NWP / 128;
  const int xcd = bid & 7, slot = bid >> 3, nslots = (nb + 7 - xcd) >> 3;
  const int nprompt = 32 * NT;
  const int n_p = slot < nprompt ? (nprompt - slot + nslots - 1) / nslots : 0;
  const int n_s = bid < 4 * NT ? (4 * NT - bid + nb - 1) / nb : 0;
  for (int i_ = 0; i_ < n_p + n_s; i_++) {
    int mt, nt;
    if (i_ < n_p) { int q = slot + i_ * nslots; int sub = q / (8 * NT), rem = q - sub * (8 * NT); nt = rem >> 3; mt = xcd * 32 + sub * 8 + (rem & 7); }
    else { int it = bid + (i_ - n_p) * nb; mt = 256 + it / NT; nt = it - (it / NT) * NT; }
    int m0 = mt * 128, n0 = nt * 128;
    f32x4 acc[4][4];
#pragma unroll
    for (int i = 0; i < 4; i++)
#pragma unroll
      for (int j = 0; j < 4; j++) acc[i][j] = f32x4{0.f, 0.f, 0.f, 0.f};
    gemm_loop<4, 4>(XB + (size_t)m0 * DM, DM, WT + (size_t)n0 * DM, DM, DM, acc, sA);
    const int rbase = m0 + wr * 64 + quad * 4;
    const int cbase = n0 + wc * 64 + l16;
    if (m0 >= TP) {
      float* hs = (float*)(p.ws + OFF_HS);
      bfu* gaS = (bfu*)(p.out + O_YS); bfu* gbS = gaS + (size_t)TS * DM;
#pragma unroll
      for (int mi = 0; mi < 4; mi++)
#pragma unroll
        for (int j = 0; j < 4; j++) {
          int row = rbase + mi * 16 + j; float rs = rstd1[row]; int sr = row - TP;
#pragma unroll
          for (int ni = 0; ni < 4; ni++) {
            int col = cbase + ni * 16; float v = acc[mi][ni][j] * rs;
            if (n0 >= 4608 && n0 < 5632) gaS[(size_t)sr * DM + col - 4608] = f2bf(v);
            else if (n0 >= 5632 && n0 < 6656) gbS[(size_t)sr * DM + col - 5632] = f2bf(v);
            else hs[(size_t)sr * NWP + col] = v;
          }
        }
      continue;
    }
    const int b = m0 >> 14;
    if (n0 < 1024) {
      const int isK = n0 >= 512; const int head = ((n0 & 511) >> 6) + wc;
      const float l2g = l2gamma(head);
      bfu* dst = (bfu*)(p.ws + (isK ? OFF_KT : OFF_QT));
      bfu* ktT = (bfu*)(p.ws + OFF_KTT);
#pragma unroll
      for (int mi = 0; mi < 4; mi++) {
#pragma unroll
        for (int ni = 0; ni < 2; ni++) {
          int d = ni * 16 + l16;
          float y1[4], y2[4];
#pragma unroll
          for (int j = 0; j < 4; j++) {
            int row = rbase + mi * 16 + j; int t = row & (SEQ - 1); int l = t & (RC - 1);
            float rs = rstd1[row];
            float dec = exp2f((float)(l + 1) * l2g);
            float sc = isK ? 0.125f / dec : dec;
            float cs, sn; rot_angle(t, d, cs, sn);
            float x1 = acc[mi][ni][j] * rs, x2 = acc[mi][ni + 2][j] * rs;
            y1[j] = (x1 * cs - x2 * sn) * sc; y2[j] = (x2 * cs + x1 * sn) * sc;
            dst[(size_t)row * 512 + head * 64 + d] = f2bf(y1[j]);
            dst[(size_t)row * 512 + head * 64 + d + 32] = f2bf(y2[j]);
          }
          if (isK) {
            int t0 = (rbase + mi * 16) & (SEQ - 1);
            *(uint2*)(ktT + ((size_t)((b * 8 + head) * 64 + d)) * SEQ + t0) = make_uint2(pack2(y1[0], y1[1]), pack2(y1[2], y1[3]));
            *(uint2*)(ktT + ((size_t)((b * 8 + head) * 64 + d + 32)) * SEQ + t0) = make_uint2(pack2(y2[0], y2[1]), pack2(y2[2], y2[3]));
          }
        }
      }
    } else if (n0 < 2048) {
      const int head = (n0 - 1024) >> 7;
      bfu* vT = (bfu*)(p.ws + OFF_VT);
#pragma unroll
      for (int mi = 0; mi < 4; mi++) {
        int row0 = rbase + mi * 16; int t0 = row0 & (SEQ - 1);
        float r0 = rstd1[row0], r1 = rstd1[row0 + 1], r2 = rstd1[row0 + 2], r3 = rstd1[row0 + 3];
#pragma unroll
        for (int ni = 0; ni < 4; ni++) {
          int dv = wc * 64 + ni * 16 + l16;
          *(uint2*)(vT + ((size_t)((b * 8 + head) * 128 + dv)) * SEQ + t0) =
              make_uint2(pack2(acc[mi][ni][0] * r0, acc[mi][ni][1] * r1), pack2(acc[mi][ni][2] * r2, acc[mi][ni][3] * r3));
        }
      }
    } else if (n0 < 3072 || (n0 >= 4608 && n0 < 6656)) {
      bfu* dst; int c0;
      if (n0 < 3072) { dst = (bfu*)(p.ws + OFF_RG); c0 = 2048; }
      else if (n0 < 5632) { dst = (bfu*)(p.out + O_YP); c0 = 4608; }
      else { dst = (bfu*)(p.out + O_YP) + (size_t)TP * DM; c0 = 5632; }
#pragma unroll
      for (int mi = 0; mi < 4; mi++)
#pragma unroll
        for (int j = 0; j < 4; j++) {
          int row = rbase + mi * 16 + j; float rs = rstd1[row];
#pragma unroll
          for (int ni = 0; ni < 4; ni++) dst[(size_t)row * DM + cbase + ni * 16 - c0] = f2bf(acc[mi][ni][j] * rs);
        }
    } else if (n0 < 4096) {
      const int isK = n0 >= 3584; const int head = (((n0 - 3072) & 511) >> 6) + wc;
      const float* g = isK ? p.fk_g : p.fq_g;
      float gv[4];
#pragma unroll
      for (int ni = 0; ni < 4; ni++) gv[ni] = g[ni * 16 + l16];
      bfu* fq = (bfu*)(p.ws + OFF_FQ); bfu* fkb = (bfu*)(p.ws + OFF_FKB);
#pragma unroll
      for (int mi = 0; mi < 4; mi++)
#pragma unroll
        for (int j = 0; j < 4; j++) {
          int row = rbase + mi * 16 + j; float rs = rstd1[row];
          float v[4]; float ss = 0.f;
#pragma unroll
          for (int ni = 0; ni < 4; ni++) { v[ni] = acc[mi][ni][j] * rs; ss += v[ni] * v[ni]; }
          ss = sum16(ss);
          float r = rsqrtf(ss * (1.f / 64.f) + EPSN);
#pragma unroll
          for (int ni = 0; ni < 4; ni++) {
            float y = v[ni] * r * gv[ni]; size_t o = (size_t)row * 512 + head * 64 + ni * 16 + l16;
            if (isK) { p.out[O_FKP + o] = y; fkb[o] = f2bf(y); }
            else fq[o] = f2bf(y * (0.125f * LOG2E));
          }
        }
    } else if (n0 < 4608) {
      const int head = ((n0 - 4096) >> 6) + wc;
      bfu* fvT = (bfu*)(p.ws + OFF_FVT);
#pragma unroll
      for (int mi = 0; mi < 4; mi++) {
        int row0 = rbase + mi * 16; int t0 = row0 & (SEQ - 1);
        float r[4] = {rstd1[row0], rstd1[row0 + 1], rstd1[row0 + 2], rstd1[row0 + 3]};
#pragma unroll
        for (int ni = 0; ni < 4; ni++) {
          int d = ni * 16 + l16; float v[4];
#pragma unroll
          for (int j = 0; j < 4; j++) { v[j] = acc[mi][ni][j] * r[j]; p.out[O_FVP + (size_t)(row0 + j) * 512 + head * 64 + d] = v[j]; }
          *(uint2*)(fvT + ((size_t)((b * 8 + head) * 64 + d)) * SEQ + t0) = make_uint2(pack2(v[0], v[1]), pack2(v[2], v[3]));
        }
      }
    } else {
      if (wc == 0 && l16 < 8) {
        float bf = p.b_f[l16];
#pragma unroll
        for (int mi = 0; mi < 4; mi++)
#pragma unroll
          for (int j = 0; j < 4; j++) {
            int row = rbase + mi * 16 + j;
            float z = acc[mi][0][j] * rstd1[row] + bf;
            p.out[O_LFP + (size_t)row * 8 + l16] = fminf(z, 0.f) - log1pf(__expf(-fabsf(z)));
          }
      }
    }
  }
}

DEV void phase2(const Params& p, int bid, int nb, char* smem) {
  const int tid = threadIdx.x, lane = tid & 63, w = tid >> 6, wr = w >> 1, wc = w & 1, l16 = lane & 15, quad = lane >> 4;
  bfu* sA = (bfu*)smem; bfu* sB = sA + 128 * 72;
  const bfu* vT = (const bfu*)(p.ws + OFF_VT); const bfu* ktT = (const bfu*)(p.ws + OFF_KTT);
  float* U = (float*)(p.ws + OFF_XB);
  constexpr int NR1 = 16 * NCH;
  for (int it = bid; it < NR1 + 16; it += nb) {
    if (it < 16) {
      int bh = it, b = bh >> 3, h = bh & 7;
      double* sd = (double*)smem;
      const float* lf = p.out + O_LFP + (size_t)b * SEQ * 8 + h;
      float part = 0.f;
      for (int i = 0; i < 64; i++) part += lf[(size_t)(tid * 64 + i) * 8];
      __syncthreads();
      sd[tid] = (double)part;
      __syncthreads();
      if (tid == 0) { double run = 0.0; for (int i = 0; i < 256; i++) { double v = sd[i]; sd[i] = run; run += v; } }
      __syncthreads();
      double run = sd[tid];
      float* c2 = (float*)(p.ws + OFF_C2) + (size_t)bh * SEQ;
      for (int i = 0; i < 64; i++) { run += (double)lf[(size_t)(tid * 64 + i) * 8]; c2[tid * 64 + i] = (float)(run * (double)LOG2E); }
      __syncthreads();
    } else {
      int j = it - 16; int bh = j / NCH, c = j - bh * NCH;
      f32x4 acc[4][2];
#pragma unroll
      for (int i = 0; i < 4; i++) { acc[i][0] = f32x4{0.f, 0.f, 0.f, 0.f}; acc[i][1] = f32x4{0.f, 0.f, 0.f, 0.f}; }
      gemm_loop<4, 2>(vT + (size_t)bh * 128 * SEQ + c * RC, SEQ, ktT + (size_t)bh * 64 * SEQ + c * RC, SEQ, RC, acc, sA);
      float gC = exp2f((float)RC * l2gamma(bh & 7));
      float* Uo = U + (size_t)j * 8192;
#pragma unroll
      for (int mi = 0; mi < 4; mi++)
#pragma unroll
        for (int ni = 0; ni < 2; ni++)
#pragma unroll
          for (int jj = 0; jj < 4; jj++) {
            int dv = wr * 64 + mi * 16 + quad * 4 + jj, dk = wc * 32 + ni * 16 + l16;
            Uo[dv * 64 + dk] = acc[mi][ni][jj] * gC;
          }
    }
  }
}

DEV void sample_item(const Params& p, int item, char* smem) {
  const int tid = threadIdx.x;
  const int b = item >> 3, h = item & 7;
  float* sq = (float*)smem;
  float* sk = sq + 1024;
  float* sv = sk + 1024;
  float* sP = sv + 2048;
  float* so = sP + 256;
  float* sr = so + 2048;
  float* sc = (float*)smem;
  float* fq = (float*)(smem + 34816);
  float* fk = fq + 1024;
  float* cn = fk + 1024;
  float* suf = cn + 16;
  float* red = suf + 1024;
  float* sL = red + 256;
  const float* hs = (const float*)(p.ws + OFF_HS) + (size_t)b * 16 * NWP;
  const float l2g = l2gamma(h);
  __syncthreads();
  for (int i = tid; i < 512; i += 256) {
    int l = i >> 5, d = i & 31; float cs, sn; rot_angle(1024 + l, d, cs, sn);
    float dec = exp2f((float)(l + 1) * l2g);
    const float* r = hs + (size_t)l * NWP;
    float x1 = r[h * 64 + d], x2 = r[h * 64 + d + 32];
    sq[l * 64 + d] = (x1 * cs - x2 * sn) * dec; sq[l * 64 + d + 32] = (x2 * cs + x1 * sn) * dec;
    x1 = r[512 + h * 64 + d]; x2 = r[512 + h * 64 + d + 32];
    float sc_ = 0.125f / dec;
    sk[l * 64 + d] = (x1 * cs - x2 * sn) * sc_; sk[l * 64 + d + 32] = (x2 * cs + x1 * sn) * sc_;
  }
  for (int i = tid; i < 2048; i += 256) { int l = i >> 7, dv = i & 127; sv[i] = hs[(size_t)l * NWP + 1024 + h * 128 + dv]; }
  __syncthreads();
  { int l = tid >> 4, m = tid & 15; float a = 0.f;
    if (l >= m) for (int d = 0; d < 64; d++) a += sq[l * 64 + d] * sk[m * 64 + d];
    sP[tid] = a; }
  __syncthreads();
  const float* S = p.state_ret + (size_t)(b * 8 + h) * 8192;
  { int dv = tid & 127, lh = tid >> 7; float o[8];
#pragma unroll
    for (int i = 0; i < 8; i++) o[i] = 0.f;
    for (int dk = 0; dk < 64; dk++) { float s = S[dk * 128 + dv];
#pragma unroll
      for (int i = 0; i < 8; i++) o[i] += sq[(lh * 8 + i) * 64 + dk] * s; }
    for (int m = 0; m < 16; m++) { float v = sv[m * 128 + dv];
#pragma unroll
      for (int i = 0; i < 8; i++) o[i] += sP[(lh * 8 + i) * 16 + m] * v; }
#pragma unroll
    for (int i = 0; i < 8; i++) so[(lh * 8 + i) * 128 + dv] = o[i];
    float g16 = exp2f(16.f * l2g);
    float* So = p.out + O_SS + (size_t)(b * 8 + h) * 8192;
    for (int i = 0; i < 32; i++) { int dk = lh * 32 + i; float a = S[dk * 128 + dv];
      for (int m = 0; m < 16; m++) a += sk[m * 64 + dk] * sv[m * 128 + dv];
      So[dk * 128 + dv] = a * g16; }
  }
  __syncthreads();
  if (tid < 16) { float ss = 0.f; for (int i = 0; i < 128; i++) { float v = so[tid * 128 + i]; ss += v * v; } sr[tid] = rsqrtf(ss * (1.f / 128.f) + EPSN); }
  __syncthreads();
  { int dv = tid & 127, lh = tid >> 7; bfu* gated = (bfu*)(p.ws + OFF_RG);
    float gg = p.gn_g[h * 128 + dv];
    for (int i = 0; i < 8; i++) { int l = lh * 8 + i; float rgv = hs[(size_t)l * NWP + 2048 + h * 128 + dv];
      float v = so[l * 128 + dv] * sr[l] * gg * (rgv * sigmoidf_(rgv));
      gated[(size_t)(TP + b * 16 + l) * DM + h * 128 + dv] = f2bf(v); } }
  {
    int l = tid >> 4, dl = tid & 15; const float* r = hs + (size_t)l * NWP;
    float qv[4], kv[4]; float sq_ = 0.f, sk_ = 0.f;
#pragma unroll
    for (int i = 0; i < 4; i++) { qv[i] = r[3072 + h * 64 + dl * 4 + i]; kv[i] = r[3584 + h * 64 + dl * 4 + i]; sq_ += qv[i] * qv[i]; sk_ += kv[i] * kv[i]; }
    sq_ = sum16(sq_); sk_ = sum16(sk_);
    float rq = rsqrtf(sq_ * (1.f / 64.f) + EPSN), rk = rsqrtf(sk_ * (1.f / 64.f) + EPSN);
#pragma unroll
    for (int i = 0; i < 4; i++) { int d = dl * 4 + i;
      fq[l * 64 + d] = qv[i] * rq * p.fq_g[d] * 0.125f;
      float kk = kv[i] * rk * p.fk_g[d]; fk[l * 64 + d] = kk;
      p.out[O_FKS + (size_t)((b * 16 + l) * 8 + h) * 64 + d] = kk;
      p.out[O_FVS + (size_t)((b * 16 + l) * 8 + h) * 64 + d] = r[4096 + h * 64 + d]; }
  }
  if (tid < 16) { float z = hs[(size_t)tid * NWP + 6656 + h] + p.b_f[h]; float lf = fminf(z, 0.f) - log1pf(__expf(-fabsf(z)));
    p.out[O_LFS + (size_t)(b * 16 + tid) * 8 + h] = lf; cn[tid] = lf; }
  { const float* cl = p.clogf + (size_t)b * 1024 * 8 + h; float v[4]; float part = 0.f;
#pragma unroll
    for (int i = 0; i < 4; i++) { v[i] = cl[(size_t)(tid * 4 + i) * 8]; part += v[i]; }
    red[tid] = part;
    __syncthreads();
    if (tid == 0) { float run = 0.f; for (int i = 255; i >= 0; i--) { float t = red[i]; red[i] = run; run += t; }
      float c = 0.f; for (int i = 0; i < 16; i++) { c += cn[i]; cn[i] = c; } }
    __syncthreads();
    float run = red[tid];
    for (int i = 3; i >= 0; i--) { suf[tid * 4 + i] = run; run += v[i]; }
  }
  __syncthreads();
  const float* CK = p.ck + (size_t)b * 1024 * 512 + h * 64; const float* CV = p.cv + (size_t)b * 1024 * 512 + h * 64;
  for (int pass = 0; pass < 2; pass++) {
    __syncthreads();
    for (int j = tid; j < 1040; j += 256) {
      float a[8];
#pragma unroll
      for (int qi = 0; qi < 8; qi++) a[qi] = 0.f;
      if (j < 1024) {
        const float4* kp = (const float4*)(CK + (size_t)j * 512);
#pragma unroll 4
        for (int i = 0; i < 16; i++) { float4 t = kp[i];
#pragma unroll
          for (int qi = 0; qi < 8; qi++) { const float* qq = fq + (pass * 8 + qi) * 64 + i * 4; a[qi] += qq[0] * t.x + qq[1] * t.y + qq[2] * t.z + qq[3] * t.w; } }
      } else {
        const float* kp = fk + (j - 1024) * 64;
#pragma unroll 4
        for (int i = 0; i < 64; i++) { float t = kp[i];
#pragma unroll
          for (int qi = 0; qi < 8; qi++) a[qi] += fq[(pass * 8 + qi) * 64 + i] * t; }
      }
#pragma unroll
      for (int qi = 0; qi < 8; qi++) { int q = pass * 8 + qi;
        float bias;
        if (j < 1024) bias = suf[j] + cn[q]; else { int m = j - 1024; bias = (m <= q) ? (cn[q] - cn[m]) : -INFINITY; }
        sc[qi * 1040 + j] = a[qi] + bias; }
    }
    __syncthreads();
    { int qi = tid >> 5, l32 = tid & 31; float m = -INFINITY;
      for (int j = l32; j < 1040; j += 32) m = fmaxf(m, sc[qi * 1040 + j]);
#pragma unroll
      for (int o = 16; o >= 1; o >>= 1) m = fmaxf(m, __shfl_xor(m, o));
      float s = 0.f;
      for (int j = l32; j < 1040; j += 32) { float e = __expf(sc[qi * 1040 + j] - m); sc[qi * 1040 + j] = e; s += e; }
#pragma unroll
      for (int o = 16; o >= 1; o >>= 1) s += __shfl_xor(s, o);
      if (l32 == 0) sL[qi] = s; }
    __syncthreads();
    { int qi = tid >> 5, d2 = (tid & 31) * 2; float a0 = 0.f, a1 = 0.f;
      for (int j = 0; j < 1024; j++) { float pj = sc[qi * 1040 + j]; float2 v = *(const float2*)(CV + (size_t)j * 512 + d2); a0 += pj * v.x; a1 += pj * v.y; }
      for (int m = 0; m < 16; m++) { float pj = sc[qi * 1040 + 1024 + m]; const float* r = hs + (size_t)m * NWP + 4096 + h * 64 + d2; a0 += pj * r[0]; a1 += pj * r[1]; }
      float inv = 1.f / sL[qi]; bfu* fo = (bfu*)(p.ws + OFF_FQ);
      *(unsigned*)(fo + (size_t)(TP + b * 16 + pass * 8 + qi) * 512 + h * 64 + d2) = pack2(a0 * inv, a1 * inv); }
  }
  __syncthreads();
}

DEV void phase3(const Params& p, int bid, int nb, char* smem) {
  const int tid = threadIdx.x;
  const float* U = (const float*)(p.ws + OFF_XB); bfu* SST = (bfu*)(p.ws + OFF_SST);
  for (int it = bid; it < 256 + 512; it += nb) {
    if (it < 256) { sample_item(p, it, smem); continue; }
    int g = (it - 256) * 256 + tid; int bh = g >> 13, e = g & 8191;
    float G = exp2f((float)RC * l2gamma(bh & 7));
    float s = 0.f;
    const float* Up = U + (size_t)bh * NCH * 8192 + e; bfu* Sp = SST + (size_t)bh * NCH * 8192 + e;
    Sp[0] = 0;
    for (int c0 = 0; c0 < NCH; c0 += 8) {
      float u[8];
#pragma unroll
      for (int i = 0; i < 8; i++) u[i] = Up[(size_t)(c0 + i) * 8192];
#pragma unroll
      for (int i = 0; i < 8; i++) { s = s * G + u[i]; if (c0 + i + 1 < NCH) Sp[(size_t)(c0 + i + 1) * 8192] = f2bf(s); }
    }
    int dv = e >> 6, dk = e & 63;
    p.out[O_SP + (size_t)bh * 8192 + dk * 128 + dv] = s;
  }
}

DEV void attn_item(const Params& p, int item, char* smem, float thr, bool dry) {
  const int tid = threadIdx.x, lane = tid & 63, w = tid >> 6, r32 = lane & 31, hi = lane >> 5;
  const int bh = item >> 7, qt = 127 - (item & 127);
  const int b = bh >> 3, h = bh & 7;
  const int q0 = qt * 128;
  bfu* sK = (bfu*)smem;
  bfu* sV = sK + 64 * 72;
  float* sC = (float*)(sV + 64 * 72);
  const float* c2 = (const float*)(p.ws + OFF_C2) + (size_t)bh * SEQ;
  bfu* FQ = (bfu*)(p.ws + OFF_FQ);
  const bfu* FKB = (const bfu*)(p.ws + OFF_FKB) + (size_t)b * SEQ * 512 + h * 64;
  const bfu* FVT = (const bfu*)(p.ws + OFF_FVT) + (size_t)bh * 64 * SEQ;
  const int jd0 = q0 >> 6;
  int pred = 0;
  if (tid < jd0) pred = (c2[q0] - c2[tid * 64 + 63]) < -thr;
  const int jstart = __syncthreads_count(pred);
  const int qrow = q0 + w * 32 + r32;
  bf16x8 qf[4];
  const bfu* qp = FQ + (size_t)(b * SEQ + qrow) * 512 + h * 64 + hi * 8;
#pragma unroll
  for (int d0 = 0; d0 < 4; d0++) qf[d0] = *(const bf16x8*)(qp + d0 * 16);
  const float cq = c2[qrow];
  float m = -INFINITY, lsum = 0.f;
  f32x16 o0, o1;
#pragma unroll
  for (int r = 0; r < 16; r++) { o0[r] = 0.f; o1[r] = 0.f; }
  u32x4 rk0, rk1, rv0, rv1; float rc = 0.f;
  const int srow = tid >> 3, sch = tid & 7;
#define ATT_GLOAD(j_) do { \
    rk0 = *(const u32x4*)(FKB + (size_t)((j_) * 64 + srow) * 512 + sch * 8); \
    rk1 = *(const u32x4*)(FKB + (size_t)((j_) * 64 + srow + 32) * 512 + sch * 8); \
    rv0 = *(const u32x4*)(FVT + (size_t)srow * SEQ + (j_) * 64 + sch * 8); \
    rv1 = *(const u32x4*)(FVT + (size_t)(srow + 32) * SEQ + (j_) * 64 + sch * 8); \
    if (tid < 64) rc = c2[(j_) * 64 + tid]; } while (0)
  ATT_GLOAD(jstart);
  for (int j = jstart; j <= jd0 + 1; j++) {
    __syncthreads();
    *(u32x4*)(sK + srow * 72 + sch * 8) = rk0; *(u32x4*)(sK + (srow + 32) * 72 + sch * 8) = rk1;
    *(u32x4*)(sV + srow * 72 + sch * 8) = rv0; *(u32x4*)(sV + (srow + 32) * 72 + sch * 8) = rv1;
    if (tid < 64) sC[tid] = rc;
    __syncthreads();
    if (j < jd0 + 1) ATT_GLOAD(j + 1);
    if (j * 64 > q0 + w * 32 + 31) continue;
    f32x16 s0, s1;
#pragma unroll
    for (int r = 0; r < 16; r++) { s0[r] = 0.f; s1[r] = 0.f; }
#pragma unroll
    for (int d0 = 0; d0 < 4; d0++) {
      bf16x8 k0 = *(const bf16x8*)(sK + r32 * 72 + d0 * 16 + hi * 8);
      bf16x8 k1 = *(const bf16x8*)(sK + (32 + r32) * 72 + d0 * 16 + hi * 8);
      s0 = __builtin_amdgcn_mfma_f32_32x32x16_bf16(k0, qf[d0], s0, 0, 0, 0);
      s1 = __builtin_amdgcn_mfma_f32_32x32x16_bf16(k1, qf[d0], s1, 0, 0, 0);
    }
    const bool diag = (j >= jd0);
    const int kbase = j * 64 + 4 * hi;
    float mloc = -INFINITY;
#pragma unroll
    for (int g = 0; g < 4; g++) {
      float4 c0 = *(const float4*)(sC + 8 * g + 4 * hi), c1 = *(const float4*)(sC + 32 + 8 * g + 4 * hi);
      float cc0[4] = {c0.x, c0.y, c0.z, c0.w}, cc1[4] = {c1.x, c1.y, c1.z, c1.w};
#pragma unroll
      for (int e = 0; e < 4; e++) {
        int r = g * 4 + e;
        float a = s0[r] + (cq - cc0[e]), bb = s1[r] + (cq - cc1[e]);
        if (diag) { int key = kbase + 8 * g + e; if (key > qrow) a = -INFINITY; if (key + 32 > qrow) bb = -INFINITY; }
        s0[r] = a; s1[r] = bb; mloc = fmaxf(mloc, fmaxf(a, bb));
      }
    }
    mloc = fmaxf(mloc, __shfl_xor(mloc, 32));
    float mn = fmaxf(m, mloc);
    float alpha = __builtin_amdgcn_exp2f(m - mn);
    m = mn;
    float ps = 0.f;
#pragma unroll
    for (int r = 0; r < 16; r++) { s0[r] = __builtin_amdgcn_exp2f(s0[r] - mn); s1[r] = __builtin_amdgcn_exp2f(s1[r] - mn); ps += s0[r] + s1[r]; }
    lsum = lsum * alpha + ps;
#pragma unroll
    for (int r = 0; r < 16; r++) { o0[r] *= alpha; o1[r] *= alpha; }
#pragma unroll
    for (int ks = 0; ks < 4; ks++) {
      union { bf16x8 v; unsigned u[4]; } pf;
#pragma unroll
      for (int e = 0; e < 4; e++) {
        int r = (ks & 1) * 8 + 2 * e;
        pf.u[e] = (ks < 2) ? pack2(s0[r], s0[r + 1]) : pack2(s1[r], s1[r + 1]);
      }
#pragma unroll
      for (int db = 0; db < 2; db++) {
        const bfu* vp = sV + (db * 32 + r32) * 72 + ks * 16 + 4 * hi;
        union { bf16x8 v; uint2 u[2]; } vf;
        vf.u[0] = *(const uint2*)vp; vf.u[1] = *(const uint2*)(vp + 8);
        if (db == 0) o0 = __builtin_amdgcn_mfma_f32_32x32x16_bf16(vf.v, pf.v, o0, 0, 0, 0);
        else o1 = __builtin_amdgcn_mfma_f32_32x32x16_bf16(vf.v, pf.v, o1, 0, 0, 0);
      }
    }
  }
  float lt = lsum + __shfl_xor(lsum, 32);
  float inv = 1.f / lt;
  bfu* op = (dry ? (bfu*)(p.ws + OFF_XB) : FQ) + (size_t)(b * SEQ + qrow) * 512 + h * 64;
#pragma unroll
  for (int g = 0; g < 4; g++) {
    *(uint2*)(op + 8 * g + 4 * hi) = make_uint2(pack2(o0[g * 4] * inv, o0[g * 4 + 1] * inv), pack2(o0[g * 4 + 2] * inv, o0[g * 4 + 3] * inv));
    *(uint2*)(op + 32 + 8 * g + 4 * hi) = make_uint2(pack2(o1[g * 4] * inv, o1[g * 4 + 1] * inv), pack2(o1[g * 4 + 2] * inv, o1[g * 4 + 3] * inv));
  }
  __syncthreads();
}

DEV void r3_item(const Params& p, int item, char* smem, bool dry) {
  const int tid = threadIdx.x, lane = tid & 63, w = tid >> 6, wr = w >> 1, wc = w & 1, l16 = lane & 15, quad = lane >> 4;
  const int bh = item / NCH, c = item - bh * NCH; const int b = bh >> 3, h = bh & 7;
  bfu* sQ = (bfu*)smem; bfu* sK = sQ + 128 * 72; bfu* sP = sK + 128 * 72; float* sRed = (float*)(sP + 128 * 136);
  const size_t row0 = (size_t)b * SEQ + c * RC;
  const bfu* Q = (const bfu*)(p.ws + OFF_QT) + row0 * 512 + h * 64;
  const bfu* Kk = (const bfu*)(p.ws + OFF_KT) + row0 * 512 + h * 64;
  const bfu* vT = (const bfu*)(p.ws + OFF_VT) + (size_t)bh * 128 * SEQ + c * RC;
  const bfu* ST = (const bfu*)(p.ws + OFF_SST) + (size_t)item * 8192;
  u32x4 ra[4], rb[4];
  g2r<128>(Q, 512, ra); g2r<128>(Kk, 512, rb);
  __syncthreads();
  r2s<128>(sQ, ra); r2s<128>(sK, rb);
  __syncthreads();
  g2r<128>(vT, SEQ, rb);
  f32x4 acc[4][4];
#pragma unroll
  for (int i = 0; i < 4; i++)
#pragma unroll
    for (int j = 0; j < 4; j++) acc[i][j] = f32x4{0.f, 0.f, 0.f, 0.f};
  mma64<4, 4>(sQ, 72, sK, 72, acc);
#pragma unroll
  for (int mi = 0; mi < 4; mi++)
#pragma unroll
    for (int ni = 0; ni < 4; ni++)
#pragma unroll
      for (int j = 0; j < 4; j++) {
        int row = wr * 64 + mi * 16 + quad * 4 + j, col = wc * 64 + ni * 16 + l16;
        sP[row * 136 + col] = (col <= row) ? f2bf(acc[mi][ni][j]) : (bfu)0;
      }
#pragma unroll
  for (int i = 0; i < 4; i++)
#pragma unroll
    for (int j = 0; j < 4; j++) acc[i][j] = f32x4{0.f, 0.f, 0.f, 0.f};
  __syncthreads();
  r2s<128>(sK, rb);
  __syncthreads();
  g2r<128>(vT + 64, SEQ, rb);
  mma64<4, 4>(sP, 136, sK, 72, acc);
  __syncthreads();
  r2s<128>(sK, rb);
  __syncthreads();
  g2r<128>(ST, 64, rb);
  mma64<4, 4>(sP + 64, 136, sK, 72, acc);
  __syncthreads();
  r2s<128>(sK, rb);
  __syncthreads();
  mma64<4, 4>(sQ, 72, sK, 72, acc);
  float ssq[4][4];
#pragma unroll
  for (int mi = 0; mi < 4; mi++)
#pragma unroll
    for (int j = 0; j < 4; j++) { float s = 0.f;
#pragma unroll
      for (int ni = 0; ni < 4; ni++) s += acc[mi][ni][j] * acc[mi][ni][j];
      s = sum16(s); ssq[mi][j] = s;
      if (l16 == 0) sRed[(wr * 64 + mi * 16 + quad * 4 + j) * 2 + wc] = s; }
  __syncthreads();
  bfu* RG = (bfu*)(p.ws + OFF_RG);
  float gg[4];
#pragma unroll
  for (int ni = 0; ni < 4; ni++) gg[ni] = p.gn_g[h * 128 + wc * 64 + ni * 16 + l16];
#pragma unroll
  for (int mi = 0; mi < 4; mi++)
#pragma unroll
    for (int j = 0; j < 4; j++) {
      int row = wr * 64 + mi * 16 + quad * 4 + j;
      float tot = sRed[row * 2] + sRed[row * 2 + 1];
      float r = rsqrtf(tot * (1.f / 128.f) + EPSN);
#pragma unroll
      for (int ni = 0; ni < 4; ni++) {
        size_t o = (row0 + row) * DM + h * 128 + wc * 64 + ni * 16 + l16;
        float rgv = bf2f(RG[o]);
        (dry ? (bfu*)(p.ws + OFF_XB) + (o & 0xffffff) : RG + o)[0] = f2bf(acc[mi][ni][j] * r * gg[ni] * (rgv * sigmoidf_(rgv)));
      }
    }
  __syncthreads();
}

DEV void phase4(const Params& p, int bid, int nb, char* smem, bool dry = false) {
  float gq = 0.f, gk = 0.f;
  for (int i = 0; i < 64; i++) { gq = fmaxf(gq, fabsf(p.fq_g[i])); gk = fmaxf(gk, fabsf(p.fk_g[i])); }
  const float thr = 2.f * (8.f * gq * gk * 1.03f * LOG2E) + 44.f;
  for (int it = bid; it < 2048 + 16 * NCH; it += nb) {
    if (it < 2048) attn_item(p, it, smem, thr, dry); else r3_item(p, it - 2048, smem, dry);
  }
}

DEV void phase5(const Params& p, int bid, int nb, char* smem) {
  const int tid = threadIdx.x, lane = tid & 63, w = tid >> 6, wr = w >> 1, wc = w & 1, l16 = lane & 15, quad = lane >> 4;
  bfu* sA = (bfu*)smem; bfu* sB = sA + 128 * 72;
  const bfu* G = (const bfu*)(p.ws + OFF_RG); const bfu* FO = (const bfu*)(p.ws + OFF_FQ);
  const bfu* WR = (const bfu*)(p.ws + OFF_WRT); const bfu* WF = (const bfu*)(p.ws + OFF_WFT);
  bfu* MX = (bfu*)(p.ws + OFF_XB);
  constexpr int NG = (TT / 128) * 8, NCV = 8192;
  const int cv0 = nb > 64 ? bid - 32 : bid, cvs = nb > 64 ? nb - 32 : nb;
  for (int it = NG + cv0; it < NG + NCV && cv0 >= 0; it += cvs) {
    {
      int r = (it - NG) * 4 + w;
      const float* src = r < 16384 ? p.peer_u + (size_t)r * DM : p.peer_v + (size_t)(r - 16384) * DM;
      float4 v0 = *(const float4*)(src + lane * 16), v1 = *(const float4*)(src + lane * 16 + 4), v2 = *(const float4*)(src + lane * 16 + 8), v3 = *(const float4*)(src + lane * 16 + 12);
      float am = fmaxf(fmaxf(fmaxf(fabsf(v0.x), fabsf(v0.y)), fmaxf(fabsf(v0.z), fabsf(v0.w))), fmaxf(fmaxf(fabsf(v1.x), fabsf(v1.y)), fmaxf(fabsf(v1.z), fabsf(v1.w))));
      am = fmaxf(am, fmaxf(fmaxf(fmaxf(fabsf(v2.x), fabsf(v2.y)), fmaxf(fabsf(v2.z), fabsf(v2.w))), fmaxf(fmaxf(fabsf(v3.x), fabsf(v3.y)), fmaxf(fabsf(v3.z), fabsf(v3.w)))));
#pragma unroll
      for (int o = 32; o >= 1; o >>= 1) am = fmaxf(am, __shfl_xor(am, o));
      float sc = am > 0.f ? 440.f / am : 1.f;
      int w0 = __builtin_amdgcn_cvt_pk_fp8_f32(v0.x * sc, v0.y * sc, 0, false); w0 = __builtin_amdgcn_cvt_pk_fp8_f32(v0.z * sc, v0.w * sc, w0, true);
      int w1 = __builtin_amdgcn_cvt_pk_fp8_f32(v1.x * sc, v1.y * sc, 0, false); w1 = __builtin_amdgcn_cvt_pk_fp8_f32(v1.z * sc, v1.w * sc, w1, true);
      int w2 = __builtin_amdgcn_cvt_pk_fp8_f32(v2.x * sc, v2.y * sc, 0, false); w2 = __builtin_amdgcn_cvt_pk_fp8_f32(v2.z * sc, v2.w * sc, w2, true);
      int w3 = __builtin_amdgcn_cvt_pk_fp8_f32(v3.x * sc, v3.y * sc, 0, false); w3 = __builtin_amdgcn_cvt_pk_fp8_f32(v3.z * sc, v3.w * sc, w3, true);
      uint4* dst = (uint4*)(p.ws + (r < 16384 ? OFF_PUB : OFF_PVB)) + (size_t)(r & 16383) * 64 + lane;
      *dst = make_uint4((unsigned)w0, (unsigned)w1, (unsigned)w2, (unsigned)w3);
      if (lane == 0) ((float*)(p.ws + OFF_PSC))[r] = am > 0.f ? am / 440.f : 1.f;
    }
  }
  const int xcd = bid & 7, slot = bid >> 3, nslots = (nb + 7 - xcd) >> 3;
  const int n_p = slot < 256 ? (256 - slot + nslots - 1) / nslots : 0;
  const int n_s = bid < 32 ? 1 : 0;
  for (int i_ = 0; i_ < n_p + n_s; i_++) {
    int mt, nt;
    if (i_ < n_p) { int q = slot + i_ * nslots; mt = xcd * 32 + (q >> 3); nt = q & 7; } else { mt = 256 + (bid >> 3); nt = bid & 7; }
    int m0 = mt * 128, n0 = nt * 128;
    f32x4 a1[4][4];
#pragma unroll
    for (int i = 0; i < 4; i++)
#pragma unroll
      for (int j = 0; j < 4; j++) a1[i][j] = f32x4{0.f, 0.f, 0.f, 0.f};
    gemm_loop<4, 4>(G + (size_t)m0 * DM, DM, WR + (size_t)n0 * DM, DM, DM, a1, sA);
    const bfu *ga, *gb;
    if (m0 < TP) { ga = (const bfu*)(p.out + O_YP) + (size_t)m0 * DM + n0; gb = ga + (size_t)TP * DM; }
    else { ga = (const bfu*)(p.out + O_YS) + (size_t)(m0 - TP) * DM + n0; gb = ga + (size_t)TS * DM; }
    bfu* mxT = MX + (size_t)m0 * DM + n0;
    unsigned loff = (unsigned)((wr * 64 + quad * 4) * DM + wc * 64 + l16); asm volatile("" : "+v"(loff));
#pragma unroll
    for (int mi = 0; mi < 4; mi++)
#pragma unroll
      for (int ni = 0; ni < 4; ni++) {
#pragma unroll
        for (int j = 0; j < 4; j++) { unsigned o = loff + (unsigned)((mi * 16 + j) * DM + ni * 16);
          mxT[o] = f2bf(sigmoidf_(bf2f(ga[o])) * a1[mi][ni][j]); }
        a1[mi][ni] = f32x4{0.f, 0.f, 0.f, 0.f};
        __builtin_amdgcn_sched_barrier(0);
      }
    gemm_loop<4, 4>(FO + (size_t)m0 * 512, 512, WF + (size_t)n0 * 512, 512, 512, a1, sA);
    unsigned loff2 = loff; asm volatile("" : "+v"(loff2));
#pragma unroll
    for (int mi = 0; mi < 4; mi++)
#pragma unroll
      for (int ni = 0; ni < 4; ni++) {
#pragma unroll
        for (int j = 0; j < 4; j++) { unsigned o = loff2 + (unsigned)((mi * 16 + j) * DM + ni * 16);
          mxT[o] = f2bf(bf2f(mxT[o]) + sigmoidf_(bf2f(gb[o])) * a1[mi][ni][j]); }
        __builtin_amdgcn_sched_barrier(0);
      }
  }
}

DEV void phase6(const Params& p, int bid, int nb, char* smem) {
  const int tid = threadIdx.x, lane = tid & 63, w = tid >> 6, wr = w >> 1, wc = w & 1, l16 = lane & 15, quad = lane >> 4;
  bfu* sA = (bfu*)smem; bfu* sB = sA + 128 * 72;
  const bfu* MX = (const bfu*)(p.ws + OFF_XB); const bfu* WO = (const bfu*)(p.ws + OFF_WOT);
  bfu* X1B = (bfu*)(p.ws + OFF_X1B); float* SSQ2 = (float*)(p.ws + OFF_SSQ2);
  constexpr int NG = (TT / 128) * 8;
  const int xcd = bid & 7, slot = bid >> 3, nslots = (nb + 7 - xcd) >> 3;
  const int n_p = slot < 256 ? (256 - slot + nslots - 1) / nslots : 0;
  const int n_s = bid < 32 ? 1 : 0;
  for (int i_ = 0; i_ < n_p + n_s; i_++) {
    int mt, nt;
    if (i_ < n_p) { int q = slot + i_ * nslots; mt = xcd * 32 + (q >> 3); nt = q & 7; } else { mt = 256 + (bid >> 3); nt = bid & 7; }
    int m0 = mt * 128, n0 = nt * 128;
    f32x4 acc[4][4];
#pragma unroll
    for (int i = 0; i < 4; i++)
#pragma unroll
      for (int j = 0; j < 4; j++) acc[i][j] = f32x4{0.f, 0.f, 0.f, 0.f};
    gemm_loop<4, 4>(MX + (size_t)m0 * DM, DM, WO + (size_t)n0 * DM, DM, DM, acc, sA);
    const float* xin = (m0 < TP ? p.x_p + (size_t)m0 * DM : p.x_s + (size_t)(m0 - TP) * DM) + n0;
    float* y = (m0 < TP ? p.out + O_YP + (size_t)m0 * DM : p.out + O_YS + (size_t)(m0 - TP) * DM) + n0;
    bfu* xb1 = X1B + (size_t)m0 * DM + n0;
    unsigned loff = (unsigned)((wr * 64 + quad * 4) * DM + wc * 64 + l16); asm volatile("" : "+v"(loff));
#pragma unroll
    for (int mi = 0; mi < 4; mi++)
#pragma unroll
      for (int j = 0; j < 4; j++) {
        int lr = wr * 64 + mi * 16 + quad * 4 + j; float ss = 0.f;
#pragma unroll
        for (int ni = 0; ni < 4; ni++) {
          unsigned o = loff + (unsigned)((mi * 16 + j) * DM + ni * 16);
          float v = xin[o] + acc[mi][ni][j];
          y[o] = v; xb1[o] = f2bf(v); ss += v * v;
        }
        ss = sum16(ss);
        if (l16 == 0) (SSQ2 + (size_t)m0 * 16 + nt * 2)[(unsigned)(lr * 16 + wc)] = ss;
      }
  }
}

DEV int fkey(float x, int idx, int mask) { int b = __float_as_int(x); b ^= (b >> 31) & 0x7fffffff; return (b & ~mask) | idx; }
DEV void ins16(int (&t)[16], int v) {
#pragma unroll
  for (int s = 0; s < 16; s++) { int hi = max(t[s], v); v = min(t[s], v); t[s] = hi; }
}

DEV void phase7(const Params& p, int bid, int nb, char* smem) {
  const int tid = threadIdx.x, lane = tid & 63, w = tid >> 6, wr = w >> 1, wc = w & 1, l16 = lane & 15, quad = lane >> 4;
  bfu* sA = (bfu*)smem;
  float* sS = (float*)smem;
  int* sL = (int*)(smem + 33024);
  float* sTV = (float*)(smem + 55296);
  int* sTI = (int*)(sTV + 2 * 64 * 17);
  const bfu* X1B = (const bfu*)(p.ws + OFF_X1B); const bfu* MT = (const bfu*)(p.ws + OFF_MT);
  const float* SSQ2 = (const float*)(p.ws + OFF_SSQ2);
  int2* ROUTE = (int2*)(p.ws + OFF_ROUTE);
  constexpr int NI7 = (TT / 64) * 8;
  const int xcd = bid & 7, slot = bid >> 3, nslots = (nb + 7 - xcd) >> 3;
  for (int q = slot; q < 520; q += nslots) {
    int hg = q / 260, q2 = q - hg * 260; int mt = xcd * 65 + (q2 >> 2), h = hg * 4 + (q2 & 3); int m0 = mt * 64;
    for (int half = 0; half < 2; half++) {
      f32x4 acc[2][4];
#pragma unroll
      for (int i = 0; i < 2; i++)
#pragma unroll
        for (int j = 0; j < 4; j++) acc[i][j] = f32x4{0.f, 0.f, 0.f, 0.f};
      gemm_loop<2, 4>(X1B + (size_t)m0 * DM, DM, MT + (size_t)(h * 256 + half * 128) * DM, DM, DM, acc, sA);
      __syncthreads();
#pragma unroll
      for (int mi = 0; mi < 2; mi++)
#pragma unroll
        for (int j = 0; j < 4; j++) {
          int lr = wr * 32 + mi * 16 + quad * 4 + j;
          const float* sp = SSQ2 + (size_t)(m0 + lr) * 16; float tot = 0.f;
#pragma unroll
          for (int i = 0; i < 16; i++) tot += sp[i];
          float rs = rsqrtf(tot * (1.f / DM) + EPSN);
#pragma unroll
          for (int ni = 0; ni < 4; ni++) sS[lr * 129 + wc * 64 + ni * 16 + l16] = acc[mi][ni][j] * rs;
        }
      __syncthreads();
      { int row = tid & 63, q = tid >> 6; int t[16];
#pragma unroll
        for (int s = 0; s < 16; s++) t[s] = (int)0x80000000;
        for (int i = 0; i < 32; i++) { int idx = q * 32 + i; ins16(t, fkey(sS[row * 129 + idx], idx, 127)); }
#pragma unroll
        for (int s = 0; s < 16; s++) sL[row * 65 + q * 16 + s] = t[s]; }
      __syncthreads();
      if (tid < 64) { int row = tid; int p0 = 0, p1 = 0, p2 = 0, p3 = 0; const int* L = sL + row * 65;
        for (int r = 0; r < 16; r++) {
          int a0 = L[p0], a1 = L[16 + p1], a2 = L[32 + p2], a3 = L[48 + p3];
          int mx = max(max(a0, a1), max(a2, a3));
          if (mx == a0) p0++; else if (mx == a1) p1++; else if (mx == a2) p2++; else p3++;
          int idx = mx & 127;
          sTV[(half * 64 + row) * 17 + r] = sS[row * 129 + idx]; sTI[(half * 64 + row) * 17 + r] = idx; } }
      __syncthreads();
    }
    if (tid < 64) {
      int row = tid; float v1[16], v2[16];
#pragma unroll
      for (int i = 0; i < 16; i++) { v1[i] = sTV[row * 17 + i]; v2[i] = sTV[(64 + row) * 17 + i]; }
      int t[16];
#pragma unroll
      for (int s = 0; s < 16; s++) t[s] = (int)0x80000000;
#pragma unroll
      for (int i = 0; i < 16; i++)
#pragma unroll
        for (int j = 0; j < 16; j++)
          if ((i + 1) * (j + 1) <= 16) ins16(t, fkey(v1[i] + v2[j], i * 16 + j, 255));
      float es[16]; int ei[16]; float mx = 0.f, sum = 0.f;
#pragma unroll
      for (int r = 0; r < 16; r++) { int c = t[r] & 255; int i = c >> 4, j = c & 15;
        float s = sTV[row * 17 + i] + sTV[(64 + row) * 17 + j];
        ei[r] = sTI[row * 17 + i] * 128 + sTI[(64 + row) * 17 + j];
        if (r == 0) mx = s;
        es[r] = __expf(s - mx); sum += es[r]; }
      float inv = 1.f / sum;
      int2* ro = ROUTE + ((size_t)(m0 + row) * 8 + h) * 16;
#pragma unroll
      for (int r = 0; r < 16; r++) ro[r] = make_int2(ei[r], __float_as_int(es[r] * inv));
    }
    __syncthreads();
  }
}

DEV float dot16_fp8(const u32x4& u, const float (&xn)[16]) {
  f32x2 a;
  float d;
  a = __builtin_amdgcn_cvt_pk_f32_fp8((int)u.x, false); d = a[0] * xn[0] + a[1] * xn[1];
  a = __builtin_amdgcn_cvt_pk_f32_fp8((int)u.x, true); d += a[0] * xn[2] + a[1] * xn[3];
  a = __builtin_amdgcn_cvt_pk_f32_fp8((int)u.y, false); d += a[0] * xn[4] + a[1] * xn[5];
  a = __builtin_amdgcn_cvt_pk_f32_fp8((int)u.y, true); d += a[0] * xn[6] + a[1] * xn[7];
  a = __builtin_amdgcn_cvt_pk_f32_fp8((int)u.z, false); d += a[0] * xn[8] + a[1] * xn[9];
  a = __builtin_amdgcn_cvt_pk_f32_fp8((int)u.z, true); d += a[0] * xn[10] + a[1] * xn[11];
  a = __builtin_amdgcn_cvt_pk_f32_fp8((int)u.w, false); d += a[0] * xn[12] + a[1] * xn[13];
  a = __builtin_amdgcn_cvt_pk_f32_fp8((int)u.w, true); d += a[0] * xn[14] + a[1] * xn[15];
  return d;
}
DEV void axpy16_fp8(const u32x4& u, float wj, float (&acc)[16]) {
  f32x2 a;
  a = __builtin_amdgcn_cvt_pk_f32_fp8((int)u.x, false); acc[0] += wj * a[0]; acc[1] += wj * a[1];
  a = __builtin_amdgcn_cvt_pk_f32_fp8((int)u.x, true); acc[2] += wj * a[0]; acc[3] += wj * a[1];
  a = __builtin_amdgcn_cvt_pk_f32_fp8((int)u.y, false); acc[4] += wj * a[0]; acc[5] += wj * a[1];
  a = __builtin_amdgcn_cvt_pk_f32_fp8((int)u.y, true); acc[6] += wj * a[0]; acc[7] += wj * a[1];
  a = __builtin_amdgcn_cvt_pk_f32_fp8((int)u.z, false); acc[8] += wj * a[0]; acc[9] += wj * a[1];
  a = __builtin_amdgcn_cvt_pk_f32_fp8((int)u.z, true); acc[10] += wj * a[0]; acc[11] += wj * a[1];
  a = __builtin_amdgcn_cvt_pk_f32_fp8((int)u.w, false); acc[12] += wj * a[0]; acc[13] += wj * a[1];
  a = __builtin_amdgcn_cvt_pk_f32_fp8((int)u.w, true); acc[14] += wj * a[0]; acc[15] += wj * a[1];
}
template <int S>
DEV void red_step(float (&pp)[16], int lane) {
  const bool up = (lane & S) != 0;
#pragma unroll
  for (int i = 0; i < S; i++) {
    float send = up ? pp[i] : pp[i + S];
    float keep = up ? pp[i + S] : pp[i];
    pp[i] = keep + __shfl_xor(send, S);
  }
}
DEV float reduce16(float (&pp)[16], int lane) {
  red_step<8>(pp, lane); red_step<4>(pp, lane); red_step<2>(pp, lane); red_step<1>(pp, lane);
  float v = pp[0];
  v += __shfl_xor(v, 16); v += __shfl_xor(v, 32);
  return v;
}

DEV void phase8(const Params& p, int bid, int nb, char* smem, bool dry = false) {
  const int tid = threadIdx.x, lane = tid & 63, w = __builtin_amdgcn_readfirstlane(tid >> 6);
  const u32x4* PUB = (const u32x4*)(p.ws + OFF_PUB); const u32x4* PVB = (const u32x4*)(p.ws + OFF_PVB);
  const float* PSC = (const float*)(p.ws + OFF_PSC);
  const float* SSQ2 = (const float*)(p.ws + OFF_SSQ2); const int2* ROUTE = (const int2*)(p.ws + OFF_ROUTE);
  for (int it = bid; it < TT / 4; it += nb) {
    int tok = it * 4 + w;
    float* y = tok < TP ? p.out + O_YP + (size_t)tok * DM : p.out + O_YS + (size_t)(tok - TP) * DM;
    float x[16], xn[16];
    { float4 a0 = *(const float4*)(y + lane * 16), a1 = *(const float4*)(y + lane * 16 + 4), b0 = *(const float4*)(y + lane * 16 + 8), b1 = *(const float4*)(y + lane * 16 + 12);
      x[0] = a0.x; x[1] = a0.y; x[2] = a0.z; x[3] = a0.w; x[4] = a1.x; x[5] = a1.y; x[6] = a1.z; x[7] = a1.w;
      x[8] = b0.x; x[9] = b0.y; x[10] = b0.z; x[11] = b0.w; x[12] = b1.x; x[13] = b1.y; x[14] = b1.z; x[15] = b1.w; }
    float tot = 0.f;
    { const float* sp = SSQ2 + (size_t)tok * 16;
#pragma unroll
      for (int i = 0; i < 16; i++) tot += sp[i]; }
    float rs = rsqrtf(tot * (1.f / DM) + EPSN);
#pragma unroll
    for (int i = 0; i < 16; i++) xn[i] = x[i] * rs * p.norm2_g[lane * 16 + i];
    const int2* rt = ROUTE + (size_t)tok * 128;
    int2 r0 = rt[lane], r1 = rt[lane + 64];
    float d0 = 0.f, d1 = 0.f;
#pragma unroll 1
    for (int g = 0; g < 4; g++) {
      float pp[16]; u32x4 u[16];
#pragma unroll
      for (int jj = 0; jj < 16; jj++) { int e = __builtin_amdgcn_readlane(r0.x, g * 16 + jj); u[jj] = PUB[(size_t)e * 64 + lane]; }
      __builtin_amdgcn_sched_barrier(0);
#pragma unroll
      for (int jj = 0; jj < 16; jj++) pp[jj] = dot16_fp8(u[jj], xn);
      float v = reduce16(pp, lane);
      if ((lane >> 4) == g) d0 = v;
    }
#pragma unroll 1
    for (int g = 0; g < 4; g++) {
      float pp[16]; u32x4 u[16];
#pragma unroll
      for (int jj = 0; jj < 16; jj++) { int e = __builtin_amdgcn_readlane(r1.x, g * 16 + jj); u[jj] = PUB[(size_t)e * 64 + lane]; }
      __builtin_amdgcn_sched_barrier(0);
#pragma unroll
      for (int jj = 0; jj < 16; jj++) pp[jj] = dot16_fp8(u[jj], xn);
      float v = reduce16(pp, lane);
      if ((lane >> 4) == g) d1 = v;
    }
    d0 *= PSC[r0.x]; d1 *= PSC[r1.x];
    const float w0 = 0.5f * d0 * (1.f + erff(d0 * 0.70710678118654752f)) * __int_as_float(r0.y) * PSC[16384 + r0.x];
    const float w1 = 0.5f * d1 * (1.f + erff(d1 * 0.70710678118654752f)) * __int_as_float(r1.y) * PSC[16384 + r1.x];
    float acc[16];
#pragma unroll
    for (int i = 0; i < 16; i++) acc[i] = 0.f;
#pragma unroll 1
    for (int g = 0; g < 8; g++) {
      const int rx = g < 4 ? r0.x : r1.x; const int wx = __float_as_int(g < 4 ? w0 : w1);
      u32x4 u[16];
#pragma unroll
      for (int jj = 0; jj < 16; jj++) { int e = __builtin_amdgcn_readlane(rx, (g & 3) * 16 + jj); u[jj] = PVB[(size_t)e * 64 + lane]; }
      __builtin_amdgcn_sched_barrier(0);
#pragma unroll
      for (int jj = 0; jj < 16; jj++) { float wj = __int_as_float(__builtin_amdgcn_readlane(wx, (g & 3) * 16 + jj)); axpy16_fp8(u[jj], wj, acc); }
    }
    if (dry) y = (float*)(p.ws + OFF_XB) + (size_t)(tok & 8191) * DM;
    *(float4*)(y + lane * 16) = make_float4(x[0] + acc[0], x[1] + acc[1], x[2] + acc[2], x[3] + acc[3]);
    *(float4*)(y + lane * 16 + 4) = make_float4(x[4] + acc[4], x[5] + acc[5], x[6] + acc[6], x[7] + acc[7]);
    *(float4*)(y + lane * 16 + 8) = make_float4(x[8] + acc[8], x[9] + acc[9], x[10] + acc[10], x[11] + acc[11]);
    *(float4*)(y + lane * 16 + 12) = make_float4(x[12] + acc[12], x[13] + acc[13], x[14] + acc[14], x[15] + acc[15]);
  }
}

__global__ void __launch_bounds__(256, 2) fwd_kernel(Params p, int ph_lo, int ph_hi, int coop) {
  __shared__ __attribute__((aligned(16))) char smem[SMEM_BYTES];
  const int bid = blockIdx.x, nb = gridDim.x;
#ifndef REPS
#define REPS {1,1,1,1,1,1,1,1,1}
#endif
  constexpr int REP[9] = REPS;
#define RUN_PHASE(N) if (ph_lo <= N && N <= ph_hi) { for (int r_ = 0; r_ < REP[N]; r_++) phase##N(p, bid, nb, smem); if (coop && N < ph_hi) cg::this_grid().sync(); }
#define RUN_PHASE_DRY(N) if (ph_lo <= N && N <= ph_hi) { for (int r_ = 1; r_ < REP[N]; r_++) phase##N(p, bid, nb, smem, true); phase##N(p, bid, nb, smem, false); if (coop && N < ph_hi) cg::this_grid().sync(); }
  RUN_PHASE(0) RUN_PHASE(1) RUN_PHASE(2) RUN_PHASE(3) RUN_PHASE_DRY(4) RUN_PHASE(5) RUN_PHASE(6) RUN_PHASE(7) RUN_PHASE_DRY(8)
}

extern "C" void kernel_launch(void* const* d_in, const int* in_sizes, int n_in, void* d_out, int out_size,
                              void* d_ws, size_t ws_size, hipStream_t stream) {
  if (ws_size < WS_NEED) { fprintf(stderr, "workspace too small\n"); return; }
  static int grid_blocks = 0;
  if (!grid_blocks) {
    int dev = 0, cus = 0, per_cu = 0;
    hipGetDevice(&dev);
    hipDeviceGetAttribute(&cus, hipDeviceAttributeMultiprocessorCount, dev);
    hipOccupancyMaxActiveBlocksPerMultiprocessor(&per_cu, fwd_kernel, 256, 0);
    if (per_cu < 1) per_cu = 1;
    if (per_cu > 2) per_cu = 2;
    grid_blocks = cus * per_cu;
  }
  Params p{};
  const float* const* in = (const float* const*)d_in;
  p.x_p = in[0]; p.x_s = in[1]; p.state_ret = in[2]; p.ck = in[3]; p.cv = in[4]; p.clogf = in[5]; p.norm1_g = in[6];
  p.w_in = in[7]; p.b_f = in[8]; p.fq_g = in[9]; p.fk_g = in[10]; p.gn_g = in[11]; p.w_ret_out = in[12]; p.w_fox_out = in[13];
  p.w_o = in[14]; p.norm2_g = in[15]; p.peer_wq = in[16]; p.k1 = in[17]; p.k2 = in[18]; p.peer_u = in[19]; p.peer_v = in[20];
  p.out = (float*)d_out; p.ws = (char*)d_ws;
#ifndef MULTI_LAUNCH
#define MULTI_LAUNCH 0
#endif
#if MULTI_LAUNCH
  for (int ph = 0; ph <= 8; ph++) fwd_kernel<<<grid_blocks, 256, 0, stream>>>(p, ph, ph, 0);
#else
  int lo = 0, hi = 8, coop = 1;
  void* args[] = {&p, &lo, &hi, &coop};
  hipError_t e = hipLaunchCooperativeKernel((void*)fwd_kernel, dim3(grid_blocks), dim3(256), args, 0, stream);
  if (e != hipSuccess) fprintf(stderr, "cooperative launch failed: %s (grid %d)\n", hipGetErrorString(e), grid_blocks);
#endif
}
```

```cpp
#include <hip/hip_runtime.h>
#include <hip/hip_cooperative_groups.h>
#include <stdint.h>
#include <stdio.h>
namespace cg = cooperative_groups;

#define DEV __device__ __forceinline__
typedef unsigned short bfu;
typedef __attribute__((ext_vector_type(8))) short bf16x8;
typedef __attribute__((ext_vector_type(4))) short bf16x4;
typedef __attribute__((ext_vector_type(4))) float f32x4;
typedef __attribute__((ext_vector_type(16))) float f32x16;
typedef __attribute__((ext_vector_type(4))) unsigned u32x4;
typedef __attribute__((ext_vector_type(2))) float f32x2;

constexpr int DM = 1024, SEQ = 16384, TP = 32768, TS = 512, TT = 33280;
constexpr int NWP = 6784;
constexpr int RC = 128;
constexpr int NCH = SEQ / RC;
constexpr float LOG2E = 1.4426950408889634f;
constexpr float EPSN = 1e-6f;

constexpr size_t O_YP = 0, O_YS = 33554432, O_SP = 34078720, O_FKP = 34209792, O_FVP = 50987008,
                 O_LFP = 67764224, O_SS = 68026368, O_FKS = 70123520, O_FVS = 70385664, O_LFS = 70647808;
constexpr size_t MiB = 1u << 20;
constexpr size_t OFF_XB = 0;
constexpr size_t OFF_WINT = 66 * MiB, OFF_WRT = 80 * MiB, OFF_WFT = 82 * MiB, OFF_WOT = 83 * MiB, OFF_MT = 85 * MiB;
constexpr size_t OFF_RSTD1 = 89 * MiB, OFF_C2 = 90 * MiB, OFF_HS = 91 * MiB;
constexpr size_t OFF_QT = 105 * MiB, OFF_KT = 137 * MiB, OFF_KTT = 169 * MiB, OFF_VT = 201 * MiB;
constexpr size_t OFF_X1B = OFF_HS;
constexpr size_t OFF_RG = 265 * MiB, OFF_FQ = 331 * MiB, OFF_FKB = 364 * MiB, OFF_FVT = 396 * MiB;
constexpr size_t OFF_PUB = OFF_KTT, OFF_PVB = OFF_KTT + 16 * MiB;
constexpr size_t OFF_ROUTE = OFF_FKB, OFF_SSQ2 = OFF_FKB + 33 * MiB;
constexpr size_t OFF_PSC = OFF_RSTD1 + 512 * 1024;
constexpr size_t OFF_SST = 428 * MiB;
constexpr size_t WS_NEED = 460 * MiB;

constexpr int SMEM_BYTES = 75776;

struct Params {
  const float *x_p, *x_s, *state_ret, *ck, *cv, *clogf, *norm1_g, *w_in, *b_f, *fq_g, *fk_g, *gn_g,
      *w_ret_out, *w_fox_out, *w_o, *norm2_g, *peer_wq, *k1, *k2, *peer_u, *peer_v;
  float* out;
  char* ws;
};

DEV bfu f2bf(float f) { unsigned u = __float_as_uint(f); u += 0x7fffu + ((u >> 16) & 1u); return (bfu)(u >> 16); }
DEV float bf2f(bfu b) { return __uint_as_float(((unsigned)b) << 16); }
DEV unsigned pack2(float a, float b) { return (unsigned)f2bf(a) | ((unsigned)f2bf(b) << 16); }
DEV float bflo(unsigned u) { return __uint_as_float(u << 16); }
DEV float bfhi(unsigned u) { return __uint_as_float(u & 0xffff0000u); }
DEV float sigmoidf_(float z) { return 1.f / (1.f + __expf(-z)); }
DEV float l2gamma(int h) { return log2f(1.f - exp2f(-5.f - (float)h)); }
DEV float wave_sum(float v) {
#pragma unroll
  for (int o = 32; o >= 1; o >>= 1) v += __shfl_xor(v, o);
  return v;
}
DEV float sum16(float v) {
  v += __shfl_xor(v, 1); v += __shfl_xor(v, 2); v += __shfl_xor(v, 4); v += __shfl_xor(v, 8);
  return v;
}

template <int ROWS>
DEV void g2r(const bfu* g, int ld, u32x4 (&r)[ROWS / 32], int tid_ = threadIdx.x) {
#pragma unroll
  for (int i = 0; i < ROWS / 32; i++) {
    int id = tid_ + i * 256; int row = id >> 3, ch = id & 7;
    const unsigned off = (unsigned)(row * ld + ch * 8);
    r[i] = *(const u32x4*)(g + off);
  }
}
template <int ROWS>
DEV void r2s(bfu* s, const u32x4 (&r)[ROWS / 32], int tid_ = threadIdx.x) {
#pragma unroll
  for (int i = 0; i < ROWS / 32; i++) {
    int id = tid_ + i * 256; int row = id >> 3, ch = id & 7;
    *(u32x4*)(s + row * 72 + ch * 8) = r[i];
  }
}
template <int MI, int NI>
DEV void mma64(const bfu* sA, int sldA, const bfu* sB, int sldB, f32x4 (&acc)[MI][NI]) {
  const int lane = threadIdx.x & 63, w = threadIdx.x >> 6, wr = w >> 1, wc = w & 1, l16 = lane & 15, quad = lane >> 4;
#pragma unroll
  for (int kk = 0; kk < 2; kk++) {
    bf16x8 a[MI], b[NI];
#pragma unroll
    for (int mi = 0; mi < MI; mi++) a[mi] = *(const bf16x8*)(sA + (wr * MI * 16 + mi * 16 + l16) * sldA + kk * 32 + quad * 8);
#pragma unroll
    for (int ni = 0; ni < NI; ni++) b[ni] = *(const bf16x8*)(sB + (wc * NI * 16 + ni * 16 + l16) * sldB + kk * 32 + quad * 8);
#pragma unroll
    for (int mi = 0; mi < MI; mi++)
#pragma unroll
      for (int ni = 0; ni < NI; ni++) acc[mi][ni] = __builtin_amdgcn_mfma_f32_16x16x32_bf16(a[mi], b[ni], acc[mi][ni], 0, 0, 0);
  }
}
template <int ROWS>
DEV void r2sw(bfu* s, const u32x4 (&r)[ROWS / 32], int tid_) {
#pragma unroll
  for (int i = 0; i < ROWS / 32; i++) {
    int id = tid_ + i * 256; int row = id >> 3, ch = id & 7;
    int byte = (((row >> 4) * 2 + (ch >> 2)) << 10) + ((((row & 15) << 6) + ((ch & 3) << 4)) ^ (((row >> 3) & 1) << 5));
    *(u32x4*)((char*)s + byte) = r[i];
  }
}
template <int MI, int NI>
DEV void mma64w(const bfu* sA, const bfu* sB, f32x4 (&acc)[MI][NI]) {
  const int lane = threadIdx.x & 63, w = threadIdx.x >> 6, wr = w >> 1, wc = w & 1, l16 = lane & 15, quad = lane >> 4;
  const int lo = ((l16 << 6) + (quad << 4)) ^ (((l16 >> 3) & 1) << 5);
#pragma unroll
  for (int kk = 0; kk < 2; kk++) {
    bf16x8 a[MI], b[NI];
#pragma unroll
    for (int mi = 0; mi < MI; mi++) a[mi] = *(const bf16x8*)((const char*)sA + (((wr * MI + mi) * 2 + kk) << 10) + lo);
#pragma unroll
    for (int ni = 0; ni < NI; ni++) b[ni] = *(const bf16x8*)((const char*)sB + (((wc * NI + ni) * 2 + kk) << 10) + lo);
#pragma unroll
    for (int mi = 0; mi < MI; mi++)
#pragma unroll
      for (int ni = 0; ni < NI; ni++) acc[mi][ni] = __builtin_amdgcn_mfma_f32_16x16x32_bf16(a[mi], b[ni], acc[mi][ni], 0, 0, 0);
  }
}
template <int MI, int NI>
DEV void mma64w_big(const bfu* sA, const bfu* sB, f32x4 (&acc)[MI][NI]) {
  const int lane = threadIdx.x & 63, w = threadIdx.x >> 6, wr = w >> 1, wc = w & 1, l16 = lane & 15, quad = lane >> 4;
  const int lo = ((l16 << 6) + (quad << 4)) ^ (((l16 >> 3) & 1) << 5);
#pragma unroll
  for (int kk = 0; kk < 2; kk++) {
    bf16x8 b[NI];
#pragma unroll
    for (int ni = 0; ni < NI; ni++) b[ni] = *(const bf16x8*)((const char*)sB + (((wc * NI + ni) * 2 + kk) << 10) + lo);
#pragma unroll
    for (int mi = 0; mi < MI; mi++) {
      bf16x8 a = *(const bf16x8*)((const char*)sA + (((wr * MI + mi) * 2 + kk) << 10) + lo);
#pragma unroll
      for (int ni = 0; ni < NI; ni++) acc[mi][ni] = __builtin_amdgcn_mfma_f32_16x16x32_bf16(a, b[ni], acc[mi][ni], 0, 0, 0);
    }
  }
}
template <int MI, int NI>
DEV void gemm_loop_sb(const bfu* A, int lda, const bfu* B, int ldb, int K, f32x4 (&acc)[MI][NI], bfu* sbuf) {
  constexpr int BM = 32 * MI, BN = 32 * NI;
  bfu* sA = sbuf; bfu* sB = sA + BM * 64;
  const int nk = K >> 6;
  int t_ = threadIdx.x; asm volatile("" : "+v"(t_));
  u32x4 ra[BM / 32], rb[BN / 32];
  g2r<BM>(A, lda, ra, t_); g2r<BN>(B, ldb, rb, t_);
#pragma unroll 1
  for (int k = 0; k < nk; k++) {
    __syncthreads();
    r2sw<BM>(sA, ra, t_); r2sw<BN>(sB, rb, t_);
    __syncthreads();
    if (k + 1 < nk) { g2r<BM>(A + (k + 1) * 64, lda, ra, t_); g2r<BN>(B + (k + 1) * 64, ldb, rb, t_); }
    mma64w_big<MI, NI>(sA, sB, acc);
  }
}

template <int MI, int NI>
DEV void gemm_loop(const bfu* A, int lda, const bfu* B, int ldb, int K, f32x4 (&acc)[MI][NI], bfu* sbuf) {
  constexpr int BM = 32 * MI, BN = 32 * NI;
  bfu* sA0 = sbuf; bfu* sB0 = sA0 + BM * 64; bfu* sA1 = sB0 + BN * 64; bfu* sB1 = sA1 + BM * 64;
  const int nk = K >> 6;
  int t_ = threadIdx.x; asm volatile("" : "+v"(t_));
  u32x4 ra0[BM / 32], rb0[BN / 32], ra1[BM / 32], rb1[BN / 32];
  g2r<BM>(A, lda, ra0, t_); g2r<BN>(B, ldb, rb0, t_);
  if (nk > 1) { g2r<BM>(A + 64, lda, ra1, t_); g2r<BN>(B + 64, ldb, rb1, t_); }
  __syncthreads();
  r2sw<BM>(sA0, ra0, t_); r2sw<BN>(sB0, rb0, t_);
  if (nk > 2) { g2r<BM>(A + 128, lda, ra0, t_); g2r<BN>(B + 128, ldb, rb0, t_); }
  __syncthreads();
  for (int k = 0; k < nk; k += 2) {
    if (k + 1 < nk) { r2sw<BM>(sA1, ra1, t_); r2sw<BN>(sB1, rb1, t_); }
    if (k + 3 < nk) { g2r<BM>(A + (k + 3) * 64, lda, ra1, t_); g2r<BN>(B + (k + 3) * 64, ldb, rb1, t_); }
    mma64w<MI, NI>(sA0, sB0, acc);
    __syncthreads();
    if (k + 1 >= nk) break;
    if (k + 2 < nk) { r2sw<BM>(sA0, ra0, t_); r2sw<BN>(sB0, rb0, t_); }
    if (k + 4 < nk) { g2r<BM>(A + (k + 4) * 64, lda, ra0, t_); g2r<BN>(B + (k + 4) * 64, ldb, rb0, t_); }
    mma64w<MI, NI>(sA1, sB1, acc);
    __syncthreads();
  }
}

DEV void transpose_tile(const float* src, int ldsrc, int srccol0, int validcols, const float* scale,
                        bfu* dst, int lddst, int n0, int k0, float* sT) {
  const int tid = threadIdx.x;
  __syncthreads();
#pragma unroll
  for (int i = 0; i < 4; i++) {
    int kk = (tid >> 4) + i * 16, c = (tid & 15) * 4;
    float4 v = make_float4(0.f, 0.f, 0.f, 0.f);
    if (c < validcols) v = *(const float4*)(src + (size_t)(k0 + kk) * ldsrc + srccol0 + c);
    float s = scale ? scale[k0 + kk] : 1.f;
    sT[kk * 65 + c] = v.x * s; sT[kk * 65 + c + 1] = v.y * s; sT[kk * 65 + c + 2] = v.z * s; sT[kk * 65 + c + 3] = v.w * s;
  }
  __syncthreads();
  int n = tid >> 2, kc = (tid & 3) * 16;
  unsigned o[8];
#pragma unroll
  for (int e = 0; e < 8; e++) o[e] = pack2(sT[(kc + 2 * e) * 65 + n], sT[(kc + 2 * e + 1) * 65 + n]);
  uint4* d = (uint4*)(dst + (size_t)(n0 + n) * lddst + k0 + kc);
  d[0] = make_uint4(o[0], o[1], o[2], o[3]); d[1] = make_uint4(o[4], o[5], o[6], o[7]);
}

DEV void phase0(const Params& p, int bid, int nb, char* smem) {
  const int tid = threadIdx.x, lane = tid & 63, w = tid >> 6;
  constexpr int N_X = TT / 4, N_TW = 106 * 16, N_TR = 256, N_TF = 128, N_TO = 256, N_MT = 512;
  constexpr int B1 = N_X, B2 = B1 + N_TW, B3 = B2 + N_TR, B4 = B3 + N_TF, B5 = B4 + N_TO, TOT = B5 + N_MT;
  bfu* xb = (bfu*)(p.ws + OFF_XB); float* rstd1 = (float*)(p.ws + OFF_RSTD1);
  for (int it = bid; it < TOT; it += nb) {
    if (it < B1) {
      int row = it * 4 + w;
      const float* src = row < TP ? p.x_p + (size_t)row * DM : p.x_s + (size_t)(row - TP) * DM;
      float4 a0 = *(const float4*)(src + lane * 8), a1 = *(const float4*)(src + lane * 8 + 4);
      float4 b0 = *(const float4*)(src + 512 + lane * 8), b1 = *(const float4*)(src + 512 + lane * 8 + 4);
      float ss = a0.x * a0.x + a0.y * a0.y + a0.z * a0.z + a0.w * a0.w + a1.x * a1.x + a1.y * a1.y + a1.z * a1.z + a1.w * a1.w +
                 b0.x * b0.x + b0.y * b0.y + b0.z * b0.z + b0.w * b0.w + b1.x * b1.x + b1.y * b1.y + b1.z * b1.z + b1.w * b1.w;
      ss = wave_sum(ss);
      if (lane == 0) rstd1[row] = rsqrtf(ss * (1.f / DM) + EPSN);
      *(uint4*)(xb + (size_t)row * DM + lane * 8) = make_uint4(pack2(a0.x, a0.y), pack2(a0.z, a0.w), pack2(a1.x, a1.y), pack2(a1.z, a1.w));
      *(uint4*)(xb + (size_t)row * DM + 512 + lane * 8) = make_uint4(pack2(b0.x, b0.y), pack2(b0.z, b0.w), pack2(b1.x, b1.y), pack2(b1.z, b1.w));
    } else if (it < B2) {
      int j = it - B1; int nt = j >> 4, kt = j & 15; int n0 = nt * 64;
      int sc0, vc;
      if (n0 < 4608) { sc0 = n0; vc = 64; } else if (n0 < 6656) { sc0 = n0 + 8; vc = 64; } else if (n0 == 6656) { sc0 = 4608; vc = 8; } else { sc0 = 0; vc = 0; }
      transpose_tile(p.w_in, 6664, sc0, vc, p.norm1_g, (bfu*)(p.ws + OFF_WINT), DM, n0, kt * 64, (float*)smem);
    } else if (it < B3) {
      int j = it - B2; transpose_tile(p.w_ret_out, 1024, (j >> 4) * 64, 64, nullptr, (bfu*)(p.ws + OFF_WRT), 1024, (j >> 4) * 64, (j & 15) * 64, (float*)smem);
    } else if (it < B4) {
      int j = it - B3; transpose_tile(p.w_fox_out, 1024, (j >> 3) * 64, 64, nullptr, (bfu*)(p.ws + OFF_WFT), 512, (j >> 3) * 64, (j & 7) * 64, (float*)smem);
    } else if (it < B5) {
      int j = it - B4; transpose_tile(p.w_o, 1024, (j >> 4) * 64, 64, nullptr, (bfu*)(p.ws + OFF_WOT), 1024, (j >> 4) * 64, (j & 15) * 64, (float*)smem);
    } else {
      int j = it - B5; int hh = j >> 5, kt = (j >> 4) & 1, dt = j & 15;
      float* sW = (float*)smem; float* sK = sW + 64 * 129;
      const float* ksub = (hh & 1) ? p.k2 : p.k1;
      __syncthreads();
#pragma unroll
      for (int i = 0; i < 8; i++) {
        int id = tid + i * 256; int row = id >> 5, c4 = (id & 31) * 4;
        float4 v = *(const float4*)(p.peer_wq + (size_t)(dt * 64 + row) * 2048 + hh * 128 + c4);
        sW[row * 129 + c4] = v.x; sW[row * 129 + c4 + 1] = v.y; sW[row * 129 + c4 + 2] = v.z; sW[row * 129 + c4 + 3] = v.w;
        float4 u = *(const float4*)(ksub + (size_t)(kt * 64 + row) * 128 + c4);
        sK[row * 129 + c4] = u.x; sK[row * 129 + c4 + 1] = u.y; sK[row * 129 + c4 + 2] = u.z; sK[row * 129 + c4 + 3] = u.w;
      }
      __syncthreads();
      int ky = (tid >> 4) * 4, dd = (tid & 15) * 4;
      float a[4][4];
#pragma unroll
      for (int i = 0; i < 4; i++)
#pragma unroll
        for (int jj = 0; jj < 4; jj++) a[i][jj] = 0.f;
      for (int c = 0; c < 128; c++) {
        float kv[4], wv[4];
#pragma unroll
        for (int i = 0; i < 4; i++) { kv[i] = sK[(ky + i) * 129 + c]; wv[i] = sW[(dd + i) * 129 + c]; }
#pragma unroll
        for (int i = 0; i < 4; i++)
#pragma unroll
          for (int jj = 0; jj < 4; jj++) a[i][jj] += kv[i] * wv[jj];
      }
      bfu* MT = (bfu*)(p.ws + OFF_MT);
      float g0 = p.norm2_g[dt * 64 + dd], g1 = p.norm2_g[dt * 64 + dd + 1], g2 = p.norm2_g[dt * 64 + dd + 2], g3 = p.norm2_g[dt * 64 + dd + 3];
#pragma unroll
      for (int i = 0; i < 4; i++)
        *(uint2*)(MT + (size_t)(hh * 128 + kt * 64 + ky + i) * DM + dt * 64 + dd) = make_uint2(pack2(a[i][0] * g0, a[i][1] * g1), pack2(a[i][2] * g2, a[i][3] * g3));
    }
  }
}

DEV void rot_angle(int pos, int d, float& cs, float& sn) {
  float inv = exp2f(-(float)d * (13.287712379549449f / 32.f));
  float ang = (float)pos * inv;
  float rev = ang * 0.15915494309189535f;
  rev = rev - floorf(rev);
  sn = __builtin_amdgcn_sinf(rev); cs = __builtin_amdgcn_cosf(rev);
}

DEV void phase1(const Params& p, int bid, int nb, char* smem, bool noepi = false) {
  bfu* sA = (bfu*)smem; bfu* sB = sA + 128 * 72;
  const bfu* XB = (const bfu*)(p.ws + OFF_XB); const bfu* WT = (const bfu*)(p.ws + OFF_WINT);
  const float* rstd1 = (const float*)(p.ws + OFF_RSTD1);
  constexpr int NT = NWP / 128;
  const int xcd = bid & 7, slot = bid >> 3, nslots = (nb + 7 - xcd) >> 3;
  constexpr int MI1 = 8;
  const int nprompt = 16 * NT;
  const int n_p = slot < nprompt ? (nprompt - slot + nslots - 1) / nslots : 0;
  const int n_s = bid < 2 * NT ? (2 * NT - bid + nb - 1) / nb : 0;
  for (int i_ = 0; i_ < n_p + n_s; i_++) {
    int mt, nt;
    if (i_ < n_p) { int q = slot + i_ * nslots; int sub = q / (8 * NT), rem = q - sub * (8 * NT); nt = rem >> 3; mt = xcd * 16 + sub * 8 + (rem & 7); }
    else { int it = bid + (i_ - n_p) * nb; mt = 128 + it / NT; nt = it - (it / NT) * NT; }
    int m0 = mt * 256, n0 = nt * 128;
    int tid = threadIdx.x; asm volatile("" : "+v"(tid));
    const int lane = tid & 63, w = tid >> 6, wr = w >> 1, wc = w & 1, l16 = lane & 15, quad = lane >> 4;
    f32x4 acc[MI1][4];
#pragma unroll
    for (int i = 0; i < MI1; i++)
#pragma unroll
      for (int j = 0; j < 4; j++) acc[i][j] = f32x4{0.f, 0.f, 0.f, 0.f};
    gemm_loop_sb<MI1, 4>(XB + (size_t)m0 * DM, DM, WT + (size_t)n0 * DM, DM, DM, acc, sA);
    if (noepi) { float t_ = 0.f;
#pragma unroll
      for (int i = 0; i < MI1; i++)
#pragma unroll
        for (int j = 0; j < 4; j++) t_ += acc[i][j][0] + acc[i][j][1] + acc[i][j][2] + acc[i][j][3];
      if (t_ == 12345.678f) p.out[0] = 1.f; continue; }
    const int rbase = m0 + wr * (MI1 * 16) + quad * 4;
    const int cbase = n0 + wc * 64 + l16;
    if (m0 >= TP) {
      float* hs = (float*)(p.ws + OFF_HS);
      bfu* gaS = (bfu*)(p.out + O_YS); bfu* gbS = gaS + (size_t)TS * DM;
#pragma unroll
      for (int mi = 0; mi < MI1; mi++)
#pragma unroll
        for (int j = 0; j < 4; j++) {
          int row = rbase + mi * 16 + j; float rs = rstd1[row]; int sr = row - TP;
#pragma unroll
          for (int ni = 0; ni < 4; ni++) {
            int col = cbase + ni * 16; float v = acc[mi][ni][j] * rs;
            if (n0 >= 4608 && n0 < 5632) gaS[(size_t)sr * DM + col - 4608] = f2bf(v);
            else if (n0 >= 5632 && n0 < 6656) gbS[(size_t)sr * DM + col - 5632] = f2bf(v);
            else hs[(size_t)sr * NWP + col] = v;
          }
        }
      continue;
    }
    const int b = m0 >> 14;
    if (n0 < 1024) {
      const int isK = n0 >= 512; const int head = ((n0 & 511) >> 6) + wc;
      const float l2g = l2gamma(head);
      bfu* dst = (bfu*)(p.ws + (isK ? OFF_KT : OFF_QT));
      bfu* ktT = (bfu*)(p.ws + OFF_KTT);
#pragma unroll
      for (int mi = 0; mi < MI1; mi++) {
#pragma unroll
        for (int ni = 0; ni < 2; ni++) {
          int d = ni * 16 + l16;
          float y1[4], y2[4];
#pragma unroll
          for (int j = 0; j < 4; j++) {
            int row = rbase + mi * 16 + j; int t = row & (SEQ - 1); int l = t & (RC - 1);
            float rs = rstd1[row];
            float dec = exp2f((float)(l + 1) * l2g);
            float sc = isK ? 0.125f / dec : dec;
            float cs, sn; rot_angle(t, d, cs, sn);
            float x1 = acc[mi][ni][j] * rs, x2 = acc[mi][ni + 2][j] * rs;
            y1[j] = (x1 * cs - x2 * sn) * sc; y2[j] = (x2 * cs + x1 * sn) * sc;
            dst[(size_t)row * 512 + head * 64 + d] = f2bf(y1[j]);
            dst[(size_t)row * 512 + head * 64 + d + 32] = f2bf(y2[j]);
          }
          if (isK) {
            int t0 = (rbase + mi * 16) & (SEQ - 1);
            *(uint2*)(ktT + ((size_t)((b * 8 + head) * 64 + d)) * SEQ + t0) = make_uint2(pack2(y1[0], y1[1]), pack2(y1[2], y1[3]));
            *(uint2*)(ktT + ((size_t)((b * 8 + head) * 64 + d + 32)) * SEQ + t0) = make_uint2(pack2(y2[0], y2[1]), pack2(y2[2], y2[3]));
          }
        }
      }
    } else if (n0 < 2048) {
      const int head = (n0 - 1024) >> 7;
      bfu* vT = (bfu*)(p.ws + OFF_VT);
#pragma unroll
      for (int mi = 0; mi < MI1; mi++) {
        int row0 = rbase + mi * 16; int t0 = row0 & (SEQ - 1);
        float r0 = rstd1[row0], r1 = rstd1[row0 + 1], r2 = rstd1[row0 + 2], r3 = rstd1[row0 + 3];
#pragma unroll
        for (int ni = 0; ni < 4; ni++) {
          int dv = wc * 64 + ni * 16 + l16;
          *(uint2*)(vT + ((size_t)((b * 8 + head) * 128 + dv)) * SEQ + t0) =
              make_uint2(pack2(acc[mi][ni][0] * r0, acc[mi][ni][1] * r1), pack2(acc[mi][ni][2] * r2, acc[mi][ni][3] * r3));
        }
      }
    } else if (n0 < 3072 || (n0 >= 4608 && n0 < 6656)) {
      bfu* dst; int c0;
      if (n0 < 3072) { dst = (bfu*)(p.ws + OFF_RG); c0 = 2048; }
      else if (n0 < 5632) { dst = (bfu*)(p.out + O_YP); c0 = 4608; }
      else { dst = (bfu*)(p.out + O_YP) + (size_t)TP * DM; c0 = 5632; }
#pragma unroll
      for (int mi = 0; mi < MI1; mi++)
#pragma unroll
        for (int j = 0; j < 4; j++) {
          int row = rbase + mi * 16 + j; float rs = rstd1[row];
#pragma unroll
          for (int ni = 0; ni < 4; ni++) dst[(size_t)row * DM + cbase + ni * 16 - c0] = f2bf(acc[mi][ni][j] * rs);
        }
    } else if (n0 < 4096) {
      const int isK = n0 >= 3584; const int head = (((n0 - 3072) & 511) >> 6) + wc;
      const float* g = isK ? p.fk_g : p.fq_g;
      float gv[4];
#pragma unroll
      for (int ni = 0; ni < 4; ni++) gv[ni] = g[ni * 16 + l16];
      bfu* fq = (bfu*)(p.ws + OFF_FQ); bfu* fkb = (bfu*)(p.ws + OFF_FKB);
#pragma unroll
      for (int mi = 0; mi < MI1; mi++)
#pragma unroll
        for (int j = 0; j < 4; j++) {
          int row = rbase + mi * 16 + j; float rs = rstd1[row];
          float v[4]; float ss = 0.f;
#pragma unroll
          for (int ni = 0; ni < 4; ni++) { v[ni] = acc[mi][ni][j] * rs; ss += v[ni] * v[ni]; }
          ss = sum16(ss);
          float r = rsqrtf(ss * (1.f / 64.f) + EPSN);
#pragma unroll
          for (int ni = 0; ni < 4; ni++) {
            float y = v[ni] * r * gv[ni]; size_t o = (size_t)row * 512 + head * 64 + ni * 16 + l16;
            if (isK) { p.out[O_FKP + o] = y; fkb[o] = f2bf(y); }
            else fq[o] = f2bf(y * (0.125f * LOG2E));
          }
        }
    } else if (n0 < 4608) {
      const int head = ((n0 - 4096) >> 6) + wc;
      bfu* fvT = (bfu*)(p.ws + OFF_FVT);
#pragma unroll
      for (int mi = 0; mi < MI1; mi++) {
        int row0 = rbase + mi * 16; int t0 = row0 & (SEQ - 1);
        float r[4] = {rstd1[row0], rstd1[row0 + 1], rstd1[row0 + 2], rstd1[row0 + 3]};
#pragma unroll
        for (int ni = 0; ni < 4; ni++) {
          int d = ni * 16 + l16; float v[4];
#pragma unroll
          for (int j = 0; j < 4; j++) { v[j] = acc[mi][ni][j] * r[j]; p.out[O_FVP + (size_t)(row0 + j) * 512 + head * 64 + d] = v[j]; }
          *(uint2*)(fvT + ((size_t)((b * 8 + head) * 64 + d)) * SEQ + t0) = make_uint2(pack2(v[0], v[1]), pack2(v[2], v[3]));
        }
      }
    } else {
      if (wc == 0 && l16 < 8) {
        float bf = p.b_f[l16];
#pragma unroll
        for (int mi = 0; mi < MI1; mi++)
#pragma unroll
          for (int j = 0; j < 4; j++) {
            int row = rbase + mi * 16 + j;
            float z = acc[mi][0][j] * rstd1[row] + bf;
            p.out[O_LFP + (size_t)row * 8 + l16] = fminf(z, 0.f) - log1pf(__expf(-fabsf(z)));
          }
      }
    }
  }
}

DEV void phase2(const Params& p, int bid, int nb, char* smem) {
  const int tid = threadIdx.x, lane = tid & 63, w = tid >> 6, wr = w >> 1, wc = w & 1, l16 = lane & 15, quad = lane >> 4;
  bfu* sA = (bfu*)smem; bfu* sB = sA + 128 * 72;
  const bfu* vT = (const bfu*)(p.ws + OFF_VT); const bfu* ktT = (const bfu*)(p.ws + OFF_KTT);
  float* U = (float*)(p.ws + OFF_XB);
  constexpr int NR1 = 16 * NCH;
  for (int it = bid; it < NR1 + 16; it += nb) {
    if (it < 16) {
      int bh = it, b = bh >> 3, h = bh & 7;
      double* sd = (double*)smem;
      const float* lf = p.out + O_LFP + (size_t)b * SEQ * 8 + h;
      float part = 0.f;
      for (int i = 0; i < 64; i++) part += lf[(size_t)(tid * 64 + i) * 8];
      __syncthreads();
      sd[tid] = (double)part;
      __syncthreads();
      if (tid == 0) { double run = 0.0; for (int i = 0; i < 256; i++) { double v = sd[i]; sd[i] = run; run += v; } }
      __syncthreads();
      double run = sd[tid];
      float* c2 = (float*)(p.ws + OFF_C2) + (size_t)bh * SEQ;
      for (int i = 0; i < 64; i++) { run += (double)lf[(size_t)(tid * 64 + i) * 8]; c2[tid * 64 + i] = (float)(run * (double)LOG2E); }
      __syncthreads();
    } else {
      int j = it - 16; int bh = j / NCH, c = j - bh * NCH;
      f32x4 acc[4][2];
#pragma unroll
      for (int i = 0; i < 4; i++) { acc[i][0] = f32x4{0.f, 0.f, 0.f, 0.f}; acc[i][1] = f32x4{0.f, 0.f, 0.f, 0.f}; }
      gemm_loop<4, 2>(vT + (size_t)bh * 128 * SEQ + c * RC, SEQ, ktT + (size_t)bh * 64 * SEQ + c * RC, SEQ, RC, acc, sA);
      float gC = exp2f((float)RC * l2gamma(bh & 7));
      float* Uo = U + (size_t)j * 8192;
#pragma unroll
      for (int mi = 0; mi < 4; mi++)
#pragma unroll
        for (int ni = 0; ni < 2; ni++)
#pragma unroll
          for (int jj = 0; jj < 4; jj++) {
            int dv = wr * 64 + mi * 16 + quad * 4 + jj, dk = wc * 32 + ni * 16 + l16;
            Uo[dv * 64 + dk] = acc[mi][ni][jj] * gC;
          }
    }
  }
}

DEV void sample_item(const Params& p, int item, char* smem) {
  int tid = threadIdx.x; asm volatile("" : "+v"(tid));
  const int b = item >> 3, h = item & 7;
  float* sq = (float*)smem;
  float* sk = sq + 1024;
  float* sv = sk + 1024;
  float* sP = sv + 2048;
  float* so = sP + 256;
  float* sr = so + 2048;
  float* sc = (float*)smem;
  float* fq = (float*)(smem + 34816);
  float* fk = fq + 1024;
  float* cn = fk + 1024;
  float* suf = cn + 16;
  float* red = suf + 1024;
  float* sL = red + 256;
  float* pvr = sL + 16;
  const float* hs = (const float*)(p.ws + OFF_HS) + (size_t)b * 16 * NWP;
  const float l2g = l2gamma(h);
  __syncthreads();
  for (int i = tid; i < 512; i += 256) {
    int l = i >> 5, d = i & 31; float cs, sn; rot_angle(1024 + l, d, cs, sn);
    float dec = exp2f((float)(l + 1) * l2g);
    const float* r = hs + (size_t)l * NWP;
    float x1 = r[h * 64 + d], x2 = r[h * 64 + d + 32];
    sq[l * 64 + d] = (x1 * cs - x2 * sn) * dec; sq[l * 64 + d + 32] = (x2 * cs + x1 * sn) * dec;
    x1 = r[512 + h * 64 + d]; x2 = r[512 + h * 64 + d + 32];
    float sc_ = 0.125f / dec;
    sk[l * 64 + d] = (x1 * cs - x2 * sn) * sc_; sk[l * 64 + d + 32] = (x2 * cs + x1 * sn) * sc_;
  }
  for (int i = tid; i < 2048; i += 256) { int l = i >> 7, dv = i & 127; sv[i] = hs[(size_t)l * NWP + 1024 + h * 128 + dv]; }
  __syncthreads();
  { int l = tid >> 4, m = tid & 15; float a = 0.f;
    if (l >= m) for (int d = 0; d < 64; d++) a += sq[l * 64 + d] * sk[m * 64 + d];
    sP[tid] = a; }
  __syncthreads();
  const float* S = p.state_ret + (size_t)(b * 8 + h) * 8192;
  { int dv = tid & 127, lh = tid >> 7; float o[8];
#pragma unroll
    for (int i = 0; i < 8; i++) o[i] = 0.f;
#pragma unroll 16
    for (int dk = 0; dk < 64; dk++) { float s = S[dk * 128 + dv];
#pragma unroll
      for (int i = 0; i < 8; i++) o[i] += sq[(lh * 8 + i) * 64 + dk] * s; }
    for (int m = 0; m < 16; m++) { float v = sv[m * 128 + dv];
#pragma unroll
      for (int i = 0; i < 8; i++) o[i] += sP[(lh * 8 + i) * 16 + m] * v; }
#pragma unroll
    for (int i = 0; i < 8; i++) so[(lh * 8 + i) * 128 + dv] = o[i];
    float g16 = exp2f(16.f * l2g);
    float* So = p.out + O_SS + (size_t)(b * 8 + h) * 8192;
#pragma unroll 8
    for (int i = 0; i < 32; i++) { int dk = lh * 32 + i; float a = S[dk * 128 + dv];
      for (int m = 0; m < 16; m++) a += sk[m * 64 + dk] * sv[m * 128 + dv];
      So[dk * 128 + dv] = a * g16; }
  }
  __syncthreads();
  if (tid < 16) { float ss = 0.f; for (int i = 0; i < 128; i++) { float v = so[tid * 128 + i]; ss += v * v; } sr[tid] = rsqrtf(ss * (1.f / 128.f) + EPSN); }
  __syncthreads();
  { int dv = tid & 127, lh = tid >> 7; bfu* gated = (bfu*)(p.ws + OFF_RG);
    float gg = p.gn_g[h * 128 + dv];
    for (int i = 0; i < 8; i++) { int l = lh * 8 + i; float rgv = hs[(size_t)l * NWP + 2048 + h * 128 + dv];
      float v = so[l * 128 + dv] * sr[l] * gg * (rgv * sigmoidf_(rgv));
      gated[(size_t)(TP + b * 16 + l) * DM + h * 128 + dv] = f2bf(v); } }
  {
    int l = tid >> 4, dl = tid & 15; const float* r = hs + (size_t)l * NWP;
    float qv[4], kv[4]; float sq_ = 0.f, sk_ = 0.f;
#pragma unroll
    for (int i = 0; i < 4; i++) { qv[i] = r[3072 + h * 64 + dl * 4 + i]; kv[i] = r[3584 + h * 64 + dl * 4 + i]; sq_ += qv[i] * qv[i]; sk_ += kv[i] * kv[i]; }
    sq_ = sum16(sq_); sk_ = sum16(sk_);
    float rq = rsqrtf(sq_ * (1.f / 64.f) + EPSN), rk = rsqrtf(sk_ * (1.f / 64.f) + EPSN);
#pragma unroll
    for (int i = 0; i < 4; i++) { int d = dl * 4 + i;
      fq[l * 64 + d] = qv[i] * rq * p.fq_g[d] * 0.125f;
      float kk = kv[i] * rk * p.fk_g[d]; fk[l * 64 + d] = kk;
      p.out[O_FKS + (size_t)((b * 16 + l) * 8 + h) * 64 + d] = kk;
      p.out[O_FVS + (size_t)((b * 16 + l) * 8 + h) * 64 + d] = r[4096 + h * 64 + d]; }
  }
  if (tid < 16) { float z = hs[(size_t)tid * NWP + 6656 + h] + p.b_f[h]; float lf = fminf(z, 0.f) - log1pf(__expf(-fabsf(z)));
    p.out[O_LFS + (size_t)(b * 16 + tid) * 8 + h] = lf; cn[tid] = lf; }
  { const float* cl = p.clogf + (size_t)b * 1024 * 8 + h; float v[4]; float part = 0.f;
#pragma unroll
    for (int i = 0; i < 4; i++) { v[i] = cl[(size_t)(tid * 4 + i) * 8]; part += v[i]; }
    float inc = part;
#pragma unroll
    for (int o = 1; o < 64; o <<= 1) { float t = __shfl_down(inc, o); if ((tid & 63) + o < 64) inc += t; }
    if ((tid & 63) == 0) red[tid >> 6] = inc;
    __syncthreads();
    if (tid == 0) { float c = 0.f; for (int i = 0; i < 16; i++) { c += cn[i]; cn[i] = c; } }
    float later = 0.f;
    for (int ww = (tid >> 6) + 1; ww < 4; ww++) later += red[ww];
    __syncthreads();
    float run = inc - part + later;
    for (int i = 3; i >= 0; i--) { suf[tid * 4 + i] = run; run += v[i]; }
  }
  __syncthreads();
  const float* CK = p.ck + (size_t)b * 1024 * 512 + h * 64; const float* CV = p.cv + (size_t)b * 1024 * 512 + h * 64;
  for (int pass = 0; pass < 2; pass++) {
    __syncthreads();
    for (int j = tid; j < 1040; j += 256) {
      float a[8];
#pragma unroll
      for (int qi = 0; qi < 8; qi++) a[qi] = 0.f;
      if (j < 1024) {
        const f32x4* kp = (const f32x4*)(CK + (size_t)j * 512);
        f32x4 tt[16];
#pragma unroll
        for (int i = 0; i < 16; i++) tt[i] = kp[i];
#pragma unroll
        for (int i = 0; i < 16; i++) { f32x4 t = tt[i];
#pragma unroll
          for (int qi = 0; qi < 8; qi++) { const float* qq = fq + (pass * 8 + qi) * 64 + i * 4; a[qi] += qq[0] * t[0] + qq[1] * t[1] + qq[2] * t[2] + qq[3] * t[3]; } }
      } else {
        const float* kp = fk + (j - 1024) * 64;
#pragma unroll 4
        for (int i = 0; i < 64; i++) { float t = kp[i];
#pragma unroll
          for (int qi = 0; qi < 8; qi++) a[qi] += fq[(pass * 8 + qi) * 64 + i] * t; }
      }
#pragma unroll
      for (int qi = 0; qi < 8; qi++) { int q = pass * 8 + qi;
        float bias;
        if (j < 1024) bias = suf[j] + cn[q]; else { int m = j - 1024; bias = (m <= q) ? (cn[q] - cn[m]) : -INFINITY; }
        sc[qi * 1040 + j] = a[qi] + bias; }
    }
    __syncthreads();
    { int qi = tid >> 5, l32 = tid & 31; float m = -INFINITY;
      for (int j = l32; j < 1040; j += 32) m = fmaxf(m, sc[qi * 1040 + j]);
#pragma unroll
      for (int o = 16; o >= 1; o >>= 1) m = fmaxf(m, __shfl_xor(m, o));
      float s = 0.f;
      for (int j = l32; j < 1040; j += 32) { float e = __expf(sc[qi * 1040 + j] - m); sc[qi * 1040 + j] = e; s += e; }
#pragma unroll
      for (int o = 16; o >= 1; o >>= 1) s += __shfl_xor(s, o);
      if (l32 == 0) sL[qi] = s; }
    __syncthreads();
    {
      const int kg = tid >> 4, d4 = (tid & 15) * 4;
      float ac[8][4];
#pragma unroll
      for (int qi = 0; qi < 8; qi++) { ac[qi][0] = 0.f; ac[qi][1] = 0.f; ac[qi][2] = 0.f; ac[qi][3] = 0.f; }
#pragma unroll 8
      for (int i = 0; i < 64; i++) { int j = kg + 16 * i;
        float4 v = *(const float4*)(CV + (size_t)j * 512 + d4);
#pragma unroll
        for (int qi = 0; qi < 8; qi++) { float pj = sc[qi * 1040 + j]; ac[qi][0] += pj * v.x; ac[qi][1] += pj * v.y; ac[qi][2] += pj * v.z; ac[qi][3] += pj * v.w; } }
      { const float* r = hs + (size_t)kg * NWP + 4096 + h * 64 + d4;
#pragma unroll
        for (int qi = 0; qi < 8; qi++) { float pj = sc[qi * 1040 + 1024 + kg]; ac[qi][0] += pj * r[0]; ac[qi][1] += pj * r[1]; ac[qi][2] += pj * r[2]; ac[qi][3] += pj * r[3]; } }
#pragma unroll
      for (int qi = 0; qi < 8; qi++)
#pragma unroll
        for (int c = 0; c < 4; c++) { float t = ac[qi][c]; t += __shfl_xor(t, 16); t += __shfl_xor(t, 32); ac[qi][c] = t; }
      if ((tid & 63) < 16) {
#pragma unroll
        for (int qi = 0; qi < 8; qi++)
#pragma unroll
          for (int c = 0; c < 4; c++) pvr[((tid >> 6) * 8 + qi) * 64 + d4 + c] = ac[qi][c];
      }
      __syncthreads();
      int qi = tid >> 5, d2 = (tid & 31) * 2;
      float a0 = pvr[(0 * 8 + qi) * 64 + d2] + pvr[(1 * 8 + qi) * 64 + d2] + pvr[(2 * 8 + qi) * 64 + d2] + pvr[(3 * 8 + qi) * 64 + d2];
      float a1 = pvr[(0 * 8 + qi) * 64 + d2 + 1] + pvr[(1 * 8 + qi) * 64 + d2 + 1] + pvr[(2 * 8 + qi) * 64 + d2 + 1] + pvr[(3 * 8 + qi) * 64 + d2 + 1];
      float inv = 1.f / sL[qi]; bfu* fo = (bfu*)(p.ws + OFF_FQ);
      *(unsigned*)(fo + (size_t)(TP + b * 16 + pass * 8 + qi) * 512 + h * 64 + d2) = pack2(a0 * inv, a1 * inv); }
  }
  __syncthreads();
}

DEV void peer_convert_item(const Params& p, int item) {
  const int tid = threadIdx.x, lane = tid & 63, w = tid >> 6;
  constexpr int NG = 0; const int it = item;
    {
      int r = (it - NG) * 4 + w;
      const float* src = r < 16384 ? p.peer_u + (size_t)r * DM : p.peer_v + (size_t)(r - 16384) * DM;
      float4 v0 = *(const float4*)(src + lane * 16), v1 = *(const float4*)(src + lane * 16 + 4), v2 = *(const float4*)(src + lane * 16 + 8), v3 = *(const float4*)(src + lane * 16 + 12);
      float am = fmaxf(fmaxf(fmaxf(fabsf(v0.x), fabsf(v0.y)), fmaxf(fabsf(v0.z), fabsf(v0.w))), fmaxf(fmaxf(fabsf(v1.x), fabsf(v1.y)), fmaxf(fabsf(v1.z), fabsf(v1.w))));
      am = fmaxf(am, fmaxf(fmaxf(fmaxf(fabsf(v2.x), fabsf(v2.y)), fmaxf(fabsf(v2.z), fabsf(v2.w))), fmaxf(fmaxf(fabsf(v3.x), fabsf(v3.y)), fmaxf(fabsf(v3.z), fabsf(v3.w)))));
#pragma unroll
      for (int o = 32; o >= 1; o >>= 1) am = fmaxf(am, __shfl_xor(am, o));
      float sc = am > 0.f ? 440.f / am : 1.f;
      int w0 = __builtin_amdgcn_cvt_pk_fp8_f32(v0.x * sc, v0.y * sc, 0, false); w0 = __builtin_amdgcn_cvt_pk_fp8_f32(v0.z * sc, v0.w * sc, w0, true);
      int w1 = __builtin_amdgcn_cvt_pk_fp8_f32(v1.x * sc, v1.y * sc, 0, false); w1 = __builtin_amdgcn_cvt_pk_fp8_f32(v1.z * sc, v1.w * sc, w1, true);
      int w2 = __builtin_amdgcn_cvt_pk_fp8_f32(v2.x * sc, v2.y * sc, 0, false); w2 = __builtin_amdgcn_cvt_pk_fp8_f32(v2.z * sc, v2.w * sc, w2, true);
      int w3 = __builtin_amdgcn_cvt_pk_fp8_f32(v3.x * sc, v3.y * sc, 0, false); w3 = __builtin_amdgcn_cvt_pk_fp8_f32(v3.z * sc, v3.w * sc, w3, true);
      uint4* dst = (uint4*)(p.ws + (r < 16384 ? OFF_PUB : OFF_PVB)) + (size_t)(r & 16383) * 64 + lane;
      *dst = make_uint4((unsigned)w0, (unsigned)w1, (unsigned)w2, (unsigned)w3);
      if (lane == 0) ((float*)(p.ws + OFF_PSC))[r] = am > 0.f ? am / 440.f : 1.f;
    }
}

DEV void phase3(const Params& p, int bid, int nb, char* smem) {
  const int tid = threadIdx.x;
  const float* U = (const float*)(p.ws + OFF_XB); bfu* SST = (bfu*)(p.ws + OFF_SST);
  { const int c0 = nb > 256 ? bid - 256 : bid, cs = nb > 256 ? nb - 256 : nb;
    if (c0 >= 0) for (int it = c0; it < 8192; it += cs) peer_convert_item(p, it); }
  for (int it = bid; it < 256 + 512; it += nb) {
    if (it < 256) { sample_item(p, it, smem); continue; }
    int g = (it - 256) * 256 + tid; int bh = g >> 13, e = g & 8191;
    float G = exp2f((float)RC * l2gamma(bh & 7));
    float s = 0.f;
    const float* Up = U + (size_t)bh * NCH * 8192 + e; bfu* Sp = SST + (size_t)bh * NCH * 8192 + e;
    Sp[0] = 0;
    for (int c0 = 0; c0 < NCH; c0 += 8) {
      float u[8];
#pragma unroll
      for (int i = 0; i < 8; i++) u[i] = Up[(size_t)(c0 + i) * 8192];
#pragma unroll
      for (int i = 0; i < 8; i++) { s = s * G + u[i]; if (c0 + i + 1 < NCH) Sp[(size_t)(c0 + i + 1) * 8192] = f2bf(s); }
    }
    int dv = e >> 6, dk = e & 63;
    p.out[O_SP + (size_t)bh * 8192 + dk * 128 + dv] = s;
  }
}

DEV void attn_item(const Params& p, int item, char* smem, float thr, bool dry) {
  const int tid = threadIdx.x, lane = tid & 63, w = tid >> 6, r32 = lane & 31, hi = lane >> 5;
  const int bh = item >> 7, qt = 127 - (item & 127);
  const int b = bh >> 3, h = bh & 7;
  const int q0 = qt * 128;
  bfu* sK = (bfu*)smem;
  bfu* sV = sK + 64 * 72;
  float* sC = (float*)(sV + 64 * 72);
  const float* c2 = (const float*)(p.ws + OFF_C2) + (size_t)bh * SEQ;
  bfu* FQ = (bfu*)(p.ws + OFF_FQ);
  const bfu* FKB = (const bfu*)(p.ws + OFF_FKB) + (size_t)b * SEQ * 512 + h * 64;
  const bfu* FVT = (const bfu*)(p.ws + OFF_FVT) + (size_t)bh * 64 * SEQ;
  const int jd0 = q0 >> 6;
  int pred = 0;
  if (tid < jd0) pred = (c2[q0] - c2[tid * 64 + 63]) < -thr;
  const int jstart = __syncthreads_count(pred);
  const int qrow = q0 + w * 32 + r32;
  bf16x8 qf[4];
  const bfu* qp = FQ + (size_t)(b * SEQ + qrow) * 512 + h * 64 + hi * 8;
#pragma unroll
  for (int d0 = 0; d0 < 4; d0++) qf[d0] = *(const bf16x8*)(qp + d0 * 16);
  const float cq = c2[qrow];
  float m = -INFINITY, lsum = 0.f;
  f32x16 o0, o1;
#pragma unroll
  for (int r = 0; r < 16; r++) { o0[r] = 0.f; o1[r] = 0.f; }
  u32x4 rk0, rk1, rv0, rv1; float rc = 0.f;
  const int srow = tid >> 3, sch = tid & 7;
#define ATT_GLOAD(j_) do { \
    rk0 = *(const u32x4*)(FKB + (size_t)((j_) * 64 + srow) * 512 + sch * 8); \
    rk1 = *(const u32x4*)(FKB + (size_t)((j_) * 64 + srow + 32) * 512 + sch * 8); \
    rv0 = *(const u32x4*)(FVT + (size_t)srow * SEQ + (j_) * 64 + sch * 8); \
    rv1 = *(const u32x4*)(FVT + (size_t)(srow + 32) * SEQ + (j_) * 64 + sch * 8); \
    if (tid < 64) rc = c2[(j_) * 64 + tid]; } while (0)
  ATT_GLOAD(jstart);
  for (int j = jstart; j <= jd0 + 1; j++) {
    __syncthreads();
    *(u32x4*)(sK + srow * 72 + sch * 8) = rk0; *(u32x4*)(sK + (srow + 32) * 72 + sch * 8) = rk1;
    *(u32x4*)(sV + srow * 72 + sch * 8) = rv0; *(u32x4*)(sV + (srow + 32) * 72 + sch * 8) = rv1;
    if (tid < 64) sC[tid] = rc;
    __syncthreads();
    if (j < jd0 + 1) ATT_GLOAD(j + 1);
    if (j * 64 > q0 + w * 32 + 31) continue;
    f32x16 s0, s1;
#pragma unroll
    for (int r = 0; r < 16; r++) { s0[r] = 0.f; s1[r] = 0.f; }
#pragma unroll
    for (int d0 = 0; d0 < 4; d0++) {
      bf16x8 k0 = *(const bf16x8*)(sK + r32 * 72 + d0 * 16 + hi * 8);
      bf16x8 k1 = *(const bf16x8*)(sK + (32 + r32) * 72 + d0 * 16 + hi * 8);
      s0 = __builtin_amdgcn_mfma_f32_32x32x16_bf16(k0, qf[d0], s0, 0, 0, 0);
      s1 = __builtin_amdgcn_mfma_f32_32x32x16_bf16(k1, qf[d0], s1, 0, 0, 0);
    }
    const bool diag = (j >= jd0);
    const int kbase = j * 64 + 4 * hi;
    float mloc = -INFINITY;
#pragma unroll
    for (int g = 0; g < 4; g++) {
      float4 c0 = *(const float4*)(sC + 8 * g + 4 * hi), c1 = *(const float4*)(sC + 32 + 8 * g + 4 * hi);
      float cc0[4] = {c0.x, c0.y, c0.z, c0.w}, cc1[4] = {c1.x, c1.y, c1.z, c1.w};
#pragma unroll
      for (int e = 0; e < 4; e++) {
        int r = g * 4 + e;
        float a = s0[r] + (cq - cc0[e]), bb = s1[r] + (cq - cc1[e]);
        if (diag) { int key = kbase + 8 * g + e; if (key > qrow) a = -INFINITY; if (key + 32 > qrow) bb = -INFINITY; }
        s0[r] = a; s1[r] = bb; mloc = fmaxf(mloc, fmaxf(a, bb));
      }
    }
    mloc = fmaxf(mloc, __shfl_xor(mloc, 32));
    float mn = fmaxf(m, mloc);
    float alpha = __builtin_amdgcn_exp2f(m - mn);
    m = mn;
    float ps = 0.f;
#pragma unroll
    for (int r = 0; r < 16; r++) { s0[r] = __builtin_amdgcn_exp2f(s0[r] - mn); s1[r] = __builtin_amdgcn_exp2f(s1[r] - mn); ps += s0[r] + s1[r]; }
    lsum = lsum * alpha + ps;
#pragma unroll
    for (int r = 0; r < 16; r++) { o0[r] *= alpha; o1[r] *= alpha; }
#pragma unroll
    for (int ks = 0; ks < 4; ks++) {
      union { bf16x8 v; unsigned u[4]; } pf;
#pragma unroll
      for (int e = 0; e < 4; e++) {
        int r = (ks & 1) * 8 + 2 * e;
        pf.u[e] = (ks < 2) ? pack2(s0[r], s0[r + 1]) : pack2(s1[r], s1[r + 1]);
      }
#pragma unroll
      for (int db = 0; db < 2; db++) {
        const bfu* vp = sV + (db * 32 + r32) * 72 + ks * 16 + 4 * hi;
        union { bf16x8 v; uint2 u[2]; } vf;
        vf.u[0] = *(const uint2*)vp; vf.u[1] = *(const uint2*)(vp + 8);
        if (db == 0) o0 = __builtin_amdgcn_mfma_f32_32x32x16_bf16(vf.v, pf.v, o0, 0, 0, 0);
        else o1 = __builtin_amdgcn_mfma_f32_32x32x16_bf16(vf.v, pf.v, o1, 0, 0, 0);
      }
    }
  }
  float lt = lsum + __shfl_xor(lsum, 32);
  float inv = 1.f / lt;
  bfu* op = (dry ? (bfu*)(p.ws + OFF_XB) : FQ) + (size_t)(b * SEQ + qrow) * 512 + h * 64;
#pragma unroll
  for (int g = 0; g < 4; g++) {
    *(uint2*)(op + 8 * g + 4 * hi) = make_uint2(pack2(o0[g * 4] * inv, o0[g * 4 + 1] * inv), pack2(o0[g * 4 + 2] * inv, o0[g * 4 + 3] * inv));
    *(uint2*)(op + 32 + 8 * g + 4 * hi) = make_uint2(pack2(o1[g * 4] * inv, o1[g * 4 + 1] * inv), pack2(o1[g * 4 + 2] * inv, o1[g * 4 + 3] * inv));
  }
  __syncthreads();
}

DEV void r3_item(const Params& p, int item, char* smem, bool dry) {
  const int tid = threadIdx.x, lane = tid & 63, w = tid >> 6, wr = w >> 1, wc = w & 1, l16 = lane & 15, quad = lane >> 4;
  const int bh = item / NCH, c = item - bh * NCH; const int b = bh >> 3, h = bh & 7;
  bfu* sQ = (bfu*)smem; bfu* sK = sQ + 128 * 72; bfu* sP = sK + 128 * 72; float* sRed = (float*)(sP + 128 * 136);
  const size_t row0 = (size_t)b * SEQ + c * RC;
  const bfu* Q = (const bfu*)(p.ws + OFF_QT) + row0 * 512 + h * 64;
  const bfu* Kk = (const bfu*)(p.ws + OFF_KT) + row0 * 512 + h * 64;
  const bfu* vT = (const bfu*)(p.ws + OFF_VT) + (size_t)bh * 128 * SEQ + c * RC;
  const bfu* ST = (const bfu*)(p.ws + OFF_SST) + (size_t)item * 8192;
  u32x4 ra[4], rb[4];
  g2r<128>(Q, 512, ra); g2r<128>(Kk, 512, rb);
  __syncthreads();
  r2s<128>(sQ, ra); r2s<128>(sK, rb);
  __syncthreads();
  g2r<128>(vT, SEQ, rb);
  f32x4 acc[4][4];
#pragma unroll
  for (int i = 0; i < 4; i++)
#pragma unroll
    for (int j = 0; j < 4; j++) acc[i][j] = f32x4{0.f, 0.f, 0.f, 0.f};
  mma64<4, 4>(sQ, 72, sK, 72, acc);
#pragma unroll
  for (int mi = 0; mi < 4; mi++)
#pragma unroll
    for (int ni = 0; ni < 4; ni++)
#pragma unroll
      for (int j = 0; j < 4; j++) {
        int row = wr * 64 + mi * 16 + quad * 4 + j, col = wc * 64 + ni * 16 + l16;
        sP[row * 136 + col] = (col <= row) ? f2bf(acc[mi][ni][j]) : (bfu)0;
      }
#pragma unroll
  for (int i = 0; i < 4; i++)
#pragma unroll
    for (int j = 0; j < 4; j++) acc[i][j] = f32x4{0.f, 0.f, 0.f, 0.f};
  __syncthreads();
  r2s<128>(sK, rb);
  __syncthreads();
  g2r<128>(vT + 64, SEQ, rb);
  mma64<4, 4>(sP, 136, sK, 72, acc);
  __syncthreads();
  r2s<128>(sK, rb);
  __syncthreads();
  g2r<128>(ST, 64, rb);
  mma64<4, 4>(sP + 64, 136, sK, 72, acc);
  __syncthreads();
  r2s<128>(sK, rb);
  __syncthreads();
  mma64<4, 4>(sQ, 72, sK, 72, acc);
  float ssq[4][4];
#pragma unroll
  for (int mi = 0; mi < 4; mi++)
#pragma unroll
    for (int j = 0; j < 4; j++) { float s = 0.f;
#pragma unroll
      for (int ni = 0; ni < 4; ni++) s += acc[mi][ni][j] * acc[mi][ni][j];
      s = sum16(s); ssq[mi][j] = s;
      if (l16 == 0) sRed[(wr * 64 + mi * 16 + quad * 4 + j) * 2 + wc] = s; }
  __syncthreads();
  bfu* RG = (bfu*)(p.ws + OFF_RG);
  float gg[4];
#pragma unroll
  for (int ni = 0; ni < 4; ni++) gg[ni] = p.gn_g[h * 128 + wc * 64 + ni * 16 + l16];
#pragma unroll
  for (int mi = 0; mi < 4; mi++)
#pragma unroll
    for (int j = 0; j < 4; j++) {
      int row = wr * 64 + mi * 16 + quad * 4 + j;
      float tot = sRed[row * 2] + sRed[row * 2 + 1];
      float r = rsqrtf(tot * (1.f / 128.f) + EPSN);
#pragma unroll
      for (int ni = 0; ni < 4; ni++) {
        size_t o = (row0 + row) * DM + h * 128 + wc * 64 + ni * 16 + l16;
        float rgv = bf2f(RG[o]);
        (dry ? (bfu*)(p.ws + OFF_XB) + (o & 0xffffff) : RG + o)[0] = f2bf(acc[mi][ni][j] * r * gg[ni] * (rgv * sigmoidf_(rgv)));
      }
    }
  __syncthreads();
}

DEV void phase4(const Params& p, int bid, int nb, char* smem, bool dry = false) {
  float gq = 0.f, gk = 0.f;
  for (int i = 0; i < 64; i++) { gq = fmaxf(gq, fabsf(p.fq_g[i])); gk = fmaxf(gk, fabsf(p.fk_g[i])); }
  const float thr = 2.f * (8.f * gq * gk * 1.03f * LOG2E) + 44.f;
  for (int it = bid; it < 2048 + 16 * NCH; it += nb) {
    if (it < 2048) attn_item(p, it, smem, thr, dry); else r3_item(p, it - 2048, smem, dry);
  }
}

DEV void phase5(const Params& p, int bid, int nb, char* smem) {
  const int tid = threadIdx.x, lane = tid & 63, w = tid >> 6, wr = w >> 1, wc = w & 1, l16 = lane & 15, quad = lane >> 4;
  bfu* sA = (bfu*)smem; bfu* sB = sA + 128 * 72;
  const bfu* G = (const bfu*)(p.ws + OFF_RG); const bfu* FO = (const bfu*)(p.ws + OFF_FQ);
  const bfu* WR = (const bfu*)(p.ws + OFF_WRT); const bfu* WF = (const bfu*)(p.ws + OFF_WFT);
  bfu* MX = (bfu*)(p.ws + OFF_XB);
  constexpr int NG = (TT / 128) * 8, NCV = 8192;
  const int xcd = bid & 7, slot = bid >> 3, nslots = (nb + 7 - xcd) >> 3;
  const int n_p = slot < 128 ? (128 - slot + nslots - 1) / nslots : 0;
  for (int i_ = 0; i_ < n_p; i_++) {
    int q = slot + i_ * nslots; int mt = xcd * 16 + (q >> 3), nt = q & 7;
    int m0 = mt * 256, n0 = nt * 128;
    int tid2 = threadIdx.x; asm volatile("" : "+v"(tid2));
    const int lane2 = tid2 & 63, w2 = tid2 >> 6, wr2 = w2 >> 1, wc2 = w2 & 1, l162 = lane2 & 15, quad2 = lane2 >> 4;
    f32x4 a1[8][4];
#pragma unroll
    for (int i = 0; i < 8; i++)
#pragma unroll
      for (int j = 0; j < 4; j++) a1[i][j] = f32x4{0.f, 0.f, 0.f, 0.f};
    gemm_loop_sb<8, 4>(G + (size_t)m0 * DM, DM, WR + (size_t)n0 * DM, DM, DM, a1, sA);
    const bfu* ga = (const bfu*)(p.out + O_YP) + (size_t)m0 * DM + n0; const bfu* gb = ga + (size_t)TP * DM;
    bfu* mxT = MX + (size_t)m0 * DM + n0;
    unsigned loff = (unsigned)((wr2 * 128 + quad2 * 4) * DM + wc2 * 64 + l162); asm volatile("" : "+v"(loff));
#pragma unroll
    for (int mi = 0; mi < 8; mi++)
#pragma unroll
      for (int ni = 0; ni < 4; ni++) {
#pragma unroll
        for (int j = 0; j < 4; j++) { unsigned o = loff + (unsigned)((mi * 16 + j) * DM + ni * 16);
          mxT[o] = f2bf(sigmoidf_(bf2f(ga[o])) * a1[mi][ni][j]); }
        a1[mi][ni] = f32x4{0.f, 0.f, 0.f, 0.f};
      }
    gemm_loop_sb<8, 4>(FO + (size_t)m0 * 512, 512, WF + (size_t)n0 * 512, 512, 512, a1, sA);
    unsigned loff2 = loff; asm volatile("" : "+v"(loff2));
#pragma unroll
    for (int mi = 0; mi < 8; mi++)
#pragma unroll
      for (int ni = 0; ni < 4; ni++) {
#pragma unroll
        for (int j = 0; j < 4; j++) { unsigned o = loff2 + (unsigned)((mi * 16 + j) * DM + ni * 16);
          mxT[o] = f2bf(bf2f(mxT[o]) + sigmoidf_(bf2f(gb[o])) * a1[mi][ni][j]); }
      }
  }
  if (bid < 128) {
    int nt = bid & 7;
    int m0 = TP + (bid >> 3) * 32, n0 = nt * 128;
    f32x4 a1[1][4];
#pragma unroll
    for (int j = 0; j < 4; j++) a1[0][j] = f32x4{0.f, 0.f, 0.f, 0.f};
    gemm_loop<1, 4>(G + (size_t)m0 * DM, DM, WR + (size_t)n0 * DM, DM, DM, a1, sA);
    const bfu* ga = (const bfu*)(p.out + O_YS) + (size_t)(m0 - TP) * DM + n0; const bfu* gb = ga + (size_t)TS * DM;
    bfu* mxT = MX + (size_t)m0 * DM + n0;
    unsigned loff = (unsigned)((wr * 16 + quad * 4) * DM + wc * 64 + l16); asm volatile("" : "+v"(loff));
#pragma unroll
    for (int ni = 0; ni < 4; ni++) {
#pragma unroll
      for (int j = 0; j < 4; j++) { unsigned o = loff + (unsigned)(j * DM + ni * 16);
        mxT[o] = f2bf(sigmoidf_(bf2f(ga[o])) * a1[0][ni][j]); }
      a1[0][ni] = f32x4{0.f, 0.f, 0.f, 0.f};
    }
    gemm_loop<1, 4>(FO + (size_t)m0 * 512, 512, WF + (size_t)n0 * 512, 512, 512, a1, sA);
    unsigned loff2 = loff; asm volatile("" : "+v"(loff2));
#pragma unroll
    for (int ni = 0; ni < 4; ni++) {
#pragma unroll
      for (int j = 0; j < 4; j++) { unsigned o = loff2 + (unsigned)(j * DM + ni * 16);
        mxT[o] = f2bf(bf2f(mxT[o]) + sigmoidf_(bf2f(gb[o])) * a1[0][ni][j]); }
    }
  }
}

DEV void phase6(const Params& p, int bid, int nb, char* smem) {
  bfu* sA = (bfu*)smem;
  const bfu* MX = (const bfu*)(p.ws + OFF_XB); const bfu* WO = (const bfu*)(p.ws + OFF_WOT);
  bfu* X1B = (bfu*)(p.ws + OFF_X1B); float* SSQ2 = (float*)(p.ws + OFF_SSQ2);
  const int xcd = bid & 7, slot = bid >> 3, nslots = (nb + 7 - xcd) >> 3;
  const int n_p = slot < 128 ? (128 - slot + nslots - 1) / nslots : 0;
  for (int i_ = 0; i_ < n_p; i_++) {
    int q = slot + i_ * nslots; int mt = xcd * 16 + (q >> 3), nt = q & 7;
    int m0 = mt * 256, n0 = nt * 128;
    int tid = threadIdx.x; asm volatile("" : "+v"(tid));
    const int lane = tid & 63, w = tid >> 6, wr = w >> 1, wc = w & 1, l16 = lane & 15, quad = lane >> 4;
    f32x4 acc[8][4];
#pragma unroll
    for (int i = 0; i < 8; i++)
#pragma unroll
      for (int j = 0; j < 4; j++) acc[i][j] = f32x4{0.f, 0.f, 0.f, 0.f};
    gemm_loop_sb<8, 4>(MX + (size_t)m0 * DM, DM, WO + (size_t)n0 * DM, DM, DM, acc, sA);
    const float* xin = p.x_p + (size_t)m0 * DM + n0;
    float* y = p.out + O_YP + (size_t)m0 * DM + n0;
    bfu* xb1 = X1B + (size_t)m0 * DM + n0;
    unsigned loff = (unsigned)((wr * 128 + quad * 4) * DM + wc * 64 + l16); asm volatile("" : "+v"(loff));
#pragma unroll
    for (int mi = 0; mi < 8; mi++)
#pragma unroll
      for (int j = 0; j < 4; j++) {
        int lr = wr * 128 + mi * 16 + quad * 4 + j; float ss = 0.f;
#pragma unroll
        for (int ni = 0; ni < 4; ni++) {
          unsigned o = loff + (unsigned)((mi * 16 + j) * DM + ni * 16);
          float v = xin[o] + acc[mi][ni][j];
          y[o] = v; xb1[o] = f2bf(v); ss += v * v;
        }
        ss = sum16(ss);
        if (l16 == 0) (SSQ2 + (size_t)m0 * 16 + nt * 2)[(unsigned)(lr * 16 + wc)] = ss;
      }
  }
  if (bid < 128) {
    const int tid = threadIdx.x, lane = tid & 63, w = tid >> 6, wr = w >> 1, wc = w & 1, l16 = lane & 15, quad = lane >> 4;
    int nt = bid & 7;
    int m0 = TP + (bid >> 3) * 32, n0 = nt * 128;
    f32x4 acc[1][4];
#pragma unroll
    for (int j = 0; j < 4; j++) acc[0][j] = f32x4{0.f, 0.f, 0.f, 0.f};
    gemm_loop<1, 4>(MX + (size_t)m0 * DM, DM, WO + (size_t)n0 * DM, DM, DM, acc, sA);
    const float* xin = p.x_s + (size_t)(m0 - TP) * DM + n0;
    float* y = p.out + O_YS + (size_t)(m0 - TP) * DM + n0;
    bfu* xb1 = X1B + (size_t)m0 * DM + n0;
    unsigned loff = (unsigned)((wr * 16 + quad * 4) * DM + wc * 64 + l16); asm volatile("" : "+v"(loff));
#pragma unroll
    for (int j = 0; j < 4; j++) {
      int lr = wr * 16 + quad * 4 + j; float ss = 0.f;
#pragma unroll
      for (int ni = 0; ni < 4; ni++) {
        unsigned o = loff + (unsigned)(j * DM + ni * 16);
        float v = xin[o] + acc[0][ni][j];
        y[o] = v; xb1[o] = f2bf(v); ss += v * v;
      }
      ss = sum16(ss);
      if (l16 == 0) (SSQ2 + (size_t)m0 * 16 + nt * 2)[(unsigned)(lr * 16 + wc)] = ss;
    }
  }
}

DEV int fkey(float x, int idx, int mask) { int b = __float_as_int(x); b ^= (b >> 31) & 0x7fffffff; return (b & ~mask) | idx; }
DEV void ins16(int (&t)[16], int v) {
#pragma unroll
  for (int s = 0; s < 16; s++) { int hi = max(t[s], v); v = min(t[s], v); t[s] = hi; }
}

DEV void phase7(const Params& p, int bid, int nb, char* smem) {
  const int tid = threadIdx.x, lane = tid & 63, w = tid >> 6, wr = w >> 1, wc = w & 1, l16 = lane & 15, quad = lane >> 4;
  bfu* sA = (bfu*)smem;
  float* sS = (float*)smem;
  int* sL = (int*)(smem + 33024);
  float* sTV = (float*)(smem + 55296);
  int* sTI = (int*)(sTV + 2 * 64 * 17);
  const bfu* X1B = (const bfu*)(p.ws + OFF_X1B); const bfu* MT = (const bfu*)(p.ws + OFF_MT);
  const float* SSQ2 = (const float*)(p.ws + OFF_SSQ2);
  int2* ROUTE = (int2*)(p.ws + OFF_ROUTE);
  constexpr int NI7 = (TT / 64) * 8;
  const int xcd = bid & 7, slot = bid >> 3, nslots = (nb + 7 - xcd) >> 3;
  for (int q = slot; q < 520; q += nslots) {
    int hg = q / 260, q2 = q - hg * 260; int mt = xcd * 65 + (q2 >> 2), h = hg * 4 + (q2 & 3); int m0 = mt * 64;
    for (int half = 0; half < 2; half++) {
      f32x4 acc[2][4];
#pragma unroll
      for (int i = 0; i < 2; i++)
#pragma unroll
        for (int j = 0; j < 4; j++) acc[i][j] = f32x4{0.f, 0.f, 0.f, 0.f};
      gemm_loop<2, 4>(X1B + (size_t)m0 * DM, DM, MT + (size_t)(h * 256 + half * 128) * DM, DM, DM, acc, sA);
      __syncthreads();
#pragma unroll
      for (int mi = 0; mi < 2; mi++)
#pragma unroll
        for (int j = 0; j < 4; j++) {
          int lr = wr * 32 + mi * 16 + quad * 4 + j;
          const float* sp = SSQ2 + (size_t)(m0 + lr) * 16; float tot = 0.f;
#pragma unroll
          for (int i = 0; i < 16; i++) tot += sp[i];
          float rs = rsqrtf(tot * (1.f / DM) + EPSN);
#pragma unroll
          for (int ni = 0; ni < 4; ni++) sS[lr * 129 + wc * 64 + ni * 16 + l16] = acc[mi][ni][j] * rs;
        }
      __syncthreads();
      { int row = tid & 63, q = tid >> 6; int t[16];
#pragma unroll
        for (int s = 0; s < 16; s++) t[s] = (int)0x80000000;
        for (int i = 0; i < 32; i++) { int idx = q * 32 + i; ins16(t, fkey(sS[row * 129 + idx], idx, 127)); }
#pragma unroll
        for (int s = 0; s < 16; s++) sL[row * 65 + q * 16 + s] = t[s]; }
      __syncthreads();
      if (tid < 64) { int row = tid; int p0 = 0, p1 = 0, p2 = 0, p3 = 0; const int* L = sL + row * 65;
        for (int r = 0; r < 16; r++) {
          int a0 = L[p0], a1 = L[16 + p1], a2 = L[32 + p2], a3 = L[48 + p3];
          int mx = max(max(a0, a1), max(a2, a3));
          if (mx == a0) p0++; else if (mx == a1) p1++; else if (mx == a2) p2++; else p3++;
          int idx = mx & 127;
          sTV[(half * 64 + row) * 17 + r] = sS[row * 129 + idx]; sTI[(half * 64 + row) * 17 + r] = idx; } }
      __syncthreads();
    }
    if (tid < 64) {
      int row = tid; float v1[16], v2[16];
#pragma unroll
      for (int i = 0; i < 16; i++) { v1[i] = sTV[row * 17 + i]; v2[i] = sTV[(64 + row) * 17 + i]; }
      int t[16];
#pragma unroll
      for (int s = 0; s < 16; s++) t[s] = (int)0x80000000;
#pragma unroll
      for (int i = 0; i < 16; i++)
#pragma unroll
        for (int j = 0; j < 16; j++)
          if ((i + 1) * (j + 1) <= 16) ins16(t, fkey(v1[i] + v2[j], i * 16 + j, 255));
      float es[16]; int ei[16]; float mx = 0.f, sum = 0.f;
#pragma unroll
      for (int r = 0; r < 16; r++) { int c = t[r] & 255; int i = c >> 4, j = c & 15;
        float s = sTV[row * 17 + i] + sTV[(64 + row) * 17 + j];
        ei[r] = sTI[row * 17 + i] * 128 + sTI[(64 + row) * 17 + j];
        if (r == 0) mx = s;
        es[r] = __expf(s - mx); sum += es[r]; }
      float inv = 1.f / sum;
      int2* ro = ROUTE + ((size_t)(m0 + row) * 8 + h) * 16;
#pragma unroll
      for (int r = 0; r < 16; r++) ro[r] = make_int2(ei[r], __float_as_int(es[r] * inv));
    }
    __syncthreads();
  }
}

DEV float dot16_fp8(const u32x4& u, const float (&xn)[16]) {
  f32x2 a;
  float d;
  a = __builtin_amdgcn_cvt_pk_f32_fp8((int)u.x, false); d = a[0] * xn[0] + a[1] * xn[1];
  a = __builtin_amdgcn_cvt_pk_f32_fp8((int)u.x, true); d += a[0] * xn[2] + a[1] * xn[3];
  a = __builtin_amdgcn_cvt_pk_f32_fp8((int)u.y, false); d += a[0] * xn[4] + a[1] * xn[5];
  a = __builtin_amdgcn_cvt_pk_f32_fp8((int)u.y, true); d += a[0] * xn[6] + a[1] * xn[7];
  a = __builtin_amdgcn_cvt_pk_f32_fp8((int)u.z, false); d += a[0] * xn[8] + a[1] * xn[9];
  a = __builtin_amdgcn_cvt_pk_f32_fp8((int)u.z, true); d += a[0] * xn[10] + a[1] * xn[11];
  a = __builtin_amdgcn_cvt_pk_f32_fp8((int)u.w, false); d += a[0] * xn[12] + a[1] * xn[13];
  a = __builtin_amdgcn_cvt_pk_f32_fp8((int)u.w, true); d += a[0] * xn[14] + a[1] * xn[15];
  return d;
}
DEV void axpy16_fp8(const u32x4& u, float wj, float (&acc)[16]) {
  f32x2 a;
  a = __builtin_amdgcn_cvt_pk_f32_fp8((int)u.x, false); acc[0] += wj * a[0]; acc[1] += wj * a[1];
  a = __builtin_amdgcn_cvt_pk_f32_fp8((int)u.x, true); acc[2] += wj * a[0]; acc[3] += wj * a[1];
  a = __builtin_amdgcn_cvt_pk_f32_fp8((int)u.y, false); acc[4] += wj * a[0]; acc[5] += wj * a[1];
  a = __builtin_amdgcn_cvt_pk_f32_fp8((int)u.y, true); acc[6] += wj * a[0]; acc[7] += wj * a[1];
  a = __builtin_amdgcn_cvt_pk_f32_fp8((int)u.z, false); acc[8] += wj * a[0]; acc[9] += wj * a[1];
  a = __builtin_amdgcn_cvt_pk_f32_fp8((int)u.z, true); acc[10] += wj * a[0]; acc[11] += wj * a[1];
  a = __builtin_amdgcn_cvt_pk_f32_fp8((int)u.w, false); acc[12] += wj * a[0]; acc[13] += wj * a[1];
  a = __builtin_amdgcn_cvt_pk_f32_fp8((int)u.w, true); acc[14] += wj * a[0]; acc[15] += wj * a[1];
}
template <int S>
DEV void red_step(float (&pp)[16], int lane) {
  const bool up = (lane & S) != 0;
#pragma unroll
  for (int i = 0; i < S; i++) {
    float send = up ? pp[i] : pp[i + S];
    float keep = up ? pp[i + S] : pp[i];
    pp[i] = keep + __shfl_xor(send, S);
  }
}
DEV float reduce16(float (&pp)[16], int lane) {
  red_step<8>(pp, lane); red_step<4>(pp, lane); red_step<2>(pp, lane); red_step<1>(pp, lane);
  float v = pp[0];
  v += __shfl_xor(v, 16); v += __shfl_xor(v, 32);
  return v;
}

DEV void phase8(const Params& p, int bid, int nb, char* smem, bool dry = false) {
  const int tid = threadIdx.x, lane = tid & 63, w = __builtin_amdgcn_readfirstlane(tid >> 6);
  const u32x4* PUB = (const u32x4*)(p.ws + OFF_PUB); const u32x4* PVB = (const u32x4*)(p.ws + OFF_PVB);
  const float* PSC = (const float*)(p.ws + OFF_PSC);
  const float* SSQ2 = (const float*)(p.ws + OFF_SSQ2); const int2* ROUTE = (const int2*)(p.ws + OFF_ROUTE);
  for (int it = bid; it < TT / 4; it += nb) {
    int tok = it * 4 + w;
    float* y = tok < TP ? p.out + O_YP + (size_t)tok * DM : p.out + O_YS + (size_t)(tok - TP) * DM;
    float x[16], xn[16];
    { float4 a0 = *(const float4*)(y + lane * 16), a1 = *(const float4*)(y + lane * 16 + 4), b0 = *(const float4*)(y + lane * 16 + 8), b1 = *(const float4*)(y + lane * 16 + 12);
      x[0] = a0.x; x[1] = a0.y; x[2] = a0.z; x[3] = a0.w; x[4] = a1.x; x[5] = a1.y; x[6] = a1.z; x[7] = a1.w;
      x[8] = b0.x; x[9] = b0.y; x[10] = b0.z; x[11] = b0.w; x[12] = b1.x; x[13] = b1.y; x[14] = b1.z; x[15] = b1.w; }
    float tot = 0.f;
    { const float* sp = SSQ2 + (size_t)tok * 16;
#pragma unroll
      for (int i = 0; i < 16; i++) tot += sp[i]; }
    float rs = rsqrtf(tot * (1.f / DM) + EPSN);
#pragma unroll
    for (int i = 0; i < 16; i++) xn[i] = x[i] * rs * p.norm2_g[lane * 16 + i];
    const int2* rt = ROUTE + (size_t)tok * 128;
    int2 r0 = rt[lane], r1 = rt[lane + 64];
    float d0 = 0.f, d1 = 0.f;
#pragma unroll 1
    for (int g = 0; g < 4; g++) {
      float pp[16]; u32x4 u[16];
#pragma unroll
      for (int jj = 0; jj < 16; jj++) { int e = __builtin_amdgcn_readlane(r0.x, g * 16 + jj); u[jj] = PUB[(size_t)e * 64 + lane]; }
      __builtin_amdgcn_sched_barrier(0);
#pragma unroll
      for (int jj = 0; jj < 16; jj++) pp[jj] = dot16_fp8(u[jj], xn);
      float v = reduce16(pp, lane);
      if ((lane >> 4) == g) d0 = v;
    }
#pragma unroll 1
    for (int g = 0; g < 4; g++) {
      float pp[16]; u32x4 u[16];
#pragma unroll
      for (int jj = 0; jj < 16; jj++) { int e = __builtin_amdgcn_readlane(r1.x, g * 16 + jj); u[jj] = PUB[(size_t)e * 64 + lane]; }
      __builtin_amdgcn_sched_barrier(0);
#pragma unroll
      for (int jj = 0; jj < 16; jj++) pp[jj] = dot16_fp8(u[jj], xn);
      float v = reduce16(pp, lane);
      if ((lane >> 4) == g) d1 = v;
    }
    d0 *= PSC[r0.x]; d1 *= PSC[r1.x];
    const float w0 = 0.5f * d0 * (1.f + erff(d0 * 0.70710678118654752f)) * __int_as_float(r0.y) * PSC[16384 + r0.x];
    const float w1 = 0.5f * d1 * (1.f + erff(d1 * 0.70710678118654752f)) * __int_as_float(r1.y) * PSC[16384 + r1.x];
    float acc[16];
#pragma unroll
    for (int i = 0; i < 16; i++) acc[i] = 0.f;
#pragma unroll 1
    for (int g = 0; g < 8; g++) {
      const int rx = g < 4 ? r0.x : r1.x; const int wx = __float_as_int(g < 4 ? w0 : w1);
      u32x4 u[16];
#pragma unroll
      for (int jj = 0; jj < 16; jj++) { int e = __builtin_amdgcn_readlane(rx, (g & 3) * 16 + jj); u[jj] = PVB[(size_t)e * 64 + lane]; }
      __builtin_amdgcn_sched_barrier(0);
#pragma unroll
      for (int jj = 0; jj < 16; jj++) { float wj = __int_as_float(__builtin_amdgcn_readlane(wx, (g & 3) * 16 + jj)); axpy16_fp8(u[jj], wj, acc); }
    }
    if (dry) y = (float*)(p.ws + OFF_XB) + (size_t)(tok & 8191) * DM;
    *(float4*)(y + lane * 16) = make_float4(x[0] + acc[0], x[1] + acc[1], x[2] + acc[2], x[3] + acc[3]);
    *(float4*)(y + lane * 16 + 4) = make_float4(x[4] + acc[4], x[5] + acc[5], x[6] + acc[6], x[7] + acc[7]);
    *(float4*)(y + lane * 16 + 8) = make_float4(x[8] + acc[8], x[9] + acc[9], x[10] + acc[10], x[11] + acc[11]);
    *(float4*)(y + lane * 16 + 12) = make_float4(x[12] + acc[12], x[13] + acc[13], x[14] + acc[14], x[15] + acc[15]);
  }
}

__global__ void __launch_bounds__(256, 2) fwd_kernel(Params p, int ph_lo, int ph_hi, int coop) {
  __shared__ __attribute__((aligned(16))) char smem[SMEM_BYTES];
  const int bid = blockIdx.x, nb = gridDim.x;
#ifndef REPS
#define REPS {1,1,1,1,1,1,1,1,1}
#endif
  constexpr int REP[9] = REPS;
#define RUN_PHASE(N) if (ph_lo <= N && N <= ph_hi) { for (int r_ = 0; r_ < REP[N]; r_++) phase##N(p, bid, nb, smem); if (coop && N < ph_hi) cg::this_grid().sync(); }
#define RUN_PHASE_DRY(N) if (ph_lo <= N && N <= ph_hi) { for (int r_ = 1; r_ < REP[N]; r_++) phase##N(p, bid, nb, smem, true); phase##N(p, bid, nb, smem, false); if (coop && N < ph_hi) cg::this_grid().sync(); }
  RUN_PHASE(0) RUN_PHASE_DRY(1) RUN_PHASE(2) RUN_PHASE(3) RUN_PHASE_DRY(4) RUN_PHASE(5) RUN_PHASE(6) RUN_PHASE(7) RUN_PHASE_DRY(8)
}

extern "C" void kernel_launch(void* const* d_in, const int* in_sizes, int n_in, void* d_out, int out_size,
                              void* d_ws, size_t ws_size, hipStream_t stream) {
  if (ws_size < WS_NEED) { fprintf(stderr, "workspace too small\n"); return; }
  static int grid_blocks = 0;
  if (!grid_blocks) {
    int dev = 0, cus = 0, per_cu = 0;
    hipGetDevice(&dev);
    hipDeviceGetAttribute(&cus, hipDeviceAttributeMultiprocessorCount, dev);
    hipOccupancyMaxActiveBlocksPerMultiprocessor(&per_cu, fwd_kernel, 256, 0);
    if (per_cu < 1) per_cu = 1;
    if (per_cu > 2) per_cu = 2;
    grid_blocks = cus * per_cu;
  }
  Params p{};
  const float* const* in = (const float* const*)d_in;
  p.x_p = in[0]; p.x_s = in[1]; p.state_ret = in[2]; p.ck = in[3]; p.cv = in[4]; p.clogf = in[5]; p.norm1_g = in[6];
  p.w_in = in[7]; p.b_f = in[8]; p.fq_g = in[9]; p.fk_g = in[10]; p.gn_g = in[11]; p.w_ret_out = in[12]; p.w_fox_out = in[13];
  p.w_o = in[14]; p.norm2_g = in[15]; p.peer_wq = in[16]; p.k1 = in[17]; p.k2 = in[18]; p.peer_u = in[19]; p.peer_v = in[20];
  p.out = (float*)d_out; p.ws = (char*)d_ws;
#ifndef MULTI_LAUNCH
#define MULTI_LAUNCH 0
#endif
#if MULTI_LAUNCH
  for (int ph = 0; ph <= 8; ph++) fwd_kernel<<<grid_blocks, 256, 0, stream>>>(p, ph, ph, 0);
#else
  int lo = 0, hi = 8, coop = 1;
  void* args[] = {&p, &lo, &hi, &coop};
  hipError_t e = hipLaunchCooperativeKernel((void*)fwd_kernel, dim3(grid_blocks), dim3(256), args, 0, stream);
  if (e != hipSuccess) fprintf(stderr, "cooperative launch failed: %s (grid %d)\n", hipGetErrorString(e), grid_blocks);
#endif
}
```

```cpp
#include <hip/hip_runtime.h>
#include <hip/hip_cooperative_groups.h>
#include <stdint.h>
#include <stdio.h>
namespace cg = cooperative_groups;

#define DEV __device__ __forceinline__
typedef unsigned short bfu;
typedef __attribute__((ext_vector_type(8))) short bf16x8;
typedef __attribute__((ext_vector_type(4))) short bf16x4;
typedef __attribute__((ext_vector_type(4))) float f32x4;
typedef __attribute__((ext_vector_type(16))) float f32x16;
typedef __attribute__((ext_vector_type(4))) unsigned u32x4;
typedef __attribute__((ext_vector_type(2))) float f32x2;

constexpr int DM = 1024, SEQ = 16384, TP = 32768, TS = 512, TT = 33280;
constexpr int NWP = 6784;
constexpr int RC = 128;
constexpr int NCH = SEQ / RC;
constexpr float LOG2E = 1.4426950408889634f;
constexpr float EPSN = 1e-6f;

constexpr size_t O_YP = 0, O_YS = 33554432, O_SP = 34078720, O_FKP = 34209792, O_FVP = 50987008,
                 O_LFP = 67764224, O_SS = 68026368, O_FKS = 70123520, O_FVS = 70385664, O_LFS = 70647808;
constexpr size_t MiB = 1u << 20;
constexpr size_t OFF_XB = 0;
constexpr size_t OFF_WINT = 66 * MiB, OFF_WRT = 80 * MiB, OFF_WFT = 82 * MiB, OFF_WOT = 83 * MiB, OFF_MT = 85 * MiB;
constexpr size_t OFF_RSTD1 = 89 * MiB, OFF_C2 = 90 * MiB, OFF_HS = 91 * MiB;
constexpr size_t OFF_QT = 105 * MiB, OFF_KT = 137 * MiB, OFF_KTT = 169 * MiB, OFF_VT = 201 * MiB;
constexpr size_t OFF_X1B = OFF_HS;
constexpr size_t OFF_RG = 265 * MiB, OFF_FQ = 331 * MiB, OFF_FKB = 364 * MiB, OFF_FVT = 396 * MiB;
constexpr size_t OFF_PUB = OFF_KTT, OFF_PVB = OFF_KTT + 16 * MiB;
constexpr size_t OFF_ROUTE = OFF_FKB, OFF_SSQ2 = OFF_FKB + 33 * MiB;
constexpr size_t OFF_PSC = OFF_RSTD1 + 512 * 1024;
constexpr size_t OFF_SST = 428 * MiB;
constexpr size_t WS_NEED = 460 * MiB;

constexpr int SMEM_BYTES = 75776;

struct Params {
  const float *x_p, *x_s, *state_ret, *ck, *cv, *clogf, *norm1_g, *w_in, *b_f, *fq_g, *fk_g, *gn_g,
      *w_ret_out, *w_fox_out, *w_o, *norm2_g, *peer_wq, *k1, *k2, *peer_u, *peer_v;
  float* out;
  char* ws;
};

DEV bfu f2bf(float f) { unsigned u = __float_as_uint(f); u += 0x7fffu + ((u >> 16) & 1u); return (bfu)(u >> 16); }
DEV float bf2f(bfu b) { return __uint_as_float(((unsigned)b) << 16); }
DEV unsigned pack2(float a, float b) { return (unsigned)f2bf(a) | ((unsigned)f2bf(b) << 16); }
DEV float bflo(unsigned u) { return __uint_as_float(u << 16); }
DEV float bfhi(unsigned u) { return __uint_as_float(u & 0xffff0000u); }
DEV float sigmoidf_(float z) { return 1.f / (1.f + __expf(-z)); }
DEV float l2gamma(int h) { return log2f(1.f - exp2f(-5.f - (float)h)); }
DEV float wave_sum(float v) {
#pragma unroll
  for (int o = 32; o >= 1; o >>= 1) v += __shfl_xor(v, o);
  return v;
}
DEV float sum16(float v) {
  v += __shfl_xor(v, 1); v += __shfl_xor(v, 2); v += __shfl_xor(v, 4); v += __shfl_xor(v, 8);
  return v;
}

template <int ROWS>
DEV void g2r(const bfu* g, int ld, u32x4 (&r)[ROWS / 32], int tid_ = threadIdx.x) {
#pragma unroll
  for (int i = 0; i < ROWS / 32; i++) {
    int id = tid_ + i * 256; int row = id >> 3, ch = id & 7;
    const unsigned off = (unsigned)(row * ld + ch * 8);
    r[i] = *(const u32x4*)(g + off);
  }
}
template <int ROWS>
DEV void r2s(bfu* s, const u32x4 (&r)[ROWS / 32], int tid_ = threadIdx.x) {
#pragma unroll
  for (int i = 0; i < ROWS / 32; i++) {
    int id = tid_ + i * 256; int row = id >> 3, ch = id & 7;
    *(u32x4*)(s + row * 72 + ch * 8) = r[i];
  }
}
template <int MI, int NI>
DEV void mma64(const bfu* sA, int sldA, const bfu* sB, int sldB, f32x4 (&acc)[MI][NI]) {
  const int lane = threadIdx.x & 63, w = threadIdx.x >> 6, wr = w >> 1, wc = w & 1, l16 = lane & 15, quad = lane >> 4;
#pragma unroll
  for (int kk = 0; kk < 2; kk++) {
    bf16x8 a[MI], b[NI];
#pragma unroll
    for (int mi = 0; mi < MI; mi++) a[mi] = *(const bf16x8*)(sA + (wr * MI * 16 + mi * 16 + l16) * sldA + kk * 32 + quad * 8);
#pragma unroll
    for (int ni = 0; ni < NI; ni++) b[ni] = *(const bf16x8*)(sB + (wc * NI * 16 + ni * 16 + l16) * sldB + kk * 32 + quad * 8);
#pragma unroll
    for (int mi = 0; mi < MI; mi++)
#pragma unroll
      for (int ni = 0; ni < NI; ni++) acc[mi][ni] = __builtin_amdgcn_mfma_f32_16x16x32_bf16(a[mi], b[ni], acc[mi][ni], 0, 0, 0);
  }
}
template <int ROWS>
DEV void r2sw(bfu* s, const u32x4 (&r)[ROWS / 32], int tid_) {
#pragma unroll
  for (int i = 0; i < ROWS / 32; i++) {
    int id = tid_ + i * 256; int row = id >> 3, ch = id & 7;
    int byte = (((row >> 4) * 2 + (ch >> 2)) << 10) + ((((row & 15) << 6) + ((ch & 3) << 4)) ^ (((row >> 3) & 1) << 5));
    *(u32x4*)((char*)s + byte) = r[i];
  }
}
template <int MI, int NI>
DEV void mma64w(const bfu* sA, const bfu* sB, f32x4 (&acc)[MI][NI]) {
  const int lane = threadIdx.x & 63, w = threadIdx.x >> 6, wr = w >> 1, wc = w & 1, l16 = lane & 15, quad = lane >> 4;
  const int lo = ((l16 << 6) + (quad << 4)) ^ (((l16 >> 3) & 1) << 5);
#pragma unroll
  for (int kk = 0; kk < 2; kk++) {
    bf16x8 a[MI], b[NI];
#pragma unroll
    for (int mi = 0; mi < MI; mi++) a[mi] = *(const bf16x8*)((const char*)sA + (((wr * MI + mi) * 2 + kk) << 10) + lo);
#pragma unroll
    for (int ni = 0; ni < NI; ni++) b[ni] = *(const bf16x8*)((const char*)sB + (((wc * NI + ni) * 2 + kk) << 10) + lo);
#pragma unroll
    for (int mi = 0; mi < MI; mi++)
#pragma unroll
      for (int ni = 0; ni < NI; ni++) acc[mi][ni] = __builtin_amdgcn_mfma_f32_16x16x32_bf16(a[mi], b[ni], acc[mi][ni], 0, 0, 0);
  }
}
template <int MI, int NI>
DEV void mma64w_big(const bfu* sA, const bfu* sB, f32x4 (&acc)[MI][NI]) {
  const int lane = threadIdx.x & 63, w = threadIdx.x >> 6, wr = w >> 1, wc = w & 1, l16 = lane & 15, quad = lane >> 4;
  const int lo = ((l16 << 6) + (quad << 4)) ^ (((l16 >> 3) & 1) << 5);
#pragma unroll
  for (int kk = 0; kk < 2; kk++) {
    bf16x8 b[NI];
#pragma unroll
    for (int ni = 0; ni < NI; ni++) b[ni] = *(const bf16x8*)((const char*)sB + (((wc * NI + ni) * 2 + kk) << 10) + lo);
#pragma unroll
    for (int mi = 0; mi < MI; mi++) {
      bf16x8 a = *(const bf16x8*)((const char*)sA + (((wr * MI + mi) * 2 + kk) << 10) + lo);
#pragma unroll
      for (int ni = 0; ni < NI; ni++) acc[mi][ni] = __builtin_amdgcn_mfma_f32_16x16x32_bf16(a, b[ni], acc[mi][ni], 0, 0, 0);
    }
  }
}
template <int MI, int NI>
DEV void gemm_loop_sb(const bfu* A, int lda, const bfu* B, int ldb, int K, f32x4 (&acc)[MI][NI], bfu* sbuf) {
  constexpr int BM = 32 * MI, BN = 32 * NI;
  bfu* sA = sbuf; bfu* sB = sA + BM * 64;
  const int nk = K >> 6;
  int t_ = threadIdx.x; asm volatile("" : "+v"(t_));
  u32x4 ra[BM / 32], rb[BN / 32];
  g2r<BM>(A, lda, ra, t_); g2r<BN>(B, ldb, rb, t_);
#pragma unroll 1
  for (int k = 0; k < nk; k++) {
    __syncthreads();
    r2sw<BM>(sA, ra, t_); r2sw<BN>(sB, rb, t_);
    __syncthreads();
    if (k + 1 < nk) { g2r<BM>(A + (k + 1) * 64, lda, ra, t_); g2r<BN>(B + (k + 1) * 64, ldb, rb, t_); }
    mma64w_big<MI, NI>(sA, sB, acc);
  }
}

template <int MI, int NI>
DEV void gemm_loop(const bfu* A, int lda, const bfu* B, int ldb, int K, f32x4 (&acc)[MI][NI], bfu* sbuf) {
  constexpr int BM = 32 * MI, BN = 32 * NI;
  bfu* sA0 = sbuf; bfu* sB0 = sA0 + BM * 64; bfu* sA1 = sB0 + BN * 64; bfu* sB1 = sA1 + BM * 64;
  const int nk = K >> 6;
  int t_ = threadIdx.x; asm volatile("" : "+v"(t_));
  u32x4 ra0[BM / 32], rb0[BN / 32], ra1[BM / 32], rb1[BN / 32];
  g2r<BM>(A, lda, ra0, t_); g2r<BN>(B, ldb, rb0, t_);
  if (nk > 1) { g2r<BM>(A + 64, lda, ra1, t_); g2r<BN>(B + 64, ldb, rb1, t_); }
  __syncthreads();
  r2sw<BM>(sA0, ra0, t_); r2sw<BN>(sB0, rb0, t_);
  if (nk > 2) { g2r<BM>(A + 128, lda, ra0, t_); g2r<BN>(B + 128, ldb, rb0, t_); }
  __syncthreads();
  for (int k = 0; k < nk; k += 2) {
    if (k + 1 < nk) { r2sw<BM>(sA1, ra1, t_); r2sw<BN>(sB1, rb1, t_); }
    if (k + 3 < nk) { g2r<BM>(A + (k + 3) * 64, lda, ra1, t_); g2r<BN>(B + (k + 3) * 64, ldb, rb1, t_); }
    mma64w<MI, NI>(sA0, sB0, acc);
    __syncthreads();
    if (k + 1 >= nk) break;
    if (k + 2 < nk) { r2sw<BM>(sA0, ra0, t_); r2sw<BN>(sB0, rb0, t_); }
    if (k + 4 < nk) { g2r<BM>(A + (k + 4) * 64, lda, ra0, t_); g2r<BN>(B + (k + 4) * 64, ldb, rb0, t_); }
    mma64w<MI, NI>(sA1, sB1, acc);
    __syncthreads();
  }
}

constexpr int EPI_OFF = 49152, EPI_WAVE = 16 * 68;
DEV void to_rows(const f32x4 (&v)[4], float (&r)[16], float* sw, int lane) {
  const int l16 = lane & 15, quad = lane >> 4;
  __builtin_amdgcn_wave_barrier();
#pragma unroll
  for (int ni = 0; ni < 4; ni++)
#pragma unroll
    for (int j = 0; j < 4; j++) sw[(quad * 4 + j) * 68 + ni * 16 + l16] = v[ni][j];
  __builtin_amdgcn_wave_barrier();
  const f32x4* rp = (const f32x4*)(sw + (lane >> 2) * 68 + (lane & 3) * 16);
#pragma unroll
  for (int c = 0; c < 4; c++) { f32x4 t = rp[c]; r[4 * c] = t[0]; r[4 * c + 1] = t[1]; r[4 * c + 2] = t[2]; r[4 * c + 3] = t[3]; }
}
DEV void st_bf16x16(bfu* dst, const float (&r)[16]) {
  u32x4 a = {pack2(r[0], r[1]), pack2(r[2], r[3]), pack2(r[4], r[5]), pack2(r[6], r[7])};
  u32x4 b = {pack2(r[8], r[9]), pack2(r[10], r[11]), pack2(r[12], r[13]), pack2(r[14], r[15])};
  *(u32x4*)dst = a; *(u32x4*)(dst + 8) = b;
}
DEV void ld_bf16x16(const bfu* src, float (&r)[16]) {
  u32x4 a = *(const u32x4*)src, b = *(const u32x4*)(src + 8);
#pragma unroll
  for (int i = 0; i < 4; i++) { r[2 * i] = bflo(a[i]); r[2 * i + 1] = bfhi(a[i]); r[8 + 2 * i] = bflo(b[i]); r[9 + 2 * i] = bfhi(b[i]); }
}
DEV void st_f32x16(float* dst, const float (&r)[16]) {
#pragma unroll
  for (int c = 0; c < 4; c++) *(f32x4*)(dst + 4 * c) = f32x4{r[4 * c], r[4 * c + 1], r[4 * c + 2], r[4 * c + 3]};
}

DEV void transpose_tile(const float* src, int ldsrc, int srccol0, int validcols, const float* scale,
                        bfu* dst, int lddst, int n0, int k0, float* sT) {
  const int tid = threadIdx.x;
  __syncthreads();
#pragma unroll
  for (int i = 0; i < 4; i++) {
    int kk = (tid >> 4) + i * 16, c = (tid & 15) * 4;
    float4 v = make_float4(0.f, 0.f, 0.f, 0.f);
    if (c < validcols) v = *(const float4*)(src + (size_t)(k0 + kk) * ldsrc + srccol0 + c);
    float s = scale ? scale[k0 + kk] : 1.f;
    sT[kk * 65 + c] = v.x * s; sT[kk * 65 + c + 1] = v.y * s; sT[kk * 65 + c + 2] = v.z * s; sT[kk * 65 + c + 3] = v.w * s;
  }
  __syncthreads();
  int n = tid >> 2, kc = (tid & 3) * 16;
  unsigned o[8];
#pragma unroll
  for (int e = 0; e < 8; e++) o[e] = pack2(sT[(kc + 2 * e) * 65 + n], sT[(kc + 2 * e + 1) * 65 + n]);
  uint4* d = (uint4*)(dst + (size_t)(n0 + n) * lddst + k0 + kc);
  d[0] = make_uint4(o[0], o[1], o[2], o[3]); d[1] = make_uint4(o[4], o[5], o[6], o[7]);
}

DEV void phase0(const Params& p, int bid, int nb, char* smem) {
  const int tid = threadIdx.x, lane = tid & 63, w = tid >> 6;
  constexpr int N_X = TT / 4, N_TW = 106 * 16, N_TR = 256, N_TF = 128, N_TO = 256, N_MT = 512;
  constexpr int B1 = N_X, B2 = B1 + N_TW, B3 = B2 + N_TR, B4 = B3 + N_TF, B5 = B4 + N_TO, TOT = B5 + N_MT;
  bfu* xb = (bfu*)(p.ws + OFF_XB); float* rstd1 = (float*)(p.ws + OFF_RSTD1);
  for (int it = bid; it < TOT; it += nb) {
    if (it < B1) {
      int row = it * 4 + w;
      const float* src = row < TP ? p.x_p + (size_t)row * DM : p.x_s + (size_t)(row - TP) * DM;
      float4 a0 = *(const float4*)(src + lane * 8), a1 = *(const float4*)(src + lane * 8 + 4);
      float4 b0 = *(const float4*)(src + 512 + lane * 8), b1 = *(const float4*)(src + 512 + lane * 8 + 4);
      float ss = a0.x * a0.x + a0.y * a0.y + a0.z * a0.z + a0.w * a0.w + a1.x * a1.x + a1.y * a1.y + a1.z * a1.z + a1.w * a1.w +
                 b0.x * b0.x + b0.y * b0.y + b0.z * b0.z + b0.w * b0.w + b1.x * b1.x + b1.y * b1.y + b1.z * b1.z + b1.w * b1.w;
      ss = wave_sum(ss);
      if (lane == 0) rstd1[row] = rsqrtf(ss * (1.f / DM) + EPSN);
      *(uint4*)(xb + (size_t)row * DM + lane * 8) = make_uint4(pack2(a0.x, a0.y), pack2(a0.z, a0.w), pack2(a1.x, a1.y), pack2(a1.z, a1.w));
      *(uint4*)(xb + (size_t)row * DM + 512 + lane * 8) = make_uint4(pack2(b0.x, b0.y), pack2(b0.z, b0.w), pack2(b1.x, b1.y), pack2(b1.z, b1.w));
    } else if (it < B2) {
      int j = it - B1; int nt = j >> 4, kt = j & 15; int n0 = nt * 64;
      int sc0, vc;
      if (n0 < 4608) { sc0 = n0; vc = 64; } else if (n0 < 6656) { sc0 = n0 + 8; vc = 64; } else if (n0 == 6656) { sc0 = 4608; vc = 8; } else { sc0 = 0; vc = 0; }
      transpose_tile(p.w_in, 6664, sc0, vc, p.norm1_g, (bfu*)(p.ws + OFF_WINT), DM, n0, kt * 64, (float*)smem);
    } else if (it < B3) {
      int j = it - B2; transpose_tile(p.w_ret_out, 1024, (j >> 4) * 64, 64, nullptr, (bfu*)(p.ws + OFF_WRT), 1024, (j >> 4) * 64, (j & 15) * 64, (float*)smem);
    } else if (it < B4) {
      int j = it - B3; transpose_tile(p.w_fox_out, 1024, (j >> 3) * 64, 64, nullptr, (bfu*)(p.ws + OFF_WFT), 512, (j >> 3) * 64, (j & 7) * 64, (float*)smem);
    } else if (it < B5) {
      int j = it - B4; transpose_tile(p.w_o, 1024, (j >> 4) * 64, 64, nullptr, (bfu*)(p.ws + OFF_WOT), 1024, (j >> 4) * 64, (j & 15) * 64, (float*)smem);
    } else {
      int j = it - B5; int hh = j >> 5, kt = (j >> 4) & 1, dt = j & 15;
      float* sW = (float*)smem; float* sK = sW + 64 * 129;
      const float* ksub = (hh & 1) ? p.k2 : p.k1;
      __syncthreads();
#pragma unroll
      for (int i = 0; i < 8; i++) {
        int id = tid + i * 256; int row = id >> 5, c4 = (id & 31) * 4;
        float4 v = *(const float4*)(p.peer_wq + (size_t)(dt * 64 + row) * 2048 + hh * 128 + c4);
        sW[row * 129 + c4] = v.x; sW[row * 129 + c4 + 1] = v.y; sW[row * 129 + c4 + 2] = v.z; sW[row * 129 + c4 + 3] = v.w;
        float4 u = *(const float4*)(ksub + (size_t)(kt * 64 + row) * 128 + c4);
        sK[row * 129 + c4] = u.x; sK[row * 129 + c4 + 1] = u.y; sK[row * 129 + c4 + 2] = u.z; sK[row * 129 + c4 + 3] = u.w;
      }
      __syncthreads();
      int ky = (tid >> 4) * 4, dd = (tid & 15) * 4;
      float a[4][4];
#pragma unroll
      for (int i = 0; i < 4; i++)
#pragma unroll
        for (int jj = 0; jj < 4; jj++) a[i][jj] = 0.f;
      for (int c = 0; c < 128; c++) {
        float kv[4], wv[4];
#pragma unroll
        for (int i = 0; i < 4; i++) { kv[i] = sK[(ky + i) * 129 + c]; wv[i] = sW[(dd + i) * 129 + c]; }
#pragma unroll
        for (int i = 0; i < 4; i++)
#pragma unroll
          for (int jj = 0; jj < 4; jj++) a[i][jj] += kv[i] * wv[jj];
      }
      bfu* MT = (bfu*)(p.ws + OFF_MT);
      float g0 = p.norm2_g[dt * 64 + dd], g1 = p.norm2_g[dt * 64 + dd + 1], g2 = p.norm2_g[dt * 64 + dd + 2], g3 = p.norm2_g[dt * 64 + dd + 3];
#pragma unroll
      for (int i = 0; i < 4; i++)
        *(uint2*)(MT + (size_t)(hh * 128 + kt * 64 + ky + i) * DM + dt * 64 + dd) = make_uint2(pack2(a[i][0] * g0, a[i][1] * g1), pack2(a[i][2] * g2, a[i][3] * g3));
    }
  }
}

DEV void rot_angle(int pos, int d, float& cs, float& sn) {
  float inv = exp2f(-(float)d * (13.287712379549449f / 32.f));
  float ang = (float)pos * inv;
  float rev = ang * 0.15915494309189535f;
  rev = rev - floorf(rev);
  sn = __builtin_amdgcn_sinf(rev); cs = __builtin_amdgcn_cosf(rev);
}

DEV void phase1(const Params& p, int bid, int nb, char* smem, bool noepi = false) {
  bfu* sA = (bfu*)smem; bfu* sB = sA + 128 * 72;
  const bfu* XB = (const bfu*)(p.ws + OFF_XB); const bfu* WT = (const bfu*)(p.ws + OFF_WINT);
  const float* rstd1 = (const float*)(p.ws + OFF_RSTD1);
  constexpr int NT = NWP / 128;
  const int xcd = bid & 7, slot = bid >> 3, nslots = (nb + 7 - xcd) >> 3;
  constexpr int MI1 = 8;
  const int nprompt = 16 * NT;
  const int n_p = slot < nprompt ? (nprompt - slot + nslots - 1) / nslots : 0;
  const int n_s = bid < 2 * NT ? (2 * NT - bid + nb - 1) / nb : 0;
  for (int i_ = 0; i_ < n_p + n_s; i_++) {
    int mt, nt;
    if (i_ < n_p) { int q = slot + i_ * nslots; int sub = q / (8 * NT), rem = q - sub * (8 * NT); nt = rem >> 3; mt = xcd * 16 + sub * 8 + (rem & 7); }
    else { int it = bid + (i_ - n_p) * nb; mt = 128 + it / NT; nt = it - (it / NT) * NT; }
    int m0 = mt * 256, n0 = nt * 128;
    int tid = threadIdx.x; asm volatile("" : "+v"(tid));
    const int lane = tid & 63, w = tid >> 6, wr = w >> 1, wc = w & 1, l16 = lane & 15, quad = lane >> 4;
    f32x4 acc[MI1][4];
#pragma unroll
    for (int i = 0; i < MI1; i++)
#pragma unroll
      for (int j = 0; j < 4; j++) acc[i][j] = f32x4{0.f, 0.f, 0.f, 0.f};
    gemm_loop_sb<MI1, 4>(XB + (size_t)m0 * DM, DM, WT + (size_t)n0 * DM, DM, DM, acc, sA);
    if (noepi) { float t_ = 0.f;
#pragma unroll
      for (int i = 0; i < MI1; i++)
#pragma unroll
        for (int j = 0; j < 4; j++) t_ += acc[i][j][0] + acc[i][j][1] + acc[i][j][2] + acc[i][j][3];
      if (t_ == 12345.678f) p.out[0] = 1.f; continue; }
    const int rbase = m0 + wr * (MI1 * 16) + quad * 4;
    const int cbase = n0 + wc * 64 + l16;
    if (m0 >= TP) {
      float* hs = (float*)(p.ws + OFF_HS);
      bfu* gaS = (bfu*)(p.out + O_YS); bfu* gbS = gaS + (size_t)TS * DM;
#pragma unroll
      for (int mi = 0; mi < MI1; mi++)
#pragma unroll
        for (int j = 0; j < 4; j++) {
          int row = rbase + mi * 16 + j; float rs = rstd1[row]; int sr = row - TP;
#pragma unroll
          for (int ni = 0; ni < 4; ni++) {
            int col = cbase + ni * 16; float v = acc[mi][ni][j] * rs;
            if (n0 >= 4608 && n0 < 5632) gaS[(size_t)sr * DM + col - 4608] = f2bf(v);
            else if (n0 >= 5632 && n0 < 6656) gbS[(size_t)sr * DM + col - 5632] = f2bf(v);
            else hs[(size_t)sr * NWP + col] = v;
          }
        }
      continue;
    }
    const int b = m0 >> 14;
    if (n0 < 1024) {
      const int isK = n0 >= 512; const int head = ((n0 & 511) >> 6) + wc;
      const float l2g = l2gamma(head);
      bfu* dst = (bfu*)(p.ws + (isK ? OFF_KT : OFF_QT));
      bfu* ktT = (bfu*)(p.ws + OFF_KTT);
#pragma unroll
      for (int mi = 0; mi < MI1; mi++) {
#pragma unroll
        for (int ni = 0; ni < 2; ni++) {
          int d = ni * 16 + l16;
          float y1[4], y2[4];
#pragma unroll
          for (int j = 0; j < 4; j++) {
            int row = rbase + mi * 16 + j; int t = row & (SEQ - 1); int l = t & (RC - 1);
            float rs = rstd1[row];
            float dec = exp2f((float)(l + 1) * l2g);
            float sc = isK ? 0.125f / dec : dec;
            float cs, sn; rot_angle(t, d, cs, sn);
            float x1 = acc[mi][ni][j] * rs, x2 = acc[mi][ni + 2][j] * rs;
            y1[j] = (x1 * cs - x2 * sn) * sc; y2[j] = (x2 * cs + x1 * sn) * sc;
            dst[(size_t)row * 512 + head * 64 + d] = f2bf(y1[j]);
            dst[(size_t)row * 512 + head * 64 + d + 32] = f2bf(y2[j]);
          }
          if (isK) {
            int t0 = (rbase + mi * 16) & (SEQ - 1);
            *(uint2*)(ktT + ((size_t)((b * 8 + head) * 64 + d)) * SEQ + t0) = make_uint2(pack2(y1[0], y1[1]), pack2(y1[2], y1[3]));
            *(uint2*)(ktT + ((size_t)((b * 8 + head) * 64 + d + 32)) * SEQ + t0) = make_uint2(pack2(y2[0], y2[1]), pack2(y2[2], y2[3]));
          }
        }
      }
    } else if (n0 < 2048) {
      const int head = (n0 - 1024) >> 7;
      bfu* vT = (bfu*)(p.ws + OFF_VT);
#pragma unroll
      for (int mi = 0; mi < MI1; mi++) {
        int row0 = rbase + mi * 16; int t0 = row0 & (SEQ - 1);
        float r0 = rstd1[row0], r1 = rstd1[row0 + 1], r2 = rstd1[row0 + 2], r3 = rstd1[row0 + 3];
#pragma unroll
        for (int ni = 0; ni < 4; ni++) {
          int dv = wc * 64 + ni * 16 + l16;
          *(uint2*)(vT + ((size_t)((b * 8 + head) * 128 + dv)) * SEQ + t0) =
              make_uint2(pack2(acc[mi][ni][0] * r0, acc[mi][ni][1] * r1), pack2(acc[mi][ni][2] * r2, acc[mi][ni][3] * r3));
        }
      }
    } else if (n0 < 3072 || (n0 >= 4608 && n0 < 6656)) {
      bfu* dst; int c0;
      if (n0 < 3072) { dst = (bfu*)(p.ws + OFF_RG); c0 = 2048; }
      else if (n0 < 5632) { dst = (bfu*)(p.out + O_YP); c0 = 4608; }
      else { dst = (bfu*)(p.out + O_YP) + (size_t)TP * DM; c0 = 5632; }
#pragma unroll
      for (int mi = 0; mi < MI1; mi++)
#pragma unroll
        for (int j = 0; j < 4; j++) {
          int row = rbase + mi * 16 + j; float rs = rstd1[row];
#pragma unroll
          for (int ni = 0; ni < 4; ni++) dst[(size_t)row * DM + cbase + ni * 16 - c0] = f2bf(acc[mi][ni][j] * rs);
        }
    } else if (n0 < 4096) {
      const int isK = n0 >= 3584; const int head = (((n0 - 3072) & 511) >> 6) + wc;
      const float* g = isK ? p.fk_g : p.fq_g;
      float gv[4];
#pragma unroll
      for (int ni = 0; ni < 4; ni++) gv[ni] = g[ni * 16 + l16];
      bfu* fq = (bfu*)(p.ws + OFF_FQ); bfu* fkb = (bfu*)(p.ws + OFF_FKB);
#pragma unroll
      for (int mi = 0; mi < MI1; mi++)
#pragma unroll
        for (int j = 0; j < 4; j++) {
          int row = rbase + mi * 16 + j; float rs = rstd1[row];
          float v[4]; float ss = 0.f;
#pragma unroll
          for (int ni = 0; ni < 4; ni++) { v[ni] = acc[mi][ni][j] * rs; ss += v[ni] * v[ni]; }
          ss = sum16(ss);
          float r = rsqrtf(ss * (1.f / 64.f) + EPSN);
#pragma unroll
          for (int ni = 0; ni < 4; ni++) {
            float y = v[ni] * r * gv[ni]; size_t o = (size_t)row * 512 + head * 64 + ni * 16 + l16;
            if (isK) { p.out[O_FKP + o] = y; fkb[o] = f2bf(y); }
            else fq[o] = f2bf(y * (0.125f * LOG2E));
          }
        }
    } else if (n0 < 4608) {
      const int head = ((n0 - 4096) >> 6) + wc;
      bfu* fvT = (bfu*)(p.ws + OFF_FVT);
#pragma unroll
      for (int mi = 0; mi < MI1; mi++) {
        int row0 = rbase + mi * 16; int t0 = row0 & (SEQ - 1);
        float r[4] = {rstd1[row0], rstd1[row0 + 1], rstd1[row0 + 2], rstd1[row0 + 3]};
#pragma unroll
        for (int ni = 0; ni < 4; ni++) {
          int d = ni * 16 + l16; float v[4];
#pragma unroll
          for (int j = 0; j < 4; j++) { v[j] = acc[mi][ni][j] * r[j]; p.out[O_FVP + (size_t)(row0 + j) * 512 + head * 64 + d] = v[j]; }
          *(uint2*)(fvT + ((size_t)((b * 8 + head) * 64 + d)) * SEQ + t0) = make_uint2(pack2(v[0], v[1]), pack2(v[2], v[3]));
        }
      }
    } else {
      if (wc == 0 && l16 < 8) {
        float bf = p.b_f[l16];
#pragma unroll
        for (int mi = 0; mi < MI1; mi++)
#pragma unroll
          for (int j = 0; j < 4; j++) {
            int row = rbase + mi * 16 + j;
            float z = acc[mi][0][j] * rstd1[row] + bf;
            p.out[O_LFP + (size_t)row * 8 + l16] = fminf(z, 0.f) - log1pf(__expf(-fabsf(z)));
          }
      }
    }
  }
}

DEV void phase2(const Params& p, int bid, int nb, char* smem) {
  const int tid = threadIdx.x, lane = tid & 63, w = tid >> 6, wr = w >> 1, wc = w & 1, l16 = lane & 15, quad = lane >> 4;
  bfu* sA = (bfu*)smem; bfu* sB = sA + 128 * 72;
  const bfu* vT = (const bfu*)(p.ws + OFF_VT); const bfu* ktT = (const bfu*)(p.ws + OFF_KTT);
  float* U = (float*)(p.ws + OFF_XB);
  constexpr int NR1 = 16 * NCH;
  for (int it = bid; it < NR1 + 16; it += nb) {
    if (it < 16) {
      int bh = it, b = bh >> 3, h = bh & 7;
      double* sd = (double*)smem;
      const float* lf = p.out + O_LFP + (size_t)b * SEQ * 8 + h;
      float part = 0.f;
      for (int i = 0; i < 64; i++) part += lf[(size_t)(tid * 64 + i) * 8];
      __syncthreads();
      sd[tid] = (double)part;
      __syncthreads();
      if (tid == 0) { double run = 0.0; for (int i = 0; i < 256; i++) { double v = sd[i]; sd[i] = run; run += v; } }
      __syncthreads();
      double run = sd[tid];
      float* c2 = (float*)(p.ws + OFF_C2) + (size_t)bh * SEQ;
      for (int i = 0; i < 64; i++) { run += (double)lf[(size_t)(tid * 64 + i) * 8]; c2[tid * 64 + i] = (float)(run * (double)LOG2E); }
      __syncthreads();
    } else {
      int j = it - 16; int bh = j / NCH, c = j - bh * NCH;
      f32x4 acc[4][2];
#pragma unroll
      for (int i = 0; i < 4; i++) { acc[i][0] = f32x4{0.f, 0.f, 0.f, 0.f}; acc[i][1] = f32x4{0.f, 0.f, 0.f, 0.f}; }
      gemm_loop<4, 2>(vT + (size_t)bh * 128 * SEQ + c * RC, SEQ, ktT + (size_t)bh * 64 * SEQ + c * RC, SEQ, RC, acc, sA);
      float gC = exp2f((float)RC * l2gamma(bh & 7));
      float* Uo = U + (size_t)j * 8192;
#pragma unroll
      for (int mi = 0; mi < 4; mi++)
#pragma unroll
        for (int ni = 0; ni < 2; ni++)
#pragma unroll
          for (int jj = 0; jj < 4; jj++) {
            int dv = wr * 64 + mi * 16 + quad * 4 + jj, dk = wc * 32 + ni * 16 + l16;
            Uo[dv * 64 + dk] = acc[mi][ni][jj] * gC;
          }
    }
  }
}

DEV void sample_item(const Params& p, int item, char* smem) {
  int tid = threadIdx.x; asm volatile("" : "+v"(tid));
  const int b = item >> 3, h = item & 7;
  float* sq = (float*)smem;
  float* sk = sq + 1024;
  float* sv = sk + 1024;
  float* sP = sv + 2048;
  float* so = sP + 256;
  float* sr = so + 2048;
  float* sc = (float*)smem;
  float* fq = (float*)(smem + 34816);
  float* fk = fq + 1024;
  float* cn = fk + 1024;
  float* suf = cn + 16;
  float* red = suf + 1024;
  float* sL = red + 256;
  float* pvr = sL + 16;
  const float* hs = (const float*)(p.ws + OFF_HS) + (size_t)b * 16 * NWP;
  const float l2g = l2gamma(h);
  __syncthreads();
  for (int i = tid; i < 512; i += 256) {
    int l = i >> 5, d = i & 31; float cs, sn; rot_angle(1024 + l, d, cs, sn);
    float dec = exp2f((float)(l + 1) * l2g);
    const float* r = hs + (size_t)l * NWP;
    float x1 = r[h * 64 + d], x2 = r[h * 64 + d + 32];
    sq[l * 64 + d] = (x1 * cs - x2 * sn) * dec; sq[l * 64 + d + 32] = (x2 * cs + x1 * sn) * dec;
    x1 = r[512 + h * 64 + d]; x2 = r[512 + h * 64 + d + 32];
    float sc_ = 0.125f / dec;
    sk[l * 64 + d] = (x1 * cs - x2 * sn) * sc_; sk[l * 64 + d + 32] = (x2 * cs + x1 * sn) * sc_;
  }
  for (int i = tid; i < 2048; i += 256) { int l = i >> 7, dv = i & 127; sv[i] = hs[(size_t)l * NWP + 1024 + h * 128 + dv]; }
  __syncthreads();
  { int l = tid >> 4, m = tid & 15; float a = 0.f;
    if (l >= m) for (int d = 0; d < 64; d++) a += sq[l * 64 + d] * sk[m * 64 + d];
    sP[tid] = a; }
  __syncthreads();
  const float* S = p.state_ret + (size_t)(b * 8 + h) * 8192;
  { int dv = tid & 127, lh = tid >> 7; float o[8];
#pragma unroll
    for (int i = 0; i < 8; i++) o[i] = 0.f;
#pragma unroll 16
    for (int dk = 0; dk < 64; dk++) { float s = S[dk * 128 + dv];
#pragma unroll
      for (int i = 0; i < 8; i++) o[i] += sq[(lh * 8 + i) * 64 + dk] * s; }
    for (int m = 0; m < 16; m++) { float v = sv[m * 128 + dv];
#pragma unroll
      for (int i = 0; i < 8; i++) o[i] += sP[(lh * 8 + i) * 16 + m] * v; }
#pragma unroll
    for (int i = 0; i < 8; i++) so[(lh * 8 + i) * 128 + dv] = o[i];
    float g16 = exp2f(16.f * l2g);
    float* So = p.out + O_SS + (size_t)(b * 8 + h) * 8192;
#pragma unroll 8
    for (int i = 0; i < 32; i++) { int dk = lh * 32 + i; float a = S[dk * 128 + dv];
      for (int m = 0; m < 16; m++) a += sk[m * 64 + dk] * sv[m * 128 + dv];
      So[dk * 128 + dv] = a * g16; }
  }
  __syncthreads();
  if (tid < 16) { float ss = 0.f; for (int i = 0; i < 128; i++) { float v = so[tid * 128 + i]; ss += v * v; } sr[tid] = rsqrtf(ss * (1.f / 128.f) + EPSN); }
  __syncthreads();
  { int dv = tid & 127, lh = tid >> 7; bfu* gated = (bfu*)(p.ws + OFF_RG);
    float gg = p.gn_g[h * 128 + dv];
    for (int i = 0; i < 8; i++) { int l = lh * 8 + i; float rgv = hs[(size_t)l * NWP + 2048 + h * 128 + dv];
      float v = so[l * 128 + dv] * sr[l] * gg * (rgv * sigmoidf_(rgv));
      gated[(size_t)(TP + b * 16 + l) * DM + h * 128 + dv] = f2bf(v); } }
  {
    int l = tid >> 4, dl = tid & 15; const float* r = hs + (size_t)l * NWP;
    float qv[4], kv[4]; float sq_ = 0.f, sk_ = 0.f;
#pragma unroll
    for (int i = 0; i < 4; i++) { qv[i] = r[3072 + h * 64 + dl * 4 + i]; kv[i] = r[3584 + h * 64 + dl * 4 + i]; sq_ += qv[i] * qv[i]; sk_ += kv[i] * kv[i]; }
    sq_ = sum16(sq_); sk_ = sum16(sk_);
    float rq = rsqrtf(sq_ * (1.f / 64.f) + EPSN), rk = rsqrtf(sk_ * (1.f / 64.f) + EPSN);
#pragma unroll
    for (int i = 0; i < 4; i++) { int d = dl * 4 + i;
      fq[l * 64 + d] = qv[i] * rq * p.fq_g[d] * 0.125f;
      float kk = kv[i] * rk * p.fk_g[d]; fk[l * 64 + d] = kk;
      p.out[O_FKS + (size_t)((b * 16 + l) * 8 + h) * 64 + d] = kk;
      p.out[O_FVS + (size_t)((b * 16 + l) * 8 + h) * 64 + d] = r[4096 + h * 64 + d]; }
  }
  if (tid < 16) { float z = hs[(size_t)tid * NWP + 6656 + h] + p.b_f[h]; float lf = fminf(z, 0.f) - log1pf(__expf(-fabsf(z)));
    p.out[O_LFS + (size_t)(b * 16 + tid) * 8 + h] = lf; cn[tid] = lf; }
  { const float* cl = p.clogf + (size_t)b * 1024 * 8 + h; float v[4]; float part = 0.f;
#pragma unroll
    for (int i = 0; i < 4; i++) { v[i] = cl[(size_t)(tid * 4 + i) * 8]; part += v[i]; }
    float inc = part;
#pragma unroll
    for (int o = 1; o < 64; o <<= 1) { float t = __shfl_down(inc, o); if ((tid & 63) + o < 64) inc += t; }
    if ((tid & 63) == 0) red[tid >> 6] = inc;
    __syncthreads();
    if (tid == 0) { float c = 0.f; for (int i = 0; i < 16; i++) { c += cn[i]; cn[i] = c; } }
    float later = 0.f;
    for (int ww = (tid >> 6) + 1; ww < 4; ww++) later += red[ww];
    __syncthreads();
    float run = inc - part + later;
    for (int i = 3; i >= 0; i--) { suf[tid * 4 + i] = run; run += v[i]; }
  }
  __syncthreads();
  const float* CK = p.ck + (size_t)b * 1024 * 512 + h * 64; const float* CV = p.cv + (size_t)b * 1024 * 512 + h * 64;
  for (int pass = 0; pass < 2; pass++) {
    __syncthreads();
    for (int j = tid; j < 1040; j += 256) {
      float a[8];
#pragma unroll
      for (int qi = 0; qi < 8; qi++) a[qi] = 0.f;
      if (j < 1024) {
        const f32x4* kp = (const f32x4*)(CK + (size_t)j * 512);
        f32x4 tt[16];
#pragma unroll
        for (int i = 0; i < 16; i++) tt[i] = kp[i];
#pragma unroll
        for (int i = 0; i < 16; i++) { f32x4 t = tt[i];
#pragma unroll
          for (int qi = 0; qi < 8; qi++) { const float* qq = fq + (pass * 8 + qi) * 64 + i * 4; a[qi] += qq[0] * t[0] + qq[1] * t[1] + qq[2] * t[2] + qq[3] * t[3]; } }
      } else {
        const float* kp = fk + (j - 1024) * 64;
#pragma unroll 4
        for (int i = 0; i < 64; i++) { float t = kp[i];
#pragma unroll
          for (int qi = 0; qi < 8; qi++) a[qi] += fq[(pass * 8 + qi) * 64 + i] * t; }
      }
#pragma unroll
      for (int qi = 0; qi < 8; qi++) { int q = pass * 8 + qi;
        float bias;
        if (j < 1024) bias = suf[j] + cn[q]; else { int m = j - 1024; bias = (m <= q) ? (cn[q] - cn[m]) : -INFINITY; }
        sc[qi * 1040 + j] = a[qi] + bias; }
    }
    __syncthreads();
    { int qi = tid >> 5, l32 = tid & 31; float m = -INFINITY;
      for (int j = l32; j < 1040; j += 32) m = fmaxf(m, sc[qi * 1040 + j]);
#pragma unroll
      for (int o = 16; o >= 1; o >>= 1) m = fmaxf(m, __shfl_xor(m, o));
      float s = 0.f;
      for (int j = l32; j < 1040; j += 32) { float e = __expf(sc[qi * 1040 + j] - m); sc[qi * 1040 + j] = e; s += e; }
#pragma unroll
      for (int o = 16; o >= 1; o >>= 1) s += __shfl_xor(s, o);
      if (l32 == 0) sL[qi] = s; }
    __syncthreads();
    {
      const int kg = tid >> 4, d4 = (tid & 15) * 4;
      float ac[8][4];
#pragma unroll
      for (int qi = 0; qi < 8; qi++) { ac[qi][0] = 0.f; ac[qi][1] = 0.f; ac[qi][2] = 0.f; ac[qi][3] = 0.f; }
#pragma unroll 8
      for (int i = 0; i < 64; i++) { int j = kg + 16 * i;
        float4 v = *(const float4*)(CV + (size_t)j * 512 + d4);
#pragma unroll
        for (int qi = 0; qi < 8; qi++) { float pj = sc[qi * 1040 + j]; ac[qi][0] += pj * v.x; ac[qi][1] += pj * v.y; ac[qi][2] += pj * v.z; ac[qi][3] += pj * v.w; } }
      { const float* r = hs + (size_t)kg * NWP + 4096 + h * 64 + d4;
#pragma unroll
        for (int qi = 0; qi < 8; qi++) { float pj = sc[qi * 1040 + 1024 + kg]; ac[qi][0] += pj * r[0]; ac[qi][1] += pj * r[1]; ac[qi][2] += pj * r[2]; ac[qi][3] += pj * r[3]; } }
#pragma unroll
      for (int qi = 0; qi < 8; qi++)
#pragma unroll
        for (int c = 0; c < 4; c++) { float t = ac[qi][c]; t += __shfl_xor(t, 16); t += __shfl_xor(t, 32); ac[qi][c] = t; }
      if ((tid & 63) < 16) {
#pragma unroll
        for (int qi = 0; qi < 8; qi++)
#pragma unroll
          for (int c = 0; c < 4; c++) pvr[((tid >> 6) * 8 + qi) * 64 + d4 + c] = ac[qi][c];
      }
      __syncthreads();
      int qi = tid >> 5, d2 = (tid & 31) * 2;
      float a0 = pvr[(0 * 8 + qi) * 64 + d2] + pvr[(1 * 8 + qi) * 64 + d2] + pvr[(2 * 8 + qi) * 64 + d2] + pvr[(3 * 8 + qi) * 64 + d2];
      float a1 = pvr[(0 * 8 + qi) * 64 + d2 + 1] + pvr[(1 * 8 + qi) * 64 + d2 + 1] + pvr[(2 * 8 + qi) * 64 + d2 + 1] + pvr[(3 * 8 + qi) * 64 + d2 + 1];
      float inv = 1.f / sL[qi]; bfu* fo = (bfu*)(p.ws + OFF_FQ);
      *(unsigned*)(fo + (size_t)(TP + b * 16 + pass * 8 + qi) * 512 + h * 64 + d2) = pack2(a0 * inv, a1 * inv); }
  }
  __syncthreads();
}

DEV void peer_convert_item(const Params& p, int item) {
  const int tid = threadIdx.x, lane = tid & 63, w = tid >> 6;
  constexpr int NG = 0; const int it = item;
    {
      int r = (it - NG) * 4 + w;
      const float* src = r < 16384 ? p.peer_u + (size_t)r * DM : p.peer_v + (size_t)(r - 16384) * DM;
      float4 v0 = *(const float4*)(src + lane * 16), v1 = *(const float4*)(src + lane * 16 + 4), v2 = *(const float4*)(src + lane * 16 + 8), v3 = *(const float4*)(src + lane * 16 + 12);
      float am = fmaxf(fmaxf(fmaxf(fabsf(v0.x), fabsf(v0.y)), fmaxf(fabsf(v0.z), fabsf(v0.w))), fmaxf(fmaxf(fabsf(v1.x), fabsf(v1.y)), fmaxf(fabsf(v1.z), fabsf(v1.w))));
      am = fmaxf(am, fmaxf(fmaxf(fmaxf(fabsf(v2.x), fabsf(v2.y)), fmaxf(fabsf(v2.z), fabsf(v2.w))), fmaxf(fmaxf(fabsf(v3.x), fabsf(v3.y)), fmaxf(fabsf(v3.z), fabsf(v3.w)))));
#pragma unroll
      for (int o = 32; o >= 1; o >>= 1) am = fmaxf(am, __shfl_xor(am, o));
      float sc = am > 0.f ? 440.f / am : 1.f;
      int w0 = __builtin_amdgcn_cvt_pk_fp8_f32(v0.x * sc, v0.y * sc, 0, false); w0 = __builtin_amdgcn_cvt_pk_fp8_f32(v0.z * sc, v0.w * sc, w0, true);
      int w1 = __builtin_amdgcn_cvt_pk_fp8_f32(v1.x * sc, v1.y * sc, 0, false); w1 = __builtin_amdgcn_cvt_pk_fp8_f32(v1.z * sc, v1.w * sc, w1, true);
      int w2 = __builtin_amdgcn_cvt_pk_fp8_f32(v2.x * sc, v2.y * sc, 0, false); w2 = __builtin_amdgcn_cvt_pk_fp8_f32(v2.z * sc, v2.w * sc, w2, true);
      int w3 = __builtin_amdgcn_cvt_pk_fp8_f32(v3.x * sc, v3.y * sc, 0, false); w3 = __builtin_amdgcn_cvt_pk_fp8_f32(v3.z * sc, v3.w * sc, w3, true);
      uint4* dst = (uint4*)(p.ws + (r < 16384 ? OFF_PUB : OFF_PVB)) + (size_t)(r & 16383) * 64 + lane;
      *dst = make_uint4((unsigned)w0, (unsigned)w1, (unsigned)w2, (unsigned)w3);
      if (lane == 0) ((float*)(p.ws + OFF_PSC))[r] = am > 0.f ? am / 440.f : 1.f;
    }
}

DEV void phase3(const Params& p, int bid, int nb, char* smem) {
  const int tid = threadIdx.x;
  const float* U = (const float*)(p.ws + OFF_XB); bfu* SST = (bfu*)(p.ws + OFF_SST);
  { const int c0 = nb > 256 ? bid - 256 : bid, cs = nb > 256 ? nb - 256 : nb;
    if (c0 >= 0) for (int it = c0; it < 8192; it += cs) peer_convert_item(p, it); }
  for (int it = bid; it < 256 + 512; it += nb) {
    if (it < 256) { sample_item(p, it, smem); continue; }
    int g = (it - 256) * 256 + tid; int bh = g >> 13, e = g & 8191;
    float G = exp2f((float)RC * l2gamma(bh & 7));
    float s = 0.f;
    const float* Up = U + (size_t)bh * NCH * 8192 + e; bfu* Sp = SST + (size_t)bh * NCH * 8192 + e;
    Sp[0] = 0;
    for (int c0 = 0; c0 < NCH; c0 += 8) {
      float u[8];
#pragma unroll
      for (int i = 0; i < 8; i++) u[i] = Up[(size_t)(c0 + i) * 8192];
#pragma unroll
      for (int i = 0; i < 8; i++) { s = s * G + u[i]; if (c0 + i + 1 < NCH) Sp[(size_t)(c0 + i + 1) * 8192] = f2bf(s); }
    }
    int dv = e >> 6, dk = e & 63;
    p.out[O_SP + (size_t)bh * 8192 + dk * 128 + dv] = s;
  }
}

DEV void attn_item(const Params& p, int item, char* smem, float thr, bool dry) {
  const int tid = threadIdx.x, lane = tid & 63, w = tid >> 6, r32 = lane & 31, hi = lane >> 5;
  const int bh = item >> 7, qt = 127 - (item & 127);
  const int b = bh >> 3, h = bh & 7;
  const int q0 = qt * 128;
  bfu* sK = (bfu*)smem;
  bfu* sV = sK + 64 * 72;
  float* sC = (float*)(sV + 64 * 72);
  const float* c2 = (const float*)(p.ws + OFF_C2) + (size_t)bh * SEQ;
  bfu* FQ = (bfu*)(p.ws + OFF_FQ);
  const bfu* FKB = (const bfu*)(p.ws + OFF_FKB) + (size_t)b * SEQ * 512 + h * 64;
  const bfu* FVT = (const bfu*)(p.ws + OFF_FVT) + (size_t)bh * 64 * SEQ;
  const int jd0 = q0 >> 6;
  int pred = 0;
  if (tid < jd0) pred = (c2[q0] - c2[tid * 64 + 63]) < -thr;
  const int jstart = __syncthreads_count(pred);
  const int qrow = q0 + w * 32 + r32;
  bf16x8 qf[4];
  const bfu* qp = FQ + (size_t)(b * SEQ + qrow) * 512 + h * 64 + hi * 8;
#pragma unroll
  for (int d0 = 0; d0 < 4; d0++) qf[d0] = *(const bf16x8*)(qp + d0 * 16);
  const float cq = c2[qrow];
  float m = -INFINITY, lsum = 0.f;
  f32x16 o0, o1;
#pragma unroll
  for (int r = 0; r < 16; r++) { o0[r] = 0.f; o1[r] = 0.f; }
  u32x4 rk0, rk1, rv0, rv1; float rc = 0.f;
  const int srow = tid >> 3, sch = tid & 7;
#define ATT_GLOAD(j_) do { \
    rk0 = *(const u32x4*)(FKB + (size_t)((j_) * 64 + srow) * 512 + sch * 8); \
    rk1 = *(const u32x4*)(FKB + (size_t)((j_) * 64 + srow + 32) * 512 + sch * 8); \
    rv0 = *(const u32x4*)(FVT + (size_t)srow * SEQ + (j_) * 64 + sch * 8); \
    rv1 = *(const u32x4*)(FVT + (size_t)(srow + 32) * SEQ + (j_) * 64 + sch * 8); \
    if (tid < 64) rc = c2[(j_) * 64 + tid]; } while (0)
  ATT_GLOAD(jstart);
  for (int j = jstart; j <= jd0 + 1; j++) {
    __syncthreads();
    *(u32x4*)(sK + srow * 72 + sch * 8) = rk0; *(u32x4*)(sK + (srow + 32) * 72 + sch * 8) = rk1;
    *(u32x4*)(sV + srow * 72 + sch * 8) = rv0; *(u32x4*)(sV + (srow + 32) * 72 + sch * 8) = rv1;
    if (tid < 64) sC[tid] = rc;
    __syncthreads();
    if (j < jd0 + 1) ATT_GLOAD(j + 1);
    if (j * 64 > q0 + w * 32 + 31) continue;
    f32x16 s0, s1;
#pragma unroll
    for (int r = 0; r < 16; r++) { s0[r] = 0.f; s1[r] = 0.f; }
#pragma unroll
    for (int d0 = 0; d0 < 4; d0++) {
      bf16x8 k0 = *(const bf16x8*)(sK + r32 * 72 + d0 * 16 + hi * 8);
      bf16x8 k1 = *(const bf16x8*)(sK + (32 + r32) * 72 + d0 * 16 + hi * 8);
      s0 = __builtin_amdgcn_mfma_f32_32x32x16_bf16(k0, qf[d0], s0, 0, 0, 0);
      s1 = __builtin_amdgcn_mfma_f32_32x32x16_bf16(k1, qf[d0], s1, 0, 0, 0);
    }
    const bool diag = (j >= jd0);
    const int kbase = j * 64 + 4 * hi;
    float mloc = -INFINITY;
#pragma unroll
    for (int g = 0; g < 4; g++) {
      float4 c0 = *(const float4*)(sC + 8 * g + 4 * hi), c1 = *(const float4*)(sC + 32 + 8 * g + 4 * hi);
      float cc0[4] = {c0.x, c0.y, c0.z, c0.w}, cc1[4] = {c1.x, c1.y, c1.z, c1.w};
#pragma unroll
      for (int e = 0; e < 4; e++) {
        int r = g * 4 + e;
        float a = s0[r] + (cq - cc0[e]), bb = s1[r] + (cq - cc1[e]);
        if (diag) { int key = kbase + 8 * g + e; if (key > qrow) a = -INFINITY; if (key + 32 > qrow) bb = -INFINITY; }
        s0[r] = a; s1[r] = bb; mloc = fmaxf(mloc, fmaxf(a, bb));
      }
    }
    mloc = fmaxf(mloc, __shfl_xor(mloc, 32));
    float mn = fmaxf(m, mloc);
    float alpha = __builtin_amdgcn_exp2f(m - mn);
    m = mn;
    float ps = 0.f;
#pragma unroll
    for (int r = 0; r < 16; r++) { s0[r] = __builtin_amdgcn_exp2f(s0[r] - mn); s1[r] = __builtin_amdgcn_exp2f(s1[r] - mn); ps += s0[r] + s1[r]; }
    lsum = lsum * alpha + ps;
#pragma unroll
    for (int r = 0; r < 16; r++) { o0[r] *= alpha; o1[r] *= alpha; }
#pragma unroll
    for (int ks = 0; ks < 4; ks++) {
      union { bf16x8 v; unsigned u[4]; } pf;
#pragma unroll
      for (int e = 0; e < 4; e++) {
        int r = (ks & 1) * 8 + 2 * e;
        pf.u[e] = (ks < 2) ? pack2(s0[r], s0[r + 1]) : pack2(s1[r], s1[r + 1]);
      }
#pragma unroll
      for (int db = 0; db < 2; db++) {
        const bfu* vp = sV + (db * 32 + r32) * 72 + ks * 16 + 4 * hi;
        union { bf16x8 v; uint2 u[2]; } vf;
        vf.u[0] = *(const uint2*)vp; vf.u[1] = *(const uint2*)(vp + 8);
        if (db == 0) o0 = __builtin_amdgcn_mfma_f32_32x32x16_bf16(vf.v, pf.v, o0, 0, 0, 0);
        else o1 = __builtin_amdgcn_mfma_f32_32x32x16_bf16(vf.v, pf.v, o1, 0, 0, 0);
      }
    }
  }
  float lt = lsum + __shfl_xor(lsum, 32);
  float inv = 1.f / lt;
  bfu* op = (dry ? (bfu*)(p.ws + OFF_XB) : FQ) + (size_t)(b * SEQ + qrow) * 512 + h * 64;
#pragma unroll
  for (int g = 0; g < 4; g++) {
    *(uint2*)(op + 8 * g + 4 * hi) = make_uint2(pack2(o0[g * 4] * inv, o0[g * 4 + 1] * inv), pack2(o0[g * 4 + 2] * inv, o0[g * 4 + 3] * inv));
    *(uint2*)(op + 32 + 8 * g + 4 * hi) = make_uint2(pack2(o1[g * 4] * inv, o1[g * 4 + 1] * inv), pack2(o1[g * 4 + 2] * inv, o1[g * 4 + 3] * inv));
  }
  __syncthreads();
}

DEV void r3_item(const Params& p, int item, char* smem, bool dry) {
  const int tid = threadIdx.x, lane = tid & 63, w = tid >> 6, wr = w >> 1, wc = w & 1, l16 = lane & 15, quad = lane >> 4;
  const int bh = item / NCH, c = item - bh * NCH; const int b = bh >> 3, h = bh & 7;
  bfu* sQ = (bfu*)smem; bfu* sK = sQ + 128 * 72; bfu* sP = sK + 128 * 72; float* sRed = (float*)(sP + 128 * 136);
  const size_t row0 = (size_t)b * SEQ + c * RC;
  const bfu* Q = (const bfu*)(p.ws + OFF_QT) + row0 * 512 + h * 64;
  const bfu* Kk = (const bfu*)(p.ws + OFF_KT) + row0 * 512 + h * 64;
  const bfu* vT = (const bfu*)(p.ws + OFF_VT) + (size_t)bh * 128 * SEQ + c * RC;
  const bfu* ST = (const bfu*)(p.ws + OFF_SST) + (size_t)item * 8192;
  u32x4 ra[4], rb[4];
  g2r<128>(Q, 512, ra); g2r<128>(Kk, 512, rb);
  __syncthreads();
  r2s<128>(sQ, ra); r2s<128>(sK, rb);
  __syncthreads();
  g2r<128>(vT, SEQ, rb);
  f32x4 acc[4][4];
#pragma unroll
  for (int i = 0; i < 4; i++)
#pragma unroll
    for (int j = 0; j < 4; j++) acc[i][j] = f32x4{0.f, 0.f, 0.f, 0.f};
  mma64<4, 4>(sQ, 72, sK, 72, acc);
#pragma unroll
  for (int mi = 0; mi < 4; mi++)
#pragma unroll
    for (int ni = 0; ni < 4; ni++)
#pragma unroll
      for (int j = 0; j < 4; j++) {
        int row = wr * 64 + mi * 16 + quad * 4 + j, col = wc * 64 + ni * 16 + l16;
        sP[row * 136 + col] = (col <= row) ? f2bf(acc[mi][ni][j]) : (bfu)0;
      }
#pragma unroll
  for (int i = 0; i < 4; i++)
#pragma unroll
    for (int j = 0; j < 4; j++) acc[i][j] = f32x4{0.f, 0.f, 0.f, 0.f};
  __syncthreads();
  r2s<128>(sK, rb);
  __syncthreads();
  g2r<128>(vT + 64, SEQ, rb);
  mma64<4, 4>(sP, 136, sK, 72, acc);
  __syncthreads();
  r2s<128>(sK, rb);
  __syncthreads();
  g2r<128>(ST, 64, rb);
  mma64<4, 4>(sP + 64, 136, sK, 72, acc);
  __syncthreads();
  r2s<128>(sK, rb);
  __syncthreads();
  mma64<4, 4>(sQ, 72, sK, 72, acc);
  float ssq[4][4];
#pragma unroll
  for (int mi = 0; mi < 4; mi++)
#pragma unroll
    for (int j = 0; j < 4; j++) { float s = 0.f;
#pragma unroll
      for (int ni = 0; ni < 4; ni++) s += acc[mi][ni][j] * acc[mi][ni][j];
      s = sum16(s); ssq[mi][j] = s;
      if (l16 == 0) sRed[(wr * 64 + mi * 16 + quad * 4 + j) * 2 + wc] = s; }
  __syncthreads();
  bfu* RG = (bfu*)(p.ws + OFF_RG);
  float gg[4];
#pragma unroll
  for (int ni = 0; ni < 4; ni++) gg[ni] = p.gn_g[h * 128 + wc * 64 + ni * 16 + l16];
#pragma unroll
  for (int mi = 0; mi < 4; mi++)
#pragma unroll
    for (int j = 0; j < 4; j++) {
      int row = wr * 64 + mi * 16 + quad * 4 + j;
      float tot = sRed[row * 2] + sRed[row * 2 + 1];
      float r = rsqrtf(tot * (1.f / 128.f) + EPSN);
#pragma unroll
      for (int ni = 0; ni < 4; ni++) {
        size_t o = (row0 + row) * DM + h * 128 + wc * 64 + ni * 16 + l16;
        float rgv = bf2f(RG[o]);
        (dry ? (bfu*)(p.ws + OFF_XB) + (o & 0xffffff) : RG + o)[0] = f2bf(acc[mi][ni][j] * r * gg[ni] * (rgv * sigmoidf_(rgv)));
      }
    }
  __syncthreads();
}

DEV void phase4(const Params& p, int bid, int nb, char* smem, bool dry = false) {
  float gq = 0.f, gk = 0.f;
  for (int i = 0; i < 64; i++) { gq = fmaxf(gq, fabsf(p.fq_g[i])); gk = fmaxf(gk, fabsf(p.fk_g[i])); }
  const float thr = 2.f * (8.f * gq * gk * 1.03f * LOG2E) + 44.f;
  for (int it = bid; it < 2048 + 16 * NCH; it += nb) {
    if (it < 2048) attn_item(p, it, smem, thr, dry); else r3_item(p, it - 2048, smem, dry);
  }
}

DEV void phase5(const Params& p, int bid, int nb, char* smem) {
  const int tid = threadIdx.x, lane = tid & 63, w = tid >> 6, wr = w >> 1, wc = w & 1, l16 = lane & 15, quad = lane >> 4;
  bfu* sA = (bfu*)smem; bfu* sB = sA + 128 * 72;
  const bfu* G = (const bfu*)(p.ws + OFF_RG); const bfu* FO = (const bfu*)(p.ws + OFF_FQ);
  const bfu* WR = (const bfu*)(p.ws + OFF_WRT); const bfu* WF = (const bfu*)(p.ws + OFF_WFT);
  bfu* MX = (bfu*)(p.ws + OFF_XB);
  constexpr int NG = (TT / 128) * 8, NCV = 8192;
  const int xcd = bid & 7, slot = bid >> 3, nslots = (nb + 7 - xcd) >> 3;
  const int n_p = slot < 128 ? (128 - slot + nslots - 1) / nslots : 0;
  for (int i_ = 0; i_ < n_p; i_++) {
    int q = slot + i_ * nslots; int mt = xcd * 16 + (q >> 3), nt = q & 7;
    int m0 = mt * 256, n0 = nt * 128;
    int tid2 = threadIdx.x; asm volatile("" : "+v"(tid2));
    const int lane2 = tid2 & 63, w2 = tid2 >> 6, wr2 = w2 >> 1, wc2 = w2 & 1, l162 = lane2 & 15, quad2 = lane2 >> 4;
    f32x4 a1[8][4];
#pragma unroll
    for (int i = 0; i < 8; i++)
#pragma unroll
      for (int j = 0; j < 4; j++) a1[i][j] = f32x4{0.f, 0.f, 0.f, 0.f};
    gemm_loop_sb<8, 4>(G + (size_t)m0 * DM, DM, WR + (size_t)n0 * DM, DM, DM, a1, sA);
    const bfu* ga = (const bfu*)(p.out + O_YP); const bfu* gb = ga + (size_t)TP * DM;
    float* sw = (float*)(smem + EPI_OFF) + w2 * EPI_WAVE;
    const int rr = lane2 >> 2, c0 = wc2 * 64 + (lane2 & 3) * 16;
#pragma unroll
    for (int mi = 0; mi < 8; mi++) {
      float r[16], g[16]; to_rows(a1[mi], r, sw, lane2);
      int rr_ = rr; asm volatile("" : "+v"(rr_));
      const size_t o = (size_t)(m0 + wr2 * 128 + mi * 16 + rr_) * DM + n0 + c0;
      ld_bf16x16(ga + o, g);
#pragma unroll
      for (int e = 0; e < 16; e++) r[e] *= sigmoidf_(g[e]);
      st_bf16x16(MX + o, r);
#pragma unroll
      for (int ni = 0; ni < 4; ni++) a1[mi][ni] = f32x4{0.f, 0.f, 0.f, 0.f};
    }
    gemm_loop_sb<8, 4>(FO + (size_t)m0 * 512, 512, WF + (size_t)n0 * 512, 512, 512, a1, sA);
#pragma unroll
    for (int mi = 0; mi < 8; mi++) {
      float r[16], g[16], m[16]; to_rows(a1[mi], r, sw, lane2);
      int rr_ = rr; asm volatile("" : "+v"(rr_));
      const size_t o = (size_t)(m0 + wr2 * 128 + mi * 16 + rr_) * DM + n0 + c0;
      ld_bf16x16(gb + o, g); ld_bf16x16(MX + o, m);
#pragma unroll
      for (int e = 0; e < 16; e++) r[e] = m[e] + sigmoidf_(g[e]) * r[e];
      st_bf16x16(MX + o, r);
    }
  }
  if (bid < 128) {
    int nt = bid & 7;
    int m0 = TP + (bid >> 3) * 32, n0 = nt * 128;
    f32x4 a1[1][4];
#pragma unroll
    for (int j = 0; j < 4; j++) a1[0][j] = f32x4{0.f, 0.f, 0.f, 0.f};
    gemm_loop<1, 4>(G + (size_t)m0 * DM, DM, WR + (size_t)n0 * DM, DM, DM, a1, sA);
    const bfu* ga = (const bfu*)(p.out + O_YS) + (size_t)(m0 - TP) * DM + n0; const bfu* gb = ga + (size_t)TS * DM;
    bfu* mxT = MX + (size_t)m0 * DM + n0;
    unsigned loff = (unsigned)((wr * 16 + quad * 4) * DM + wc * 64 + l16); asm volatile("" : "+v"(loff));
#pragma unroll
    for (int ni = 0; ni < 4; ni++) {
#pragma unroll
      for (int j = 0; j < 4; j++) { unsigned o = loff + (unsigned)(j * DM + ni * 16);
        mxT[o] = f2bf(sigmoidf_(bf2f(ga[o])) * a1[0][ni][j]); }
      a1[0][ni] = f32x4{0.f, 0.f, 0.f, 0.f};
    }
    gemm_loop<1, 4>(FO + (size_t)m0 * 512, 512, WF + (size_t)n0 * 512, 512, 512, a1, sA);
    unsigned loff2 = loff; asm volatile("" : "+v"(loff2));
#pragma unroll
    for (int ni = 0; ni < 4; ni++) {
#pragma unroll
      for (int j = 0; j < 4; j++) { unsigned o = loff2 + (unsigned)(j * DM + ni * 16);
        mxT[o] = f2bf(bf2f(mxT[o]) + sigmoidf_(bf2f(gb[o])) * a1[0][ni][j]); }
    }
  }
}

DEV void phase6(const Params& p, int bid, int nb, char* smem) {
  bfu* sA = (bfu*)smem;
  const bfu* MX = (const bfu*)(p.ws + OFF_XB); const bfu* WO = (const bfu*)(p.ws + OFF_WOT);
  bfu* X1B = (bfu*)(p.ws + OFF_X1B); float* SSQ2 = (float*)(p.ws + OFF_SSQ2);
  const int xcd = bid & 7, slot = bid >> 3, nslots = (nb + 7 - xcd) >> 3;
  const int n_p = slot < 128 ? (128 - slot + nslots - 1) / nslots : 0;
  for (int i_ = 0; i_ < n_p; i_++) {
    int q = slot + i_ * nslots; int mt = xcd * 16 + (q >> 3), nt = q & 7;
    int m0 = mt * 256, n0 = nt * 128;
    int tid = threadIdx.x; asm volatile("" : "+v"(tid));
    const int lane = tid & 63, w = tid >> 6, wr = w >> 1, wc = w & 1, l16 = lane & 15, quad = lane >> 4;
    f32x4 acc[8][4];
#pragma unroll
    for (int i = 0; i < 8; i++)
#pragma unroll
      for (int j = 0; j < 4; j++) acc[i][j] = f32x4{0.f, 0.f, 0.f, 0.f};
    gemm_loop_sb<8, 4>(MX + (size_t)m0 * DM, DM, WO + (size_t)n0 * DM, DM, DM, acc, sA);
    float* sw = (float*)(smem + EPI_OFF) + w * EPI_WAVE;
    const int rr = lane >> 2, c0 = wc * 64 + (lane & 3) * 16;
#pragma unroll
    for (int mi = 0; mi < 8; mi++) {
      float r[16]; to_rows(acc[mi], r, sw, lane);
      int rr_ = rr; asm volatile("" : "+v"(rr_));
      const size_t o = (size_t)(m0 + wr * 128 + mi * 16 + rr_) * DM + n0 + c0;
      const float* xp = (m0 < TP ? p.x_p : p.x_s - (size_t)TP * DM) + o;
      float ss = 0.f;
#pragma unroll
      for (int c = 0; c < 4; c++) { f32x4 xv = *(const f32x4*)(xp + 4 * c);
#pragma unroll
        for (int e = 0; e < 4; e++) { r[4 * c + e] += xv[e]; ss += r[4 * c + e] * r[4 * c + e]; } }
      st_f32x16(p.out + O_YP + o, r);
      st_bf16x16(X1B + o, r);
      ss += __shfl_xor(ss, 1); ss += __shfl_xor(ss, 2);
      if ((lane & 3) == 0) SSQ2[(size_t)(m0 + wr * 128 + mi * 16 + rr) * 16 + nt * 2 + wc] = ss;
    }
  }
  if (bid < 128) {
    const int tid = threadIdx.x, lane = tid & 63, w = tid >> 6, wr = w >> 1, wc = w & 1, l16 = lane & 15, quad = lane >> 4;
    int nt = bid & 7;
    int m0 = TP + (bid >> 3) * 32, n0 = nt * 128;
    f32x4 acc[1][4];
#pragma unroll
    for (int j = 0; j < 4; j++) acc[0][j] = f32x4{0.f, 0.f, 0.f, 0.f};
    gemm_loop<1, 4>(MX + (size_t)m0 * DM, DM, WO + (size_t)n0 * DM, DM, DM, acc, sA);
    const float* xin = p.x_s + (size_t)(m0 - TP) * DM + n0;
    float* y = p.out + O_YS + (size_t)(m0 - TP) * DM + n0;
    bfu* xb1 = X1B + (size_t)m0 * DM + n0;
    unsigned loff = (unsigned)((wr * 16 + quad * 4) * DM + wc * 64 + l16); asm volatile("" : "+v"(loff));
#pragma unroll
    for (int j = 0; j < 4; j++) {
      int lr = wr * 16 + quad * 4 + j; float ss = 0.f;
#pragma unroll
      for (int ni = 0; ni < 4; ni++) {
        unsigned o = loff + (unsigned)(j * DM + ni * 16);
        float v = xin[o] + acc[0][ni][j];
        y[o] = v; xb1[o] = f2bf(v); ss += v * v;
      }
      ss = sum16(ss);
      if (l16 == 0) (SSQ2 + (size_t)m0 * 16 + nt * 2)[(unsigned)(lr * 16 + wc)] = ss;
    }
  }
}

DEV int fkey(float x, int idx, int mask) { int b = __float_as_int(x); b ^= (b >> 31) & 0x7fffffff; return (b & ~mask) | idx; }
DEV void ins16(int (&t)[16], int v) {
#pragma unroll
  for (int s = 0; s < 16; s++) { int hi = max(t[s], v); v = min(t[s], v); t[s] = hi; }
}

DEV void phase7(const Params& p, int bid, int nb, char* smem) {
  const int tid = threadIdx.x, lane = tid & 63, w = tid >> 6, wr = w >> 1, wc = w & 1, l16 = lane & 15, quad = lane >> 4;
  bfu* sA = (bfu*)smem;
  float* sS = (float*)smem;
  int* sL = (int*)(smem + 33024);
  float* sTV = (float*)(smem + 55296);
  int* sTI = (int*)(sTV + 2 * 64 * 17);
  const bfu* X1B = (const bfu*)(p.ws + OFF_X1B); const bfu* MT = (const bfu*)(p.ws + OFF_MT);
  const float* SSQ2 = (const float*)(p.ws + OFF_SSQ2);
  int2* ROUTE = (int2*)(p.ws + OFF_ROUTE);
  constexpr int NI7 = (TT / 64) * 8;
  const int xcd = bid & 7, slot = bid >> 3, nslots = (nb + 7 - xcd) >> 3;
  for (int q = slot; q < 520; q += nslots) {
    int hg = q / 260, q2 = q - hg * 260; int mt = xcd * 65 + (q2 >> 2), h = hg * 4 + (q2 & 3); int m0 = mt * 64;
    for (int half = 0; half < 2; half++) {
      f32x4 acc[2][4];
#pragma unroll
      for (int i = 0; i < 2; i++)
#pragma unroll
        for (int j = 0; j < 4; j++) acc[i][j] = f32x4{0.f, 0.f, 0.f, 0.f};
      gemm_loop<2, 4>(X1B + (size_t)m0 * DM, DM, MT + (size_t)(h * 256 + half * 128) * DM, DM, DM, acc, sA);
      __syncthreads();
#pragma unroll
      for (int mi = 0; mi < 2; mi++)
#pragma unroll
        for (int j = 0; j < 4; j++) {
          int lr = wr * 32 + mi * 16 + quad * 4 + j;
          const float* sp = SSQ2 + (size_t)(m0 + lr) * 16; float tot = 0.f;
#pragma unroll
          for (int i = 0; i < 16; i++) tot += sp[i];
          float rs = rsqrtf(tot * (1.f / DM) + EPSN);
#pragma unroll
          for (int ni = 0; ni < 4; ni++) sS[lr * 129 + wc * 64 + ni * 16 + l16] = acc[mi][ni][j] * rs;
        }
      __syncthreads();
      { int row = tid & 63, q = tid >> 6; int t[16];
#pragma unroll
        for (int s = 0; s < 16; s++) t[s] = (int)0x80000000;
        for (int i = 0; i < 32; i++) { int idx = q * 32 + i; ins16(t, fkey(sS[row * 129 + idx], idx, 127)); }
#pragma unroll
        for (int s = 0; s < 16; s++) sL[row * 65 + q * 16 + s] = t[s]; }
      __syncthreads();
      if (tid < 64) { int row = tid; int p0 = 0, p1 = 0, p2 = 0, p3 = 0; const int* L = sL + row * 65;
        for (int r = 0; r < 16; r++) {
          int a0 = L[p0], a1 = L[16 + p1], a2 = L[32 + p2], a3 = L[48 + p3];
          int mx = max(max(a0, a1), max(a2, a3));
          if (mx == a0) p0++; else if (mx == a1) p1++; else if (mx == a2) p2++; else p3++;
          int idx = mx & 127;
          sTV[(half * 64 + row) * 17 + r] = sS[row * 129 + idx]; sTI[(half * 64 + row) * 17 + r] = idx; } }
      __syncthreads();
    }
    if (tid < 64) {
      int row = tid; float v1[16], v2[16];
#pragma unroll
      for (int i = 0; i < 16; i++) { v1[i] = sTV[row * 17 + i]; v2[i] = sTV[(64 + row) * 17 + i]; }
      int t[16];
#pragma unroll
      for (int s = 0; s < 16; s++) t[s] = (int)0x80000000;
#pragma unroll
      for (int i = 0; i < 16; i++)
#pragma unroll
        for (int j = 0; j < 16; j++)
          if ((i + 1) * (j + 1) <= 16) ins16(t, fkey(v1[i] + v2[j], i * 16 + j, 255));
      float es[16]; int ei[16]; float mx = 0.f, sum = 0.f;
#pragma unroll
      for (int r = 0; r < 16; r++) { int c = t[r] & 255; int i = c >> 4, j = c & 15;
        float s = sTV[row * 17 + i] + sTV[(64 + row) * 17 + j];
        ei[r] = sTI[row * 17 + i] * 128 + sTI[(64 + row) * 17 + j];
        if (r == 0) mx = s;
        es[r] = __expf(s - mx); sum += es[r]; }
      float inv = 1.f / sum;
      int2* ro = ROUTE + ((size_t)(m0 + row) * 8 + h) * 16;
#pragma unroll
      for (int r = 0; r < 16; r++) ro[r] = make_int2(ei[r], __float_as_int(es[r] * inv));
    }
    __syncthreads();
  }
}

DEV float dot16_fp8(const u32x4& u, const f32x2 (&xn)[8]) {
  f32x2 s = __builtin_amdgcn_cvt_pk_f32_fp8((int)u[0], false) * xn[0];
  s = __builtin_amdgcn_cvt_pk_f32_fp8((int)u[0], true) * xn[1] + s;
  s = __builtin_amdgcn_cvt_pk_f32_fp8((int)u[1], false) * xn[2] + s;
  s = __builtin_amdgcn_cvt_pk_f32_fp8((int)u[1], true) * xn[3] + s;
  s = __builtin_amdgcn_cvt_pk_f32_fp8((int)u[2], false) * xn[4] + s;
  s = __builtin_amdgcn_cvt_pk_f32_fp8((int)u[2], true) * xn[5] + s;
  s = __builtin_amdgcn_cvt_pk_f32_fp8((int)u[3], false) * xn[6] + s;
  s = __builtin_amdgcn_cvt_pk_f32_fp8((int)u[3], true) * xn[7] + s;
  return s[0] + s[1];
}
DEV void axpy16_fp8(const u32x4& u, float wj, f32x2 (&acc)[8]) {
  const f32x2 w2 = {wj, wj};
  acc[0] = __builtin_amdgcn_cvt_pk_f32_fp8((int)u[0], false) * w2 + acc[0];
  acc[1] = __builtin_amdgcn_cvt_pk_f32_fp8((int)u[0], true) * w2 + acc[1];
  acc[2] = __builtin_amdgcn_cvt_pk_f32_fp8((int)u[1], false) * w2 + acc[2];
  acc[3] = __builtin_amdgcn_cvt_pk_f32_fp8((int)u[1], true) * w2 + acc[3];
  acc[4] = __builtin_amdgcn_cvt_pk_f32_fp8((int)u[2], false) * w2 + acc[4];
  acc[5] = __builtin_amdgcn_cvt_pk_f32_fp8((int)u[2], true) * w2 + acc[5];
  acc[6] = __builtin_amdgcn_cvt_pk_f32_fp8((int)u[3], false) * w2 + acc[6];
  acc[7] = __builtin_amdgcn_cvt_pk_f32_fp8((int)u[3], true) * w2 + acc[7];
}
template <int S>
DEV void red_step(float (&pp)[16], int lane) {
  const bool up = (lane & S) != 0;
#pragma unroll
  for (int i = 0; i < S; i++) {
    float send = up ? pp[i] : pp[i + S];
    float keep = up ? pp[i + S] : pp[i];
    pp[i] = keep + __shfl_xor(send, S);
  }
}
DEV float reduce16(float (&pp)[16], int lane) {
  red_step<8>(pp, lane); red_step<4>(pp, lane); red_step<2>(pp, lane); red_step<1>(pp, lane);
  float v = pp[0];
  v += __shfl_xor(v, 16); v += __shfl_xor(v, 32);
  return v;
}

DEV void phase8(const Params& p, int bid, int nb, char* smem, bool dry = false) {
  const int tid = threadIdx.x, lane = tid & 63, w = __builtin_amdgcn_readfirstlane(tid >> 6);
  const u32x4* PUB = (const u32x4*)(p.ws + OFF_PUB); const u32x4* PVB = (const u32x4*)(p.ws + OFF_PVB);
  const float* PSC = (const float*)(p.ws + OFF_PSC);
  const float* SSQ2 = (const float*)(p.ws + OFF_SSQ2); const int2* ROUTE = (const int2*)(p.ws + OFF_ROUTE);
  for (int it = bid; it < TT / 4; it += nb) {
    int tok = it * 4 + w;
    float* y = tok < TP ? p.out + O_YP + (size_t)tok * DM : p.out + O_YS + (size_t)(tok - TP) * DM;
    float x[16]; f32x2 xn[8];
    { float4 a0 = *(const float4*)(y + lane * 16), a1 = *(const float4*)(y + lane * 16 + 4), b0 = *(const float4*)(y + lane * 16 + 8), b1 = *(const float4*)(y + lane * 16 + 12);
      x[0] = a0.x; x[1] = a0.y; x[2] = a0.z; x[3] = a0.w; x[4] = a1.x; x[5] = a1.y; x[6] = a1.z; x[7] = a1.w;
      x[8] = b0.x; x[9] = b0.y; x[10] = b0.z; x[11] = b0.w; x[12] = b1.x; x[13] = b1.y; x[14] = b1.z; x[15] = b1.w; }
    float tot = 0.f;
    { const float* sp = SSQ2 + (size_t)tok * 16;
#pragma unroll
      for (int i = 0; i < 16; i++) tot += sp[i]; }
    float rs = rsqrtf(tot * (1.f / DM) + EPSN);
#pragma unroll
    for (int i = 0; i < 8; i++) { xn[i][0] = x[2 * i] * rs * p.norm2_g[lane * 16 + 2 * i]; xn[i][1] = x[2 * i + 1] * rs * p.norm2_g[lane * 16 + 2 * i + 1]; }
    const int2* rt = ROUTE + (size_t)tok * 128;
    int2 r0 = rt[lane], r1 = rt[lane + 64];
    float d0 = 0.f, d1 = 0.f;
#pragma unroll 1
    for (int g = 0; g < 4; g++) {
      float pp[16]; u32x4 u[16];
#pragma unroll
      for (int jj = 0; jj < 16; jj++) { int e = __builtin_amdgcn_readlane(r0.x, g * 16 + jj); u[jj] = PUB[(size_t)e * 64 + lane]; }
      __builtin_amdgcn_sched_barrier(0);
#pragma unroll
      for (int jj = 0; jj < 16; jj++) pp[jj] = dot16_fp8(u[jj], xn);
      float v = reduce16(pp, lane);
      if ((lane >> 4) == g) d0 = v;
    }
#pragma unroll 1
    for (int g = 0; g < 4; g++) {
      float pp[16]; u32x4 u[16];
#pragma unroll
      for (int jj = 0; jj < 16; jj++) { int e = __builtin_amdgcn_readlane(r1.x, g * 16 + jj); u[jj] = PUB[(size_t)e * 64 + lane]; }
      __builtin_amdgcn_sched_barrier(0);
#pragma unroll
      for (int jj = 0; jj < 16; jj++) pp[jj] = dot16_fp8(u[jj], xn);
      float v = reduce16(pp, lane);
      if ((lane >> 4) == g) d1 = v;
    }
    d0 *= PSC[r0.x]; d1 *= PSC[r1.x];
    const float w0 = 0.5f * d0 * (1.f + erff(d0 * 0.70710678118654752f)) * __int_as_float(r0.y) * PSC[16384 + r0.x];
    const float w1 = 0.5f * d1 * (1.f + erff(d1 * 0.70710678118654752f)) * __int_as_float(r1.y) * PSC[16384 + r1.x];
    f32x2 acc[8];
#pragma unroll
    for (int i = 0; i < 8; i++) acc[i] = f32x2{0.f, 0.f};
#pragma unroll 1
    for (int g = 0; g < 8; g++) {
      const int rx = g < 4 ? r0.x : r1.x; const int wx = __float_as_int(g < 4 ? w0 : w1);
      u32x4 u[16];
#pragma unroll
      for (int jj = 0; jj < 16; jj++) { int e = __builtin_amdgcn_readlane(rx, (g & 3) * 16 + jj); u[jj] = PVB[(size_t)e * 64 + lane]; }
      __builtin_amdgcn_sched_barrier(0);
#pragma unroll
      for (int jj = 0; jj < 16; jj++) { float wj = __int_as_float(__builtin_amdgcn_readlane(wx, (g & 3) * 16 + jj)); axpy16_fp8(u[jj], wj, acc); }
    }
    if (dry) y = (float*)(p.ws + OFF_XB) + (size_t)(tok & 8191) * DM;
    *(float4*)(y + lane * 16) = make_float4(x[0] + acc[0][0], x[1] + acc[0][1], x[2] + acc[1][0], x[3] + acc[1][1]);
    *(float4*)(y + lane * 16 + 4) = make_float4(x[4] + acc[2][0], x[5] + acc[2][1], x[6] + acc[3][0], x[7] + acc[3][1]);
    *(float4*)(y + lane * 16 + 8) = make_float4(x[8] + acc[4][0], x[9] + acc[4][1], x[10] + acc[5][0], x[11] + acc[5][1]);
    *(float4*)(y + lane * 16 + 12) = make_float4(x[12] + acc[6][0], x[13] + acc[6][1], x[14] + acc[7][0], x[15] + acc[7][1]);
  }
}

__global__ void __launch_bounds__(256, 2) fwd_kernel(Params p, int ph_lo, int ph_hi, int coop) {
  __shared__ __attribute__((aligned(16))) char smem[SMEM_BYTES];
  const int bid = blockIdx.x, nb = gridDim.x;
#ifndef REPS
#define REPS {1,1,1,1,1,1,1,1,1}
#endif
  constexpr int REP[9] = REPS;
#define RUN_PHASE(N) if (ph_lo <= N && N <= ph_hi) { for (int r_ = 0; r_ < REP[N]; r_++) phase##N(p, bid, nb, smem); if (coop && N < ph_hi) cg::this_grid().sync(); }
#define RUN_PHASE_DRY(N) if (ph_lo <= N && N <= ph_hi) { for (int r_ = 1; r_ < REP[N]; r_++) phase##N(p, bid, nb, smem, true); phase##N(p, bid, nb, smem, false); if (coop && N < ph_hi) cg::this_grid().sync(); }
  RUN_PHASE(0) RUN_PHASE_DRY(1) RUN_PHASE(2) RUN_PHASE(3) RUN_PHASE_DRY(4) RUN_PHASE(5) RUN_PHASE(6) RUN_PHASE(7) RUN_PHASE_DRY(8)
}

extern "C" void kernel_launch(void* const* d_in, const int* in_sizes, int n_in, void* d_out, int out_size,
                              void* d_ws, size_t ws_size, hipStream_t stream) {
  if (ws_size < WS_NEED) { fprintf(stderr, "workspace too small\n"); return; }
  static int grid_blocks = 0;
  if (!grid_blocks) {
    int dev = 0, cus = 0, per_cu = 0;
    hipGetDevice(&dev);
    hipDeviceGetAttribute(&cus, hipDeviceAttributeMultiprocessorCount, dev);
    hipOccupancyMaxActiveBlocksPerMultiprocessor(&per_cu, fwd_kernel, 256, 0);
    if (per_cu < 1) per_cu = 1;
    if (per_cu > 2) per_cu = 2;
    grid_blocks = cus * per_cu;
  }
  Params p{};
  const float* const* in = (const float* const*)d_in;
  p.x_p = in[0]; p.x_s = in[1]; p.state_ret = in[2]; p.ck = in[3]; p.cv = in[4]; p.clogf = in[5]; p.norm1_g = in[6];
  p.w_in = in[7]; p.b_f = in[8]; p.fq_g = in[9]; p.fk_g = in[10]; p.gn_g = in[11]; p.w_ret_out = in[12]; p.w_fox_out = in[13];
  p.w_o = in[14]; p.norm2_g = in[15]; p.peer_wq = in[16]; p.k1 = in[17]; p.k2 = in[18]; p.peer_u = in[19]; p.peer_v = in[20];
  p.out = (float*)d_out; p.ws = (char*)d_ws;
#ifndef MULTI_LAUNCH
#define MULTI_LAUNCH 0
#endif
#if MULTI_LAUNCH
  for (int ph = 0; ph <= 8; ph++) fwd_kernel<<<grid_blocks, 256, 0, stream>>>(p, ph, ph, 0);
#else
  int lo = 0, hi = 8, coop = 1;
  void* args[] = {&p, &lo, &hi, &coop};
  hipError_t e = hipLaunchCooperativeKernel((void*)fwd_kernel, dim3(grid_blocks), dim3(256), args, 0, stream);
  if (e != hipSuccess) fprintf(stderr, "cooperative launch failed: %s (grid %d)\n", hipGetErrorString(e), grid_blocks);
#endif
}
```

```cpp
#include <hip/hip_runtime.h>
#include <hip/hip_cooperative_groups.h>
#include <stdint.h>
#include <stdio.h>
namespace cg = cooperative_groups;

#define DEV __device__ __forceinline__
typedef unsigned short bfu;
typedef __attribute__((ext_vector_type(8))) short bf16x8;
typedef __attribute__((ext_vector_type(4))) short bf16x4;
typedef __attribute__((ext_vector_type(4))) float f32x4;
typedef __attribute__((ext_vector_type(16))) float f32x16;
typedef __attribute__((ext_vector_type(4))) unsigned u32x4;
typedef __attribute__((ext_vector_type(2))) float f32x2;
typedef __attribute__((ext_vector_type(2))) unsigned u32x2;

constexpr int DM = 1024, SEQ = 16384, TP = 32768, TS = 512, TT = 33280;
constexpr int NWP = 6784;
constexpr int RC = 128;
constexpr int NCH = SEQ / RC;
constexpr float LOG2E = 1.4426950408889634f;
constexpr float EPSN = 1e-6f;

constexpr size_t O_YP = 0, O_YS = 33554432, O_SP = 34078720, O_FKP = 34209792, O_FVP = 50987008,
                 O_LFP = 67764224, O_SS = 68026368, O_FKS = 70123520, O_FVS = 70385664, O_LFS = 70647808;
constexpr size_t MiB = 1u << 20;
constexpr size_t OFF_XB = 0;
constexpr size_t OFF_WINT = 66 * MiB, OFF_WRT = 80 * MiB, OFF_WFT = 82 * MiB, OFF_WOT = 83 * MiB, OFF_MT = 85 * MiB;
constexpr size_t OFF_RSTD1 = 89 * MiB, OFF_C2 = 90 * MiB, OFF_HS = 91 * MiB;
constexpr size_t OFF_QT = 105 * MiB, OFF_KT = 137 * MiB, OFF_KTT = 169 * MiB, OFF_VT = 201 * MiB;
constexpr size_t OFF_X1B = OFF_HS;
constexpr size_t OFF_RG = 265 * MiB, OFF_FQ = 331 * MiB, OFF_FKB = 364 * MiB, OFF_FVT = 396 * MiB;
constexpr size_t OFF_PUB = OFF_KTT, OFF_PVB = OFF_KTT + 16 * MiB;
constexpr size_t OFF_ROUTE = OFF_FKB, OFF_SSQ2 = OFF_FKB + 33 * MiB;
constexpr size_t OFF_PSC = OFF_RSTD1 + 512 * 1024;
constexpr size_t OFF_SST = 428 * MiB;
constexpr size_t WS_NEED = 460 * MiB;

constexpr int SMEM_BYTES = 75776;

struct Params {
  const float *x_p, *x_s, *state_ret, *ck, *cv, *clogf, *norm1_g, *w_in, *b_f, *fq_g, *fk_g, *gn_g,
      *w_ret_out, *w_fox_out, *w_o, *norm2_g, *peer_wq, *k1, *k2, *peer_u, *peer_v;
  float* out;
  char* ws;
};

DEV bfu f2bf(float f) { unsigned u = __float_as_uint(f); u += 0x7fffu + ((u >> 16) & 1u); return (bfu)(u >> 16); }
DEV float bf2f(bfu b) { return __uint_as_float(((unsigned)b) << 16); }
DEV unsigned pack2(float a, float b) { return (unsigned)f2bf(a) | ((unsigned)f2bf(b) << 16); }
DEV float bflo(unsigned u) { return __uint_as_float(u << 16); }
DEV float bfhi(unsigned u) { return __uint_as_float(u & 0xffff0000u); }
DEV float sigmoidf_(float z) { return 1.f / (1.f + __expf(-z)); }
DEV float l2gamma(int h) { return log2f(1.f - exp2f(-5.f - (float)h)); }
DEV float wave_sum(float v) {
#pragma unroll
  for (int o = 32; o >= 1; o >>= 1) v += __shfl_xor(v, o);
  return v;
}
DEV float sum16(float v) {
  v += __shfl_xor(v, 1); v += __shfl_xor(v, 2); v += __shfl_xor(v, 4); v += __shfl_xor(v, 8);
  return v;
}

template <int ROWS>
DEV void g2r(const bfu* g, int ld, u32x4 (&r)[ROWS / 32], int tid_ = threadIdx.x) {
#pragma unroll
  for (int i = 0; i < ROWS / 32; i++) {
    int id = tid_ + i * 256; int row = id >> 3, ch = id & 7;
    const unsigned off = (unsigned)(row * ld + ch * 8);
    r[i] = *(const u32x4*)(g + off);
  }
}
template <int ROWS>
DEV void r2s(bfu* s, const u32x4 (&r)[ROWS / 32], int tid_ = threadIdx.x) {
#pragma unroll
  for (int i = 0; i < ROWS / 32; i++) {
    int id = tid_ + i * 256; int row = id >> 3, ch = id & 7;
    *(u32x4*)(s + row * 72 + ch * 8) = r[i];
  }
}
template <int MI, int NI>
DEV void mma64(const bfu* sA, int sldA, const bfu* sB, int sldB, f32x4 (&acc)[MI][NI]) {
  const int lane = threadIdx.x & 63, w = threadIdx.x >> 6, wr = w >> 1, wc = w & 1, l16 = lane & 15, quad = lane >> 4;
#pragma unroll
  for (int kk = 0; kk < 2; kk++) {
    bf16x8 a[MI], b[NI];
#pragma unroll
    for (int mi = 0; mi < MI; mi++) a[mi] = *(const bf16x8*)(sA + (wr * MI * 16 + mi * 16 + l16) * sldA + kk * 32 + quad * 8);
#pragma unroll
    for (int ni = 0; ni < NI; ni++) b[ni] = *(const bf16x8*)(sB + (wc * NI * 16 + ni * 16 + l16) * sldB + kk * 32 + quad * 8);
#pragma unroll
    for (int mi = 0; mi < MI; mi++)
#pragma unroll
      for (int ni = 0; ni < NI; ni++) acc[mi][ni] = __builtin_amdgcn_mfma_f32_16x16x32_bf16(a[mi], b[ni], acc[mi][ni], 0, 0, 0);
  }
}
template <int ROWS>
DEV void r2sw(bfu* s, const u32x4 (&r)[ROWS / 32], int tid_) {
#pragma unroll
  for (int i = 0; i < ROWS / 32; i++) {
    int id = tid_ + i * 256; int row = id >> 3, ch = id & 7;
    int byte = (((row >> 4) * 2 + (ch >> 2)) << 10) + ((((row & 15) << 6) + ((ch & 3) << 4)) ^ (((row >> 3) & 1) << 5));
    *(u32x4*)((char*)s + byte) = r[i];
  }
}
template <int MI, int NI>
DEV void mma64w(const bfu* sA, const bfu* sB, f32x4 (&acc)[MI][NI]) {
  const int lane = threadIdx.x & 63, w = threadIdx.x >> 6, wr = w >> 1, wc = w & 1, l16 = lane & 15, quad = lane >> 4;
  const int lo = ((l16 << 6) + (quad << 4)) ^ (((l16 >> 3) & 1) << 5);
#pragma unroll
  for (int kk = 0; kk < 2; kk++) {
    bf16x8 a[MI], b[NI];
#pragma unroll
    for (int mi = 0; mi < MI; mi++) a[mi] = *(const bf16x8*)((const char*)sA + (((wr * MI + mi) * 2 + kk) << 10) + lo);
#pragma unroll
    for (int ni = 0; ni < NI; ni++) b[ni] = *(const bf16x8*)((const char*)sB + (((wc * NI + ni) * 2 + kk) << 10) + lo);
#pragma unroll
    for (int mi = 0; mi < MI; mi++)
#pragma unroll
      for (int ni = 0; ni < NI; ni++) acc[mi][ni] = __builtin_amdgcn_mfma_f32_16x16x32_bf16(a[mi], b[ni], acc[mi][ni], 0, 0, 0);
  }
}
template <int MI, int NI>
DEV void mma64w_big(const bfu* sA, const bfu* sB, f32x4 (&acc)[MI][NI]) {
  const int lane = threadIdx.x & 63, w = threadIdx.x >> 6, wr = w >> 1, wc = w & 1, l16 = lane & 15, quad = lane >> 4;
  const int lo = ((l16 << 6) + (quad << 4)) ^ (((l16 >> 3) & 1) << 5);
#pragma unroll
  for (int kk = 0; kk < 2; kk++) {
    bf16x8 b[NI];
#pragma unroll
    for (int ni = 0; ni < NI; ni++) b[ni] = *(const bf16x8*)((const char*)sB + (((wc * NI + ni) * 2 + kk) << 10) + lo);
#pragma unroll
    for (int mi = 0; mi < MI; mi++) {
      bf16x8 a = *(const bf16x8*)((const char*)sA + (((wr * MI + mi) * 2 + kk) << 10) + lo);
#pragma unroll
      for (int ni = 0; ni < NI; ni++) acc[mi][ni] = __builtin_amdgcn_mfma_f32_16x16x32_bf16(a, b[ni], acc[mi][ni], 0, 0, 0);
    }
  }
}
template <int MI, int NI>
DEV void gemm_loop_sb(const bfu* A, int lda, const bfu* B, int ldb, int K, f32x4 (&acc)[MI][NI], bfu* sbuf) {
  constexpr int BM = 32 * MI, BN = 32 * NI;
  bfu* sA = sbuf; bfu* sB = sA + BM * 64;
  const int nk = K >> 6;
  int t_ = threadIdx.x; asm volatile("" : "+v"(t_));
  u32x4 ra[BM / 32], rb[BN / 32];
  g2r<BM>(A, lda, ra, t_); g2r<BN>(B, ldb, rb, t_);
#pragma unroll 1
  for (int k = 0; k < nk; k++) {
    __syncthreads();
    r2sw<BM>(sA, ra, t_); r2sw<BN>(sB, rb, t_);
    __syncthreads();
    if (k + 1 < nk) { g2r<BM>(A + (k + 1) * 64, lda, ra, t_); g2r<BN>(B + (k + 1) * 64, ldb, rb, t_); }
    mma64w_big<MI, NI>(sA, sB, acc);
  }
}

template <int MI, int NI>
DEV void gemm_loop(const bfu* A, int lda, const bfu* B, int ldb, int K, f32x4 (&acc)[MI][NI], bfu* sbuf) {
  constexpr int BM = 32 * MI, BN = 32 * NI;
  bfu* sA0 = sbuf; bfu* sB0 = sA0 + BM * 64; bfu* sA1 = sB0 + BN * 64; bfu* sB1 = sA1 + BM * 64;
  const int nk = K >> 6;
  int t_ = threadIdx.x; asm volatile("" : "+v"(t_));
  u32x4 ra0[BM / 32], rb0[BN / 32], ra1[BM / 32], rb1[BN / 32];
  g2r<BM>(A, lda, ra0, t_); g2r<BN>(B, ldb, rb0, t_);
  if (nk > 1) { g2r<BM>(A + 64, lda, ra1, t_); g2r<BN>(B + 64, ldb, rb1, t_); }
  __syncthreads();
  r2sw<BM>(sA0, ra0, t_); r2sw<BN>(sB0, rb0, t_);
  if (nk > 2) { g2r<BM>(A + 128, lda, ra0, t_); g2r<BN>(B + 128, ldb, rb0, t_); }
  __syncthreads();
  for (int k = 0; k < nk; k += 2) {
    if (k + 1 < nk) { r2sw<BM>(sA1, ra1, t_); r2sw<BN>(sB1, rb1, t_); }
    if (k + 3 < nk) { g2r<BM>(A + (k + 3) * 64, lda, ra1, t_); g2r<BN>(B + (k + 3) * 64, ldb, rb1, t_); }
    mma64w<MI, NI>(sA0, sB0, acc);
    __syncthreads();
    if (k + 1 >= nk) break;
    if (k + 2 < nk) { r2sw<BM>(sA0, ra0, t_); r2sw<BN>(sB0, rb0, t_); }
    if (k + 4 < nk) { g2r<BM>(A + (k + 4) * 64, lda, ra0, t_); g2r<BN>(B + (k + 4) * 64, ldb, rb0, t_); }
    mma64w<MI, NI>(sA1, sB1, acc);
    __syncthreads();
  }
}

constexpr int EPI_OFF = 49152, EPI_WAVE = 16 * 68;
DEV void to_rows(const f32x4 (&v)[4], float (&r)[16], float* sw, int lane) {
  const int l16 = lane & 15, quad = lane >> 4;
  __builtin_amdgcn_wave_barrier();
#pragma unroll
  for (int ni = 0; ni < 4; ni++)
#pragma unroll
    for (int j = 0; j < 4; j++) sw[(quad * 4 + j) * 68 + ni * 16 + l16] = v[ni][j];
  __builtin_amdgcn_wave_barrier();
  const f32x4* rp = (const f32x4*)(sw + (lane >> 2) * 68 + (lane & 3) * 16);
#pragma unroll
  for (int c = 0; c < 4; c++) { f32x4 t = rp[c]; r[4 * c] = t[0]; r[4 * c + 1] = t[1]; r[4 * c + 2] = t[2]; r[4 * c + 3] = t[3]; }
}
DEV void st_bf16x16(bfu* dst, const float (&r)[16]) {
  u32x4 a = {pack2(r[0], r[1]), pack2(r[2], r[3]), pack2(r[4], r[5]), pack2(r[6], r[7])};
  u32x4 b = {pack2(r[8], r[9]), pack2(r[10], r[11]), pack2(r[12], r[13]), pack2(r[14], r[15])};
  *(u32x4*)dst = a; *(u32x4*)(dst + 8) = b;
}
DEV void ld_bf16x16(const bfu* src, float (&r)[16]) {
  u32x4 a = *(const u32x4*)src, b = *(const u32x4*)(src + 8);
#pragma unroll
  for (int i = 0; i < 4; i++) { r[2 * i] = bflo(a[i]); r[2 * i + 1] = bfhi(a[i]); r[8 + 2 * i] = bflo(b[i]); r[9 + 2 * i] = bfhi(b[i]); }
}
DEV void st_f32x16(float* dst, const float (&r)[16]) {
#pragma unroll
  for (int c = 0; c < 4; c++) *(f32x4*)(dst + 4 * c) = f32x4{r[4 * c], r[4 * c + 1], r[4 * c + 2], r[4 * c + 3]};
}

DEV void transpose_tile(const float* src, int ldsrc, int srccol0, int validcols, const float* scale,
                        bfu* dst, int lddst, int n0, int k0, float* sT) {
  const int tid = threadIdx.x;
  __syncthreads();
#pragma unroll
  for (int i = 0; i < 4; i++) {
    int kk = (tid >> 4) + i * 16, c = (tid & 15) * 4;
    float4 v = make_float4(0.f, 0.f, 0.f, 0.f);
    if (c < validcols) v = *(const float4*)(src + (size_t)(k0 + kk) * ldsrc + srccol0 + c);
    float s = scale ? scale[k0 + kk] : 1.f;
    sT[kk * 65 + c] = v.x * s; sT[kk * 65 + c + 1] = v.y * s; sT[kk * 65 + c + 2] = v.z * s; sT[kk * 65 + c + 3] = v.w * s;
  }
  __syncthreads();
  int n = tid >> 2, kc = (tid & 3) * 16;
  unsigned o[8];
#pragma unroll
  for (int e = 0; e < 8; e++) o[e] = pack2(sT[(kc + 2 * e) * 65 + n], sT[(kc + 2 * e + 1) * 65 + n]);
  uint4* d = (uint4*)(dst + (size_t)(n0 + n) * lddst + k0 + kc);
  d[0] = make_uint4(o[0], o[1], o[2], o[3]); d[1] = make_uint4(o[4], o[5], o[6], o[7]);
}

DEV void phase0(const Params& p, int bid, int nb, char* smem) {
  const int tid = threadIdx.x, lane = tid & 63, w = tid >> 6;
  constexpr int N_X = TT / 4, N_TW = 106 * 16, N_TR = 256, N_TF = 128, N_TO = 256, N_MT = 512;
  constexpr int B1 = N_X, B2 = B1 + N_TW, B3 = B2 + N_TR, B4 = B3 + N_TF, B5 = B4 + N_TO, TOT = B5 + N_MT;
  bfu* xb = (bfu*)(p.ws + OFF_XB); float* rstd1 = (float*)(p.ws + OFF_RSTD1);
  for (int it = bid; it < TOT; it += nb) {
    if (it < B1) {
      int row = it * 4 + w;
      const float* src = row < TP ? p.x_p + (size_t)row * DM : p.x_s + (size_t)(row - TP) * DM;
      float4 a0 = *(const float4*)(src + lane * 8), a1 = *(const float4*)(src + lane * 8 + 4);
      float4 b0 = *(const float4*)(src + 512 + lane * 8), b1 = *(const float4*)(src + 512 + lane * 8 + 4);
      float ss = a0.x * a0.x + a0.y * a0.y + a0.z * a0.z + a0.w * a0.w + a1.x * a1.x + a1.y * a1.y + a1.z * a1.z + a1.w * a1.w +
                 b0.x * b0.x + b0.y * b0.y + b0.z * b0.z + b0.w * b0.w + b1.x * b1.x + b1.y * b1.y + b1.z * b1.z + b1.w * b1.w;
      ss = wave_sum(ss);
      if (lane == 0) rstd1[row] = rsqrtf(ss * (1.f / DM) + EPSN);
      *(uint4*)(xb + (size_t)row * DM + lane * 8) = make_uint4(pack2(a0.x, a0.y), pack2(a0.z, a0.w), pack2(a1.x, a1.y), pack2(a1.z, a1.w));
      *(uint4*)(xb + (size_t)row * DM + 512 + lane * 8) = make_uint4(pack2(b0.x, b0.y), pack2(b0.z, b0.w), pack2(b1.x, b1.y), pack2(b1.z, b1.w));
    } else if (it < B2) {
      int j = it - B1; int nt = j >> 4, kt = j & 15; int n0 = nt * 64;
      int sc0, vc;
      if (n0 < 4608) { sc0 = n0; vc = 64; } else if (n0 < 6656) { sc0 = n0 + 8; vc = 64; } else if (n0 == 6656) { sc0 = 4608; vc = 8; } else { sc0 = 0; vc = 0; }
      transpose_tile(p.w_in, 6664, sc0, vc, p.norm1_g, (bfu*)(p.ws + OFF_WINT), DM, n0, kt * 64, (float*)smem);
    } else if (it < B3) {
      int j = it - B2; transpose_tile(p.w_ret_out, 1024, (j >> 4) * 64, 64, nullptr, (bfu*)(p.ws + OFF_WRT), 1024, (j >> 4) * 64, (j & 15) * 64, (float*)smem);
    } else if (it < B4) {
      int j = it - B3; transpose_tile(p.w_fox_out, 1024, (j >> 3) * 64, 64, nullptr, (bfu*)(p.ws + OFF_WFT), 512, (j >> 3) * 64, (j & 7) * 64, (float*)smem);
    } else if (it < B5) {
      int j = it - B4; transpose_tile(p.w_o, 1024, (j >> 4) * 64, 64, nullptr, (bfu*)(p.ws + OFF_WOT), 1024, (j >> 4) * 64, (j & 15) * 64, (float*)smem);
    } else {
      int j = it - B5; int hh = j >> 5, kt = (j >> 4) & 1, dt = j & 15;
      float* sW = (float*)smem; float* sK = sW + 64 * 129;
      const float* ksub = (hh & 1) ? p.k2 : p.k1;
      __syncthreads();
#pragma unroll
      for (int i = 0; i < 8; i++) {
        int id = tid + i * 256; int row = id >> 5, c4 = (id & 31) * 4;
        float4 v = *(const float4*)(p.peer_wq + (size_t)(dt * 64 + row) * 2048 + hh * 128 + c4);
        sW[row * 129 + c4] = v.x; sW[row * 129 + c4 + 1] = v.y; sW[row * 129 + c4 + 2] = v.z; sW[row * 129 + c4 + 3] = v.w;
        float4 u = *(const float4*)(ksub + (size_t)(kt * 64 + row) * 128 + c4);
        sK[row * 129 + c4] = u.x; sK[row * 129 + c4 + 1] = u.y; sK[row * 129 + c4 + 2] = u.z; sK[row * 129 + c4 + 3] = u.w;
      }
      __syncthreads();
      int ky = (tid >> 4) * 4, dd = (tid & 15) * 4;
      float a[4][4];
#pragma unroll
      for (int i = 0; i < 4; i++)
#pragma unroll
        for (int jj = 0; jj < 4; jj++) a[i][jj] = 0.f;
      for (int c = 0; c < 128; c++) {
        float kv[4], wv[4];
#pragma unroll
        for (int i = 0; i < 4; i++) { kv[i] = sK[(ky + i) * 129 + c]; wv[i] = sW[(dd + i) * 129 + c]; }
#pragma unroll
        for (int i = 0; i < 4; i++)
#pragma unroll
          for (int jj = 0; jj < 4; jj++) a[i][jj] += kv[i] * wv[jj];
      }
      bfu* MT = (bfu*)(p.ws + OFF_MT);
      float g0 = p.norm2_g[dt * 64 + dd], g1 = p.norm2_g[dt * 64 + dd + 1], g2 = p.norm2_g[dt * 64 + dd + 2], g3 = p.norm2_g[dt * 64 + dd + 3];
#pragma unroll
      for (int i = 0; i < 4; i++)
        *(uint2*)(MT + (size_t)(hh * 128 + kt * 64 + ky + i) * DM + dt * 64 + dd) = make_uint2(pack2(a[i][0] * g0, a[i][1] * g1), pack2(a[i][2] * g2, a[i][3] * g3));
    }
  }
}

DEV void rot_angle(int pos, int d, float& cs, float& sn) {
  float inv = exp2f(-(float)d * (13.287712379549449f / 32.f));
  float ang = (float)pos * inv;
  float rev = ang * 0.15915494309189535f;
  rev = rev - floorf(rev);
  sn = __builtin_amdgcn_sinf(rev); cs = __builtin_amdgcn_cosf(rev);
}

DEV void phase1(const Params& p, int bid, int nb, char* smem, bool noepi = false) {
  bfu* sA = (bfu*)smem; bfu* sB = sA + 128 * 72;
  const bfu* XB = (const bfu*)(p.ws + OFF_XB); const bfu* WT = (const bfu*)(p.ws + OFF_WINT);
  const float* rstd1 = (const float*)(p.ws + OFF_RSTD1);
  constexpr int NT = NWP / 128;
  const int xcd = bid & 7, slot = bid >> 3, nslots = (nb + 7 - xcd) >> 3;
  constexpr int MI1 = 8;
  const int nprompt = 16 * NT;
  const int n_p = slot < nprompt ? (nprompt - slot + nslots - 1) / nslots : 0;
  const int n_s = bid < 2 * NT ? (2 * NT - bid + nb - 1) / nb : 0;
  for (int i_ = 0; i_ < n_p + n_s; i_++) {
    int mt, nt;
    if (i_ < n_p) { int q = slot + i_ * nslots; int sub = q / (8 * NT), rem = q - sub * (8 * NT); nt = rem >> 3; mt = xcd * 16 + sub * 8 + (rem & 7); }
    else { int it = bid + (i_ - n_p) * nb; mt = 128 + it / NT; nt = it - (it / NT) * NT; }
    int m0 = mt * 256, n0 = nt * 128;
    int tid = threadIdx.x; asm volatile("" : "+v"(tid));
    const int lane = tid & 63, w = tid >> 6, wr = w >> 1, wc = w & 1, l16 = lane & 15, quad = lane >> 4;
    f32x4 acc[MI1][4];
#pragma unroll
    for (int i = 0; i < MI1; i++)
#pragma unroll
      for (int j = 0; j < 4; j++) acc[i][j] = f32x4{0.f, 0.f, 0.f, 0.f};
    gemm_loop_sb<MI1, 4>(XB + (size_t)m0 * DM, DM, WT + (size_t)n0 * DM, DM, DM, acc, sA);
    if (noepi) { float t_ = 0.f;
#pragma unroll
      for (int i = 0; i < MI1; i++)
#pragma unroll
        for (int j = 0; j < 4; j++) t_ += acc[i][j][0] + acc[i][j][1] + acc[i][j][2] + acc[i][j][3];
      if (t_ == 12345.678f) p.out[0] = 1.f; continue; }
    const int rbase = m0 + wr * (MI1 * 16) + quad * 4;
    const int cbase = n0 + wc * 64 + l16;
    if (m0 >= TP) {
      float* hs = (float*)(p.ws + OFF_HS);
      bfu* gaS = (bfu*)(p.out + O_YS); bfu* gbS = gaS + (size_t)TS * DM;
#pragma unroll
      for (int mi = 0; mi < MI1; mi++)
#pragma unroll
        for (int j = 0; j < 4; j++) {
          int row = rbase + mi * 16 + j; float rs = rstd1[row]; int sr = row - TP;
#pragma unroll
          for (int ni = 0; ni < 4; ni++) {
            int col = cbase + ni * 16; float v = acc[mi][ni][j] * rs;
            if (n0 >= 4608 && n0 < 5632) gaS[(size_t)sr * DM + col - 4608] = f2bf(v);
            else if (n0 >= 5632 && n0 < 6656) gbS[(size_t)sr * DM + col - 5632] = f2bf(v);
            else hs[(size_t)sr * NWP + col] = v;
          }
        }
      continue;
    }
    const int b = m0 >> 14;
    float* sw = (float*)(smem + EPI_OFF) + w * EPI_WAVE;
    const int rrow = m0 + wr * (MI1 * 16) + (lane >> 2);
    const int rcol = (lane & 3) * 16;
    if (n0 < 1024) {
      const int isK = n0 >= 512; const int head = ((n0 & 511) >> 6) + wc;
      const float l2g = l2gamma(head);
      bfu* dst = (bfu*)(p.ws + (isK ? OFF_KT : OFF_QT));
      bfu* ktT = (bfu*)(p.ws + OFF_KTT);
#pragma unroll
      for (int mi = 0; mi < MI1; mi++) {
        f32x4 tv[4];
#pragma unroll
        for (int ni = 0; ni < 2; ni++) {
          int d = ni * 16 + l16;
          float y1[4], y2[4];
#pragma unroll
          for (int j = 0; j < 4; j++) {
            int row = rbase + mi * 16 + j; int t = row & (SEQ - 1); int l = t & (RC - 1);
            float rs = rstd1[row];
            float dec = exp2f((float)(l + 1) * l2g);
            float sc = isK ? 0.125f / dec : dec;
            float cs, sn; rot_angle(t, d, cs, sn);
            float x1 = acc[mi][ni][j] * rs, x2 = acc[mi][ni + 2][j] * rs;
            y1[j] = (x1 * cs - x2 * sn) * sc; y2[j] = (x2 * cs + x1 * sn) * sc;
            tv[ni][j] = y1[j]; tv[ni + 2][j] = y2[j];
          }
          if (isK) {
            int t0 = (rbase + mi * 16) & (SEQ - 1);
            *(uint2*)(ktT + ((size_t)((b * 8 + head) * 64 + d)) * SEQ + t0) = make_uint2(pack2(y1[0], y1[1]), pack2(y1[2], y1[3]));
            *(uint2*)(ktT + ((size_t)((b * 8 + head) * 64 + d + 32)) * SEQ + t0) = make_uint2(pack2(y2[0], y2[1]), pack2(y2[2], y2[3]));
          }
        }
        { float r[16]; to_rows(tv, r, sw, lane); int rr_ = rrow; asm volatile("" : "+v"(rr_));
          st_bf16x16(dst + (size_t)(rr_ + mi * 16) * 512 + head * 64 + rcol, r); }
      }
    } else if (n0 < 2048) {
      const int head = (n0 - 1024) >> 7;
      bfu* vT = (bfu*)(p.ws + OFF_VT);
#pragma unroll
      for (int mi = 0; mi < MI1; mi++) {
        int row0 = rbase + mi * 16; int t0 = row0 & (SEQ - 1);
        float r0 = rstd1[row0], r1 = rstd1[row0 + 1], r2 = rstd1[row0 + 2], r3 = rstd1[row0 + 3];
#pragma unroll
        for (int ni = 0; ni < 4; ni++) {
          int dv = wc * 64 + ni * 16 + l16;
          *(uint2*)(vT + ((size_t)((b * 8 + head) * 128 + dv)) * SEQ + t0) =
              make_uint2(pack2(acc[mi][ni][0] * r0, acc[mi][ni][1] * r1), pack2(acc[mi][ni][2] * r2, acc[mi][ni][3] * r3));
        }
      }
    } else if (n0 < 3072 || (n0 >= 4608 && n0 < 6656)) {
      bfu* dst; int c0;
      if (n0 < 3072) { dst = (bfu*)(p.ws + OFF_RG); c0 = 2048; }
      else if (n0 < 5632) { dst = (bfu*)(p.out + O_YP); c0 = 4608; }
      else { dst = (bfu*)(p.out + O_YP) + (size_t)TP * DM; c0 = 5632; }
#pragma unroll
      for (int mi = 0; mi < MI1; mi++) {
        f32x4 tv[4];
#pragma unroll
        for (int j = 0; j < 4; j++) {
          int row = rbase + mi * 16 + j; float rs = rstd1[row];
#pragma unroll
          for (int ni = 0; ni < 4; ni++) tv[ni][j] = acc[mi][ni][j] * rs;
        }
        float r[16]; to_rows(tv, r, sw, lane); int rr_ = rrow; asm volatile("" : "+v"(rr_));
        st_bf16x16(dst + (size_t)(rr_ + mi * 16) * DM + (n0 - c0) + wc * 64 + rcol, r);
      }
    } else if (n0 < 4096) {
      const int isK = n0 >= 3584; const int head = (((n0 - 3072) & 511) >> 6) + wc;
      const float* g = isK ? p.fk_g : p.fq_g;
      float gv[4];
#pragma unroll
      for (int ni = 0; ni < 4; ni++) gv[ni] = g[ni * 16 + l16];
      bfu* fq = (bfu*)(p.ws + OFF_FQ); bfu* fkb = (bfu*)(p.ws + OFF_FKB);
#pragma unroll
      for (int mi = 0; mi < MI1; mi++) {
        f32x4 tv[4];
#pragma unroll
        for (int j = 0; j < 4; j++) {
          int row = rbase + mi * 16 + j; float rs = rstd1[row];
          float v[4]; float ss = 0.f;
#pragma unroll
          for (int ni = 0; ni < 4; ni++) { v[ni] = acc[mi][ni][j] * rs; ss += v[ni] * v[ni]; }
          ss = sum16(ss);
          float r = rsqrtf(ss * (1.f / 64.f) + EPSN) * (isK ? 1.f : 0.125f * LOG2E);
#pragma unroll
          for (int ni = 0; ni < 4; ni++) tv[ni][j] = v[ni] * r * gv[ni];
        }
        float r[16]; to_rows(tv, r, sw, lane); int rr_ = rrow; asm volatile("" : "+v"(rr_));
        const size_t o = (size_t)(rr_ + mi * 16) * 512 + head * 64 + rcol;
        if (isK) { st_f32x16(p.out + O_FKP + o, r); st_bf16x16(fkb + o, r); }
        else st_bf16x16(fq + o, r);
      }
    } else if (n0 < 4608) {
      const int head = ((n0 - 4096) >> 6) + wc;
      bfu* fvT = (bfu*)(p.ws + OFF_FVT);
#pragma unroll
      for (int mi = 0; mi < MI1; mi++) {
        int row0 = rbase + mi * 16; int t0 = row0 & (SEQ - 1);
        float r[4] = {rstd1[row0], rstd1[row0 + 1], rstd1[row0 + 2], rstd1[row0 + 3]};
        f32x4 tv[4];
#pragma unroll
        for (int ni = 0; ni < 4; ni++) {
          int d = ni * 16 + l16; float v[4];
#pragma unroll
          for (int j = 0; j < 4; j++) { v[j] = acc[mi][ni][j] * r[j]; tv[ni][j] = v[j]; }
          *(uint2*)(fvT + ((size_t)((b * 8 + head) * 64 + d)) * SEQ + t0) = make_uint2(pack2(v[0], v[1]), pack2(v[2], v[3]));
        }
        { float rw[16]; to_rows(tv, rw, sw, lane); int rr_ = rrow; asm volatile("" : "+v"(rr_));
          st_f32x16(p.out + O_FVP + (size_t)(rr_ + mi * 16) * 512 + head * 64 + rcol, rw); }
      }
    } else {
      if (wc == 0 && l16 < 8) {
        float bf = p.b_f[l16];
#pragma unroll
        for (int mi = 0; mi < MI1; mi++)
#pragma unroll
          for (int j = 0; j < 4; j++) {
            int row = rbase + mi * 16 + j;
            float z = acc[mi][0][j] * rstd1[row] + bf;
            p.out[O_LFP + (size_t)row * 8 + l16] = fminf(z, 0.f) - log1pf(__expf(-fabsf(z)));
          }
      }
    }
  }
}

DEV void phase2(const Params& p, int bid, int nb, char* smem) {
  const int tid = threadIdx.x, lane = tid & 63, w = tid >> 6, wr = w >> 1, wc = w & 1, l16 = lane & 15, quad = lane >> 4;
  bfu* sA = (bfu*)smem; bfu* sB = sA + 128 * 72;
  const bfu* vT = (const bfu*)(p.ws + OFF_VT); const bfu* ktT = (const bfu*)(p.ws + OFF_KTT);
  float* U = (float*)(p.ws + OFF_XB);
  constexpr int NR1 = 16 * NCH;
  for (int it = bid; it < NR1 + 16; it += nb) {
    if (it < 16) {
      int bh = it, b = bh >> 3, h = bh & 7;
      double* sd = (double*)smem;
      const float* lf = p.out + O_LFP + (size_t)b * SEQ * 8 + h;
      float part = 0.f;
      for (int i = 0; i < 64; i++) part += lf[(size_t)(tid * 64 + i) * 8];
      __syncthreads();
      sd[tid] = (double)part;
      __syncthreads();
      if (tid == 0) { double run = 0.0; for (int i = 0; i < 256; i++) { double v = sd[i]; sd[i] = run; run += v; } }
      __syncthreads();
      double run = sd[tid];
      float* c2 = (float*)(p.ws + OFF_C2) + (size_t)bh * SEQ;
      for (int i = 0; i < 64; i++) { run += (double)lf[(size_t)(tid * 64 + i) * 8]; c2[tid * 64 + i] = (float)(run * (double)LOG2E); }
      __syncthreads();
    } else {
      int j = it - 16; int bh = j / NCH, c = j - bh * NCH;
      f32x4 acc[4][2];
#pragma unroll
      for (int i = 0; i < 4; i++) { acc[i][0] = f32x4{0.f, 0.f, 0.f, 0.f}; acc[i][1] = f32x4{0.f, 0.f, 0.f, 0.f}; }
      gemm_loop<4, 2>(vT + (size_t)bh * 128 * SEQ + c * RC, SEQ, ktT + (size_t)bh * 64 * SEQ + c * RC, SEQ, RC, acc, sA);
      float gC = exp2f((float)RC * l2gamma(bh & 7));
      float* Uo = U + (size_t)j * 8192;
#pragma unroll
      for (int mi = 0; mi < 4; mi++)
#pragma unroll
        for (int ni = 0; ni < 2; ni++)
#pragma unroll
          for (int jj = 0; jj < 4; jj++) {
            int dv = wr * 64 + mi * 16 + quad * 4 + jj, dk = wc * 32 + ni * 16 + l16;
            Uo[dv * 64 + dk] = acc[mi][ni][jj] * gC;
          }
    }
  }
}

DEV void sample_item(const Params& p, int item, char* smem) {
  int tid = threadIdx.x; asm volatile("" : "+v"(tid));
  const int b = item >> 3, h = item & 7;
  float* sq = (float*)smem;
  float* sk = sq + 1024;
  float* sv = sk + 1024;
  float* sP = sv + 2048;
  float* so = sP + 256;
  float* sr = so + 2048;
  float* sc = (float*)smem;
  float* fq = (float*)(smem + 34816);
  float* fk = fq + 1024;
  float* cn = fk + 1024;
  float* suf = cn + 16;
  float* red = suf + 1024;
  float* sL = red + 256;
  float* pvr = sL + 16;
  const float* hs = (const float*)(p.ws + OFF_HS) + (size_t)b * 16 * NWP;
  const float l2g = l2gamma(h);
  __syncthreads();
  for (int i = tid; i < 512; i += 256) {
    int l = i >> 5, d = i & 31; float cs, sn; rot_angle(1024 + l, d, cs, sn);
    float dec = exp2f((float)(l + 1) * l2g);
    const float* r = hs + (size_t)l * NWP;
    float x1 = r[h * 64 + d], x2 = r[h * 64 + d + 32];
    sq[l * 64 + d] = (x1 * cs - x2 * sn) * dec; sq[l * 64 + d + 32] = (x2 * cs + x1 * sn) * dec;
    x1 = r[512 + h * 64 + d]; x2 = r[512 + h * 64 + d + 32];
    float sc_ = 0.125f / dec;
    sk[l * 64 + d] = (x1 * cs - x2 * sn) * sc_; sk[l * 64 + d + 32] = (x2 * cs + x1 * sn) * sc_;
  }
  for (int i = tid; i < 2048; i += 256) { int l = i >> 7, dv = i & 127; sv[i] = hs[(size_t)l * NWP + 1024 + h * 128 + dv]; }
  __syncthreads();
  { int l = tid >> 4, m = tid & 15; float a = 0.f;
    if (l >= m) for (int d = 0; d < 64; d++) a += sq[l * 64 + d] * sk[m * 64 + d];
    sP[tid] = a; }
  __syncthreads();
  const float* S = p.state_ret + (size_t)(b * 8 + h) * 8192;
  { int dv = tid & 127, lh = tid >> 7; float o[8];
#pragma unroll
    for (int i = 0; i < 8; i++) o[i] = 0.f;
#pragma unroll 16
    for (int dk = 0; dk < 64; dk++) { float s = S[dk * 128 + dv];
#pragma unroll
      for (int i = 0; i < 8; i++) o[i] += sq[(lh * 8 + i) * 64 + dk] * s; }
    for (int m = 0; m < 16; m++) { float v = sv[m * 128 + dv];
#pragma unroll
      for (int i = 0; i < 8; i++) o[i] += sP[(lh * 8 + i) * 16 + m] * v; }
#pragma unroll
    for (int i = 0; i < 8; i++) so[(lh * 8 + i) * 128 + dv] = o[i];
    float g16 = exp2f(16.f * l2g);
    float* So = p.out + O_SS + (size_t)(b * 8 + h) * 8192;
#pragma unroll 8
    for (int i = 0; i < 32; i++) { int dk = lh * 32 + i; float a = S[dk * 128 + dv];
      for (int m = 0; m < 16; m++) a += sk[m * 64 + dk] * sv[m * 128 + dv];
      So[dk * 128 + dv] = a * g16; }
  }
  __syncthreads();
  if (tid < 16) { float ss = 0.f; for (int i = 0; i < 128; i++) { float v = so[tid * 128 + i]; ss += v * v; } sr[tid] = rsqrtf(ss * (1.f / 128.f) + EPSN); }
  __syncthreads();
  { int dv = tid & 127, lh = tid >> 7; bfu* gated = (bfu*)(p.ws + OFF_RG);
    float gg = p.gn_g[h * 128 + dv];
    for (int i = 0; i < 8; i++) { int l = lh * 8 + i; float rgv = hs[(size_t)l * NWP + 2048 + h * 128 + dv];
      float v = so[l * 128 + dv] * sr[l] * gg * (rgv * sigmoidf_(rgv));
      gated[(size_t)(TP + b * 16 + l) * DM + h * 128 + dv] = f2bf(v); } }
  {
    int l = tid >> 4, dl = tid & 15; const float* r = hs + (size_t)l * NWP;
    float qv[4], kv[4]; float sq_ = 0.f, sk_ = 0.f;
#pragma unroll
    for (int i = 0; i < 4; i++) { qv[i] = r[3072 + h * 64 + dl * 4 + i]; kv[i] = r[3584 + h * 64 + dl * 4 + i]; sq_ += qv[i] * qv[i]; sk_ += kv[i] * kv[i]; }
    sq_ = sum16(sq_); sk_ = sum16(sk_);
    float rq = rsqrtf(sq_ * (1.f / 64.f) + EPSN), rk = rsqrtf(sk_ * (1.f / 64.f) + EPSN);
#pragma unroll
    for (int i = 0; i < 4; i++) { int d = dl * 4 + i;
      fq[l * 64 + d] = qv[i] * rq * p.fq_g[d] * 0.125f;
      float kk = kv[i] * rk * p.fk_g[d]; fk[l * 64 + d] = kk;
      p.out[O_FKS + (size_t)((b * 16 + l) * 8 + h) * 64 + d] = kk;
      p.out[O_FVS + (size_t)((b * 16 + l) * 8 + h) * 64 + d] = r[4096 + h * 64 + d]; }
  }
  if (tid < 16) { float z = hs[(size_t)tid * NWP + 6656 + h] + p.b_f[h]; float lf = fminf(z, 0.f) - log1pf(__expf(-fabsf(z)));
    p.out[O_LFS + (size_t)(b * 16 + tid) * 8 + h] = lf; cn[tid] = lf; }
  { const float* cl = p.clogf + (size_t)b * 1024 * 8 + h; float v[4]; float part = 0.f;
#pragma unroll
    for (int i = 0; i < 4; i++) { v[i] = cl[(size_t)(tid * 4 + i) * 8]; part += v[i]; }
    float inc = part;
#pragma unroll
    for (int o = 1; o < 64; o <<= 1) { float t = __shfl_down(inc, o); if ((tid & 63) + o < 64) inc += t; }
    if ((tid & 63) == 0) red[tid >> 6] = inc;
    __syncthreads();
    if (tid == 0) { float c = 0.f; for (int i = 0; i < 16; i++) { c += cn[i]; cn[i] = c; } }
    float later = 0.f;
    for (int ww = (tid >> 6) + 1; ww < 4; ww++) later += red[ww];
    __syncthreads();
    float run = inc - part + later;
    for (int i = 3; i >= 0; i--) { suf[tid * 4 + i] = run; run += v[i]; }
  }
  __syncthreads();
  const float* CK = p.ck + (size_t)b * 1024 * 512 + h * 64; const float* CV = p.cv + (size_t)b * 1024 * 512 + h * 64;
  for (int pass = 0; pass < 2; pass++) {
    __syncthreads();
    for (int j = tid; j < 1040; j += 256) {
      float a[8];
#pragma unroll
      for (int qi = 0; qi < 8; qi++) a[qi] = 0.f;
      if (j < 1024) {
        const f32x4* kp = (const f32x4*)(CK + (size_t)j * 512);
        f32x4 tt[16];
#pragma unroll
        for (int i = 0; i < 16; i++) tt[i] = kp[i];
#pragma unroll
        for (int i = 0; i < 16; i++) { f32x4 t = tt[i];
#pragma unroll
          for (int qi = 0; qi < 8; qi++) { const float* qq = fq + (pass * 8 + qi) * 64 + i * 4; a[qi] += qq[0] * t[0] + qq[1] * t[1] + qq[2] * t[2] + qq[3] * t[3]; } }
      } else {
        const float* kp = fk + (j - 1024) * 64;
#pragma unroll 4
        for (int i = 0; i < 64; i++) { float t = kp[i];
#pragma unroll
          for (int qi = 0; qi < 8; qi++) a[qi] += fq[(pass * 8 + qi) * 64 + i] * t; }
      }
#pragma unroll
      for (int qi = 0; qi < 8; qi++) { int q = pass * 8 + qi;
        float bias;
        if (j < 1024) bias = suf[j] + cn[q]; else { int m = j - 1024; bias = (m <= q) ? (cn[q] - cn[m]) : -INFINITY; }
        sc[qi * 1040 + j] = a[qi] + bias; }
    }
    __syncthreads();
    { int qi = tid >> 5, l32 = tid & 31; float m = -INFINITY;
      for (int j = l32; j < 1040; j += 32) m = fmaxf(m, sc[qi * 1040 + j]);
#pragma unroll
      for (int o = 16; o >= 1; o >>= 1) m = fmaxf(m, __shfl_xor(m, o));
      float s = 0.f;
      for (int j = l32; j < 1040; j += 32) { float e = __expf(sc[qi * 1040 + j] - m); sc[qi * 1040 + j] = e; s += e; }
#pragma unroll
      for (int o = 16; o >= 1; o >>= 1) s += __shfl_xor(s, o);
      if (l32 == 0) sL[qi] = s; }
    __syncthreads();
    {
      const int kg = tid >> 4, d4 = (tid & 15) * 4;
      float ac[8][4];
#pragma unroll
      for (int qi = 0; qi < 8; qi++) { ac[qi][0] = 0.f; ac[qi][1] = 0.f; ac[qi][2] = 0.f; ac[qi][3] = 0.f; }
#pragma unroll 8
      for (int i = 0; i < 64; i++) { int j = kg + 16 * i;
        float4 v = *(const float4*)(CV + (size_t)j * 512 + d4);
#pragma unroll
        for (int qi = 0; qi < 8; qi++) { float pj = sc[qi * 1040 + j]; ac[qi][0] += pj * v.x; ac[qi][1] += pj * v.y; ac[qi][2] += pj * v.z; ac[qi][3] += pj * v.w; } }
      { const float* r = hs + (size_t)kg * NWP + 4096 + h * 64 + d4;
#pragma unroll
        for (int qi = 0; qi < 8; qi++) { float pj = sc[qi * 1040 + 1024 + kg]; ac[qi][0] += pj * r[0]; ac[qi][1] += pj * r[1]; ac[qi][2] += pj * r[2]; ac[qi][3] += pj * r[3]; } }
#pragma unroll
      for (int qi = 0; qi < 8; qi++)
#pragma unroll
        for (int c = 0; c < 4; c++) { float t = ac[qi][c]; t += __shfl_xor(t, 16); t += __shfl_xor(t, 32); ac[qi][c] = t; }
      if ((tid & 63) < 16) {
#pragma unroll
        for (int qi = 0; qi < 8; qi++)
#pragma unroll
          for (int c = 0; c < 4; c++) pvr[((tid >> 6) * 8 + qi) * 64 + d4 + c] = ac[qi][c];
      }
      __syncthreads();
      int qi = tid >> 5, d2 = (tid & 31) * 2;
      float a0 = pvr[(0 * 8 + qi) * 64 + d2] + pvr[(1 * 8 + qi) * 64 + d2] + pvr[(2 * 8 + qi) * 64 + d2] + pvr[(3 * 8 + qi) * 64 + d2];
      float a1 = pvr[(0 * 8 + qi) * 64 + d2 + 1] + pvr[(1 * 8 + qi) * 64 + d2 + 1] + pvr[(2 * 8 + qi) * 64 + d2 + 1] + pvr[(3 * 8 + qi) * 64 + d2 + 1];
      float inv = 1.f / sL[qi]; bfu* fo = (bfu*)(p.ws + OFF_FQ);
      *(unsigned*)(fo + (size_t)(TP + b * 16 + pass * 8 + qi) * 512 + h * 64 + d2) = pack2(a0 * inv, a1 * inv); }
  }
  __syncthreads();
}

DEV void peer_convert_item(const Params& p, int item) {
  const int tid = threadIdx.x, lane = tid & 63, w = tid >> 6;
  constexpr int NG = 0; const int it = item;
    {
      int r = (it - NG) * 4 + w;
      const float* src = r < 16384 ? p.peer_u + (size_t)r * DM : p.peer_v + (size_t)(r - 16384) * DM;
      float4 v0 = *(const float4*)(src + lane * 16), v1 = *(const float4*)(src + lane * 16 + 4), v2 = *(const float4*)(src + lane * 16 + 8), v3 = *(const float4*)(src + lane * 16 + 12);
      float am = fmaxf(fmaxf(fmaxf(fabsf(v0.x), fabsf(v0.y)), fmaxf(fabsf(v0.z), fabsf(v0.w))), fmaxf(fmaxf(fabsf(v1.x), fabsf(v1.y)), fmaxf(fabsf(v1.z), fabsf(v1.w))));
      am = fmaxf(am, fmaxf(fmaxf(fmaxf(fabsf(v2.x), fabsf(v2.y)), fmaxf(fabsf(v2.z), fabsf(v2.w))), fmaxf(fmaxf(fabsf(v3.x), fabsf(v3.y)), fmaxf(fabsf(v3.z), fabsf(v3.w)))));
#pragma unroll
      for (int o = 32; o >= 1; o >>= 1) am = fmaxf(am, __shfl_xor(am, o));
      float sc = am > 0.f ? 6.f / am : 1.f;
      unsigned w0 = 0, w1 = 0;
      w0 = __builtin_amdgcn_cvt_scalef32_pk_fp4_f32(w0, v0.x * sc, v0.y * sc, 1.0f, 0);
      w0 = __builtin_amdgcn_cvt_scalef32_pk_fp4_f32(w0, v0.z * sc, v0.w * sc, 1.0f, 1);
      w0 = __builtin_amdgcn_cvt_scalef32_pk_fp4_f32(w0, v1.x * sc, v1.y * sc, 1.0f, 2);
      w0 = __builtin_amdgcn_cvt_scalef32_pk_fp4_f32(w0, v1.z * sc, v1.w * sc, 1.0f, 3);
      w1 = __builtin_amdgcn_cvt_scalef32_pk_fp4_f32(w1, v2.x * sc, v2.y * sc, 1.0f, 0);
      w1 = __builtin_amdgcn_cvt_scalef32_pk_fp4_f32(w1, v2.z * sc, v2.w * sc, 1.0f, 1);
      w1 = __builtin_amdgcn_cvt_scalef32_pk_fp4_f32(w1, v3.x * sc, v3.y * sc, 1.0f, 2);
      w1 = __builtin_amdgcn_cvt_scalef32_pk_fp4_f32(w1, v3.z * sc, v3.w * sc, 1.0f, 3);
      u32x2* dst = (u32x2*)(p.ws + (r < 16384 ? OFF_PUB : OFF_PVB)) + (size_t)(r & 16383) * 64 + lane;
      *dst = u32x2{w0, w1};
      if (lane == 0) ((float*)(p.ws + OFF_PSC))[r] = am > 0.f ? am / 6.f : 1.f;
    }
}

DEV void phase3(const Params& p, int bid, int nb, char* smem) {
  const int tid = threadIdx.x;
  const float* U = (const float*)(p.ws + OFF_XB); bfu* SST = (bfu*)(p.ws + OFF_SST);
  { const int c0 = nb > 256 ? bid - 256 : bid, cs = nb > 256 ? nb - 256 : nb;
    if (c0 >= 0) for (int it = c0; it < 8192; it += cs) peer_convert_item(p, it); }
  for (int it = bid; it < 256 + 512; it += nb) {
    if (it < 256) { sample_item(p, it, smem); continue; }
    int g = (it - 256) * 256 + tid; int bh = g >> 13, e = g & 8191;
    float G = exp2f((float)RC * l2gamma(bh & 7));
    float s = 0.f;
    const float* Up = U + (size_t)bh * NCH * 8192 + e; bfu* Sp = SST + (size_t)bh * NCH * 8192 + e;
    Sp[0] = 0;
    for (int c0 = 0; c0 < NCH; c0 += 8) {
      float u[8];
#pragma unroll
      for (int i = 0; i < 8; i++) u[i] = Up[(size_t)(c0 + i) * 8192];
#pragma unroll
      for (int i = 0; i < 8; i++) { s = s * G + u[i]; if (c0 + i + 1 < NCH) Sp[(size_t)(c0 + i + 1) * 8192] = f2bf(s); }
    }
    int dv = e >> 6, dk = e & 63;
    p.out[O_SP + (size_t)bh * 8192 + dk * 128 + dv] = s;
  }
}

DEV void attn_item(const Params& p, int item, char* smem, float thr, bool dry) {
  const int tid = threadIdx.x, lane = tid & 63, w = tid >> 6, r32 = lane & 31, hi = lane >> 5;
  const int bh = item >> 7, qt = 127 - (item & 127);
  const int b = bh >> 3, h = bh & 7;
  const int q0 = qt * 128;
  bfu* sK = (bfu*)smem;
  bfu* sV = sK + 64 * 72;
  float* sC = (float*)(sV + 64 * 72);
  const float* c2 = (const float*)(p.ws + OFF_C2) + (size_t)bh * SEQ;
  bfu* FQ = (bfu*)(p.ws + OFF_FQ);
  const bfu* FKB = (const bfu*)(p.ws + OFF_FKB) + (size_t)b * SEQ * 512 + h * 64;
  const bfu* FVT = (const bfu*)(p.ws + OFF_FVT) + (size_t)bh * 64 * SEQ;
  const int jd0 = q0 >> 6;
  int pred = 0;
  if (tid < jd0) pred = (c2[q0] - c2[tid * 64 + 63]) < -thr;
  const int jstart = __syncthreads_count(pred);
  const int qrow = q0 + w * 32 + r32;
  bf16x8 qf[4];
  const bfu* qp = FQ + (size_t)(b * SEQ + qrow) * 512 + h * 64 + hi * 8;
#pragma unroll
  for (int d0 = 0; d0 < 4; d0++) qf[d0] = *(const bf16x8*)(qp + d0 * 16);
  const float cq = c2[qrow];
  float m = -INFINITY, lsum = 0.f;
  f32x16 o0, o1;
#pragma unroll
  for (int r = 0; r < 16; r++) { o0[r] = 0.f; o1[r] = 0.f; }
  u32x4 rk0, rk1, rv0, rv1; float rc = 0.f;
  const int srow = tid >> 3, sch = tid & 7;
#define ATT_GLOAD(j_) do { \
    rk0 = *(const u32x4*)(FKB + (size_t)((j_) * 64 + srow) * 512 + sch * 8); \
    rk1 = *(const u32x4*)(FKB + (size_t)((j_) * 64 + srow + 32) * 512 + sch * 8); \
    rv0 = *(const u32x4*)(FVT + (size_t)srow * SEQ + (j_) * 64 + sch * 8); \
    rv1 = *(const u32x4*)(FVT + (size_t)(srow + 32) * SEQ + (j_) * 64 + sch * 8); \
    if (tid < 64) rc = c2[(j_) * 64 + tid]; } while (0)
  ATT_GLOAD(jstart);
  for (int j = jstart; j <= jd0 + 1; j++) {
    __syncthreads();
    *(u32x4*)(sK + srow * 72 + sch * 8) = rk0; *(u32x4*)(sK + (srow + 32) * 72 + sch * 8) = rk1;
    *(u32x4*)(sV + srow * 72 + sch * 8) = rv0; *(u32x4*)(sV + (srow + 32) * 72 + sch * 8) = rv1;
    if (tid < 64) sC[tid] = rc;
    __syncthreads();
    if (j < jd0 + 1) ATT_GLOAD(j + 1);
    if (j * 64 > q0 + w * 32 + 31) continue;
    f32x16 s0, s1;
#pragma unroll
    for (int r = 0; r < 16; r++) { s0[r] = 0.f; s1[r] = 0.f; }
#pragma unroll
    for (int d0 = 0; d0 < 4; d0++) {
      bf16x8 k0 = *(const bf16x8*)(sK + r32 * 72 + d0 * 16 + hi * 8);
      bf16x8 k1 = *(const bf16x8*)(sK + (32 + r32) * 72 + d0 * 16 + hi * 8);
      s0 = __builtin_amdgcn_mfma_f32_32x32x16_bf16(k0, qf[d0], s0, 0, 0, 0);
      s1 = __builtin_amdgcn_mfma_f32_32x32x16_bf16(k1, qf[d0], s1, 0, 0, 0);
    }
    const bool diag = (j >= jd0);
    const int kbase = j * 64 + 4 * hi;
    float mloc = -INFINITY;
#pragma unroll
    for (int g = 0; g < 4; g++) {
      float4 c0 = *(const float4*)(sC + 8 * g + 4 * hi), c1 = *(const float4*)(sC + 32 + 8 * g + 4 * hi);
      float cc0[4] = {c0.x, c0.y, c0.z, c0.w}, cc1[4] = {c1.x, c1.y, c1.z, c1.w};
#pragma unroll
      for (int e = 0; e < 4; e++) {
        int r = g * 4 + e;
        float a = s0[r] + (cq - cc0[e]), bb = s1[r] + (cq - cc1[e]);
        if (diag) { int key = kbase + 8 * g + e; if (key > qrow) a = -INFINITY; if (key + 32 > qrow) bb = -INFINITY; }
        s0[r] = a; s1[r] = bb; mloc = fmaxf(mloc, fmaxf(a, bb));
      }
    }
    mloc = fmaxf(mloc, __shfl_xor(mloc, 32));
    float mn = fmaxf(m, mloc);
    float alpha = __builtin_amdgcn_exp2f(m - mn);
    m = mn;
    float ps = 0.f;
#pragma unroll
    for (int r = 0; r < 16; r++) { s0[r] = __builtin_amdgcn_exp2f(s0[r] - mn); s1[r] = __builtin_amdgcn_exp2f(s1[r] - mn); ps += s0[r] + s1[r]; }
    lsum = lsum * alpha + ps;
#pragma unroll
    for (int r = 0; r < 16; r++) { o0[r] *= alpha; o1[r] *= alpha; }
#pragma unroll
    for (int ks = 0; ks < 4; ks++) {
      union { bf16x8 v; unsigned u[4]; } pf;
#pragma unroll
      for (int e = 0; e < 4; e++) {
        int r = (ks & 1) * 8 + 2 * e;
        pf.u[e] = (ks < 2) ? pack2(s0[r], s0[r + 1]) : pack2(s1[r], s1[r + 1]);
      }
#pragma unroll
      for (int db = 0; db < 2; db++) {
        const bfu* vp = sV + (db * 32 + r32) * 72 + ks * 16 + 4 * hi;
        union { bf16x8 v; uint2 u[2]; } vf;
        vf.u[0] = *(const uint2*)vp; vf.u[1] = *(const uint2*)(vp + 8);
        if (db == 0) o0 = __builtin_amdgcn_mfma_f32_32x32x16_bf16(vf.v, pf.v, o0, 0, 0, 0);
        else o1 = __builtin_amdgcn_mfma_f32_32x32x16_bf16(vf.v, pf.v, o1, 0, 0, 0);
      }
    }
  }
  float lt = lsum + __shfl_xor(lsum, 32);
  float inv = 1.f / lt;
  bfu* op = (dry ? (bfu*)(p.ws + OFF_XB) : FQ) + (size_t)(b * SEQ + qrow) * 512 + h * 64;
#pragma unroll
  for (int g = 0; g < 4; g++) {
    *(uint2*)(op + 8 * g + 4 * hi) = make_uint2(pack2(o0[g * 4] * inv, o0[g * 4 + 1] * inv), pack2(o0[g * 4 + 2] * inv, o0[g * 4 + 3] * inv));
    *(uint2*)(op + 32 + 8 * g + 4 * hi) = make_uint2(pack2(o1[g * 4] * inv, o1[g * 4 + 1] * inv), pack2(o1[g * 4 + 2] * inv, o1[g * 4 + 3] * inv));
  }
  __syncthreads();
}

DEV void r3_item(const Params& p, int item, char* smem, bool dry) {
  const int tid = threadIdx.x, lane = tid & 63, w = tid >> 6, wr = w >> 1, wc = w & 1, l16 = lane & 15, quad = lane >> 4;
  const int bh = item / NCH, c = item - bh * NCH; const int b = bh >> 3, h = bh & 7;
  bfu* sQ = (bfu*)smem; bfu* sK = sQ + 128 * 72; bfu* sP = sK + 128 * 72; float* sRed = (float*)(sP + 128 * 136);
  const size_t row0 = (size_t)b * SEQ + c * RC;
  const bfu* Q = (const bfu*)(p.ws + OFF_QT) + row0 * 512 + h * 64;
  const bfu* Kk = (const bfu*)(p.ws + OFF_KT) + row0 * 512 + h * 64;
  const bfu* vT = (const bfu*)(p.ws + OFF_VT) + (size_t)bh * 128 * SEQ + c * RC;
  const bfu* ST = (const bfu*)(p.ws + OFF_SST) + (size_t)item * 8192;
  u32x4 ra[4], rb[4];
  g2r<128>(Q, 512, ra); g2r<128>(Kk, 512, rb);
  __syncthreads();
  r2s<128>(sQ, ra); r2s<128>(sK, rb);
  __syncthreads();
  g2r<128>(vT, SEQ, rb);
  f32x4 acc[4][4];
#pragma unroll
  for (int i = 0; i < 4; i++)
#pragma unroll
    for (int j = 0; j < 4; j++) acc[i][j] = f32x4{0.f, 0.f, 0.f, 0.f};
  mma64<4, 4>(sQ, 72, sK, 72, acc);
#pragma unroll
  for (int mi = 0; mi < 4; mi++)
#pragma unroll
    for (int ni = 0; ni < 4; ni++)
#pragma unroll
      for (int j = 0; j < 4; j++) {
        int row = wr * 64 + mi * 16 + quad * 4 + j, col = wc * 64 + ni * 16 + l16;
        sP[row * 136 + col] = (col <= row) ? f2bf(acc[mi][ni][j]) : (bfu)0;
      }
#pragma unroll
  for (int i = 0; i < 4; i++)
#pragma unroll
    for (int j = 0; j < 4; j++) acc[i][j] = f32x4{0.f, 0.f, 0.f, 0.f};
  __syncthreads();
  r2s<128>(sK, rb);
  __syncthreads();
  g2r<128>(vT + 64, SEQ, rb);
  mma64<4, 4>(sP, 136, sK, 72, acc);
  __syncthreads();
  r2s<128>(sK, rb);
  __syncthreads();
  g2r<128>(ST, 64, rb);
  mma64<4, 4>(sP + 64, 136, sK, 72, acc);
  __syncthreads();
  r2s<128>(sK, rb);
  __syncthreads();
  mma64<4, 4>(sQ, 72, sK, 72, acc);
  float ssq[4][4];
#pragma unroll
  for (int mi = 0; mi < 4; mi++)
#pragma unroll
    for (int j = 0; j < 4; j++) { float s = 0.f;
#pragma unroll
      for (int ni = 0; ni < 4; ni++) s += acc[mi][ni][j] * acc[mi][ni][j];
      s = sum16(s); ssq[mi][j] = s;
      if (l16 == 0) sRed[(wr * 64 + mi * 16 + quad * 4 + j) * 2 + wc] = s; }
  __syncthreads();
  bfu* RG = (bfu*)(p.ws + OFF_RG);
  float gg[4];
#pragma unroll
  for (int ni = 0; ni < 4; ni++) gg[ni] = p.gn_g[h * 128 + wc * 64 + ni * 16 + l16];
#pragma unroll
  for (int mi = 0; mi < 4; mi++)
#pragma unroll
    for (int j = 0; j < 4; j++) {
      int row = wr * 64 + mi * 16 + quad * 4 + j;
      float tot = sRed[row * 2] + sRed[row * 2 + 1];
      float r = rsqrtf(tot * (1.f / 128.f) + EPSN);
#pragma unroll
      for (int ni = 0; ni < 4; ni++) {
        size_t o = (row0 + row) * DM + h * 128 + wc * 64 + ni * 16 + l16;
        float rgv = bf2f(RG[o]);
        (dry ? (bfu*)(p.ws + OFF_XB) + (o & 0xffffff) : RG + o)[0] = f2bf(acc[mi][ni][j] * r * gg[ni] * (rgv * sigmoidf_(rgv)));
      }
    }
  __syncthreads();
}

DEV void phase4(const Params& p, int bid, int nb, char* smem, bool dry = false) {
  float gq = 0.f, gk = 0.f;
  for (int i = 0; i < 64; i++) { gq = fmaxf(gq, fabsf(p.fq_g[i])); gk = fmaxf(gk, fabsf(p.fk_g[i])); }
  const float thr = 2.f * (8.f * gq * gk * 1.03f * LOG2E) + 44.f;
  for (int it = bid; it < 2048 + 16 * NCH; it += nb) {
    if (it < 2048) attn_item(p, it, smem, thr, dry); else r3_item(p, it - 2048, smem, dry);
  }
}

DEV void phase5(const Params& p, int bid, int nb, char* smem) {
  const int tid = threadIdx.x, lane = tid & 63, w = tid >> 6, wr = w >> 1, wc = w & 1, l16 = lane & 15, quad = lane >> 4;
  bfu* sA = (bfu*)smem; bfu* sB = sA + 128 * 72;
  const bfu* G = (const bfu*)(p.ws + OFF_RG); const bfu* FO = (const bfu*)(p.ws + OFF_FQ);
  const bfu* WR = (const bfu*)(p.ws + OFF_WRT); const bfu* WF = (const bfu*)(p.ws + OFF_WFT);
  bfu* MX = (bfu*)(p.ws + OFF_XB);
  constexpr int NG = (TT / 128) * 8, NCV = 8192;
  const int xcd = bid & 7, slot = bid >> 3, nslots = (nb + 7 - xcd) >> 3;
  const int n_p = slot < 128 ? (128 - slot + nslots - 1) / nslots : 0;
  for (int i_ = 0; i_ < n_p; i_++) {
    int q = slot + i_ * nslots; int mt = xcd * 16 + (q >> 3), nt = q & 7;
    int m0 = mt * 256, n0 = nt * 128;
    int tid2 = threadIdx.x; asm volatile("" : "+v"(tid2));
    const int lane2 = tid2 & 63, w2 = tid2 >> 6, wr2 = w2 >> 1, wc2 = w2 & 1, l162 = lane2 & 15, quad2 = lane2 >> 4;
    f32x4 a1[8][4];
#pragma unroll
    for (int i = 0; i < 8; i++)
#pragma unroll
      for (int j = 0; j < 4; j++) a1[i][j] = f32x4{0.f, 0.f, 0.f, 0.f};
    gemm_loop_sb<8, 4>(G + (size_t)m0 * DM, DM, WR + (size_t)n0 * DM, DM, DM, a1, sA);
    const bfu* ga = (const bfu*)(p.out + O_YP); const bfu* gb = ga + (size_t)TP * DM;
    float* sw = (float*)(smem + EPI_OFF) + w2 * EPI_WAVE;
    const int rr = lane2 >> 2, c0 = wc2 * 64 + (lane2 & 3) * 16;
#pragma unroll
    for (int mi = 0; mi < 8; mi++) {
      float r[16], g[16]; to_rows(a1[mi], r, sw, lane2);
      int rr_ = rr; asm volatile("" : "+v"(rr_));
      const size_t o = (size_t)(m0 + wr2 * 128 + mi * 16 + rr_) * DM + n0 + c0;
      ld_bf16x16(ga + o, g);
#pragma unroll
      for (int e = 0; e < 16; e++) r[e] *= sigmoidf_(g[e]);
      st_bf16x16(MX + o, r);
#pragma unroll
      for (int ni = 0; ni < 4; ni++) a1[mi][ni] = f32x4{0.f, 0.f, 0.f, 0.f};
    }
    gemm_loop_sb<8, 4>(FO + (size_t)m0 * 512, 512, WF + (size_t)n0 * 512, 512, 512, a1, sA);
#pragma unroll
    for (int mi = 0; mi < 8; mi++) {
      float r[16], g[16], m[16]; to_rows(a1[mi], r, sw, lane2);
      int rr_ = rr; asm volatile("" : "+v"(rr_));
      const size_t o = (size_t)(m0 + wr2 * 128 + mi * 16 + rr_) * DM + n0 + c0;
      ld_bf16x16(gb + o, g); ld_bf16x16(MX + o, m);
#pragma unroll
      for (int e = 0; e < 16; e++) r[e] = m[e] + sigmoidf_(g[e]) * r[e];
      st_bf16x16(MX + o, r);
    }
  }
  if (bid < 128) {
    int nt = bid & 7;
    int m0 = TP + (bid >> 3) * 32, n0 = nt * 128;
    f32x4 a1[1][4];
#pragma unroll
    for (int j = 0; j < 4; j++) a1[0][j] = f32x4{0.f, 0.f, 0.f, 0.f};
    gemm_loop<1, 4>(G + (size_t)m0 * DM, DM, WR + (size_t)n0 * DM, DM, DM, a1, sA);
    const bfu* ga = (const bfu*)(p.out + O_YS) + (size_t)(m0 - TP) * DM + n0; const bfu* gb = ga + (size_t)TS * DM;
    bfu* mxT = MX + (size_t)m0 * DM + n0;
    unsigned loff = (unsigned)((wr * 16 + quad * 4) * DM + wc * 64 + l16); asm volatile("" : "+v"(loff));
#pragma unroll
    for (int ni = 0; ni < 4; ni++) {
#pragma unroll
      for (int j = 0; j < 4; j++) { unsigned o = loff + (unsigned)(j * DM + ni * 16);
        mxT[o] = f2bf(sigmoidf_(bf2f(ga[o])) * a1[0][ni][j]); }
      a1[0][ni] = f32x4{0.f, 0.f, 0.f, 0.f};
    }
    gemm_loop<1, 4>(FO + (size_t)m0 * 512, 512, WF + (size_t)n0 * 512, 512, 512, a1, sA);
    unsigned loff2 = loff; asm volatile("" : "+v"(loff2));
#pragma unroll
    for (int ni = 0; ni < 4; ni++) {
#pragma unroll
      for (int j = 0; j < 4; j++) { unsigned o = loff2 + (unsigned)(j * DM + ni * 16);
        mxT[o] = f2bf(bf2f(mxT[o]) + sigmoidf_(bf2f(gb[o])) * a1[0][ni][j]); }
    }
  }
}

DEV void phase6(const Params& p, int bid, int nb, char* smem) {
  bfu* sA = (bfu*)smem;
  const bfu* MX = (const bfu*)(p.ws + OFF_XB); const bfu* WO = (const bfu*)(p.ws + OFF_WOT);
  bfu* X1B = (bfu*)(p.ws + OFF_X1B); float* SSQ2 = (float*)(p.ws + OFF_SSQ2);
  const int xcd = bid & 7, slot = bid >> 3, nslots = (nb + 7 - xcd) >> 3;
  const int n_p = slot < 128 ? (128 - slot + nslots - 1) / nslots : 0;
  for (int i_ = 0; i_ < n_p; i_++) {
    int q = slot + i_ * nslots; int mt = xcd * 16 + (q >> 3), nt = q & 7;
    int m0 = mt * 256, n0 = nt * 128;
    int tid = threadIdx.x; asm volatile("" : "+v"(tid));
    const int lane = tid & 63, w = tid >> 6, wr = w >> 1, wc = w & 1, l16 = lane & 15, quad = lane >> 4;
    f32x4 acc[8][4];
#pragma unroll
    for (int i = 0; i < 8; i++)
#pragma unroll
      for (int j = 0; j < 4; j++) acc[i][j] = f32x4{0.f, 0.f, 0.f, 0.f};
    gemm_loop_sb<8, 4>(MX + (size_t)m0 * DM, DM, WO + (size_t)n0 * DM, DM, DM, acc, sA);
    float* sw = (float*)(smem + EPI_OFF) + w * EPI_WAVE;
    const int rr = lane >> 2, c0 = wc * 64 + (lane & 3) * 16;
#pragma unroll
    for (int mi = 0; mi < 8; mi++) {
      float r[16]; to_rows(acc[mi], r, sw, lane);
      int rr_ = rr; asm volatile("" : "+v"(rr_));
      const size_t o = (size_t)(m0 + wr * 128 + mi * 16 + rr_) * DM + n0 + c0;
      const float* xp = (m0 < TP ? p.x_p : p.x_s - (size_t)TP * DM) + o;
      float ss = 0.f;
#pragma unroll
      for (int c = 0; c < 4; c++) { f32x4 xv = *(const f32x4*)(xp + 4 * c);
#pragma unroll
        for (int e = 0; e < 4; e++) { r[4 * c + e] += xv[e]; ss += r[4 * c + e] * r[4 * c + e]; } }
      st_f32x16(p.out + O_YP + o, r);
      st_bf16x16(X1B + o, r);
      ss += __shfl_xor(ss, 1); ss += __shfl_xor(ss, 2);
      if ((lane & 3) == 0) SSQ2[(size_t)(m0 + wr * 128 + mi * 16 + rr) * 16 + nt * 2 + wc] = ss;
    }
  }
  if (bid < 128) {
    const int tid = threadIdx.x, lane = tid & 63, w = tid >> 6, wr = w >> 1, wc = w & 1, l16 = lane & 15, quad = lane >> 4;
    int nt = bid & 7;
    int m0 = TP + (bid >> 3) * 32, n0 = nt * 128;
    f32x4 acc[1][4];
#pragma unroll
    for (int j = 0; j < 4; j++) acc[0][j] = f32x4{0.f, 0.f, 0.f, 0.f};
    gemm_loop<1, 4>(MX + (size_t)m0 * DM, DM, WO + (size_t)n0 * DM, DM, DM, acc, sA);
    const float* xin = p.x_s + (size_t)(m0 - TP) * DM + n0;
    float* y = p.out + O_YS + (size_t)(m0 - TP) * DM + n0;
    bfu* xb1 = X1B + (size_t)m0 * DM + n0;
    unsigned loff = (unsigned)((wr * 16 + quad * 4) * DM + wc * 64 + l16); asm volatile("" : "+v"(loff));
#pragma unroll
    for (int j = 0; j < 4; j++) {
      int lr = wr * 16 + quad * 4 + j; float ss = 0.f;
#pragma unroll
      for (int ni = 0; ni < 4; ni++) {
        unsigned o = loff + (unsigned)(j * DM + ni * 16);
        float v = xin[o] + acc[0][ni][j];
        y[o] = v; xb1[o] = f2bf(v); ss += v * v;
      }
      ss = sum16(ss);
      if (l16 == 0) (SSQ2 + (size_t)m0 * 16 + nt * 2)[(unsigned)(lr * 16 + wc)] = ss;
    }
  }
}

DEV int fkey(float x, int idx, int mask) { int b = __float_as_int(x); b ^= (b >> 31) & 0x7fffffff; return (b & ~mask) | idx; }
DEV void ins16(int (&t)[16], int v) {
#pragma unroll
  for (int s = 0; s < 16; s++) { int hi = max(t[s], v); v = min(t[s], v); t[s] = hi; }
}

DEV void phase7(const Params& p, int bid, int nb, char* smem) {
  const int tid = threadIdx.x, lane = tid & 63, w = tid >> 6, wr = w >> 1, wc = w & 1, l16 = lane & 15, quad = lane >> 4;
  bfu* sA = (bfu*)smem;
  float* sS = (float*)smem;
  int* sL = (int*)(smem + 33024);
  float* sTV = (float*)(smem + 55296);
  int* sTI = (int*)(sTV + 2 * 64 * 17);
  const bfu* X1B = (const bfu*)(p.ws + OFF_X1B); const bfu* MT = (const bfu*)(p.ws + OFF_MT);
  const float* SSQ2 = (const float*)(p.ws + OFF_SSQ2);
  int2* ROUTE = (int2*)(p.ws + OFF_ROUTE);
  constexpr int NI7 = (TT / 64) * 8;
  const int xcd = bid & 7, slot = bid >> 3, nslots = (nb + 7 - xcd) >> 3;
  for (int q = slot; q < 520; q += nslots) {
    int hg = q / 260, q2 = q - hg * 260; int mt = xcd * 65 + (q2 >> 2), h = hg * 4 + (q2 & 3); int m0 = mt * 64;
    for (int half = 0; half < 2; half++) {
      f32x4 acc[2][4];
#pragma unroll
      for (int i = 0; i < 2; i++)
#pragma unroll
        for (int j = 0; j < 4; j++) acc[i][j] = f32x4{0.f, 0.f, 0.f, 0.f};
      gemm_loop<2, 4>(X1B + (size_t)m0 * DM, DM, MT + (size_t)(h * 256 + half * 128) * DM, DM, DM, acc, sA);
      __syncthreads();
#pragma unroll
      for (int mi = 0; mi < 2; mi++)
#pragma unroll
        for (int j = 0; j < 4; j++) {
          int lr = wr * 32 + mi * 16 + quad * 4 + j;
          const float* sp = SSQ2 + (size_t)(m0 + lr) * 16; float tot = 0.f;
#pragma unroll
          for (int i = 0; i < 16; i++) tot += sp[i];
          float rs = rsqrtf(tot * (1.f / DM) + EPSN);
#pragma unroll
          for (int ni = 0; ni < 4; ni++) sS[lr * 129 + wc * 64 + ni * 16 + l16] = acc[mi][ni][j] * rs;
        }
      __syncthreads();
      { int row = tid & 63, q = tid >> 6; int t[16];
#pragma unroll
        for (int s = 0; s < 16; s++) t[s] = (int)0x80000000;
        for (int i = 0; i < 32; i++) { int idx = q * 32 + i; ins16(t, fkey(sS[row * 129 + idx], idx, 127)); }
#pragma unroll
        for (int s = 0; s < 16; s++) sL[row * 65 + q * 16 + s] = t[s]; }
      __syncthreads();
      if (tid < 64) { int row = tid; int p0 = 0, p1 = 0, p2 = 0, p3 = 0; const int* L = sL + row * 65;
        for (int r = 0; r < 16; r++) {
          int a0 = L[p0], a1 = L[16 + p1], a2 = L[32 + p2], a3 = L[48 + p3];
          int mx = max(max(a0, a1), max(a2, a3));
          if (mx == a0) p0++; else if (mx == a1) p1++; else if (mx == a2) p2++; else p3++;
          int idx = mx & 127;
          sTV[(half * 64 + row) * 17 + r] = sS[row * 129 + idx]; sTI[(half * 64 + row) * 17 + r] = idx; } }
      __syncthreads();
    }
    if (tid < 64) {
      int row = tid; float v1[16], v2[16];
#pragma unroll
      for (int i = 0; i < 16; i++) { v1[i] = sTV[row * 17 + i]; v2[i] = sTV[(64 + row) * 17 + i]; }
      int t[16];
#pragma unroll
      for (int s = 0; s < 16; s++) t[s] = (int)0x80000000;
#pragma unroll
      for (int i = 0; i < 16; i++)
#pragma unroll
        for (int j = 0; j < 16; j++)
          if ((i + 1) * (j + 1) <= 16) ins16(t, fkey(v1[i] + v2[j], i * 16 + j, 255));
      float es[16]; int ei[16]; float mx = 0.f, sum = 0.f;
#pragma unroll
      for (int r = 0; r < 16; r++) { int c = t[r] & 255; int i = c >> 4, j = c & 15;
        float s = sTV[row * 17 + i] + sTV[(64 + row) * 17 + j];
        ei[r] = sTI[row * 17 + i] * 128 + sTI[(64 + row) * 17 + j];
        if (r == 0) mx = s;
        es[r] = __expf(s - mx); sum += es[r]; }
      float inv = 1.f / sum;
      int2* ro = ROUTE + ((size_t)(m0 + row) * 8 + h) * 16;
#pragma unroll
      for (int r = 0; r < 16; r++) ro[r] = make_int2(ei[r], __float_as_int(es[r] * inv));
    }
    __syncthreads();
  }
}

#define FP4PK(w_, sel_) __builtin_amdgcn_cvt_scalef32_pk_f32_fp4((w_), 1.0f, (sel_))
DEV float dot16_fp8(const u32x2& u, const f32x2 (&xn)[8]) {
  f32x2 s = FP4PK(u[0], 0) * xn[0];
  s = FP4PK(u[0], 1) * xn[1] + s;
  s = FP4PK(u[0], 2) * xn[2] + s;
  s = FP4PK(u[0], 3) * xn[3] + s;
  s = FP4PK(u[1], 0) * xn[4] + s;
  s = FP4PK(u[1], 1) * xn[5] + s;
  s = FP4PK(u[1], 2) * xn[6] + s;
  s = FP4PK(u[1], 3) * xn[7] + s;
  return s[0] + s[1];
}
DEV void axpy16_fp8(const u32x2& u, float wj, f32x2 (&acc)[8]) {
  const f32x2 w2 = {wj, wj};
  acc[0] = FP4PK(u[0], 0) * w2 + acc[0];
  acc[1] = FP4PK(u[0], 1) * w2 + acc[1];
  acc[2] = FP4PK(u[0], 2) * w2 + acc[2];
  acc[3] = FP4PK(u[0], 3) * w2 + acc[3];
  acc[4] = FP4PK(u[1], 0) * w2 + acc[4];
  acc[5] = FP4PK(u[1], 1) * w2 + acc[5];
  acc[6] = FP4PK(u[1], 2) * w2 + acc[6];
  acc[7] = FP4PK(u[1], 3) * w2 + acc[7];
}
template <int S>
DEV void red_step(float (&pp)[16], int lane) {
  const bool up = (lane & S) != 0;
#pragma unroll
  for (int i = 0; i < S; i++) {
    float send = up ? pp[i] : pp[i + S];
    float keep = up ? pp[i + S] : pp[i];
    pp[i] = keep + __shfl_xor(send, S);
  }
}
DEV float reduce16(float (&pp)[16], int lane) {
  red_step<8>(pp, lane); red_step<4>(pp, lane); red_step<2>(pp, lane); red_step<1>(pp, lane);
  float v = pp[0];
  v += __shfl_xor(v, 16); v += __shfl_xor(v, 32);
  return v;
}

DEV void phase8(const Params& p, int bid, int nb, char* smem, bool dry = false) {
  const int tid = threadIdx.x, lane = tid & 63, w = __builtin_amdgcn_readfirstlane(tid >> 6);
  const u32x2* PUB = (const u32x2*)(p.ws + OFF_PUB); const u32x2* PVB = (const u32x2*)(p.ws + OFF_PVB);
  const float* PSC = (const float*)(p.ws + OFF_PSC);
  const float* SSQ2 = (const float*)(p.ws + OFF_SSQ2); const int2* ROUTE = (const int2*)(p.ws + OFF_ROUTE);
  for (int it = bid; it < TT / 4; it += nb) {
    int tok = it * 4 + w;
    float* y = tok < TP ? p.out + O_YP + (size_t)tok * DM : p.out + O_YS + (size_t)(tok - TP) * DM;
    float x[16]; f32x2 xn[8];
    { float4 a0 = *(const float4*)(y + lane * 16), a1 = *(const float4*)(y + lane * 16 + 4), b0 = *(const float4*)(y + lane * 16 + 8), b1 = *(const float4*)(y + lane * 16 + 12);
      x[0] = a0.x; x[1] = a0.y; x[2] = a0.z; x[3] = a0.w; x[4] = a1.x; x[5] = a1.y; x[6] = a1.z; x[7] = a1.w;
      x[8] = b0.x; x[9] = b0.y; x[10] = b0.z; x[11] = b0.w; x[12] = b1.x; x[13] = b1.y; x[14] = b1.z; x[15] = b1.w; }
    float tot = 0.f;
    { const float* sp = SSQ2 + (size_t)tok * 16;
#pragma unroll
      for (int i = 0; i < 16; i++) tot += sp[i]; }
    float rs = rsqrtf(tot * (1.f / DM) + EPSN);
#pragma unroll
    for (int i = 0; i < 8; i++) { xn[i][0] = x[2 * i] * rs * p.norm2_g[lane * 16 + 2 * i]; xn[i][1] = x[2 * i + 1] * rs * p.norm2_g[lane * 16 + 2 * i + 1]; }
    const int2* rt = ROUTE + (size_t)tok * 128;
    int2 r0 = rt[lane], r1 = rt[lane + 64];
    float d0 = 0.f, d1 = 0.f;
#pragma unroll 1
    for (int g = 0; g < 4; g++) {
      float pp[16]; u32x2 u[16];
#pragma unroll
      for (int jj = 0; jj < 16; jj++) { int e = __builtin_amdgcn_readlane(r0.x, g * 16 + jj); u[jj] = PUB[(size_t)e * 64 + lane]; }
      __builtin_amdgcn_sched_barrier(0);
#pragma unroll
      for (int jj = 0; jj < 16; jj++) pp[jj] = dot16_fp8(u[jj], xn);
      float v = reduce16(pp, lane);
      if ((lane >> 4) == g) d0 = v;
    }
#pragma unroll 1
    for (int g = 0; g < 4; g++) {
      float pp[16]; u32x2 u[16];
#pragma unroll
      for (int jj = 0; jj < 16; jj++) { int e = __builtin_amdgcn_readlane(r1.x, g * 16 + jj); u[jj] = PUB[(size_t)e * 64 + lane]; }
      __builtin_amdgcn_sched_barrier(0);
#pragma unroll
      for (int jj = 0; jj < 16; jj++) pp[jj] = dot16_fp8(u[jj], xn);
      float v = reduce16(pp, lane);
      if ((lane >> 4) == g) d1 = v;
    }
    d0 *= PSC[r0.x]; d1 *= PSC[r1.x];
    const float w0 = 0.5f * d0 * (1.f + erff(d0 * 0.70710678118654752f)) * __int_as_float(r0.y) * PSC[16384 + r0.x];
    const float w1 = 0.5f * d1 * (1.f + erff(d1 * 0.70710678118654752f)) * __int_as_float(r1.y) * PSC[16384 + r1.x];
    f32x2 acc[8];
#pragma unroll
    for (int i = 0; i < 8; i++) acc[i] = f32x2{0.f, 0.f};
#pragma unroll 1
    for (int g = 0; g < 8; g++) {
      const int rx = g < 4 ? r0.x : r1.x; const int wx = __float_as_int(g < 4 ? w0 : w1);
      u32x2 u[16];
#pragma unroll
      for (int jj = 0; jj < 16; jj++) { int e = __builtin_amdgcn_readlane(rx, (g & 3) * 16 + jj); u[jj] = PVB[(size_t)e * 64 + lane]; }
      __builtin_amdgcn_sched_barrier(0);
#pragma unroll
      for (int jj = 0; jj < 16; jj++) { float wj = __int_as_float(__builtin_amdgcn_readlane(wx, (g & 3) * 16 + jj)); axpy16_fp8(u[jj], wj, acc); }
    }
    if (dry) y = (float*)(p.ws + OFF_XB) + (size_t)(tok & 8191) * DM;
    *(float4*)(y + lane * 16) = make_float4(x[0] + acc[0][0], x[1] + acc[0][1], x[2] + acc[1][0], x[3] + acc[1][1]);
    *(float4*)(y + lane * 16 + 4) = make_float4(x[4] + acc[2][0], x[5] + acc[2][1], x[6] + acc[3][0], x[7] + acc[3][1]);
    *(float4*)(y + lane * 16 + 8) = make_float4(x[8] + acc[4][0], x[9] + acc[4][1], x[10] + acc[5][0], x[11] + acc[5][1]);
    *(float4*)(y + lane * 16 + 12) = make_float4(x[12] + acc[6][0], x[13] + acc[6][1], x[14] + acc[7][0], x[15] + acc[7][1]);
  }
}

__global__ void __launch_bounds__(256, 2) fwd_kernel(Params p, int ph_lo, int ph_hi, int coop) {
  __shared__ __attribute__((aligned(16))) char smem[SMEM_BYTES];
  const int bid = blockIdx.x, nb = gridDim.x;
#ifndef REPS
#define REPS {1,1,1,1,1,1,1,1,1}
#endif
  constexpr int REP[9] = REPS;
#define RUN_PHASE(N) if (ph_lo <= N && N <= ph_hi) { for (int r_ = 0; r_ < REP[N]; r_++) phase##N(p, bid, nb, smem); if (coop && N < ph_hi) cg::this_grid().sync(); }
#define RUN_PHASE_DRY(N) if (ph_lo <= N && N <= ph_hi) { for (int r_ = 1; r_ < REP[N]; r_++) phase##N(p, bid, nb, smem, true); phase##N(p, bid, nb, smem, false); if (coop && N < ph_hi) cg::this_grid().sync(); }
  RUN_PHASE(0) RUN_PHASE_DRY(1) RUN_PHASE(2) RUN_PHASE(3) RUN_PHASE_DRY(4) RUN_PHASE(5) RUN_PHASE(6) RUN_PHASE(7) RUN_PHASE_DRY(8)
}

extern "C" void kernel_launch(void* const* d_in, const int* in_sizes, int n_in, void* d_out, int out_size,
                              void* d_ws, size_t ws_size, hipStream_t stream) {
  if (ws_size < WS_NEED) { fprintf(stderr, "workspace too small\n"); return; }
  static int grid_blocks = 0;
  if (!grid_blocks) {
    int dev = 0, cus = 0, per_cu = 0;
    hipGetDevice(&dev);
    hipDeviceGetAttribute(&cus, hipDeviceAttributeMultiprocessorCount, dev);
    hipOccupancyMaxActiveBlocksPerMultiprocessor(&per_cu, fwd_kernel, 256, 0);
    if (per_cu < 1) per_cu = 1;
    if (per_cu > 2) per_cu = 2;
    grid_blocks = cus * per_cu;
  }
  Params p{};
  const float* const* in = (const float* const*)d_in;
  p.x_p = in[0]; p.x_s = in[1]; p.state_ret = in[2]; p.ck = in[3]; p.cv = in[4]; p.clogf = in[5]; p.norm1_g = in[6];
  p.w_in = in[7]; p.b_f = in[8]; p.fq_g = in[9]; p.fk_g = in[10]; p.gn_g = in[11]; p.w_ret_out = in[12]; p.w_fox_out = in[13];
  p.w_o = in[14]; p.norm2_g = in[15]; p.peer_wq = in[16]; p.k1 = in[17]; p.k2 = in[18]; p.peer_u = in[19]; p.peer_v = in[20];
  p.out = (float*)d_out; p.ws = (char*)d_ws;
#ifndef MULTI_LAUNCH
#define MULTI_LAUNCH 0
#endif
#if MULTI_LAUNCH
  for (int ph = 0; ph <= 8; ph++) fwd_kernel<<<grid_blocks, 256, 0, stream>>>(p, ph, ph, 0);
#else
  int lo = 0, hi = 8, coop = 1;
  void* args[] = {&p, &lo, &hi, &coop};
  hipError_t e = hipLaunchCooperativeKernel((void*)fwd_kernel, dim3(grid_blocks), dim3(256), args, 0, stream);
  if (e != hipSuccess) fprintf(stderr, "cooperative launch failed: %s (grid %d)\n", hipGetErrorString(e), grid_blocks);
#endif
}
```

```cpp
#include <hip/hip_runtime.h>
#include <hip/hip_cooperative_groups.h>
#include <stdint.h>
#include <stdio.h>
namespace cg = cooperative_groups;

#define DEV __device__ __forceinline__
typedef unsigned short bfu;
typedef __attribute__((ext_vector_type(8))) short bf16x8;
typedef __attribute__((ext_vector_type(4))) short bf16x4;
typedef __attribute__((ext_vector_type(4))) float f32x4;
typedef __attribute__((ext_vector_type(16))) float f32x16;
typedef __attribute__((ext_vector_type(4))) unsigned u32x4;
typedef __attribute__((ext_vector_type(2))) float f32x2;
typedef __attribute__((ext_vector_type(2))) unsigned u32x2;

constexpr int DM = 1024, SEQ = 16384, TP = 32768, TS = 512, TT = 33280;
constexpr int NWP = 6784;
constexpr int RC = 128;
constexpr int NCH = SEQ / RC;
constexpr float LOG2E = 1.4426950408889634f;
constexpr float EPSN = 1e-6f;

constexpr size_t O_YP = 0, O_YS = 33554432, O_SP = 34078720, O_FKP = 34209792, O_FVP = 50987008,
                 O_LFP = 67764224, O_SS = 68026368, O_FKS = 70123520, O_FVS = 70385664, O_LFS = 70647808;
constexpr size_t MiB = 1u << 20;
constexpr size_t OFF_XB = 0;
constexpr size_t OFF_WINT = 66 * MiB, OFF_WRT = 80 * MiB, OFF_WFT = 82 * MiB, OFF_WOT = 83 * MiB, OFF_MT = 85 * MiB;
constexpr size_t OFF_RSTD1 = 89 * MiB, OFF_C2 = 90 * MiB, OFF_HS = 91 * MiB;
constexpr size_t OFF_QT = 105 * MiB, OFF_KT = 137 * MiB, OFF_KTT = 169 * MiB, OFF_VT = 201 * MiB;
constexpr size_t OFF_X1B = OFF_HS;
constexpr size_t OFF_RG = 265 * MiB, OFF_FQ = 331 * MiB, OFF_FKB = 364 * MiB, OFF_FVT = 396 * MiB;
constexpr size_t OFF_PUB = OFF_KTT, OFF_PVB = OFF_KTT + 16 * MiB;
constexpr size_t OFF_ROUTE = OFF_FKB, OFF_SSQ2 = OFF_FKB + 33 * MiB;
constexpr size_t OFF_PSC = OFF_RSTD1 + 512 * 1024;
constexpr size_t OFF_SST = 428 * MiB;
constexpr size_t WS_NEED = 460 * MiB;

constexpr int SMEM_BYTES = 75776;

struct Params {
  const float *x_p, *x_s, *state_ret, *ck, *cv, *clogf, *norm1_g, *w_in, *b_f, *fq_g, *fk_g, *gn_g,
      *w_ret_out, *w_fox_out, *w_o, *norm2_g, *peer_wq, *k1, *k2, *peer_u, *peer_v;
  float* out;
  char* ws;
};

DEV bfu f2bf(float f) { unsigned u = __float_as_uint(f); u += 0x7fffu + ((u >> 16) & 1u); return (bfu)(u >> 16); }
DEV float bf2f(bfu b) { return __uint_as_float(((unsigned)b) << 16); }
DEV unsigned pack2(float a, float b) { return (unsigned)f2bf(a) | ((unsigned)f2bf(b) << 16); }
DEV float bflo(unsigned u) { return __uint_as_float(u << 16); }
DEV float bfhi(unsigned u) { return __uint_as_float(u & 0xffff0000u); }
DEV float sigmoidf_(float z) { return 1.f / (1.f + __expf(-z)); }
DEV float l2gamma(int h) { return log2f(1.f - exp2f(-5.f - (float)h)); }
DEV float wave_sum(float v) {
#pragma unroll
  for (int o = 32; o >= 1; o >>= 1) v += __shfl_xor(v, o);
  return v;
}
DEV float sum16(float v) {
  v += __shfl_xor(v, 1); v += __shfl_xor(v, 2); v += __shfl_xor(v, 4); v += __shfl_xor(v, 8);
  return v;
}

template <int ROWS>
DEV void g2r(const bfu* g, int ld, u32x4 (&r)[ROWS / 32], int tid_ = threadIdx.x) {
#pragma unroll
  for (int i = 0; i < ROWS / 32; i++) {
    int id = tid_ + i * 256; int row = id >> 3, ch = id & 7;
    const unsigned off = (unsigned)(row * ld + ch * 8);
    r[i] = *(const u32x4*)(g + off);
  }
}
template <int ROWS>
DEV void r2s(bfu* s, const u32x4 (&r)[ROWS / 32], int tid_ = threadIdx.x) {
#pragma unroll
  for (int i = 0; i < ROWS / 32; i++) {
    int id = tid_ + i * 256; int row = id >> 3, ch = id & 7;
    *(u32x4*)(s + row * 72 + ch * 8) = r[i];
  }
}
template <int MI, int NI>
DEV void mma64(const bfu* sA, int sldA, const bfu* sB, int sldB, f32x4 (&acc)[MI][NI]) {
  const int lane = threadIdx.x & 63, w = threadIdx.x >> 6, wr = w >> 1, wc = w & 1, l16 = lane & 15, quad = lane >> 4;
#pragma unroll
  for (int kk = 0; kk < 2; kk++) {
    bf16x8 a[MI], b[NI];
#pragma unroll
    for (int mi = 0; mi < MI; mi++) a[mi] = *(const bf16x8*)(sA + (wr * MI * 16 + mi * 16 + l16) * sldA + kk * 32 + quad * 8);
#pragma unroll
    for (int ni = 0; ni < NI; ni++) b[ni] = *(const bf16x8*)(sB + (wc * NI * 16 + ni * 16 + l16) * sldB + kk * 32 + quad * 8);
#pragma unroll
    for (int mi = 0; mi < MI; mi++)
#pragma unroll
      for (int ni = 0; ni < NI; ni++) acc[mi][ni] = __builtin_amdgcn_mfma_f32_16x16x32_bf16(a[mi], b[ni], acc[mi][ni], 0, 0, 0);
  }
}
template <int ROWS>
DEV void r2sw(bfu* s, const u32x4 (&r)[ROWS / 32], int tid_) {
#pragma unroll
  for (int i = 0; i < ROWS / 32; i++) {
    int id = tid_ + i * 256; int row = id >> 3, ch = id & 7;
    int byte = (((row >> 4) * 2 + (ch >> 2)) << 10) + ((((row & 15) << 6) + ((ch & 3) << 4)) ^ (((row >> 3) & 1) << 5));
    *(u32x4*)((char*)s + byte) = r[i];
  }
}
template <int MI, int NI>
DEV void mma64w(const bfu* sA, const bfu* sB, f32x4 (&acc)[MI][NI]) {
  const int lane = threadIdx.x & 63, w = threadIdx.x >> 6, wr = w >> 1, wc = w & 1, l16 = lane & 15, quad = lane >> 4;
  const int lo = ((l16 << 6) + (quad << 4)) ^ (((l16 >> 3) & 1) << 5);
#pragma unroll
  for (int kk = 0; kk < 2; kk++) {
    bf16x8 a[MI], b[NI];
#pragma unroll
    for (int mi = 0; mi < MI; mi++) a[mi] = *(const bf16x8*)((const char*)sA + (((wr * MI + mi) * 2 + kk) << 10) + lo);
#pragma unroll
    for (int ni = 0; ni < NI; ni++) b[ni] = *(const bf16x8*)((const char*)sB + (((wc * NI + ni) * 2 + kk) << 10) + lo);
#pragma unroll
    for (int mi = 0; mi < MI; mi++)
#pragma unroll
      for (int ni = 0; ni < NI; ni++) acc[mi][ni] = __builtin_amdgcn_mfma_f32_16x16x32_bf16(a[mi], b[ni], acc[mi][ni], 0, 0, 0);
  }
}
template <int MI, int NI>
DEV void mma64w_big(const bfu* sA, const bfu* sB, f32x4 (&acc)[MI][NI]) {
  const int lane = threadIdx.x & 63, w = threadIdx.x >> 6, wr = w >> 1, wc = w & 1, l16 = lane & 15, quad = lane >> 4;
  const int lo = ((l16 << 6) + (quad << 4)) ^ (((l16 >> 3) & 1) << 5);
#pragma unroll
  for (int kk = 0; kk < 2; kk++) {
    bf16x8 b[NI];
#pragma unroll
    for (int ni = 0; ni < NI; ni++) b[ni] = *(const bf16x8*)((const char*)sB + (((wc * NI + ni) * 2 + kk) << 10) + lo);
#pragma unroll
    for (int mi = 0; mi < MI; mi++) {
      bf16x8 a = *(const bf16x8*)((const char*)sA + (((wr * MI + mi) * 2 + kk) << 10) + lo);
#pragma unroll
      for (int ni = 0; ni < NI; ni++) acc[mi][ni] = __builtin_amdgcn_mfma_f32_16x16x32_bf16(a, b[ni], acc[mi][ni], 0, 0, 0);
    }
  }
}
template <int MI, int NI>
DEV void gemm_loop_sb(const bfu* A, int lda, const bfu* B, int ldb, int K, f32x4 (&acc)[MI][NI], bfu* sbuf) {
  constexpr int BM = 32 * MI, BN = 32 * NI;
  bfu* sA = sbuf; bfu* sB = sA + BM * 64;
  const int nk = K >> 6;
  int t_ = threadIdx.x; asm volatile("" : "+v"(t_));
  u32x4 ra[BM / 32], rb[BN / 32];
  g2r<BM>(A, lda, ra, t_); g2r<BN>(B, ldb, rb, t_);
#pragma unroll 1
  for (int k = 0; k < nk; k++) {
    __syncthreads();
    r2sw<BM>(sA, ra, t_); r2sw<BN>(sB, rb, t_);
    __syncthreads();
    if (k + 1 < nk) { g2r<BM>(A + (k + 1) * 64, lda, ra, t_); g2r<BN>(B + (k + 1) * 64, ldb, rb, t_); }
    mma64w_big<MI, NI>(sA, sB, acc);
  }
}

template <int MI, int NI>
DEV void gemm_loop(const bfu* A, int lda, const bfu* B, int ldb, int K, f32x4 (&acc)[MI][NI], bfu* sbuf) {
  constexpr int BM = 32 * MI, BN = 32 * NI;
  bfu* sA0 = sbuf; bfu* sB0 = sA0 + BM * 64; bfu* sA1 = sB0 + BN * 64; bfu* sB1 = sA1 + BM * 64;
  const int nk = K >> 6;
  int t_ = threadIdx.x; asm volatile("" : "+v"(t_));
  u32x4 ra0[BM / 32], rb0[BN / 32], ra1[BM / 32], rb1[BN / 32];
  g2r<BM>(A, lda, ra0, t_); g2r<BN>(B, ldb, rb0, t_);
  if (nk > 1) { g2r<BM>(A + 64, lda, ra1, t_); g2r<BN>(B + 64, ldb, rb1, t_); }
  __syncthreads();
  r2sw<BM>(sA0, ra0, t_); r2sw<BN>(sB0, rb0, t_);
  if (nk > 2) { g2r<BM>(A + 128, lda, ra0, t_); g2r<BN>(B + 128, ldb, rb0, t_); }
  __syncthreads();
  for (int k = 0; k < nk; k += 2) {
    if (k + 1 < nk) { r2sw<BM>(sA1, ra1, t_); r2sw<BN>(sB1, rb1, t_); }
    if (k + 3 < nk) { g2r<BM>(A + (k + 3) * 64, lda, ra1, t_); g2r<BN>(B + (k + 3) * 64, ldb, rb1, t_); }
    mma64w<MI, NI>(sA0, sB0, acc);
    __syncthreads();
    if (k + 1 >= nk) break;
    if (k + 2 < nk) { r2sw<BM>(sA0, ra0, t_); r2sw<BN>(sB0, rb0, t_); }
    if (k + 4 < nk) { g2r<BM>(A + (k + 4) * 64, lda, ra0, t_); g2r<BN>(B + (k + 4) * 64, ldb, rb0, t_); }
    mma64w<MI, NI>(sA1, sB1, acc);
    __syncthreads();
  }
}

constexpr int EPI_OFF = 49152, EPI_WAVE = 16 * 68;
DEV void to_rows(const f32x4 (&v)[4], float (&r)[16], float* sw, int lane) {
  const int l16 = lane & 15, quad = lane >> 4;
  __builtin_amdgcn_wave_barrier();
#pragma unroll
  for (int ni = 0; ni < 4; ni++)
#pragma unroll
    for (int j = 0; j < 4; j++) sw[(quad * 4 + j) * 68 + ni * 16 + l16] = v[ni][j];
  __builtin_amdgcn_wave_barrier();
  const f32x4* rp = (const f32x4*)(sw + (lane >> 2) * 68 + (lane & 3) * 16);
#pragma unroll
  for (int c = 0; c < 4; c++) { f32x4 t = rp[c]; r[4 * c] = t[0]; r[4 * c + 1] = t[1]; r[4 * c + 2] = t[2]; r[4 * c + 3] = t[3]; }
}
DEV void st_bf16x16(bfu* dst, const float (&r)[16]) {
  u32x4 a = {pack2(r[0], r[1]), pack2(r[2], r[3]), pack2(r[4], r[5]), pack2(r[6], r[7])};
  u32x4 b = {pack2(r[8], r[9]), pack2(r[10], r[11]), pack2(r[12], r[13]), pack2(r[14], r[15])};
  *(u32x4*)dst = a; *(u32x4*)(dst + 8) = b;
}
DEV void ld_bf16x16(const bfu* src, float (&r)[16]) {
  u32x4 a = *(const u32x4*)src, b = *(const u32x4*)(src + 8);
#pragma unroll
  for (int i = 0; i < 4; i++) { r[2 * i] = bflo(a[i]); r[2 * i + 1] = bfhi(a[i]); r[8 + 2 * i] = bflo(b[i]); r[9 + 2 * i] = bfhi(b[i]); }
}
DEV void st_f32x16(float* dst, const float (&r)[16]) {
#pragma unroll
  for (int c = 0; c < 4; c++) *(f32x4*)(dst + 4 * c) = f32x4{r[4 * c], r[4 * c + 1], r[4 * c + 2], r[4 * c + 3]};
}

DEV void transpose_tile(const float* src, int ldsrc, int srccol0, int validcols, const float* scale,
                        bfu* dst, int lddst, int n0, int k0, float* sT) {
  const int tid = threadIdx.x;
  __syncthreads();
#pragma unroll
  for (int i = 0; i < 4; i++) {
    int kk = (tid >> 4) + i * 16, c = (tid & 15) * 4;
    float4 v = make_float4(0.f, 0.f, 0.f, 0.f);
    if (c < validcols) v = *(const float4*)(src + (size_t)(k0 + kk) * ldsrc + srccol0 + c);
    float s = scale ? scale[k0 + kk] : 1.f;
    sT[kk * 65 + c] = v.x * s; sT[kk * 65 + c + 1] = v.y * s; sT[kk * 65 + c + 2] = v.z * s; sT[kk * 65 + c + 3] = v.w * s;
  }
  __syncthreads();
  int n = tid >> 2, kc = (tid & 3) * 16;
  unsigned o[8];
#pragma unroll
  for (int e = 0; e < 8; e++) o[e] = pack2(sT[(kc + 2 * e) * 65 + n], sT[(kc + 2 * e + 1) * 65 + n]);
  uint4* d = (uint4*)(dst + (size_t)(n0 + n) * lddst + k0 + kc);
  d[0] = make_uint4(o[0], o[1], o[2], o[3]); d[1] = make_uint4(o[4], o[5], o[6], o[7]);
}

DEV void phase0(const Params& p, int bid, int nb, char* smem) {
  const int tid = threadIdx.x, lane = tid & 63, w = tid >> 6;
  constexpr int N_X = TT / 4, N_TW = 106 * 16, N_TR = 256, N_TF = 128, N_TO = 256, N_MT = 512;
  constexpr int B1 = N_X, B2 = B1 + N_TW, B3 = B2 + N_TR, B4 = B3 + N_TF, B5 = B4 + N_TO, TOT = B5 + N_MT;
  bfu* xb = (bfu*)(p.ws + OFF_XB); float* rstd1 = (float*)(p.ws + OFF_RSTD1);
  for (int it = bid; it < TOT; it += nb) {
    if (it < B1) {
      int row = it * 4 + w;
      const float* src = row < TP ? p.x_p + (size_t)row * DM : p.x_s + (size_t)(row - TP) * DM;
      float4 a0 = *(const float4*)(src + lane * 8), a1 = *(const float4*)(src + lane * 8 + 4);
      float4 b0 = *(const float4*)(src + 512 + lane * 8), b1 = *(const float4*)(src + 512 + lane * 8 + 4);
      float ss = a0.x * a0.x + a0.y * a0.y + a0.z * a0.z + a0.w * a0.w + a1.x * a1.x + a1.y * a1.y + a1.z * a1.z + a1.w * a1.w +
                 b0.x * b0.x + b0.y * b0.y + b0.z * b0.z + b0.w * b0.w + b1.x * b1.x + b1.y * b1.y + b1.z * b1.z + b1.w * b1.w;
      ss = wave_sum(ss);
      if (lane == 0) rstd1[row] = rsqrtf(ss * (1.f / DM) + EPSN);
      *(uint4*)(xb + (size_t)row * DM + lane * 8) = make_uint4(pack2(a0.x, a0.y), pack2(a0.z, a0.w), pack2(a1.x, a1.y), pack2(a1.z, a1.w));
      *(uint4*)(xb + (size_t)row * DM + 512 + lane * 8) = make_uint4(pack2(b0.x, b0.y), pack2(b0.z, b0.w), pack2(b1.x, b1.y), pack2(b1.z, b1.w));
    } else if (it < B2) {
      int j = it - B1; int nt = j >> 4, kt = j & 15; int n0 = nt * 64;
      int sc0, vc;
      if (n0 < 4608) { sc0 = n0; vc = 64; } else if (n0 < 6656) { sc0 = n0 + 8; vc = 64; } else if (n0 == 6656) { sc0 = 4608; vc = 8; } else { sc0 = 0; vc = 0; }
      transpose_tile(p.w_in, 6664, sc0, vc, p.norm1_g, (bfu*)(p.ws + OFF_WINT), DM, n0, kt * 64, (float*)smem);
    } else if (it < B3) {
      int j = it - B2; transpose_tile(p.w_ret_out, 1024, (j >> 4) * 64, 64, nullptr, (bfu*)(p.ws + OFF_WRT), 1024, (j >> 4) * 64, (j & 15) * 64, (float*)smem);
    } else if (it < B4) {
      int j = it - B3; transpose_tile(p.w_fox_out, 1024, (j >> 3) * 64, 64, nullptr, (bfu*)(p.ws + OFF_WFT), 512, (j >> 3) * 64, (j & 7) * 64, (float*)smem);
    } else if (it < B5) {
      int j = it - B4; transpose_tile(p.w_o, 1024, (j >> 4) * 64, 64, nullptr, (bfu*)(p.ws + OFF_WOT), 1024, (j >> 4) * 64, (j & 15) * 64, (float*)smem);
    } else {
      int j = it - B5; int hh = j >> 5, kt = (j >> 4) & 1, dt = j & 15;
      float* sW = (float*)smem; float* sK = sW + 64 * 129;
      const float* ksub = (hh & 1) ? p.k2 : p.k1;
      __syncthreads();
#pragma unroll
      for (int i = 0; i < 8; i++) {
        int id = tid + i * 256; int row = id >> 5, c4 = (id & 31) * 4;
        float4 v = *(const float4*)(p.peer_wq + (size_t)(dt * 64 + row) * 2048 + hh * 128 + c4);
        sW[row * 129 + c4] = v.x; sW[row * 129 + c4 + 1] = v.y; sW[row * 129 + c4 + 2] = v.z; sW[row * 129 + c4 + 3] = v.w;
        float4 u = *(const float4*)(ksub + (size_t)(kt * 64 + row) * 128 + c4);
        sK[row * 129 + c4] = u.x; sK[row * 129 + c4 + 1] = u.y; sK[row * 129 + c4 + 2] = u.z; sK[row * 129 + c4 + 3] = u.w;
      }
      __syncthreads();
      int ky = (tid >> 4) * 4, dd = (tid & 15) * 4;
      float a[4][4];
#pragma unroll
      for (int i = 0; i < 4; i++)
#pragma unroll
        for (int jj = 0; jj < 4; jj++) a[i][jj] = 0.f;
      for (int c = 0; c < 128; c++) {
        float kv[4], wv[4];
#pragma unroll
        for (int i = 0; i < 4; i++) { kv[i] = sK[(ky + i) * 129 + c]; wv[i] = sW[(dd + i) * 129 + c]; }
#pragma unroll
        for (int i = 0; i < 4; i++)
#pragma unroll
          for (int jj = 0; jj < 4; jj++) a[i][jj] += kv[i] * wv[jj];
      }
      bfu* MT = (bfu*)(p.ws + OFF_MT);
      float g0 = p.norm2_g[dt * 64 + dd], g1 = p.norm2_g[dt * 64 + dd + 1], g2 = p.norm2_g[dt * 64 + dd + 2], g3 = p.norm2_g[dt * 64 + dd + 3];
#pragma unroll
      for (int i = 0; i < 4; i++)
        *(uint2*)(MT + (size_t)(hh * 128 + kt * 64 + ky + i) * DM + dt * 64 + dd) = make_uint2(pack2(a[i][0] * g0, a[i][1] * g1), pack2(a[i][2] * g2, a[i][3] * g3));
    }
  }
}

DEV void rot_angle(int pos, int d, float& cs, float& sn) {
  float inv = exp2f(-(float)d * (13.287712379549449f / 32.f));
  float ang = (float)pos * inv;
  float rev = ang * 0.15915494309189535f;
  rev = rev - floorf(rev);
  sn = __builtin_amdgcn_sinf(rev); cs = __builtin_amdgcn_cosf(rev);
}

DEV void phase1(const Params& p, int bid, int nb, char* smem, bool noepi = false) {
  bfu* sA = (bfu*)smem; bfu* sB = sA + 128 * 72;
  const bfu* XB = (const bfu*)(p.ws + OFF_XB); const bfu* WT = (const bfu*)(p.ws + OFF_WINT);
  const float* rstd1 = (const float*)(p.ws + OFF_RSTD1);
  constexpr int NT = NWP / 128;
  const int xcd = bid & 7, slot = bid >> 3, nslots = (nb + 7 - xcd) >> 3;
  constexpr int MI1 = 8;
  const int nprompt = 16 * NT;
  const int n_p = slot < nprompt ? (nprompt - slot + nslots - 1) / nslots : 0;
  const int n_s = bid < 2 * NT ? (2 * NT - bid + nb - 1) / nb : 0;
  for (int i_ = 0; i_ < n_p + n_s; i_++) {
    int mt, nt;
    if (i_ < n_p) { int q = slot + i_ * nslots; int sub = q / (8 * NT), rem = q - sub * (8 * NT); nt = rem >> 3; mt = xcd * 16 + sub * 8 + (rem & 7); }
    else { int it = bid + (i_ - n_p) * nb; mt = 128 + it / NT; nt = it - (it / NT) * NT; }
    int m0 = mt * 256, n0 = nt * 128;
    int tid = threadIdx.x; asm volatile("" : "+v"(tid));
    const int lane = tid & 63, w = tid >> 6, wr = w >> 1, wc = w & 1, l16 = lane & 15, quad = lane >> 4;
    f32x4 acc[MI1][4];
#pragma unroll
    for (int i = 0; i < MI1; i++)
#pragma unroll
      for (int j = 0; j < 4; j++) acc[i][j] = f32x4{0.f, 0.f, 0.f, 0.f};
    gemm_loop_sb<MI1, 4>(XB + (size_t)m0 * DM, DM, WT + (size_t)n0 * DM, DM, DM, acc, sA);
    if (noepi) { float t_ = 0.f;
#pragma unroll
      for (int i = 0; i < MI1; i++)
#pragma unroll
        for (int j = 0; j < 4; j++) t_ += acc[i][j][0] + acc[i][j][1] + acc[i][j][2] + acc[i][j][3];
      if (t_ == 12345.678f) p.out[0] = 1.f; continue; }
    const int rbase = m0 + wr * (MI1 * 16) + quad * 4;
    const int cbase = n0 + wc * 64 + l16;
    if (m0 >= TP) {
      float* hs = (float*)(p.ws + OFF_HS);
      bfu* gaS = (bfu*)(p.out + O_YS); bfu* gbS = gaS + (size_t)TS * DM;
#pragma unroll
      for (int mi = 0; mi < MI1; mi++)
#pragma unroll
        for (int j = 0; j < 4; j++) {
          int row = rbase + mi * 16 + j; float rs = rstd1[row]; int sr = row - TP;
#pragma unroll
          for (int ni = 0; ni < 4; ni++) {
            int col = cbase + ni * 16; float v = acc[mi][ni][j] * rs;
            if (n0 >= 4608 && n0 < 5632) gaS[(size_t)sr * DM + col - 4608] = f2bf(v);
            else if (n0 >= 5632 && n0 < 6656) gbS[(size_t)sr * DM + col - 5632] = f2bf(v);
            else hs[(size_t)sr * NWP + col] = v;
          }
        }
      continue;
    }
    const int b = m0 >> 14;
    float* sw = (float*)(smem + EPI_OFF) + w * EPI_WAVE;
    const int rrow = m0 + wr * (MI1 * 16) + (lane >> 2);
    const int rcol = (lane & 3) * 16;
    if (n0 < 1024) {
      const int isK = n0 >= 512; const int head = ((n0 & 511) >> 6) + wc;
      const float l2g = l2gamma(head);
      bfu* dst = (bfu*)(p.ws + (isK ? OFF_KT : OFF_QT));
      bfu* ktT = (bfu*)(p.ws + OFF_KTT);
#pragma unroll
      for (int mi = 0; mi < MI1; mi++) {
        f32x4 tv[4];
#pragma unroll
        for (int ni = 0; ni < 2; ni++) {
          int d = ni * 16 + l16;
          float y1[4], y2[4];
#pragma unroll
          for (int j = 0; j < 4; j++) {
            int row = rbase + mi * 16 + j; int t = row & (SEQ - 1); int l = t & (RC - 1);
            float rs = rstd1[row];
            float dec = exp2f((float)(l + 1) * l2g);
            float sc = isK ? 0.125f / dec : dec;
            float cs, sn; rot_angle(t, d, cs, sn);
            float x1 = acc[mi][ni][j] * rs, x2 = acc[mi][ni + 2][j] * rs;
            y1[j] = (x1 * cs - x2 * sn) * sc; y2[j] = (x2 * cs + x1 * sn) * sc;
            tv[ni][j] = y1[j]; tv[ni + 2][j] = y2[j];
          }
          if (isK) {
            int t0 = (rbase + mi * 16) & (SEQ - 1);
            *(uint2*)(ktT + ((size_t)((b * 8 + head) * 64 + d)) * SEQ + t0) = make_uint2(pack2(y1[0], y1[1]), pack2(y1[2], y1[3]));
            *(uint2*)(ktT + ((size_t)((b * 8 + head) * 64 + d + 32)) * SEQ + t0) = make_uint2(pack2(y2[0], y2[1]), pack2(y2[2], y2[3]));
          }
        }
        { float r[16]; to_rows(tv, r, sw, lane); int rr_ = rrow; asm volatile("" : "+v"(rr_));
          st_bf16x16(dst + (size_t)(rr_ + mi * 16) * 512 + head * 64 + rcol, r); }
      }
    } else if (n0 < 2048) {
      const int head = (n0 - 1024) >> 7;
      bfu* vT = (bfu*)(p.ws + OFF_VT);
#pragma unroll
      for (int mi = 0; mi < MI1; mi++) {
        int row0 = rbase + mi * 16; int t0 = row0 & (SEQ - 1);
        float r0 = rstd1[row0], r1 = rstd1[row0 + 1], r2 = rstd1[row0 + 2], r3 = rstd1[row0 + 3];
#pragma unroll
        for (int ni = 0; ni < 4; ni++) {
          int dv = wc * 64 + ni * 16 + l16;
          *(uint2*)(vT + ((size_t)((b * 8 + head) * 128 + dv)) * SEQ + t0) =
              make_uint2(pack2(acc[mi][ni][0] * r0, acc[mi][ni][1] * r1), pack2(acc[mi][ni][2] * r2, acc[mi][ni][3] * r3));
        }
      }
    } else if (n0 < 3072 || (n0 >= 4608 && n0 < 6656)) {
      bfu* dst; int c0;
      if (n0 < 3072) { dst = (bfu*)(p.ws + OFF_RG); c0 = 2048; }
      else if (n0 < 5632) { dst = (bfu*)(p.out + O_YP); c0 = 4608; }
      else { dst = (bfu*)(p.out + O_YP) + (size_t)TP * DM; c0 = 5632; }
#pragma unroll
      for (int mi = 0; mi < MI1; mi++) {
        f32x4 tv[4];
#pragma unroll
        for (int j = 0; j < 4; j++) {
          int row = rbase + mi * 16 + j; float rs = rstd1[row];
#pragma unroll
          for (int ni = 0; ni < 4; ni++) tv[ni][j] = acc[mi][ni][j] * rs;
        }
        float r[16]; to_rows(tv, r, sw, lane); int rr_ = rrow; asm volatile("" : "+v"(rr_));
        st_bf16x16(dst + (size_t)(rr_ + mi * 16) * DM + (n0 - c0) + wc * 64 + rcol, r);
      }
    } else if (n0 < 4096) {
      const int isK = n0 >= 3584; const int head = (((n0 - 3072) & 511) >> 6) + wc;
      const float* g = isK ? p.fk_g : p.fq_g;
      float gv[4];
#pragma unroll
      for (int ni = 0; ni < 4; ni++) gv[ni] = g[ni * 16 + l16];
      bfu* fq = (bfu*)(p.ws + OFF_FQ); bfu* fkb = (bfu*)(p.ws + OFF_FKB);
#pragma unroll
      for (int mi = 0; mi < MI1; mi++) {
        f32x4 tv[4];
#pragma unroll
        for (int j = 0; j < 4; j++) {
          int row = rbase + mi * 16 + j; float rs = rstd1[row];
          float v[4]; float ss = 0.f;
#pragma unroll
          for (int ni = 0; ni < 4; ni++) { v[ni] = acc[mi][ni][j] * rs; ss += v[ni] * v[ni]; }
          ss = sum16(ss);
          float r = rsqrtf(ss * (1.f / 64.f) + EPSN) * (isK ? 1.f : 0.125f * LOG2E);
#pragma unroll
          for (int ni = 0; ni < 4; ni++) tv[ni][j] = v[ni] * r * gv[ni];
        }
        float r[16]; to_rows(tv, r, sw, lane); int rr_ = rrow; asm volatile("" : "+v"(rr_));
        const size_t o = (size_t)(rr_ + mi * 16) * 512 + head * 64 + rcol;
        if (isK) { st_f32x16(p.out + O_FKP + o, r); st_bf16x16(fkb + o, r); }
        else st_bf16x16(fq + o, r);
      }
    } else if (n0 < 4608) {
      const int head = ((n0 - 4096) >> 6) + wc;
      bfu* fvT = (bfu*)(p.ws + OFF_FVT);
#pragma unroll
      for (int mi = 0; mi < MI1; mi++) {
        int row0 = rbase + mi * 16; int t0 = row0 & (SEQ - 1);
        float r[4] = {rstd1[row0], rstd1[row0 + 1], rstd1[row0 + 2], rstd1[row0 + 3]};
        f32x4 tv[4];
#pragma unroll
        for (int ni = 0; ni < 4; ni++) {
          int d = ni * 16 + l16; float v[4];
#pragma unroll
          for (int j = 0; j < 4; j++) { v[j] = acc[mi][ni][j] * r[j]; tv[ni][j] = v[j]; }
          *(uint2*)(fvT + ((size_t)((b * 8 + head) * 64 + d)) * SEQ + t0) = make_uint2(pack2(v[0], v[1]), pack2(v[2], v[3]));
        }
        { float rw[16]; to_rows(tv, rw, sw, lane); int rr_ = rrow; asm volatile("" : "+v"(rr_));
          st_f32x16(p.out + O_FVP + (size_t)(rr_ + mi * 16) * 512 + head * 64 + rcol, rw); }
      }
    } else {
      if (wc == 0 && l16 < 8) {
        float bf = p.b_f[l16];
#pragma unroll
        for (int mi = 0; mi < MI1; mi++)
#pragma unroll
          for (int j = 0; j < 4; j++) {
            int row = rbase + mi * 16 + j;
            float z = acc[mi][0][j] * rstd1[row] + bf;
            p.out[O_LFP + (size_t)row * 8 + l16] = fminf(z, 0.f) - log1pf(__expf(-fabsf(z)));
          }
      }
    }
  }
}

DEV void phase2(const Params& p, int bid, int nb, char* smem) {
  const int tid = threadIdx.x, lane = tid & 63, w = tid >> 6, wr = w >> 1, wc = w & 1, l16 = lane & 15, quad = lane >> 4;
  bfu* sA = (bfu*)smem; bfu* sB = sA + 128 * 72;
  const bfu* vT = (const bfu*)(p.ws + OFF_VT); const bfu* ktT = (const bfu*)(p.ws + OFF_KTT);
  float* U = (float*)(p.ws + OFF_XB);
  constexpr int NR1 = 16 * NCH;
  for (int it = bid; it < NR1 + 16; it += nb) {
    if (it < 16) {
      int bh = it, b = bh >> 3, h = bh & 7;
      double* sd = (double*)smem;
      const float* lf = p.out + O_LFP + (size_t)b * SEQ * 8 + h;
      float part = 0.f;
      for (int i = 0; i < 64; i++) part += lf[(size_t)(tid * 64 + i) * 8];
      __syncthreads();
      sd[tid] = (double)part;
      __syncthreads();
      if (tid == 0) { double run = 0.0; for (int i = 0; i < 256; i++) { double v = sd[i]; sd[i] = run; run += v; } }
      __syncthreads();
      double run = sd[tid];
      float* c2 = (float*)(p.ws + OFF_C2) + (size_t)bh * SEQ;
      for (int i = 0; i < 64; i++) { run += (double)lf[(size_t)(tid * 64 + i) * 8]; c2[tid * 64 + i] = (float)(run * (double)LOG2E); }
      __syncthreads();
    } else {
      int j = it - 16; int bh = j / NCH, c = j - bh * NCH;
      f32x4 acc[4][2];
#pragma unroll
      for (int i = 0; i < 4; i++) { acc[i][0] = f32x4{0.f, 0.f, 0.f, 0.f}; acc[i][1] = f32x4{0.f, 0.f, 0.f, 0.f}; }
      gemm_loop<4, 2>(vT + (size_t)bh * 128 * SEQ + c * RC, SEQ, ktT + (size_t)bh * 64 * SEQ + c * RC, SEQ, RC, acc, sA);
      float gC = exp2f((float)RC * l2gamma(bh & 7));
      float* Uo = U + (size_t)j * 8192;
#pragma unroll
      for (int mi = 0; mi < 4; mi++)
#pragma unroll
        for (int ni = 0; ni < 2; ni++)
#pragma unroll
          for (int jj = 0; jj < 4; jj++) {
            int dv = wr * 64 + mi * 16 + quad * 4 + jj, dk = wc * 32 + ni * 16 + l16;
            Uo[dv * 64 + dk] = acc[mi][ni][jj] * gC;
          }
    }
  }
}

DEV void sample_item(const Params& p, int item, char* smem) {
  int tid = threadIdx.x; asm volatile("" : "+v"(tid));
  const int b = item >> 3, h = item & 7;
  float* sq = (float*)smem;
  float* sk = sq + 1024;
  float* sv = sk + 1024;
  float* sP = sv + 2048;
  float* so = sP + 256;
  float* sr = so + 2048;
  float* sc = (float*)smem;
  float* fq = (float*)(smem + 34816);
  float* fk = fq + 1024;
  float* cn = fk + 1024;
  float* suf = cn + 16;
  float* red = suf + 1024;
  float* sL = red + 256;
  float* pvr = sL + 16;
  const float* hs = (const float*)(p.ws + OFF_HS) + (size_t)b * 16 * NWP;
  const float l2g = l2gamma(h);
  __syncthreads();
  for (int i = tid; i < 512; i += 256) {
    int l = i >> 5, d = i & 31; float cs, sn; rot_angle(1024 + l, d, cs, sn);
    float dec = exp2f((float)(l + 1) * l2g);
    const float* r = hs + (size_t)l * NWP;
    float x1 = r[h * 64 + d], x2 = r[h * 64 + d + 32];
    sq[l * 64 + d] = (x1 * cs - x2 * sn) * dec; sq[l * 64 + d + 32] = (x2 * cs + x1 * sn) * dec;
    x1 = r[512 + h * 64 + d]; x2 = r[512 + h * 64 + d + 32];
    float sc_ = 0.125f / dec;
    sk[l * 64 + d] = (x1 * cs - x2 * sn) * sc_; sk[l * 64 + d + 32] = (x2 * cs + x1 * sn) * sc_;
  }
  for (int i = tid; i < 2048; i += 256) { int l = i >> 7, dv = i & 127; sv[i] = hs[(size_t)l * NWP + 1024 + h * 128 + dv]; }
  __syncthreads();
  { int l = tid >> 4, m = tid & 15; float a = 0.f;
    if (l >= m) for (int d = 0; d < 64; d++) a += sq[l * 64 + d] * sk[m * 64 + d];
    sP[tid] = a; }
  __syncthreads();
  const float* S = p.state_ret + (size_t)(b * 8 + h) * 8192;
  { int dv = tid & 127, lh = tid >> 7; float o[8];
#pragma unroll
    for (int i = 0; i < 8; i++) o[i] = 0.f;
#pragma unroll 16
    for (int dk = 0; dk < 64; dk++) { float s = S[dk * 128 + dv];
#pragma unroll
      for (int i = 0; i < 8; i++) o[i] += sq[(lh * 8 + i) * 64 + dk] * s; }
    for (int m = 0; m < 16; m++) { float v = sv[m * 128 + dv];
#pragma unroll
      for (int i = 0; i < 8; i++) o[i] += sP[(lh * 8 + i) * 16 + m] * v; }
#pragma unroll
    for (int i = 0; i < 8; i++) so[(lh * 8 + i) * 128 + dv] = o[i];
    float g16 = exp2f(16.f * l2g);
    float* So = p.out + O_SS + (size_t)(b * 8 + h) * 8192;
#pragma unroll 8
    for (int i = 0; i < 32; i++) { int dk = lh * 32 + i; float a = S[dk * 128 + dv];
      for (int m = 0; m < 16; m++) a += sk[m * 64 + dk] * sv[m * 128 + dv];
      So[dk * 128 + dv] = a * g16; }
  }
  __syncthreads();
  if (tid < 16) { float ss = 0.f; for (int i = 0; i < 128; i++) { float v = so[tid * 128 + i]; ss += v * v; } sr[tid] = rsqrtf(ss * (1.f / 128.f) + EPSN); }
  __syncthreads();
  { int dv = tid & 127, lh = tid >> 7; bfu* gated = (bfu*)(p.ws + OFF_RG);
    float gg = p.gn_g[h * 128 + dv];
    for (int i = 0; i < 8; i++) { int l = lh * 8 + i; float rgv = hs[(size_t)l * NWP + 2048 + h * 128 + dv];
      float v = so[l * 128 + dv] * sr[l] * gg * (rgv * sigmoidf_(rgv));
      gated[(size_t)(TP + b * 16 + l) * DM + h * 128 + dv] = f2bf(v); } }
  {
    int l = tid >> 4, dl = tid & 15; const float* r = hs + (size_t)l * NWP;
    float qv[4], kv[4]; float sq_ = 0.f, sk_ = 0.f;
#pragma unroll
    for (int i = 0; i < 4; i++) { qv[i] = r[3072 + h * 64 + dl * 4 + i]; kv[i] = r[3584 + h * 64 + dl * 4 + i]; sq_ += qv[i] * qv[i]; sk_ += kv[i] * kv[i]; }
    sq_ = sum16(sq_); sk_ = sum16(sk_);
    float rq = rsqrtf(sq_ * (1.f / 64.f) + EPSN), rk = rsqrtf(sk_ * (1.f / 64.f) + EPSN);
#pragma unroll
    for (int i = 0; i < 4; i++) { int d = dl * 4 + i;
      fq[l * 64 + d] = qv[i] * rq * p.fq_g[d] * 0.125f;
      float kk = kv[i] * rk * p.fk_g[d]; fk[l * 64 + d] = kk;
      p.out[O_FKS + (size_t)((b * 16 + l) * 8 + h) * 64 + d] = kk;
      p.out[O_FVS + (size_t)((b * 16 + l) * 8 + h) * 64 + d] = r[4096 + h * 64 + d]; }
  }
  if (tid < 16) { float z = hs[(size_t)tid * NWP + 6656 + h] + p.b_f[h]; float lf = fminf(z, 0.f) - log1pf(__expf(-fabsf(z)));
    p.out[O_LFS + (size_t)(b * 16 + tid) * 8 + h] = lf; cn[tid] = lf; }
  { const float* cl = p.clogf + (size_t)b * 1024 * 8 + h; float v[4]; float part = 0.f;
#pragma unroll
    for (int i = 0; i < 4; i++) { v[i] = cl[(size_t)(tid * 4 + i) * 8]; part += v[i]; }
    float inc = part;
#pragma unroll
    for (int o = 1; o < 64; o <<= 1) { float t = __shfl_down(inc, o); if ((tid & 63) + o < 64) inc += t; }
    if ((tid & 63) == 0) red[tid >> 6] = inc;
    __syncthreads();
    if (tid == 0) { float c = 0.f; for (int i = 0; i < 16; i++) { c += cn[i]; cn[i] = c; } }
    float later = 0.f;
    for (int ww = (tid >> 6) + 1; ww < 4; ww++) later += red[ww];
    __syncthreads();
    float run = inc - part + later;
    for (int i = 3; i >= 0; i--) { suf[tid * 4 + i] = run; run += v[i]; }
  }
  __syncthreads();
  const float* CK = p.ck + (size_t)b * 1024 * 512 + h * 64; const float* CV = p.cv + (size_t)b * 1024 * 512 + h * 64;
  for (int pass = 0; pass < 2; pass++) {
    __syncthreads();
    for (int j = tid; j < 1040; j += 256) {
      float a[8];
#pragma unroll
      for (int qi = 0; qi < 8; qi++) a[qi] = 0.f;
      if (j < 1024) {
        const f32x4* kp = (const f32x4*)(CK + (size_t)j * 512);
        f32x4 tt[16];
#pragma unroll
        for (int i = 0; i < 16; i++) tt[i] = kp[i];
#pragma unroll
        for (int i = 0; i < 16; i++) { f32x4 t = tt[i];
#pragma unroll
          for (int qi = 0; qi < 8; qi++) { const float* qq = fq + (pass * 8 + qi) * 64 + i * 4; a[qi] += qq[0] * t[0] + qq[1] * t[1] + qq[2] * t[2] + qq[3] * t[3]; } }
      } else {
        const float* kp = fk + (j - 1024) * 64;
#pragma unroll 4
        for (int i = 0; i < 64; i++) { float t = kp[i];
#pragma unroll
          for (int qi = 0; qi < 8; qi++) a[qi] += fq[(pass * 8 + qi) * 64 + i] * t; }
      }
#pragma unroll
      for (int qi = 0; qi < 8; qi++) { int q = pass * 8 + qi;
        float bias;
        if (j < 1024) bias = suf[j] + cn[q]; else { int m = j - 1024; bias = (m <= q) ? (cn[q] - cn[m]) : -INFINITY; }
        sc[qi * 1040 + j] = a[qi] + bias; }
    }
    __syncthreads();
    { int qi = tid >> 5, l32 = tid & 31; float m = -INFINITY;
      for (int j = l32; j < 1040; j += 32) m = fmaxf(m, sc[qi * 1040 + j]);
#pragma unroll
      for (int o = 16; o >= 1; o >>= 1) m = fmaxf(m, __shfl_xor(m, o));
      float s = 0.f;
      for (int j = l32; j < 1040; j += 32) { float e = __expf(sc[qi * 1040 + j] - m); sc[qi * 1040 + j] = e; s += e; }
#pragma unroll
      for (int o = 16; o >= 1; o >>= 1) s += __shfl_xor(s, o);
      if (l32 == 0) sL[qi] = s; }
    __syncthreads();
    {
      const int kg = tid >> 4, d4 = (tid & 15) * 4;
      float ac[8][4];
#pragma unroll
      for (int qi = 0; qi < 8; qi++) { ac[qi][0] = 0.f; ac[qi][1] = 0.f; ac[qi][2] = 0.f; ac[qi][3] = 0.f; }
#pragma unroll 8
      for (int i = 0; i < 64; i++) { int j = kg + 16 * i;
        float4 v = *(const float4*)(CV + (size_t)j * 512 + d4);
#pragma unroll
        for (int qi = 0; qi < 8; qi++) { float pj = sc[qi * 1040 + j]; ac[qi][0] += pj * v.x; ac[qi][1] += pj * v.y; ac[qi][2] += pj * v.z; ac[qi][3] += pj * v.w; } }
      { const float* r = hs + (size_t)kg * NWP + 4096 + h * 64 + d4;
#pragma unroll
        for (int qi = 0; qi < 8; qi++) { float pj = sc[qi * 1040 + 1024 + kg]; ac[qi][0] += pj * r[0]; ac[qi][1] += pj * r[1]; ac[qi][2] += pj * r[2]; ac[qi][3] += pj * r[3]; } }
#pragma unroll
      for (int qi = 0; qi < 8; qi++)
#pragma unroll
        for (int c = 0; c < 4; c++) { float t = ac[qi][c]; t += __shfl_xor(t, 16); t += __shfl_xor(t, 32); ac[qi][c] = t; }
      if ((tid & 63) < 16) {
#pragma unroll
        for (int qi = 0; qi < 8; qi++)
#pragma unroll
          for (int c = 0; c < 4; c++) pvr[((tid >> 6) * 8 + qi) * 64 + d4 + c] = ac[qi][c];
      }
      __syncthreads();
      int qi = tid >> 5, d2 = (tid & 31) * 2;
      float a0 = pvr[(0 * 8 + qi) * 64 + d2] + pvr[(1 * 8 + qi) * 64 + d2] + pvr[(2 * 8 + qi) * 64 + d2] + pvr[(3 * 8 + qi) * 64 + d2];
      float a1 = pvr[(0 * 8 + qi) * 64 + d2 + 1] + pvr[(1 * 8 + qi) * 64 + d2 + 1] + pvr[(2 * 8 + qi) * 64 + d2 + 1] + pvr[(3 * 8 + qi) * 64 + d2 + 1];
      float inv = 1.f / sL[qi]; bfu* fo = (bfu*)(p.ws + OFF_FQ);
      *(unsigned*)(fo + (size_t)(TP + b * 16 + pass * 8 + qi) * 512 + h * 64 + d2) = pack2(a0 * inv, a1 * inv); }
  }
  __syncthreads();
}

DEV void peer_convert_item(const Params& p, int item) {
  const int tid = threadIdx.x, lane = tid & 63, w = tid >> 6;
  constexpr int NG = 0; const int it = item;
    {
      int r = (it - NG) * 4 + w;
      const float* src = r < 16384 ? p.peer_u + (size_t)r * DM : p.peer_v + (size_t)(r - 16384) * DM;
      float4 v0 = *(const float4*)(src + lane * 16), v1 = *(const float4*)(src + lane * 16 + 4), v2 = *(const float4*)(src + lane * 16 + 8), v3 = *(const float4*)(src + lane * 16 + 12);
      float am = fmaxf(fmaxf(fmaxf(fabsf(v0.x), fabsf(v0.y)), fmaxf(fabsf(v0.z), fabsf(v0.w))), fmaxf(fmaxf(fabsf(v1.x), fabsf(v1.y)), fmaxf(fabsf(v1.z), fabsf(v1.w))));
      am = fmaxf(am, fmaxf(fmaxf(fmaxf(fabsf(v2.x), fabsf(v2.y)), fmaxf(fabsf(v2.z), fabsf(v2.w))), fmaxf(fmaxf(fabsf(v3.x), fabsf(v3.y)), fmaxf(fabsf(v3.z), fabsf(v3.w)))));
#pragma unroll
      for (int o = 32; o >= 1; o >>= 1) am = fmaxf(am, __shfl_xor(am, o));
      float sc = am > 0.f ? 6.f / am : 1.f;
      unsigned w0 = 0, w1 = 0;
      w0 = __builtin_amdgcn_cvt_scalef32_pk_fp4_f32(w0, v0.x * sc, v0.y * sc, 1.0f, 0);
      w0 = __builtin_amdgcn_cvt_scalef32_pk_fp4_f32(w0, v0.z * sc, v0.w * sc, 1.0f, 1);
      w0 = __builtin_amdgcn_cvt_scalef32_pk_fp4_f32(w0, v1.x * sc, v1.y * sc, 1.0f, 2);
      w0 = __builtin_amdgcn_cvt_scalef32_pk_fp4_f32(w0, v1.z * sc, v1.w * sc, 1.0f, 3);
      w1 = __builtin_amdgcn_cvt_scalef32_pk_fp4_f32(w1, v2.x * sc, v2.y * sc, 1.0f, 0);
      w1 = __builtin_amdgcn_cvt_scalef32_pk_fp4_f32(w1, v2.z * sc, v2.w * sc, 1.0f, 1);
      w1 = __builtin_amdgcn_cvt_scalef32_pk_fp4_f32(w1, v3.x * sc, v3.y * sc, 1.0f, 2);
      w1 = __builtin_amdgcn_cvt_scalef32_pk_fp4_f32(w1, v3.z * sc, v3.w * sc, 1.0f, 3);
      u32x2* dst = (u32x2*)(p.ws + (r < 16384 ? OFF_PUB : OFF_PVB)) + (size_t)(r & 16383) * 64 + lane;
      *dst = u32x2{w0, w1};
      if (lane == 0) ((float*)(p.ws + OFF_PSC))[r] = am > 0.f ? am / 6.f : 1.f;
    }
}

DEV void phase3(const Params& p, int bid, int nb, char* smem) {
  const int tid = threadIdx.x;
  const float* U = (const float*)(p.ws + OFF_XB); bfu* SST = (bfu*)(p.ws + OFF_SST);
  { const int c0 = nb > 256 ? bid - 256 : bid, cs = nb > 256 ? nb - 256 : nb;
    if (c0 >= 0) for (int it = c0; it < 8192; it += cs) peer_convert_item(p, it); }
  for (int it = bid; it < 256 + 512; it += nb) {
    if (it < 256) { sample_item(p, it, smem); continue; }
    int g = (it - 256) * 256 + tid; int bh = g >> 13, e = g & 8191;
    float G = exp2f((float)RC * l2gamma(bh & 7));
    float s = 0.f;
    const float* Up = U + (size_t)bh * NCH * 8192 + e; bfu* Sp = SST + (size_t)bh * NCH * 8192 + e;
    Sp[0] = 0;
    for (int c0 = 0; c0 < NCH; c0 += 8) {
      float u[8];
#pragma unroll
      for (int i = 0; i < 8; i++) u[i] = Up[(size_t)(c0 + i) * 8192];
#pragma unroll
      for (int i = 0; i < 8; i++) { s = s * G + u[i]; if (c0 + i + 1 < NCH) Sp[(size_t)(c0 + i + 1) * 8192] = f2bf(s); }
    }
    int dv = e >> 6, dk = e & 63;
    p.out[O_SP + (size_t)bh * 8192 + dk * 128 + dv] = s;
  }
}

DEV void attn_item(const Params& p, int item, char* smem, float thr, bool dry) {
  const int tid = threadIdx.x, lane = tid & 63, w = tid >> 6, r32 = lane & 31, hi = lane >> 5;
  const int bh = item >> 7, qt = 127 - (item & 127);
  const int b = bh >> 3, h = bh & 7;
  const int q0 = qt * 128;
  bfu* sK = (bfu*)smem;
  bfu* sV = sK + 64 * 72;
  float* sC = (float*)(sV + 64 * 72);
  const float* c2 = (const float*)(p.ws + OFF_C2) + (size_t)bh * SEQ;
  bfu* FQ = (bfu*)(p.ws + OFF_FQ);
  const bfu* FKB = (const bfu*)(p.ws + OFF_FKB) + (size_t)b * SEQ * 512 + h * 64;
  const bfu* FVT = (const bfu*)(p.ws + OFF_FVT) + (size_t)bh * 64 * SEQ;
  const int jd0 = q0 >> 6;
  int pred = 0;
  if (tid < jd0) pred = (c2[q0] - c2[tid * 64 + 63]) < -thr;
  const int jstart = __syncthreads_count(pred);
  const int qrow = q0 + w * 32 + r32;
  bf16x8 qf[4];
  const bfu* qp = FQ + (size_t)(b * SEQ + qrow) * 512 + h * 64 + hi * 8;
#pragma unroll
  for (int d0 = 0; d0 < 4; d0++) qf[d0] = *(const bf16x8*)(qp + d0 * 16);
  const float cq = c2[qrow];
  float m = -INFINITY, lsum = 0.f;
  f32x16 o0, o1;
#pragma unroll
  for (int r = 0; r < 16; r++) { o0[r] = 0.f; o1[r] = 0.f; }
  u32x4 rk0, rk1, rv0, rv1; float rc = 0.f;
  const int srow = tid >> 3, sch = tid & 7;
#define ATT_GLOAD(j_) do { \
    rk0 = *(const u32x4*)(FKB + (size_t)((j_) * 64 + srow) * 512 + sch * 8); \
    rk1 = *(const u32x4*)(FKB + (size_t)((j_) * 64 + srow + 32) * 512 + sch * 8); \
    rv0 = *(const u32x4*)(FVT + (size_t)srow * SEQ + (j_) * 64 + sch * 8); \
    rv1 = *(const u32x4*)(FVT + (size_t)(srow + 32) * SEQ + (j_) * 64 + sch * 8); \
    if (tid < 64) rc = c2[(j_) * 64 + tid]; } while (0)
  ATT_GLOAD(jstart);
  for (int j = jstart; j <= jd0 + 1; j++) {
    __syncthreads();
    *(u32x4*)(sK + srow * 72 + sch * 8) = rk0; *(u32x4*)(sK + (srow + 32) * 72 + sch * 8) = rk1;
    *(u32x4*)(sV + srow * 72 + sch * 8) = rv0; *(u32x4*)(sV + (srow + 32) * 72 + sch * 8) = rv1;
    if (tid < 64) sC[tid] = rc;
    __syncthreads();
    if (j < jd0 + 1) ATT_GLOAD(j + 1);
    if (j * 64 > q0 + w * 32 + 31) continue;
    f32x16 s0, s1;
#pragma unroll
    for (int r = 0; r < 16; r++) { s0[r] = 0.f; s1[r] = 0.f; }
#pragma unroll
    for (int d0 = 0; d0 < 4; d0++) {
      bf16x8 k0 = *(const bf16x8*)(sK + r32 * 72 + d0 * 16 + hi * 8);
      bf16x8 k1 = *(const bf16x8*)(sK + (32 + r32) * 72 + d0 * 16 + hi * 8);
      s0 = __builtin_amdgcn_mfma_f32_32x32x16_bf16(k0, qf[d0], s0, 0, 0, 0);
      s1 = __builtin_amdgcn_mfma_f32_32x32x16_bf16(k1, qf[d0], s1, 0, 0, 0);
    }
    const bool diag = (j >= jd0);
    const int kbase = j * 64 + 4 * hi;
    float mloc = -INFINITY;
#pragma unroll
    for (int g = 0; g < 4; g++) {
      float4 c0 = *(const float4*)(sC + 8 * g + 4 * hi), c1 = *(const float4*)(sC + 32 + 8 * g + 4 * hi);
      float cc0[4] = {c0.x, c0.y, c0.z, c0.w}, cc1[4] = {c1.x, c1.y, c1.z, c1.w};
#pragma unroll
      for (int e = 0; e < 4; e++) {
        int r = g * 4 + e;
        float a = s0[r] + (cq - cc0[e]), bb = s1[r] + (cq - cc1[e]);
        if (diag) { int key = kbase + 8 * g + e; if (key > qrow) a = -INFINITY; if (key + 32 > qrow) bb = -INFINITY; }
        s0[r] = a; s1[r] = bb; mloc = fmaxf(mloc, fmaxf(a, bb));
      }
    }
    mloc = fmaxf(mloc, __shfl_xor(mloc, 32));
    float mn = fmaxf(m, mloc);
    float alpha = __builtin_amdgcn_exp2f(m - mn);
    m = mn;
    float ps = 0.f;
#pragma unroll
    for (int r = 0; r < 16; r++) { s0[r] = __builtin_amdgcn_exp2f(s0[r] - mn); s1[r] = __builtin_amdgcn_exp2f(s1[r] - mn); ps += s0[r] + s1[r]; }
    lsum = lsum * alpha + ps;
#pragma unroll
    for (int r = 0; r < 16; r++) { o0[r] *= alpha; o1[r] *= alpha; }
#pragma unroll
    for (int ks = 0; ks < 4; ks++) {
      union { bf16x8 v; unsigned u[4]; } pf;
#pragma unroll
      for (int e = 0; e < 4; e++) {
        int r = (ks & 1) * 8 + 2 * e;
        pf.u[e] = (ks < 2) ? pack2(s0[r], s0[r + 1]) : pack2(s1[r], s1[r + 1]);
      }
#pragma unroll
      for (int db = 0; db < 2; db++) {
        const bfu* vp = sV + (db * 32 + r32) * 72 + ks * 16 + 4 * hi;
        union { bf16x8 v; uint2 u[2]; } vf;
        vf.u[0] = *(const uint2*)vp; vf.u[1] = *(const uint2*)(vp + 8);
        if (db == 0) o0 = __builtin_amdgcn_mfma_f32_32x32x16_bf16(vf.v, pf.v, o0, 0, 0, 0);
        else o1 = __builtin_amdgcn_mfma_f32_32x32x16_bf16(vf.v, pf.v, o1, 0, 0, 0);
      }
    }
  }
  float lt = lsum + __shfl_xor(lsum, 32);
  float inv = 1.f / lt;
  bfu* op = (dry ? (bfu*)(p.ws + OFF_XB) : FQ) + (size_t)(b * SEQ + qrow) * 512 + h * 64;
#pragma unroll
  for (int g = 0; g < 4; g++) {
    *(uint2*)(op + 8 * g + 4 * hi) = make_uint2(pack2(o0[g * 4] * inv, o0[g * 4 + 1] * inv), pack2(o0[g * 4 + 2] * inv, o0[g * 4 + 3] * inv));
    *(uint2*)(op + 32 + 8 * g + 4 * hi) = make_uint2(pack2(o1[g * 4] * inv, o1[g * 4 + 1] * inv), pack2(o1[g * 4 + 2] * inv, o1[g * 4 + 3] * inv));
  }
  __syncthreads();
}

DEV void r3_item(const Params& p, int item, char* smem, bool dry) {
  const int tid = threadIdx.x, lane = tid & 63, w = tid >> 6, wr = w >> 1, wc = w & 1, l16 = lane & 15, quad = lane >> 4;
  const int bh = item / NCH, c = item - bh * NCH; const int b = bh >> 3, h = bh & 7;
  bfu* sQ = (bfu*)smem; bfu* sK = sQ + 128 * 72; bfu* sP = sK + 128 * 72; float* sRed = (float*)(sP + 128 * 136);
  const size_t row0 = (size_t)b * SEQ + c * RC;
  const bfu* Q = (const bfu*)(p.ws + OFF_QT) + row0 * 512 + h * 64;
  const bfu* Kk = (const bfu*)(p.ws + OFF_KT) + row0 * 512 + h * 64;
  const bfu* vT = (const bfu*)(p.ws + OFF_VT) + (size_t)bh * 128 * SEQ + c * RC;
  const bfu* ST = (const bfu*)(p.ws + OFF_SST) + (size_t)item * 8192;
  u32x4 ra[4], rb[4];
  g2r<128>(Q, 512, ra); g2r<128>(Kk, 512, rb);
  __syncthreads();
  r2s<128>(sQ, ra); r2s<128>(sK, rb);
  __syncthreads();
  g2r<128>(vT, SEQ, rb);
  f32x4 acc[4][4];
#pragma unroll
  for (int i = 0; i < 4; i++)
#pragma unroll
    for (int j = 0; j < 4; j++) acc[i][j] = f32x4{0.f, 0.f, 0.f, 0.f};
  mma64<4, 4>(sQ, 72, sK, 72, acc);
#pragma unroll
  for (int mi = 0; mi < 4; mi++)
#pragma unroll
    for (int ni = 0; ni < 4; ni++)
#pragma unroll
      for (int j = 0; j < 4; j++) {
        int row = wr * 64 + mi * 16 + quad * 4 + j, col = wc * 64 + ni * 16 + l16;
        sP[row * 136 + col] = (col <= row) ? f2bf(acc[mi][ni][j]) : (bfu)0;
      }
#pragma unroll
  for (int i = 0; i < 4; i++)
#pragma unroll
    for (int j = 0; j < 4; j++) acc[i][j] = f32x4{0.f, 0.f, 0.f, 0.f};
  __syncthreads();
  r2s<128>(sK, rb);
  __syncthreads();
  g2r<128>(vT + 64, SEQ, rb);
  mma64<4, 4>(sP, 136, sK, 72, acc);
  __syncthreads();
  r2s<128>(sK, rb);
  __syncthreads();
  g2r<128>(ST, 64, rb);
  mma64<4, 4>(sP + 64, 136, sK, 72, acc);
  __syncthreads();
  r2s<128>(sK, rb);
  __syncthreads();
  mma64<4, 4>(sQ, 72, sK, 72, acc);
  float ssq[4][4];
#pragma unroll
  for (int mi = 0; mi < 4; mi++)
#pragma unroll
    for (int j = 0; j < 4; j++) { float s = 0.f;
#pragma unroll
      for (int ni = 0; ni < 4; ni++) s += acc[mi][ni][j] * acc[mi][ni][j];
      s = sum16(s); ssq[mi][j] = s;
      if (l16 == 0) sRed[(wr * 64 + mi * 16 + quad * 4 + j) * 2 + wc] = s; }
  __syncthreads();
  bfu* RG = (bfu*)(p.ws + OFF_RG);
  float gg[4];
#pragma unroll
  for (int ni = 0; ni < 4; ni++) gg[ni] = p.gn_g[h * 128 + wc * 64 + ni * 16 + l16];
  float* sw = (float*)smem + w * EPI_WAVE;
#pragma unroll
  for (int mi = 0; mi < 4; mi++) {
    f32x4 tv[4];
#pragma unroll
    for (int j = 0; j < 4; j++) {
      int row = wr * 64 + mi * 16 + quad * 4 + j;
      float tot = sRed[row * 2] + sRed[row * 2 + 1];
      float r = rsqrtf(tot * (1.f / 128.f) + EPSN);
#pragma unroll
      for (int ni = 0; ni < 4; ni++) tv[ni][j] = acc[mi][ni][j] * r * gg[ni];
    }
    float rw[16], g[16]; to_rows(tv, rw, sw, lane);
    int rr_ = lane >> 2; asm volatile("" : "+v"(rr_));
    const size_t o = (row0 + wr * 64 + mi * 16 + rr_) * DM + h * 128 + wc * 64 + (lane & 3) * 16;
    ld_bf16x16(RG + o, g);
#pragma unroll
    for (int e = 0; e < 16; e++) rw[e] *= g[e] * sigmoidf_(g[e]);
    st_bf16x16(dry ? (bfu*)(p.ws + OFF_XB) + (o & 0xffffff) : RG + o, rw);
  }
  __syncthreads();
}

DEV void phase4(const Params& p, int bid, int nb, char* smem, bool dry = false) {
  float gq = 0.f, gk = 0.f;
  for (int i = 0; i < 64; i++) { gq = fmaxf(gq, fabsf(p.fq_g[i])); gk = fmaxf(gk, fabsf(p.fk_g[i])); }
  const float thr = 2.f * (8.f * gq * gk * 1.03f * LOG2E) + 44.f;
  for (int it = bid; it < 2048 + 16 * NCH; it += nb) {
    if (it < 2048) attn_item(p, it, smem, thr, dry); else r3_item(p, it - 2048, smem, dry);
  }
}

DEV void phase5(const Params& p, int bid, int nb, char* smem) {
  const int tid = threadIdx.x, lane = tid & 63, w = tid >> 6, wr = w >> 1, wc = w & 1, l16 = lane & 15, quad = lane >> 4;
  bfu* sA = (bfu*)smem; bfu* sB = sA + 128 * 72;
  const bfu* G = (const bfu*)(p.ws + OFF_RG); const bfu* FO = (const bfu*)(p.ws + OFF_FQ);
  const bfu* WR = (const bfu*)(p.ws + OFF_WRT); const bfu* WF = (const bfu*)(p.ws + OFF_WFT);
  bfu* MX = (bfu*)(p.ws + OFF_XB);
  constexpr int NG = (TT / 128) * 8, NCV = 8192;
  const int xcd = bid & 7, slot = bid >> 3, nslots = (nb + 7 - xcd) >> 3;
  const int n_p = slot < 128 ? (128 - slot + nslots - 1) / nslots : 0;
  for (int i_ = 0; i_ < n_p; i_++) {
    int q = slot + i_ * nslots; int mt = xcd * 16 + (q >> 3), nt = q & 7;
    int m0 = mt * 256, n0 = nt * 128;
    int tid2 = threadIdx.x; asm volatile("" : "+v"(tid2));
    const int lane2 = tid2 & 63, w2 = tid2 >> 6, wr2 = w2 >> 1, wc2 = w2 & 1, l162 = lane2 & 15, quad2 = lane2 >> 4;
    f32x4 a1[8][4];
#pragma unroll
    for (int i = 0; i < 8; i++)
#pragma unroll
      for (int j = 0; j < 4; j++) a1[i][j] = f32x4{0.f, 0.f, 0.f, 0.f};
    gemm_loop_sb<8, 4>(G + (size_t)m0 * DM, DM, WR + (size_t)n0 * DM, DM, DM, a1, sA);
    const bfu* ga = (const bfu*)(p.out + O_YP); const bfu* gb = ga + (size_t)TP * DM;
    float* sw = (float*)(smem + EPI_OFF) + w2 * EPI_WAVE;
    const int rr = lane2 >> 2, c0 = wc2 * 64 + (lane2 & 3) * 16;
#pragma unroll
    for (int mi = 0; mi < 8; mi++) {
      float r[16], g[16]; to_rows(a1[mi], r, sw, lane2);
      int rr_ = rr; asm volatile("" : "+v"(rr_));
      const size_t o = (size_t)(m0 + wr2 * 128 + mi * 16 + rr_) * DM + n0 + c0;
      ld_bf16x16(ga + o, g);
#pragma unroll
      for (int e = 0; e < 16; e++) r[e] *= sigmoidf_(g[e]);
      st_bf16x16(MX + o, r);
#pragma unroll
      for (int ni = 0; ni < 4; ni++) a1[mi][ni] = f32x4{0.f, 0.f, 0.f, 0.f};
    }
    gemm_loop_sb<8, 4>(FO + (size_t)m0 * 512, 512, WF + (size_t)n0 * 512, 512, 512, a1, sA);
#pragma unroll
    for (int mi = 0; mi < 8; mi++) {
      float r[16], g[16], m[16]; to_rows(a1[mi], r, sw, lane2);
      int rr_ = rr; asm volatile("" : "+v"(rr_));
      const size_t o = (size_t)(m0 + wr2 * 128 + mi * 16 + rr_) * DM + n0 + c0;
      ld_bf16x16(gb + o, g); ld_bf16x16(MX + o, m);
#pragma unroll
      for (int e = 0; e < 16; e++) r[e] = m[e] + sigmoidf_(g[e]) * r[e];
      st_bf16x16(MX + o, r);
    }
  }
  if (bid < 128) {
    int nt = bid & 7;
    int m0 = TP + (bid >> 3) * 32, n0 = nt * 128;
    f32x4 a1[1][4];
#pragma unroll
    for (int j = 0; j < 4; j++) a1[0][j] = f32x4{0.f, 0.f, 0.f, 0.f};
    gemm_loop<1, 4>(G + (size_t)m0 * DM, DM, WR + (size_t)n0 * DM, DM, DM, a1, sA);
    const bfu* ga = (const bfu*)(p.out + O_YS) + (size_t)(m0 - TP) * DM + n0; const bfu* gb = ga + (size_t)TS * DM;
    bfu* mxT = MX + (size_t)m0 * DM + n0;
    unsigned loff = (unsigned)((wr * 16 + quad * 4) * DM + wc * 64 + l16); asm volatile("" : "+v"(loff));
#pragma unroll
    for (int ni = 0; ni < 4; ni++) {
#pragma unroll
      for (int j = 0; j < 4; j++) { unsigned o = loff + (unsigned)(j * DM + ni * 16);
        mxT[o] = f2bf(sigmoidf_(bf2f(ga[o])) * a1[0][ni][j]); }
      a1[0][ni] = f32x4{0.f, 0.f, 0.f, 0.f};
    }
    gemm_loop<1, 4>(FO + (size_t)m0 * 512, 512, WF + (size_t)n0 * 512, 512, 512, a1, sA);
    unsigned loff2 = loff; asm volatile("" : "+v"(loff2));
#pragma unroll
    for (int ni = 0; ni < 4; ni++) {
#pragma unroll
      for (int j = 0; j < 4; j++) { unsigned o = loff2 + (unsigned)(j * DM + ni * 16);
        mxT[o] = f2bf(bf2f(mxT[o]) + sigmoidf_(bf2f(gb[o])) * a1[0][ni][j]); }
    }
  }
}

DEV void phase6(const Params& p, int bid, int nb, char* smem) {
  bfu* sA = (bfu*)smem;
  const bfu* MX = (const bfu*)(p.ws + OFF_XB); const bfu* WO = (const bfu*)(p.ws + OFF_WOT);
  bfu* X1B = (bfu*)(p.ws + OFF_X1B); float* SSQ2 = (float*)(p.ws + OFF_SSQ2);
  const int xcd = bid & 7, slot = bid >> 3, nslots = (nb + 7 - xcd) >> 3;
  const int n_p = slot < 128 ? (128 - slot + nslots - 1) / nslots : 0;
  for (int i_ = 0; i_ < n_p; i_++) {
    int q = slot + i_ * nslots; int mt = xcd * 16 + (q >> 3), nt = q & 7;
    int m0 = mt * 256, n0 = nt * 128;
    int tid = threadIdx.x; asm volatile("" : "+v"(tid));
    const int lane = tid & 63, w = tid >> 6, wr = w >> 1, wc = w & 1, l16 = lane & 15, quad = lane >> 4;
    f32x4 acc[8][4];
#pragma unroll
    for (int i = 0; i < 8; i++)
#pragma unroll
      for (int j = 0; j < 4; j++) acc[i][j] = f32x4{0.f, 0.f, 0.f, 0.f};
    gemm_loop_sb<8, 4>(MX + (size_t)m0 * DM, DM, WO + (size_t)n0 * DM, DM, DM, acc, sA);
    float* sw = (float*)(smem + EPI_OFF) + w * EPI_WAVE;
    const int rr = lane >> 2, c0 = wc * 64 + (lane & 3) * 16;
#pragma unroll
    for (int mi = 0; mi < 8; mi++) {
      float r[16]; to_rows(acc[mi], r, sw, lane);
      int rr_ = rr; asm volatile("" : "+v"(rr_));
      const size_t o = (size_t)(m0 + wr * 128 + mi * 16 + rr_) * DM + n0 + c0;
      const float* xp = (m0 < TP ? p.x_p : p.x_s - (size_t)TP * DM) + o;
      float ss = 0.f;
#pragma unroll
      for (int c = 0; c < 4; c++) { f32x4 xv = *(const f32x4*)(xp + 4 * c);
#pragma unroll
        for (int e = 0; e < 4; e++) { r[4 * c + e] += xv[e]; ss += r[4 * c + e] * r[4 * c + e]; } }
      st_f32x16(p.out + O_YP + o, r);
      st_bf16x16(X1B + o, r);
      ss += __shfl_xor(ss, 1); ss += __shfl_xor(ss, 2);
      if ((lane & 3) == 0) SSQ2[(size_t)(m0 + wr * 128 + mi * 16 + rr) * 16 + nt * 2 + wc] = ss;
    }
  }
  if (bid < 128) {
    const int tid = threadIdx.x, lane = tid & 63, w = tid >> 6, wr = w >> 1, wc = w & 1, l16 = lane & 15, quad = lane >> 4;
    int nt = bid & 7;
    int m0 = TP + (bid >> 3) * 32, n0 = nt * 128;
    f32x4 acc[1][4];
#pragma unroll
    for (int j = 0; j < 4; j++) acc[0][j] = f32x4{0.f, 0.f, 0.f, 0.f};
    gemm_loop<1, 4>(MX + (size_t)m0 * DM, DM, WO + (size_t)n0 * DM, DM, DM, acc, sA);
    const float* xin = p.x_s + (size_t)(m0 - TP) * DM + n0;
    float* y = p.out + O_YS + (size_t)(m0 - TP) * DM + n0;
    bfu* xb1 = X1B + (size_t)m0 * DM + n0;
    unsigned loff = (unsigned)((wr * 16 + quad * 4) * DM + wc * 64 + l16); asm volatile("" : "+v"(loff));
#pragma unroll
    for (int j = 0; j < 4; j++) {
      int lr = wr * 16 + quad * 4 + j; float ss = 0.f;
#pragma unroll
      for (int ni = 0; ni < 4; ni++) {
        unsigned o = loff + (unsigned)(j * DM + ni * 16);
        float v = xin[o] + acc[0][ni][j];
        y[o] = v; xb1[o] = f2bf(v); ss += v * v;
      }
      ss = sum16(ss);
      if (l16 == 0) (SSQ2 + (size_t)m0 * 16 + nt * 2)[(unsigned)(lr * 16 + wc)] = ss;
    }
  }
}

DEV int fkey(float x, int idx, int mask) { int b = __float_as_int(x); b ^= (b >> 31) & 0x7fffffff; return (b & ~mask) | idx; }
DEV void ins16(int (&t)[16], int v) {
#pragma unroll
  for (int s = 0; s < 16; s++) { int hi = max(t[s], v); v = min(t[s], v); t[s] = hi; }
}

DEV void phase7(const Params& p, int bid, int nb, char* smem) {
  const int tid = threadIdx.x, lane = tid & 63, w = tid >> 6, wr = w >> 1, wc = w & 1, l16 = lane & 15, quad = lane >> 4;
  bfu* sA = (bfu*)smem;
  float* sS = (float*)smem;
  int* sL = (int*)(smem + 33024);
  float* sTV = (float*)(smem + 55296);
  int* sTI = (int*)(sTV + 2 * 64 * 17);
  const bfu* X1B = (const bfu*)(p.ws + OFF_X1B); const bfu* MT = (const bfu*)(p.ws + OFF_MT);
  const float* SSQ2 = (const float*)(p.ws + OFF_SSQ2);
  int2* ROUTE = (int2*)(p.ws + OFF_ROUTE);
  constexpr int NI7 = (TT / 64) * 8;
  const int xcd = bid & 7, slot = bid >> 3, nslots = (nb + 7 - xcd) >> 3;
  for (int q = slot; q < 520; q += nslots) {
    int hg = q / 260, q2 = q - hg * 260; int mt = xcd * 65 + (q2 >> 2), h = hg * 4 + (q2 & 3); int m0 = mt * 64;
    for (int half = 0; half < 2; half++) {
      f32x4 acc[2][4];
#pragma unroll
      for (int i = 0; i < 2; i++)
#pragma unroll
        for (int j = 0; j < 4; j++) acc[i][j] = f32x4{0.f, 0.f, 0.f, 0.f};
      gemm_loop<2, 4>(X1B + (size_t)m0 * DM, DM, MT + (size_t)(h * 256 + half * 128) * DM, DM, DM, acc, sA);
      __syncthreads();
#pragma unroll
      for (int mi = 0; mi < 2; mi++)
#pragma unroll
        for (int j = 0; j < 4; j++) {
          int lr = wr * 32 + mi * 16 + quad * 4 + j;
          const float* sp = SSQ2 + (size_t)(m0 + lr) * 16; float tot = 0.f;
#pragma unroll
          for (int i = 0; i < 16; i++) tot += sp[i];
          float rs = rsqrtf(tot * (1.f / DM) + EPSN);
#pragma unroll
          for (int ni = 0; ni < 4; ni++) sS[lr * 129 + wc * 64 + ni * 16 + l16] = acc[mi][ni][j] * rs;
        }
      __syncthreads();
      { int row = tid & 63, q = tid >> 6; int t[16];
#pragma unroll
        for (int s = 0; s < 16; s++) t[s] = (int)0x80000000;
#pragma unroll 8
        for (int i = 0; i < 32; i++) { int idx = q * 32 + i; ins16(t, fkey(sS[row * 129 + idx], idx, 127)); }
#pragma unroll
        for (int s = 0; s < 16; s++) sL[row * 65 + q * 16 + s] = t[s]; }
      __syncthreads();
      if (tid < 64) { int row = tid; int p0 = 0, p1 = 0, p2 = 0, p3 = 0; const int* L = sL + row * 65;
        for (int r = 0; r < 16; r++) {
          int a0 = L[p0], a1 = L[16 + p1], a2 = L[32 + p2], a3 = L[48 + p3];
          int mx = max(max(a0, a1), max(a2, a3));
          if (mx == a0) p0++; else if (mx == a1) p1++; else if (mx == a2) p2++; else p3++;
          int idx = mx & 127;
          sTV[(half * 64 + row) * 17 + r] = sS[row * 129 + idx]; sTI[(half * 64 + row) * 17 + r] = idx; } }
      __syncthreads();
    }
    if (tid < 64) {
      int row = tid; float v1[16], v2[16];
#pragma unroll
      for (int i = 0; i < 16; i++) { v1[i] = sTV[row * 17 + i]; v2[i] = sTV[(64 + row) * 17 + i]; }
      int t[16];
#pragma unroll
      for (int s = 0; s < 16; s++) t[s] = (int)0x80000000;
#pragma unroll
      for (int i = 0; i < 16; i++)
#pragma unroll
        for (int j = 0; j < 16; j++)
          if ((i + 1) * (j + 1) <= 16) ins16(t, fkey(v1[i] + v2[j], i * 16 + j, 255));
      float es[16]; int ei[16]; float mx = 0.f, sum = 0.f;
#pragma unroll
      for (int r = 0; r < 16; r++) { int c = t[r] & 255; int i = c >> 4, j = c & 15;
        float s = sTV[row * 17 + i] + sTV[(64 + row) * 17 + j];
        ei[r] = sTI[row * 17 + i] * 128 + sTI[(64 + row) * 17 + j];
        if (r == 0) mx = s;
        es[r] = __expf(s - mx); sum += es[r]; }
      float inv = 1.f / sum;
      int2* ro = ROUTE + ((size_t)(m0 + row) * 8 + h) * 16;
#pragma unroll
      for (int r = 0; r < 16; r++) ro[r] = make_int2(ei[r], __float_as_int(es[r] * inv));
    }
    __syncthreads();
  }
}

#define FP4PK(w_, sel_) __builtin_amdgcn_cvt_scalef32_pk_f32_fp4((w_), 1.0f, (sel_))
DEV float dot16_fp8(const u32x2& u, const f32x2 (&xn)[8]) {
  f32x2 s = FP4PK(u[0], 0) * xn[0];
  s = FP4PK(u[0], 1) * xn[1] + s;
  s = FP4PK(u[0], 2) * xn[2] + s;
  s = FP4PK(u[0], 3) * xn[3] + s;
  s = FP4PK(u[1], 0) * xn[4] + s;
  s = FP4PK(u[1], 1) * xn[5] + s;
  s = FP4PK(u[1], 2) * xn[6] + s;
  s = FP4PK(u[1], 3) * xn[7] + s;
  return s[0] + s[1];
}
DEV void axpy16_fp8(const u32x2& u, float wj, f32x2 (&acc)[8]) {
  const f32x2 w2 = {wj, wj};
  acc[0] = FP4PK(u[0], 0) * w2 + acc[0];
  acc[1] = FP4PK(u[0], 1) * w2 + acc[1];
  acc[2] = FP4PK(u[0], 2) * w2 + acc[2];
  acc[3] = FP4PK(u[0], 3) * w2 + acc[3];
  acc[4] = FP4PK(u[1], 0) * w2 + acc[4];
  acc[5] = FP4PK(u[1], 1) * w2 + acc[5];
  acc[6] = FP4PK(u[1], 2) * w2 + acc[6];
  acc[7] = FP4PK(u[1], 3) * w2 + acc[7];
}
template <int S>
DEV void red_step(float (&pp)[16], int lane) {
  const bool up = (lane & S) != 0;
#pragma unroll
  for (int i = 0; i < S; i++) {
    float send = up ? pp[i] : pp[i + S];
    float keep = up ? pp[i + S] : pp[i];
    pp[i] = keep + __shfl_xor(send, S);
  }
}
DEV float reduce16(float (&pp)[16], int lane) {
  red_step<8>(pp, lane); red_step<4>(pp, lane); red_step<2>(pp, lane); red_step<1>(pp, lane);
  float v = pp[0];
  v += __shfl_xor(v, 16); v += __shfl_xor(v, 32);
  return v;
}

DEV void phase8(const Params& p, int bid, int nb, char* smem, bool dry = false) {
  const int tid = threadIdx.x, lane = tid & 63, w = __builtin_amdgcn_readfirstlane(tid >> 6);
  const u32x2* PUB = (const u32x2*)(p.ws + OFF_PUB); const u32x2* PVB = (const u32x2*)(p.ws + OFF_PVB);
  const float* PSC = (const float*)(p.ws + OFF_PSC);
  const float* SSQ2 = (const float*)(p.ws + OFF_SSQ2); const int2* ROUTE = (const int2*)(p.ws + OFF_ROUTE);
  for (int it = bid; it < TT / 4; it += nb) {
    int tok = it * 4 + w;
    float* y = tok < TP ? p.out + O_YP + (size_t)tok * DM : p.out + O_YS + (size_t)(tok - TP) * DM;
    float x[16]; f32x2 xn[8];
    { float4 a0 = *(const float4*)(y + lane * 16), a1 = *(const float4*)(y + lane * 16 + 4), b0 = *(const float4*)(y + lane * 16 + 8), b1 = *(const float4*)(y + lane * 16 + 12);
      x[0] = a0.x; x[1] = a0.y; x[2] = a0.z; x[3] = a0.w; x[4] = a1.x; x[5] = a1.y; x[6] = a1.z; x[7] = a1.w;
      x[8] = b0.x; x[9] = b0.y; x[10] = b0.z; x[11] = b0.w; x[12] = b1.x; x[13] = b1.y; x[14] = b1.z; x[15] = b1.w; }
    float tot = 0.f;
    { const float* sp = SSQ2 + (size_t)tok * 16;
#pragma unroll
      for (int i = 0; i < 16; i++) tot += sp[i]; }
    float rs = rsqrtf(tot * (1.f / DM) + EPSN);
#pragma unroll
    for (int i = 0; i < 8; i++) { xn[i][0] = x[2 * i] * rs * p.norm2_g[lane * 16 + 2 * i]; xn[i][1] = x[2 * i + 1] * rs * p.norm2_g[lane * 16 + 2 * i + 1]; }
    const int2* rt = ROUTE + (size_t)tok * 128;
    int2 r0 = rt[lane], r1 = rt[lane + 64];
    float d0 = 0.f, d1 = 0.f, w0 = 0.f, w1 = 0.f;
    f32x2 acc[8];
#pragma unroll
    for (int i = 0; i < 8; i++) acc[i] = f32x2{0.f, 0.f};
#define P8_LOAD(buf, tb_, gi_) do { const int rx_ = ((gi_) & 4) ? r1.x : r0.x; \
      _Pragma("unroll") for (int jj = 0; jj < 16; jj++) { int e = __builtin_amdgcn_readlane(rx_, ((gi_) & 3) * 16 + jj); buf[jj] = tb_[(size_t)e * 64 + lane]; } } while (0)
#define P8_COMPU(buf, gi_) do { float pp[16]; \
      _Pragma("unroll") for (int jj = 0; jj < 16; jj++) pp[jj] = dot16_fp8(buf[jj], xn); \
      float v_ = reduce16(pp, lane); \
      if ((lane >> 4) == ((gi_) & 3)) { if ((gi_) < 4) d0 = v_; else d1 = v_; } } while (0)
#define P8_COMPV(buf, gi_) do { const int wx_ = __float_as_int(((gi_) & 4) ? w1 : w0); \
      _Pragma("unroll") for (int jj = 0; jj < 16; jj++) { float wj = __int_as_float(__builtin_amdgcn_readlane(wx_, ((gi_) & 3) * 16 + jj)); axpy16_fp8(buf[jj], wj, acc); } } while (0)
#define P8_SB() __builtin_amdgcn_sched_barrier(0)
    {
      u32x2 ua[16], ub[16];
      P8_LOAD(ua, PUB, 0);
#pragma unroll 1
      for (int gi = 0; gi < 6; gi += 2) {
        P8_LOAD(ub, PUB, gi + 1); P8_SB();
        P8_COMPU(ua, gi); P8_SB();
        P8_LOAD(ua, PUB, gi + 2); P8_SB();
        P8_COMPU(ub, gi + 1); P8_SB();
      }
      P8_LOAD(ub, PUB, 7); P8_SB();
      P8_COMPU(ua, 6); P8_SB();
      P8_LOAD(ua, PVB, 0); P8_SB();
      P8_COMPU(ub, 7); P8_SB();
      d0 *= PSC[r0.x]; d1 *= PSC[r1.x];
      w0 = 0.5f * d0 * (1.f + erff(d0 * 0.70710678118654752f)) * __int_as_float(r0.y) * PSC[16384 + r0.x];
      w1 = 0.5f * d1 * (1.f + erff(d1 * 0.70710678118654752f)) * __int_as_float(r1.y) * PSC[16384 + r1.x];
      P8_SB();
#pragma unroll 1
      for (int gi = 0; gi < 6; gi += 2) {
        P8_LOAD(ub, PVB, gi + 1); P8_SB();
        P8_COMPV(ua, gi); P8_SB();
        P8_LOAD(ua, PVB, gi + 2); P8_SB();
        P8_COMPV(ub, gi + 1); P8_SB();
      }
      P8_LOAD(ub, PVB, 7); P8_SB();
      P8_COMPV(ua, 6); P8_SB();
      P8_COMPV(ub, 7);
    }
    if (dry) y = (float*)(p.ws + OFF_XB) + (size_t)(tok & 8191) * DM;
    *(float4*)(y + lane * 16) = make_float4(x[0] + acc[0][0], x[1] + acc[0][1], x[2] + acc[1][0], x[3] + acc[1][1]);
    *(float4*)(y + lane * 16 + 4) = make_float4(x[4] + acc[2][0], x[5] + acc[2][1], x[6] + acc[3][0], x[7] + acc[3][1]);
    *(float4*)(y + lane * 16 + 8) = make_float4(x[8] + acc[4][0], x[9] + acc[4][1], x[10] + acc[5][0], x[11] + acc[5][1]);
    *(float4*)(y + lane * 16 + 12) = make_float4(x[12] + acc[6][0], x[13] + acc[6][1], x[14] + acc[7][0], x[15] + acc[7][1]);
  }
}

__global__ void __launch_bounds__(256, 2) fwd_kernel(Params p, int ph_lo, int ph_hi, int coop) {
  __shared__ __attribute__((aligned(16))) char smem[SMEM_BYTES];
  const int bid = blockIdx.x, nb = gridDim.x;
#ifndef REPS
#define REPS {1,1,1,1,1,1,1,1,1}
#endif
  constexpr int REP[9] = REPS;
#define RUN_PHASE(N) if (ph_lo <= N && N <= ph_hi) { for (int r_ = 0; r_ < REP[N]; r_++) phase##N(p, bid, nb, smem); if (coop && N < ph_hi) cg::this_grid().sync(); }
#define RUN_PHASE_DRY(N) if (ph_lo <= N && N <= ph_hi) { for (int r_ = 1; r_ < REP[N]; r_++) phase##N(p, bid, nb, smem, true); phase##N(p, bid, nb, smem, false); if (coop && N < ph_hi) cg::this_grid().sync(); }
  RUN_PHASE(0) RUN_PHASE_DRY(1) RUN_PHASE(2) RUN_PHASE(3) RUN_PHASE_DRY(4) RUN_PHASE(5) RUN_PHASE(6) RUN_PHASE(7) RUN_PHASE_DRY(8)
}

extern "C" void kernel_launch(void* const* d_in, const int* in_sizes, int n_in, void* d_out, int out_size,
                              void* d_ws, size_t ws_size, hipStream_t stream) {
  if (ws_size < WS_NEED) { fprintf(stderr, "workspace too small\n"); return; }
  static int grid_blocks = 0;
  if (!grid_blocks) {
    int dev = 0, cus = 0, per_cu = 0;
    hipGetDevice(&dev);
    hipDeviceGetAttribute(&cus, hipDeviceAttributeMultiprocessorCount, dev);
    hipOccupancyMaxActiveBlocksPerMultiprocessor(&per_cu, fwd_kernel, 256, 0);
    if (per_cu < 1) per_cu = 1;
    if (per_cu > 2) per_cu = 2;
    grid_blocks = cus * per_cu;
  }
  Params p{};
  const float* const* in = (const float* const*)d_in;
  p.x_p = in[0]; p.x_s = in[1]; p.state_ret = in[2]; p.ck = in[3]; p.cv = in[4]; p.clogf = in[5]; p.norm1_g = in[6];
  p.w_in = in[7]; p.b_f = in[8]; p.fq_g = in[9]; p.fk_g = in[10]; p.gn_g = in[11]; p.w_ret_out = in[12]; p.w_fox_out = in[13];
  p.w_o = in[14]; p.norm2_g = in[15]; p.peer_wq = in[16]; p.k1 = in[17]; p.k2 = in[18]; p.peer_u = in[19]; p.peer_v = in[20];
  p.out = (float*)d_out; p.ws = (char*)d_ws;
#ifndef MULTI_LAUNCH
#define MULTI_LAUNCH 0
#endif
#if MULTI_LAUNCH
  for (int ph = 0; ph <= 8; ph++) fwd_kernel<<<grid_blocks, 256, 0, stream>>>(p, ph, ph, 0);
#else
  int lo = 0, hi = 8, coop = 1;
  void* args[] = {&p, &lo, &hi, &coop};
  hipError_t e = hipLaunchCooperativeKernel((void*)fwd_kernel, dim3(grid_blocks), dim3(256), args, 0, stream);
  if (e != hipSuccess) fprintf(stderr, "cooperative launch failed: %s (grid %d)\n", hipGetErrorString(e), grid_blocks);
#endif
}
```

```cpp
#include <hip/hip_runtime.h>
#include <hip/hip_cooperative_groups.h>
#include <stdint.h>
#include <stdio.h>
namespace cg = cooperative_groups;

#define DEV __device__ __forceinline__
typedef unsigned short bfu;
typedef __attribute__((ext_vector_type(8))) short bf16x8;
typedef __attribute__((ext_vector_type(4))) short bf16x4;
typedef __attribute__((ext_vector_type(4))) float f32x4;
typedef __attribute__((ext_vector_type(16))) float f32x16;
typedef __attribute__((ext_vector_type(4))) unsigned u32x4;
typedef __attribute__((ext_vector_type(2))) float f32x2;
typedef __attribute__((ext_vector_type(2))) unsigned u32x2;

constexpr int DM = 1024, SEQ = 16384, TP = 32768, TS = 512, TT = 33280;
constexpr int NWP = 6784;
constexpr int RC = 128;
constexpr int NCH = SEQ / RC;
constexpr float LOG2E = 1.4426950408889634f;
constexpr float EPSN = 1e-6f;

constexpr size_t O_YP = 0, O_YS = 33554432, O_SP = 34078720, O_FKP = 34209792, O_FVP = 50987008,
                 O_LFP = 67764224, O_SS = 68026368, O_FKS = 70123520, O_FVS = 70385664, O_LFS = 70647808;
constexpr size_t MiB = 1u << 20;
constexpr size_t OFF_XB = 0;
constexpr size_t OFF_WINT = 66 * MiB, OFF_WRT = 80 * MiB, OFF_WFT = 82 * MiB, OFF_WOT = 83 * MiB, OFF_MT = 85 * MiB;
constexpr size_t OFF_RSTD1 = 89 * MiB, OFF_C2 = 90 * MiB, OFF_HS = 91 * MiB;
constexpr size_t OFF_QT = 105 * MiB, OFF_KT = 137 * MiB, OFF_KTT = 169 * MiB, OFF_VT = 201 * MiB;
constexpr size_t OFF_X1B = OFF_HS;
constexpr size_t OFF_RG = 265 * MiB, OFF_FQ = 331 * MiB, OFF_FKB = 364 * MiB, OFF_FVT = 396 * MiB;
constexpr size_t OFF_PUB = OFF_KTT, OFF_PVB = OFF_KTT + 16 * MiB;
constexpr size_t OFF_ROUTE = OFF_FKB, OFF_SSQ2 = OFF_FKB + 33 * MiB;
constexpr size_t OFF_BAR = OFF_RSTD1 + 768 * 1024;
constexpr size_t OFF_PSC = OFF_RSTD1 + 512 * 1024;
constexpr size_t OFF_SST = 428 * MiB;
constexpr size_t WS_NEED = 460 * MiB;

constexpr int SMEM_BYTES = 75776;

struct Params {
  const float *x_p, *x_s, *state_ret, *ck, *cv, *clogf, *norm1_g, *w_in, *b_f, *fq_g, *fk_g, *gn_g,
      *w_ret_out, *w_fox_out, *w_o, *norm2_g, *peer_wq, *k1, *k2, *peer_u, *peer_v;
  float* out;
  char* ws;
};

DEV bfu f2bf(float f) { unsigned u = __float_as_uint(f); u += 0x7fffu + ((u >> 16) & 1u); return (bfu)(u >> 16); }
DEV float bf2f(bfu b) { return __uint_as_float(((unsigned)b) << 16); }
DEV unsigned pack2(float a, float b) { return (unsigned)f2bf(a) | ((unsigned)f2bf(b) << 16); }
DEV float bflo(unsigned u) { return __uint_as_float(u << 16); }
DEV float bfhi(unsigned u) { return __uint_as_float(u & 0xffff0000u); }
DEV float sigmoidf_(float z) { return 1.f / (1.f + __expf(-z)); }
DEV float l2gamma(int h) { return log2f(1.f - exp2f(-5.f - (float)h)); }
DEV float wave_sum(float v) {
#pragma unroll
  for (int o = 32; o >= 1; o >>= 1) v += __shfl_xor(v, o);
  return v;
}
DEV float sum16(float v) {
  v += __shfl_xor(v, 1); v += __shfl_xor(v, 2); v += __shfl_xor(v, 4); v += __shfl_xor(v, 8);
  return v;
}

template <int ROWS>
DEV void g2r(const bfu* g, int ld, u32x4 (&r)[ROWS / 32], int tid_ = threadIdx.x) {
#pragma unroll
  for (int i = 0; i < ROWS / 32; i++) {
    int id = tid_ + i * 256; int row = id >> 3, ch = id & 7;
    const unsigned off = (unsigned)(row * ld + ch * 8);
    r[i] = *(const u32x4*)(g + off);
  }
}
template <int ROWS>
DEV void r2s(bfu* s, const u32x4 (&r)[ROWS / 32], int tid_ = threadIdx.x) {
#pragma unroll
  for (int i = 0; i < ROWS / 32; i++) {
    int id = tid_ + i * 256; int row = id >> 3, ch = id & 7;
    *(u32x4*)(s + row * 72 + ch * 8) = r[i];
  }
}
template <int MI, int NI>
DEV void mma64(const bfu* sA, int sldA, const bfu* sB, int sldB, f32x4 (&acc)[MI][NI]) {
  const int lane = threadIdx.x & 63, w = threadIdx.x >> 6, wr = w >> 1, wc = w & 1, l16 = lane & 15, quad = lane >> 4;
#pragma unroll
  for (int kk = 0; kk < 2; kk++) {
    bf16x8 a[MI], b[NI];
#pragma unroll
    for (int mi = 0; mi < MI; mi++) a[mi] = *(const bf16x8*)(sA + (wr * MI * 16 + mi * 16 + l16) * sldA + kk * 32 + quad * 8);
#pragma unroll
    for (int ni = 0; ni < NI; ni++) b[ni] = *(const bf16x8*)(sB + (wc * NI * 16 + ni * 16 + l16) * sldB + kk * 32 + quad * 8);
#pragma unroll
    for (int mi = 0; mi < MI; mi++)
#pragma unroll
      for (int ni = 0; ni < NI; ni++) acc[mi][ni] = __builtin_amdgcn_mfma_f32_16x16x32_bf16(a[mi], b[ni], acc[mi][ni], 0, 0, 0);
  }
}
template <int ROWS>
DEV void r2sw(bfu* s, const u32x4 (&r)[ROWS / 32], int tid_) {
#pragma unroll
  for (int i = 0; i < ROWS / 32; i++) {
    int id = tid_ + i * 256; int row = id >> 3, ch = id & 7;
    int byte = (((row >> 4) * 2 + (ch >> 2)) << 10) + ((((row & 15) << 6) + ((ch & 3) << 4)) ^ (((row >> 3) & 1) << 5));
    *(u32x4*)((char*)s + byte) = r[i];
  }
}
template <int MI, int NI>
DEV void mma64w(const bfu* sA, const bfu* sB, f32x4 (&acc)[MI][NI]) {
  const int lane = threadIdx.x & 63, w = threadIdx.x >> 6, wr = w >> 1, wc = w & 1, l16 = lane & 15, quad = lane >> 4;
  const int lo = ((l16 << 6) + (quad << 4)) ^ (((l16 >> 3) & 1) << 5);
#pragma unroll
  for (int kk = 0; kk < 2; kk++) {
    bf16x8 a[MI], b[NI];
#pragma unroll
    for (int mi = 0; mi < MI; mi++) a[mi] = *(const bf16x8*)((const char*)sA + (((wr * MI + mi) * 2 + kk) << 10) + lo);
#pragma unroll
    for (int ni = 0; ni < NI; ni++) b[ni] = *(const bf16x8*)((const char*)sB + (((wc * NI + ni) * 2 + kk) << 10) + lo);
#pragma unroll
    for (int mi = 0; mi < MI; mi++)
#pragma unroll
      for (int ni = 0; ni < NI; ni++) acc[mi][ni] = __builtin_amdgcn_mfma_f32_16x16x32_bf16(a[mi], b[ni], acc[mi][ni], 0, 0, 0);
  }
}
template <int MI, int NI>
DEV void mma64w_big(const bfu* sA, const bfu* sB, f32x4 (&acc)[MI][NI]) {
  const int lane = threadIdx.x & 63, w = threadIdx.x >> 6, wr = w >> 1, wc = w & 1, l16 = lane & 15, quad = lane >> 4;
  const int lo = ((l16 << 6) + (quad << 4)) ^ (((l16 >> 3) & 1) << 5);
#pragma unroll
  for (int kk = 0; kk < 2; kk++) {
    bf16x8 b[NI];
#pragma unroll
    for (int ni = 0; ni < NI; ni++) b[ni] = *(const bf16x8*)((const char*)sB + (((wc * NI + ni) * 2 + kk) << 10) + lo);
#pragma unroll
    for (int mi = 0; mi < MI; mi++) {
      bf16x8 a = *(const bf16x8*)((const char*)sA + (((wr * MI + mi) * 2 + kk) << 10) + lo);
#pragma unroll
      for (int ni = 0; ni < NI; ni++) acc[mi][ni] = __builtin_amdgcn_mfma_f32_16x16x32_bf16(a, b[ni], acc[mi][ni], 0, 0, 0);
    }
  }
}
template <int MI, int NI>
DEV void gemm_loop_sb(const bfu* A, int lda, const bfu* B, int ldb, int K, f32x4 (&acc)[MI][NI], bfu* sbuf) {
  constexpr int BM = 32 * MI, BN = 32 * NI;
  bfu* sA = sbuf; bfu* sB = sA + BM * 64;
  const int nk = K >> 6;
  int t_ = threadIdx.x; asm volatile("" : "+v"(t_));
  u32x4 ra[BM / 32], rb[BN / 32];
  g2r<BM>(A, lda, ra, t_); g2r<BN>(B, ldb, rb, t_);
#pragma unroll 1
  for (int k = 0; k < nk; k++) {
    __syncthreads();
    r2sw<BM>(sA, ra, t_); r2sw<BN>(sB, rb, t_);
    __syncthreads();
    if (k + 1 < nk) { g2r<BM>(A + (k + 1) * 64, lda, ra, t_); g2r<BN>(B + (k + 1) * 64, ldb, rb, t_); }
    mma64w_big<MI, NI>(sA, sB, acc);
  }
}

template <int MI, int NI>
DEV void gemm_loop(const bfu* A, int lda, const bfu* B, int ldb, int K, f32x4 (&acc)[MI][NI], bfu* sbuf) {
  constexpr int BM = 32 * MI, BN = 32 * NI;
  bfu* sA0 = sbuf; bfu* sB0 = sA0 + BM * 64; bfu* sA1 = sB0 + BN * 64; bfu* sB1 = sA1 + BM * 64;
  const int nk = K >> 6;
  int t_ = threadIdx.x; asm volatile("" : "+v"(t_));
  u32x4 ra0[BM / 32], rb0[BN / 32], ra1[BM / 32], rb1[BN / 32];
  g2r<BM>(A, lda, ra0, t_); g2r<BN>(B, ldb, rb0, t_);
  if (nk > 1) { g2r<BM>(A + 64, lda, ra1, t_); g2r<BN>(B + 64, ldb, rb1, t_); }
  __syncthreads();
  r2sw<BM>(sA0, ra0, t_); r2sw<BN>(sB0, rb0, t_);
  if (nk > 2) { g2r<BM>(A + 128, lda, ra0, t_); g2r<BN>(B + 128, ldb, rb0, t_); }
  __syncthreads();
  for (int k = 0; k < nk; k += 2) {
    if (k + 1 < nk) { r2sw<BM>(sA1, ra1, t_); r2sw<BN>(sB1, rb1, t_); }
    if (k + 3 < nk) { g2r<BM>(A + (k + 3) * 64, lda, ra1, t_); g2r<BN>(B + (k + 3) * 64, ldb, rb1, t_); }
    mma64w<MI, NI>(sA0, sB0, acc);
    __syncthreads();
    if (k + 1 >= nk) break;
    if (k + 2 < nk) { r2sw<BM>(sA0, ra0, t_); r2sw<BN>(sB0, rb0, t_); }
    if (k + 4 < nk) { g2r<BM>(A + (k + 4) * 64, lda, ra0, t_); g2r<BN>(B + (k + 4) * 64, ldb, rb0, t_); }
    mma64w<MI, NI>(sA1, sB1, acc);
    __syncthreads();
  }
}

constexpr int EPI_OFF = 49152, EPI_WAVE = 16 * 68;
DEV void to_rows(const f32x4 (&v)[4], float (&r)[16], float* sw, int lane) {
  const int l16 = lane & 15, quad = lane >> 4;
  __builtin_amdgcn_wave_barrier();
#pragma unroll
  for (int ni = 0; ni < 4; ni++)
#pragma unroll
    for (int j = 0; j < 4; j++) sw[(quad * 4 + j) * 68 + ni * 16 + l16] = v[ni][j];
  __builtin_amdgcn_wave_barrier();
  const f32x4* rp = (const f32x4*)(sw + (lane >> 2) * 68 + (lane & 3) * 16);
#pragma unroll
  for (int c = 0; c < 4; c++) { f32x4 t = rp[c]; r[4 * c] = t[0]; r[4 * c + 1] = t[1]; r[4 * c + 2] = t[2]; r[4 * c + 3] = t[3]; }
}
DEV void st_bf16x16(bfu* dst, const float (&r)[16]) {
  u32x4 a = {pack2(r[0], r[1]), pack2(r[2], r[3]), pack2(r[4], r[5]), pack2(r[6], r[7])};
  u32x4 b = {pack2(r[8], r[9]), pack2(r[10], r[11]), pack2(r[12], r[13]), pack2(r[14], r[15])};
  *(u32x4*)dst = a; *(u32x4*)(dst + 8) = b;
}
DEV void ld_bf16x16(const bfu* src, float (&r)[16]) {
  u32x4 a = *(const u32x4*)src, b = *(const u32x4*)(src + 8);
#pragma unroll
  for (int i = 0; i < 4; i++) { r[2 * i] = bflo(a[i]); r[2 * i + 1] = bfhi(a[i]); r[8 + 2 * i] = bflo(b[i]); r[9 + 2 * i] = bfhi(b[i]); }
}
DEV void st_f32x16(float* dst, const float (&r)[16]) {
#pragma unroll
  for (int c = 0; c < 4; c++) *(f32x4*)(dst + 4 * c) = f32x4{r[4 * c], r[4 * c + 1], r[4 * c + 2], r[4 * c + 3]};
}

DEV void transpose_tile(const float* src, int ldsrc, int srccol0, int validcols, const float* scale,
                        bfu* dst, int lddst, int n0, int k0, float* sT) {
  const int tid = threadIdx.x;
  __syncthreads();
#pragma unroll
  for (int i = 0; i < 4; i++) {
    int kk = (tid >> 4) + i * 16, c = (tid & 15) * 4;
    float4 v = make_float4(0.f, 0.f, 0.f, 0.f);
    if (c < validcols) v = *(const float4*)(src + (size_t)(k0 + kk) * ldsrc + srccol0 + c);
    float s = scale ? scale[k0 + kk] : 1.f;
    sT[kk * 65 + c] = v.x * s; sT[kk * 65 + c + 1] = v.y * s; sT[kk * 65 + c + 2] = v.z * s; sT[kk * 65 + c + 3] = v.w * s;
  }
  __syncthreads();
  int n = tid >> 2, kc = (tid & 3) * 16;
  unsigned o[8];
#pragma unroll
  for (int e = 0; e < 8; e++) o[e] = pack2(sT[(kc + 2 * e) * 65 + n], sT[(kc + 2 * e + 1) * 65 + n]);
  uint4* d = (uint4*)(dst + (size_t)(n0 + n) * lddst + k0 + kc);
  d[0] = make_uint4(o[0], o[1], o[2], o[3]); d[1] = make_uint4(o[4], o[5], o[6], o[7]);
}

DEV void phase0(const Params& p, int bid, int nb, char* smem) {
  const int tid = threadIdx.x, lane = tid & 63, w = tid >> 6;
  constexpr int N_X = TT / 4, N_TW = 106 * 16, N_TR = 256, N_TF = 128, N_TO = 256, N_MT = 512;
  constexpr int B1 = N_X, B2 = B1 + N_TW, B3 = B2 + N_TR, B4 = B3 + N_TF, B5 = B4 + N_TO, TOT = B5 + N_MT;
  bfu* xb = (bfu*)(p.ws + OFF_XB); float* rstd1 = (float*)(p.ws + OFF_RSTD1);
  for (int it = bid; it < TOT; it += nb) {
    if (it < B1) {
      int row = it * 4 + w;
      const float* src = row < TP ? p.x_p + (size_t)row * DM : p.x_s + (size_t)(row - TP) * DM;
      float4 a0 = *(const float4*)(src + lane * 8), a1 = *(const float4*)(src + lane * 8 + 4);
      float4 b0 = *(const float4*)(src + 512 + lane * 8), b1 = *(const float4*)(src + 512 + lane * 8 + 4);
      float ss = a0.x * a0.x + a0.y * a0.y + a0.z * a0.z + a0.w * a0.w + a1.x * a1.x + a1.y * a1.y + a1.z * a1.z + a1.w * a1.w +
                 b0.x * b0.x + b0.y * b0.y + b0.z * b0.z + b0.w * b0.w + b1.x * b1.x + b1.y * b1.y + b1.z * b1.z + b1.w * b1.w;
      ss = wave_sum(ss);
      if (lane == 0) rstd1[row] = rsqrtf(ss * (1.f / DM) + EPSN);
      *(uint4*)(xb + (size_t)row * DM + lane * 8) = make_uint4(pack2(a0.x, a0.y), pack2(a0.z, a0.w), pack2(a1.x, a1.y), pack2(a1.z, a1.w));
      *(uint4*)(xb + (size_t)row * DM + 512 + lane * 8) = make_uint4(pack2(b0.x, b0.y), pack2(b0.z, b0.w), pack2(b1.x, b1.y), pack2(b1.z, b1.w));
    } else if (it < B2) {
      int j = it - B1; int nt = j >> 4, kt = j & 15; int n0 = nt * 64;
      int sc0, vc;
      if (n0 < 4608) { sc0 = n0; vc = 64; } else if (n0 < 6656) { sc0 = n0 + 8; vc = 64; } else if (n0 == 6656) { sc0 = 4608; vc = 8; } else { sc0 = 0; vc = 0; }
      transpose_tile(p.w_in, 6664, sc0, vc, p.norm1_g, (bfu*)(p.ws + OFF_WINT), DM, n0, kt * 64, (float*)smem);
    } else if (it < B3) {
      int j = it - B2; transpose_tile(p.w_ret_out, 1024, (j >> 4) * 64, 64, nullptr, (bfu*)(p.ws + OFF_WRT), 1024, (j >> 4) * 64, (j & 15) * 64, (float*)smem);
    } else if (it < B4) {
      int j = it - B3; transpose_tile(p.w_fox_out, 1024, (j >> 3) * 64, 64, nullptr, (bfu*)(p.ws + OFF_WFT), 512, (j >> 3) * 64, (j & 7) * 64, (float*)smem);
    } else if (it < B5) {
      int j = it - B4; transpose_tile(p.w_o, 1024, (j >> 4) * 64, 64, nullptr, (bfu*)(p.ws + OFF_WOT), 1024, (j >> 4) * 64, (j & 15) * 64, (float*)smem);
    } else {
      int j = it - B5; int hh = j >> 5, kt = (j >> 4) & 1, dt = j & 15;
      float* sW = (float*)smem; float* sK = sW + 64 * 129;
      const float* ksub = (hh & 1) ? p.k2 : p.k1;
      __syncthreads();
#pragma unroll
      for (int i = 0; i < 8; i++) {
        int id = tid + i * 256; int row = id >> 5, c4 = (id & 31) * 4;
        float4 v = *(const float4*)(p.peer_wq + (size_t)(dt * 64 + row) * 2048 + hh * 128 + c4);
        sW[row * 129 + c4] = v.x; sW[row * 129 + c4 + 1] = v.y; sW[row * 129 + c4 + 2] = v.z; sW[row * 129 + c4 + 3] = v.w;
        float4 u = *(const float4*)(ksub + (size_t)(kt * 64 + row) * 128 + c4);
        sK[row * 129 + c4] = u.x; sK[row * 129 + c4 + 1] = u.y; sK[row * 129 + c4 + 2] = u.z; sK[row * 129 + c4 + 3] = u.w;
      }
      __syncthreads();
      int ky = (tid >> 4) * 4, dd = (tid & 15) * 4;
      float a[4][4];
#pragma unroll
      for (int i = 0; i < 4; i++)
#pragma unroll
        for (int jj = 0; jj < 4; jj++) a[i][jj] = 0.f;
      for (int c = 0; c < 128; c++) {
        float kv[4], wv[4];
#pragma unroll
        for (int i = 0; i < 4; i++) { kv[i] = sK[(ky + i) * 129 + c]; wv[i] = sW[(dd + i) * 129 + c]; }
#pragma unroll
        for (int i = 0; i < 4; i++)
#pragma unroll
          for (int jj = 0; jj < 4; jj++) a[i][jj] += kv[i] * wv[jj];
      }
      bfu* MT = (bfu*)(p.ws + OFF_MT);
      float g0 = p.norm2_g[dt * 64 + dd], g1 = p.norm2_g[dt * 64 + dd + 1], g2 = p.norm2_g[dt * 64 + dd + 2], g3 = p.norm2_g[dt * 64 + dd + 3];
#pragma unroll
      for (int i = 0; i < 4; i++)
        *(uint2*)(MT + (size_t)(hh * 128 + kt * 64 + ky + i) * DM + dt * 64 + dd) = make_uint2(pack2(a[i][0] * g0, a[i][1] * g1), pack2(a[i][2] * g2, a[i][3] * g3));
    }
  }
}

DEV void rot_angle(int pos, int d, float& cs, float& sn) {
  float inv = exp2f(-(float)d * (13.287712379549449f / 32.f));
  float ang = (float)pos * inv;
  float rev = ang * 0.15915494309189535f;
  rev = rev - floorf(rev);
  sn = __builtin_amdgcn_sinf(rev); cs = __builtin_amdgcn_cosf(rev);
}

DEV void phase1(const Params& p, int bid, int nb, char* smem, bool noepi = false) {
  bfu* sA = (bfu*)smem; bfu* sB = sA + 128 * 72;
  const bfu* XB = (const bfu*)(p.ws + OFF_XB); const bfu* WT = (const bfu*)(p.ws + OFF_WINT);
  const float* rstd1 = (const float*)(p.ws + OFF_RSTD1);
  constexpr int NT = NWP / 128;
  const int xcd = bid & 7, slot = bid >> 3, nslots = (nb + 7 - xcd) >> 3;
  constexpr int MI1 = 8;
  const int nprompt = 16 * NT;
  const int n_p = slot < nprompt ? (nprompt - slot + nslots - 1) / nslots : 0;
  const int n_s = bid < 2 * NT ? (2 * NT - bid + nb - 1) / nb : 0;
  for (int i_ = 0; i_ < n_p + n_s; i_++) {
    int mt, nt;
    if (i_ < n_p) { int q = slot + i_ * nslots; int sub = q / (8 * NT), rem = q - sub * (8 * NT); nt = rem >> 3; mt = xcd * 16 + sub * 8 + (rem & 7); }
    else { int it = bid + (i_ - n_p) * nb; mt = 128 + it / NT; nt = it - (it / NT) * NT; }
    int m0 = mt * 256, n0 = nt * 128;
    int tid = threadIdx.x; asm volatile("" : "+v"(tid));
    const int lane = tid & 63, w = tid >> 6, wr = w >> 1, wc = w & 1, l16 = lane & 15, quad = lane >> 4;
    f32x4 acc[MI1][4];
#pragma unroll
    for (int i = 0; i < MI1; i++)
#pragma unroll
      for (int j = 0; j < 4; j++) acc[i][j] = f32x4{0.f, 0.f, 0.f, 0.f};
    gemm_loop_sb<MI1, 4>(XB + (size_t)m0 * DM, DM, WT + (size_t)n0 * DM, DM, DM, acc, sA);
    if (noepi) { float t_ = 0.f;
#pragma unroll
      for (int i = 0; i < MI1; i++)
#pragma unroll
        for (int j = 0; j < 4; j++) t_ += acc[i][j][0] + acc[i][j][1] + acc[i][j][2] + acc[i][j][3];
      if (t_ == 12345.678f) p.out[0] = 1.f; continue; }
    const int rbase = m0 + wr * (MI1 * 16) + quad * 4;
    const int cbase = n0 + wc * 64 + l16;
    if (m0 >= TP) {
      float* hs = (float*)(p.ws + OFF_HS);
      bfu* gaS = (bfu*)(p.out + O_YS); bfu* gbS = gaS + (size_t)TS * DM;
#pragma unroll
      for (int mi = 0; mi < MI1; mi++)
#pragma unroll
        for (int j = 0; j < 4; j++) {
          int row = rbase + mi * 16 + j; float rs = rstd1[row]; int sr = row - TP;
#pragma unroll
          for (int ni = 0; ni < 4; ni++) {
            int col = cbase + ni * 16; float v = acc[mi][ni][j] * rs;
            if (n0 >= 4608 && n0 < 5632) gaS[(size_t)sr * DM + col - 4608] = f2bf(v);
            else if (n0 >= 5632 && n0 < 6656) gbS[(size_t)sr * DM + col - 5632] = f2bf(v);
            else hs[(size_t)sr * NWP + col] = v;
          }
        }
      continue;
    }
    const int b = m0 >> 14;
    float* sw = (float*)(smem + EPI_OFF) + w * EPI_WAVE;
    const int rrow = m0 + wr * (MI1 * 16) + (lane >> 2);
    const int rcol = (lane & 3) * 16;
    if (n0 < 1024) {
      const int isK = n0 >= 512; const int head = ((n0 & 511) >> 6) + wc;
      const float l2g = l2gamma(head);
      bfu* dst = (bfu*)(p.ws + (isK ? OFF_KT : OFF_QT));
      bfu* ktT = (bfu*)(p.ws + OFF_KTT);
#pragma unroll
      for (int mi = 0; mi < MI1; mi++) {
        f32x4 tv[4];
#pragma unroll
        for (int ni = 0; ni < 2; ni++) {
          int d = ni * 16 + l16;
          float y1[4], y2[4];
#pragma unroll
          for (int j = 0; j < 4; j++) {
            int row = rbase + mi * 16 + j; int t = row & (SEQ - 1); int l = t & (RC - 1);
            float rs = rstd1[row];
            float dec = exp2f((float)(l + 1) * l2g);
            float sc = isK ? 0.125f / dec : dec;
            float cs, sn; rot_angle(t, d, cs, sn);
            float x1 = acc[mi][ni][j] * rs, x2 = acc[mi][ni + 2][j] * rs;
            y1[j] = (x1 * cs - x2 * sn) * sc; y2[j] = (x2 * cs + x1 * sn) * sc;
            tv[ni][j] = y1[j]; tv[ni + 2][j] = y2[j];
          }
          if (isK) {
            int t0 = (rbase + mi * 16) & (SEQ - 1);
            *(uint2*)(ktT + ((size_t)((b * 8 + head) * 64 + d)) * SEQ + t0) = make_uint2(pack2(y1[0], y1[1]), pack2(y1[2], y1[3]));
            *(uint2*)(ktT + ((size_t)((b * 8 + head) * 64 + d + 32)) * SEQ + t0) = make_uint2(pack2(y2[0], y2[1]), pack2(y2[2], y2[3]));
          }
        }
        { float r[16]; to_rows(tv, r, sw, lane); int rr_ = rrow; asm volatile("" : "+v"(rr_));
          st_bf16x16(dst + (size_t)(rr_ + mi * 16) * 512 + head * 64 + rcol, r); }
      }
    } else if (n0 < 2048) {
      const int head = (n0 - 1024) >> 7;
      bfu* vT = (bfu*)(p.ws + OFF_VT);
#pragma unroll
      for (int mi = 0; mi < MI1; mi++) {
        int row0 = rbase + mi * 16; int t0 = row0 & (SEQ - 1);
        float r0 = rstd1[row0], r1 = rstd1[row0 + 1], r2 = rstd1[row0 + 2], r3 = rstd1[row0 + 3];
#pragma unroll
        for (int ni = 0; ni < 4; ni++) {
          int dv = wc * 64 + ni * 16 + l16;
          *(uint2*)(vT + ((size_t)((b * 8 + head) * 128 + dv)) * SEQ + t0) =
              make_uint2(pack2(acc[mi][ni][0] * r0, acc[mi][ni][1] * r1), pack2(acc[mi][ni][2] * r2, acc[mi][ni][3] * r3));
        }
      }
    } else if (n0 < 3072 || (n0 >= 4608 && n0 < 6656)) {
      bfu* dst; int c0;
      if (n0 < 3072) { dst = (bfu*)(p.ws + OFF_RG); c0 = 2048; }
      else if (n0 < 5632) { dst = (bfu*)(p.out + O_YP); c0 = 4608; }
      else { dst = (bfu*)(p.out + O_YP) + (size_t)TP * DM; c0 = 5632; }
#pragma unroll
      for (int mi = 0; mi < MI1; mi++) {
        f32x4 tv[4];
#pragma unroll
        for (int j = 0; j < 4; j++) {
          int row = rbase + mi * 16 + j; float rs = rstd1[row];
#pragma unroll
          for (int ni = 0; ni < 4; ni++) tv[ni][j] = acc[mi][ni][j] * rs;
        }
        float r[16]; to_rows(tv, r, sw, lane); int rr_ = rrow; asm volatile("" : "+v"(rr_));
        st_bf16x16(dst + (size_t)(rr_ + mi * 16) * DM + (n0 - c0) + wc * 64 + rcol, r);
      }
    } else if (n0 < 4096) {
      const int isK = n0 >= 3584; const int head = (((n0 - 3072) & 511) >> 6) + wc;
      const float* g = isK ? p.fk_g : p.fq_g;
      float gv[4];
#pragma unroll
      for (int ni = 0; ni < 4; ni++) gv[ni] = g[ni * 16 + l16];
      bfu* fq = (bfu*)(p.ws + OFF_FQ); bfu* fkb = (bfu*)(p.ws + OFF_FKB);
#pragma unroll
      for (int mi = 0; mi < MI1; mi++) {
        f32x4 tv[4];
#pragma unroll
        for (int j = 0; j < 4; j++) {
          int row = rbase + mi * 16 + j; float rs = rstd1[row];
          float v[4]; float ss = 0.f;
#pragma unroll
          for (int ni = 0; ni < 4; ni++) { v[ni] = acc[mi][ni][j] * rs; ss += v[ni] * v[ni]; }
          ss = sum16(ss);
          float r = rsqrtf(ss * (1.f / 64.f) + EPSN) * (isK ? 1.f : 0.125f * LOG2E);
#pragma unroll
          for (int ni = 0; ni < 4; ni++) tv[ni][j] = v[ni] * r * gv[ni];
        }
        float r[16]; to_rows(tv, r, sw, lane); int rr_ = rrow; asm volatile("" : "+v"(rr_));
        const size_t o = (size_t)(rr_ + mi * 16) * 512 + head * 64 + rcol;
        if (isK) { st_f32x16(p.out + O_FKP + o, r); st_bf16x16(fkb + o, r); }
        else st_bf16x16(fq + o, r);
      }
    } else if (n0 < 4608) {
      const int head = ((n0 - 4096) >> 6) + wc;
      bfu* fvT = (bfu*)(p.ws + OFF_FVT);
#pragma unroll
      for (int mi = 0; mi < MI1; mi++) {
        int row0 = rbase + mi * 16; int t0 = row0 & (SEQ - 1);
        float r[4] = {rstd1[row0], rstd1[row0 + 1], rstd1[row0 + 2], rstd1[row0 + 3]};
        f32x4 tv[4];
#pragma unroll
        for (int ni = 0; ni < 4; ni++) {
          int d = ni * 16 + l16; float v[4];
#pragma unroll
          for (int j = 0; j < 4; j++) { v[j] = acc[mi][ni][j] * r[j]; tv[ni][j] = v[j]; }
          *(uint2*)(fvT + ((size_t)((b * 8 + head) * 64 + d)) * SEQ + t0) = make_uint2(pack2(v[0], v[1]), pack2(v[2], v[3]));
        }
        { float rw[16]; to_rows(tv, rw, sw, lane); int rr_ = rrow; asm volatile("" : "+v"(rr_));
          st_f32x16(p.out + O_FVP + (size_t)(rr_ + mi * 16) * 512 + head * 64 + rcol, rw); }
      }
    } else {
      if (wc == 0 && l16 < 8) {
        float bf = p.b_f[l16];
#pragma unroll
        for (int mi = 0; mi < MI1; mi++)
#pragma unroll
          for (int j = 0; j < 4; j++) {
            int row = rbase + mi * 16 + j;
            float z = acc[mi][0][j] * rstd1[row] + bf;
            p.out[O_LFP + (size_t)row * 8 + l16] = fminf(z, 0.f) - log1pf(__expf(-fabsf(z)));
          }
      }
    }
  }
}

DEV void phase2(const Params& p, int bid, int nb, char* smem) {
  const int tid = threadIdx.x, lane = tid & 63, w = tid >> 6, wr = w >> 1, wc = w & 1, l16 = lane & 15, quad = lane >> 4;
  bfu* sA = (bfu*)smem; bfu* sB = sA + 128 * 72;
  const bfu* vT = (const bfu*)(p.ws + OFF_VT); const bfu* ktT = (const bfu*)(p.ws + OFF_KTT);
  float* U = (float*)(p.ws + OFF_XB);
  constexpr int NR1 = 16 * NCH;
  for (int it = bid; it < NR1 + 16; it += nb) {
    if (it < 16) {
      int bh = it, b = bh >> 3, h = bh & 7;
      double* sd = (double*)smem;
      const float* lf = p.out + O_LFP + (size_t)b * SEQ * 8 + h;
      float part = 0.f;
      for (int i = 0; i < 64; i++) part += lf[(size_t)(tid * 64 + i) * 8];
      __syncthreads();
      sd[tid] = (double)part;
      __syncthreads();
      if (tid == 0) { double run = 0.0; for (int i = 0; i < 256; i++) { double v = sd[i]; sd[i] = run; run += v; } }
      __syncthreads();
      double run = sd[tid];
      float* c2 = (float*)(p.ws + OFF_C2) + (size_t)bh * SEQ;
      for (int i = 0; i < 64; i++) { run += (double)lf[(size_t)(tid * 64 + i) * 8]; c2[tid * 64 + i] = (float)(run * (double)LOG2E); }
      __syncthreads();
    } else {
      int j = it - 16; int bh = j / NCH, c = j - bh * NCH;
      f32x4 acc[4][2];
#pragma unroll
      for (int i = 0; i < 4; i++) { acc[i][0] = f32x4{0.f, 0.f, 0.f, 0.f}; acc[i][1] = f32x4{0.f, 0.f, 0.f, 0.f}; }
      gemm_loop<4, 2>(vT + (size_t)bh * 128 * SEQ + c * RC, SEQ, ktT + (size_t)bh * 64 * SEQ + c * RC, SEQ, RC, acc, sA);
      float gC = exp2f((float)RC * l2gamma(bh & 7));
      float* Uo = U + (size_t)j * 8192;
#pragma unroll
      for (int mi = 0; mi < 4; mi++)
#pragma unroll
        for (int ni = 0; ni < 2; ni++)
#pragma unroll
          for (int jj = 0; jj < 4; jj++) {
            int dv = wr * 64 + mi * 16 + quad * 4 + jj, dk = wc * 32 + ni * 16 + l16;
            Uo[dv * 64 + dk] = acc[mi][ni][jj] * gC;
          }
    }
  }
}

DEV void sample_item(const Params& p, int item, char* smem) {
  int tid = threadIdx.x; asm volatile("" : "+v"(tid));
  const int b = item >> 3, h = item & 7;
  float* sq = (float*)smem;
  float* sk = sq + 1024;
  float* sv = sk + 1024;
  float* sP = sv + 2048;
  float* so = sP + 256;
  float* sr = so + 2048;
  float* sc = (float*)smem;
  float* fq = (float*)(smem + 34816);
  float* fk = fq + 1024;
  float* cn = fk + 1024;
  float* suf = cn + 16;
  float* red = suf + 1024;
  float* sL = red + 256;
  float* pvr = sL + 16;
  const float* hs = (const float*)(p.ws + OFF_HS) + (size_t)b * 16 * NWP;
  const float l2g = l2gamma(h);
  __syncthreads();
  for (int i = tid; i < 512; i += 256) {
    int l = i >> 5, d = i & 31; float cs, sn; rot_angle(1024 + l, d, cs, sn);
    float dec = exp2f((float)(l + 1) * l2g);
    const float* r = hs + (size_t)l * NWP;
    float x1 = r[h * 64 + d], x2 = r[h * 64 + d + 32];
    sq[l * 64 + d] = (x1 * cs - x2 * sn) * dec; sq[l * 64 + d + 32] = (x2 * cs + x1 * sn) * dec;
    x1 = r[512 + h * 64 + d]; x2 = r[512 + h * 64 + d + 32];
    float sc_ = 0.125f / dec;
    sk[l * 64 + d] = (x1 * cs - x2 * sn) * sc_; sk[l * 64 + d + 32] = (x2 * cs + x1 * sn) * sc_;
  }
  for (int i = tid; i < 2048; i += 256) { int l = i >> 7, dv = i & 127; sv[i] = hs[(size_t)l * NWP + 1024 + h * 128 + dv]; }
  __syncthreads();
  { int l = tid >> 4, m = tid & 15; float a = 0.f;
    if (l >= m) for (int d = 0; d < 64; d++) a += sq[l * 64 + d] * sk[m * 64 + d];
    sP[tid] = a; }
  __syncthreads();
  const float* S = p.state_ret + (size_t)(b * 8 + h) * 8192;
  { int dv = tid & 127, lh = tid >> 7; float o[8];
#pragma unroll
    for (int i = 0; i < 8; i++) o[i] = 0.f;
#pragma unroll 16
    for (int dk = 0; dk < 64; dk++) { float s = S[dk * 128 + dv];
#pragma unroll
      for (int i = 0; i < 8; i++) o[i] += sq[(lh * 8 + i) * 64 + dk] * s; }
    for (int m = 0; m < 16; m++) { float v = sv[m * 128 + dv];
#pragma unroll
      for (int i = 0; i < 8; i++) o[i] += sP[(lh * 8 + i) * 16 + m] * v; }
#pragma unroll
    for (int i = 0; i < 8; i++) so[(lh * 8 + i) * 128 + dv] = o[i];
    float g16 = exp2f(16.f * l2g);
    float* So = p.out + O_SS + (size_t)(b * 8 + h) * 8192;
#pragma unroll 8
    for (int i = 0; i < 32; i++) { int dk = lh * 32 + i; float a = S[dk * 128 + dv];
      for (int m = 0; m < 16; m++) a += sk[m * 64 + dk] * sv[m * 128 + dv];
      So[dk * 128 + dv] = a * g16; }
  }
  __syncthreads();
  if (tid < 16) { float ss = 0.f; for (int i = 0; i < 128; i++) { float v = so[tid * 128 + i]; ss += v * v; } sr[tid] = rsqrtf(ss * (1.f / 128.f) + EPSN); }
  __syncthreads();
  { int dv = tid & 127, lh = tid >> 7; bfu* gated = (bfu*)(p.ws + OFF_RG);
    float gg = p.gn_g[h * 128 + dv];
    for (int i = 0; i < 8; i++) { int l = lh * 8 + i; float rgv = hs[(size_t)l * NWP + 2048 + h * 128 + dv];
      float v = so[l * 128 + dv] * sr[l] * gg * (rgv * sigmoidf_(rgv));
      gated[(size_t)(TP + b * 16 + l) * DM + h * 128 + dv] = f2bf(v); } }
  {
    int l = tid >> 4, dl = tid & 15; const float* r = hs + (size_t)l * NWP;
    float qv[4], kv[4]; float sq_ = 0.f, sk_ = 0.f;
#pragma unroll
    for (int i = 0; i < 4; i++) { qv[i] = r[3072 + h * 64 + dl * 4 + i]; kv[i] = r[3584 + h * 64 + dl * 4 + i]; sq_ += qv[i] * qv[i]; sk_ += kv[i] * kv[i]; }
    sq_ = sum16(sq_); sk_ = sum16(sk_);
    float rq = rsqrtf(sq_ * (1.f / 64.f) + EPSN), rk = rsqrtf(sk_ * (1.f / 64.f) + EPSN);
#pragma unroll
    for (int i = 0; i < 4; i++) { int d = dl * 4 + i;
      fq[l * 64 + d] = qv[i] * rq * p.fq_g[d] * 0.125f;
      float kk = kv[i] * rk * p.fk_g[d]; fk[l * 64 + d] = kk;
      p.out[O_FKS + (size_t)((b * 16 + l) * 8 + h) * 64 + d] = kk;
      p.out[O_FVS + (size_t)((b * 16 + l) * 8 + h) * 64 + d] = r[4096 + h * 64 + d]; }
  }
  if (tid < 16) { float z = hs[(size_t)tid * NWP + 6656 + h] + p.b_f[h]; float lf = fminf(z, 0.f) - log1pf(__expf(-fabsf(z)));
    p.out[O_LFS + (size_t)(b * 16 + tid) * 8 + h] = lf; cn[tid] = lf; }
  { const float* cl = p.clogf + (size_t)b * 1024 * 8 + h; float v[4]; float part = 0.f;
#pragma unroll
    for (int i = 0; i < 4; i++) { v[i] = cl[(size_t)(tid * 4 + i) * 8]; part += v[i]; }
    float inc = part;
#pragma unroll
    for (int o = 1; o < 64; o <<= 1) { float t = __shfl_down(inc, o); if ((tid & 63) + o < 64) inc += t; }
    if ((tid & 63) == 0) red[tid >> 6] = inc;
    __syncthreads();
    if (tid == 0) { float c = 0.f; for (int i = 0; i < 16; i++) { c += cn[i]; cn[i] = c; } }
    float later = 0.f;
    for (int ww = (tid >> 6) + 1; ww < 4; ww++) later += red[ww];
    __syncthreads();
    float run = inc - part + later;
    for (int i = 3; i >= 0; i--) { suf[tid * 4 + i] = run; run += v[i]; }
  }
  __syncthreads();
  const float* CK = p.ck + (size_t)b * 1024 * 512 + h * 64; const float* CV = p.cv + (size_t)b * 1024 * 512 + h * 64;
  for (int pass = 0; pass < 2; pass++) {
    __syncthreads();
    for (int j = tid; j < 1040; j += 256) {
      float a[8];
#pragma unroll
      for (int qi = 0; qi < 8; qi++) a[qi] = 0.f;
      if (j < 1024) {
        const f32x4* kp = (const f32x4*)(CK + (size_t)j * 512);
        f32x4 tt[16];
#pragma unroll
        for (int i = 0; i < 16; i++) tt[i] = kp[i];
#pragma unroll
        for (int i = 0; i < 16; i++) { f32x4 t = tt[i];
#pragma unroll
          for (int qi = 0; qi < 8; qi++) { const float* qq = fq + (pass * 8 + qi) * 64 + i * 4; a[qi] += qq[0] * t[0] + qq[1] * t[1] + qq[2] * t[2] + qq[3] * t[3]; } }
      } else {
        const float* kp = fk + (j - 1024) * 64;
#pragma unroll 4
        for (int i = 0; i < 64; i++) { float t = kp[i];
#pragma unroll
          for (int qi = 0; qi < 8; qi++) a[qi] += fq[(pass * 8 + qi) * 64 + i] * t; }
      }
#pragma unroll
      for (int qi = 0; qi < 8; qi++) { int q = pass * 8 + qi;
        float bias;
        if (j < 1024) bias = suf[j] + cn[q]; else { int m = j - 1024; bias = (m <= q) ? (cn[q] - cn[m]) : -INFINITY; }
        sc[qi * 1040 + j] = a[qi] + bias; }
    }
    __syncthreads();
    { int qi = tid >> 5, l32 = tid & 31; float m = -INFINITY;
      for (int j = l32; j < 1040; j += 32) m = fmaxf(m, sc[qi * 1040 + j]);
#pragma unroll
      for (int o = 16; o >= 1; o >>= 1) m = fmaxf(m, __shfl_xor(m, o));
      float s = 0.f;
      for (int j = l32; j < 1040; j += 32) { float e = __expf(sc[qi * 1040 + j] - m); sc[qi * 1040 + j] = e; s += e; }
#pragma unroll
      for (int o = 16; o >= 1; o >>= 1) s += __shfl_xor(s, o);
      if (l32 == 0) sL[qi] = s; }
    __syncthreads();
    {
      const int kg = tid >> 4, d4 = (tid & 15) * 4;
      float ac[8][4];
#pragma unroll
      for (int qi = 0; qi < 8; qi++) { ac[qi][0] = 0.f; ac[qi][1] = 0.f; ac[qi][2] = 0.f; ac[qi][3] = 0.f; }
#pragma unroll 8
      for (int i = 0; i < 64; i++) { int j = kg + 16 * i;
        float4 v = *(const float4*)(CV + (size_t)j * 512 + d4);
#pragma unroll
        for (int qi = 0; qi < 8; qi++) { float pj = sc[qi * 1040 + j]; ac[qi][0] += pj * v.x; ac[qi][1] += pj * v.y; ac[qi][2] += pj * v.z; ac[qi][3] += pj * v.w; } }
      { const float* r = hs + (size_t)kg * NWP + 4096 + h * 64 + d4;
#pragma unroll
        for (int qi = 0; qi < 8; qi++) { float pj = sc[qi * 1040 + 1024 + kg]; ac[qi][0] += pj * r[0]; ac[qi][1] += pj * r[1]; ac[qi][2] += pj * r[2]; ac[qi][3] += pj * r[3]; } }
#pragma unroll
      for (int qi = 0; qi < 8; qi++)
#pragma unroll
        for (int c = 0; c < 4; c++) { float t = ac[qi][c]; t += __shfl_xor(t, 16); t += __shfl_xor(t, 32); ac[qi][c] = t; }
      if ((tid & 63) < 16) {
#pragma unroll
        for (int qi = 0; qi < 8; qi++)
#pragma unroll
          for (int c = 0; c < 4; c++) pvr[((tid >> 6) * 8 + qi) * 64 + d4 + c] = ac[qi][c];
      }
      __syncthreads();
      int qi = tid >> 5, d2 = (tid & 31) * 2;
      float a0 = pvr[(0 * 8 + qi) * 64 + d2] + pvr[(1 * 8 + qi) * 64 + d2] + pvr[(2 * 8 + qi) * 64 + d2] + pvr[(3 * 8 + qi) * 64 + d2];
      float a1 = pvr[(0 * 8 + qi) * 64 + d2 + 1] + pvr[(1 * 8 + qi) * 64 + d2 + 1] + pvr[(2 * 8 + qi) * 64 + d2 + 1] + pvr[(3 * 8 + qi) * 64 + d2 + 1];
      float inv = 1.f / sL[qi]; bfu* fo = (bfu*)(p.ws + OFF_FQ);
      *(unsigned*)(fo + (size_t)(TP + b * 16 + pass * 8 + qi) * 512 + h * 64 + d2) = pack2(a0 * inv, a1 * inv); }
  }
  __syncthreads();
}

DEV void peer_convert_item(const Params& p, int item) {
  const int tid = threadIdx.x, lane = tid & 63, w = tid >> 6;
  constexpr int NG = 0; const int it = item;
    {
      int r = (it - NG) * 4 + w;
      const float* src = r < 16384 ? p.peer_u + (size_t)r * DM : p.peer_v + (size_t)(r - 16384) * DM;
      float4 v0 = *(const float4*)(src + lane * 16), v1 = *(const float4*)(src + lane * 16 + 4), v2 = *(const float4*)(src + lane * 16 + 8), v3 = *(const float4*)(src + lane * 16 + 12);
      float am = fmaxf(fmaxf(fmaxf(fabsf(v0.x), fabsf(v0.y)), fmaxf(fabsf(v0.z), fabsf(v0.w))), fmaxf(fmaxf(fabsf(v1.x), fabsf(v1.y)), fmaxf(fabsf(v1.z), fabsf(v1.w))));
      am = fmaxf(am, fmaxf(fmaxf(fmaxf(fabsf(v2.x), fabsf(v2.y)), fmaxf(fabsf(v2.z), fabsf(v2.w))), fmaxf(fmaxf(fabsf(v3.x), fabsf(v3.y)), fmaxf(fabsf(v3.z), fabsf(v3.w)))));
#pragma unroll
      for (int o = 32; o >= 1; o >>= 1) am = fmaxf(am, __shfl_xor(am, o));
      float sc = am > 0.f ? 6.f / am : 1.f;
      unsigned w0 = 0, w1 = 0;
      w0 = __builtin_amdgcn_cvt_scalef32_pk_fp4_f32(w0, v0.x * sc, v0.y * sc, 1.0f, 0);
      w0 = __builtin_amdgcn_cvt_scalef32_pk_fp4_f32(w0, v0.z * sc, v0.w * sc, 1.0f, 1);
      w0 = __builtin_amdgcn_cvt_scalef32_pk_fp4_f32(w0, v1.x * sc, v1.y * sc, 1.0f, 2);
      w0 = __builtin_amdgcn_cvt_scalef32_pk_fp4_f32(w0, v1.z * sc, v1.w * sc, 1.0f, 3);
      w1 = __builtin_amdgcn_cvt_scalef32_pk_fp4_f32(w1, v2.x * sc, v2.y * sc, 1.0f, 0);
      w1 = __builtin_amdgcn_cvt_scalef32_pk_fp4_f32(w1, v2.z * sc, v2.w * sc, 1.0f, 1);
      w1 = __builtin_amdgcn_cvt_scalef32_pk_fp4_f32(w1, v3.x * sc, v3.y * sc, 1.0f, 2);
      w1 = __builtin_amdgcn_cvt_scalef32_pk_fp4_f32(w1, v3.z * sc, v3.w * sc, 1.0f, 3);
      u32x2* dst = (u32x2*)(p.ws + (r < 16384 ? OFF_PUB : OFF_PVB)) + (size_t)(r & 16383) * 64 + lane;
      *dst = u32x2{w0, w1};
      if (lane == 0) ((float*)(p.ws + OFF_PSC))[r] = am > 0.f ? am / 6.f : 1.f;
    }
}

DEV void phase3(const Params& p, int bid, int nb, char* smem) {
  const int tid = threadIdx.x;
  const float* U = (const float*)(p.ws + OFF_XB); bfu* SST = (bfu*)(p.ws + OFF_SST);
  { const int c0 = nb > 256 ? bid - 256 : bid, cs = nb > 256 ? nb - 256 : nb;
    if (c0 >= 0) for (int it = c0; it < 8192; it += cs) peer_convert_item(p, it); }
  for (int it = bid; it < 256 + 512; it += nb) {
    if (it < 256) { sample_item(p, it, smem); continue; }
    int g = (it - 256) * 256 + tid; int bh = g >> 13, e = g & 8191;
    float G = exp2f((float)RC * l2gamma(bh & 7));
    float s = 0.f;
    const float* Up = U + (size_t)bh * NCH * 8192 + e; bfu* Sp = SST + (size_t)bh * NCH * 8192 + e;
    Sp[0] = 0;
    for (int c0 = 0; c0 < NCH; c0 += 8) {
      float u[8];
#pragma unroll
      for (int i = 0; i < 8; i++) u[i] = Up[(size_t)(c0 + i) * 8192];
#pragma unroll
      for (int i = 0; i < 8; i++) { s = s * G + u[i]; if (c0 + i + 1 < NCH) Sp[(size_t)(c0 + i + 1) * 8192] = f2bf(s); }
    }
    int dv = e >> 6, dk = e & 63;
    p.out[O_SP + (size_t)bh * 8192 + dk * 128 + dv] = s;
  }
}

DEV void attn_item(const Params& p, int item, char* smem, float thr, bool dry) {
  const int tid = threadIdx.x, lane = tid & 63, w = tid >> 6, r32 = lane & 31, hi = lane >> 5;
  const int bh = item >> 7, qt = 127 - (item & 127);
  const int b = bh >> 3, h = bh & 7;
  const int q0 = qt * 128;
  bfu* sK = (bfu*)smem;
  bfu* sV = sK + 64 * 72;
  float* sC = (float*)(sV + 64 * 72);
  const float* c2 = (const float*)(p.ws + OFF_C2) + (size_t)bh * SEQ;
  bfu* FQ = (bfu*)(p.ws + OFF_FQ);
  const bfu* FKB = (const bfu*)(p.ws + OFF_FKB) + (size_t)b * SEQ * 512 + h * 64;
  const bfu* FVT = (const bfu*)(p.ws + OFF_FVT) + (size_t)bh * 64 * SEQ;
  const int jd0 = q0 >> 6;
  int pred = 0;
  if (tid < jd0) pred = (c2[q0] - c2[tid * 64 + 63]) < -thr;
  const int jstart = __syncthreads_count(pred);
  const int qrow = q0 + w * 32 + r32;
  bf16x8 qf[4];
  const bfu* qp = FQ + (size_t)(b * SEQ + qrow) * 512 + h * 64 + hi * 8;
#pragma unroll
  for (int d0 = 0; d0 < 4; d0++) qf[d0] = *(const bf16x8*)(qp + d0 * 16);
  const float cq = c2[qrow];
  float m = -INFINITY, lsum = 0.f;
  f32x16 o0, o1;
#pragma unroll
  for (int r = 0; r < 16; r++) { o0[r] = 0.f; o1[r] = 0.f; }
  u32x4 rk0, rk1, rv0, rv1; float rc = 0.f;
  const int srow = tid >> 3, sch = tid & 7;
#define ATT_GLOAD(j_) do { \
    rk0 = *(const u32x4*)(FKB + (size_t)((j_) * 64 + srow) * 512 + sch * 8); \
    rk1 = *(const u32x4*)(FKB + (size_t)((j_) * 64 + srow + 32) * 512 + sch * 8); \
    rv0 = *(const u32x4*)(FVT + (size_t)srow * SEQ + (j_) * 64 + sch * 8); \
    rv1 = *(const u32x4*)(FVT + (size_t)(srow + 32) * SEQ + (j_) * 64 + sch * 8); \
    if (tid < 64) rc = c2[(j_) * 64 + tid]; } while (0)
  ATT_GLOAD(jstart);
  for (int j = jstart; j <= jd0 + 1; j++) {
    __syncthreads();
    *(u32x4*)(sK + srow * 72 + sch * 8) = rk0; *(u32x4*)(sK + (srow + 32) * 72 + sch * 8) = rk1;
    *(u32x4*)(sV + srow * 72 + sch * 8) = rv0; *(u32x4*)(sV + (srow + 32) * 72 + sch * 8) = rv1;
    if (tid < 64) sC[tid] = rc;
    __syncthreads();
    if (j < jd0 + 1) ATT_GLOAD(j + 1);
    if (j * 64 > q0 + w * 32 + 31) continue;
    f32x16 s0, s1;
#pragma unroll
    for (int r = 0; r < 16; r++) { s0[r] = 0.f; s1[r] = 0.f; }
#pragma unroll
    for (int d0 = 0; d0 < 4; d0++) {
      bf16x8 k0 = *(const bf16x8*)(sK + r32 * 72 + d0 * 16 + hi * 8);
      bf16x8 k1 = *(const bf16x8*)(sK + (32 + r32) * 72 + d0 * 16 + hi * 8);
      s0 = __builtin_amdgcn_mfma_f32_32x32x16_bf16(k0, qf[d0], s0, 0, 0, 0);
      s1 = __builtin_amdgcn_mfma_f32_32x32x16_bf16(k1, qf[d0], s1, 0, 0, 0);
    }
    const bool diag = (j >= jd0);
    const int kbase = j * 64 + 4 * hi;
    float mloc = -INFINITY;
#pragma unroll
    for (int g = 0; g < 4; g++) {
      float4 c0 = *(const float4*)(sC + 8 * g + 4 * hi), c1 = *(const float4*)(sC + 32 + 8 * g + 4 * hi);
      float cc0[4] = {c0.x, c0.y, c0.z, c0.w}, cc1[4] = {c1.x, c1.y, c1.z, c1.w};
#pragma unroll
      for (int e = 0; e < 4; e++) {
        int r = g * 4 + e;
        float a = s0[r] + (cq - cc0[e]), bb = s1[r] + (cq - cc1[e]);
        if (diag) { int key = kbase + 8 * g + e; if (key > qrow) a = -INFINITY; if (key + 32 > qrow) bb = -INFINITY; }
        s0[r] = a; s1[r] = bb; mloc = fmaxf(mloc, fmaxf(a, bb));
      }
    }
    mloc = fmaxf(mloc, __shfl_xor(mloc, 32));
    float mn = fmaxf(m, mloc);
    float alpha = __builtin_amdgcn_exp2f(m - mn);
    m = mn;
    float ps = 0.f;
#pragma unroll
    for (int r = 0; r < 16; r++) { s0[r] = __builtin_amdgcn_exp2f(s0[r] - mn); s1[r] = __builtin_amdgcn_exp2f(s1[r] - mn); ps += s0[r] + s1[r]; }
    lsum = lsum * alpha + ps;
#pragma unroll
    for (int r = 0; r < 16; r++) { o0[r] *= alpha; o1[r] *= alpha; }
#pragma unroll
    for (int ks = 0; ks < 4; ks++) {
      union { bf16x8 v; unsigned u[4]; } pf;
#pragma unroll
      for (int e = 0; e < 4; e++) {
        int r = (ks & 1) * 8 + 2 * e;
        pf.u[e] = (ks < 2) ? pack2(s0[r], s0[r + 1]) : pack2(s1[r], s1[r + 1]);
      }
#pragma unroll
      for (int db = 0; db < 2; db++) {
        const bfu* vp = sV + (db * 32 + r32) * 72 + ks * 16 + 4 * hi;
        union { bf16x8 v; uint2 u[2]; } vf;
        vf.u[0] = *(const uint2*)vp; vf.u[1] = *(const uint2*)(vp + 8);
        if (db == 0) o0 = __builtin_amdgcn_mfma_f32_32x32x16_bf16(vf.v, pf.v, o0, 0, 0, 0);
        else o1 = __builtin_amdgcn_mfma_f32_32x32x16_bf16(vf.v, pf.v, o1, 0, 0, 0);
      }
    }
  }
  float lt = lsum + __shfl_xor(lsum, 32);
  float inv = 1.f / lt;
  bfu* op = (dry ? (bfu*)(p.ws + OFF_XB) : FQ) + (size_t)(b * SEQ + qrow) * 512 + h * 64;
#pragma unroll
  for (int g = 0; g < 4; g++) {
    *(uint2*)(op + 8 * g + 4 * hi) = make_uint2(pack2(o0[g * 4] * inv, o0[g * 4 + 1] * inv), pack2(o0[g * 4 + 2] * inv, o0[g * 4 + 3] * inv));
    *(uint2*)(op + 32 + 8 * g + 4 * hi) = make_uint2(pack2(o1[g * 4] * inv, o1[g * 4 + 1] * inv), pack2(o1[g * 4 + 2] * inv, o1[g * 4 + 3] * inv));
  }
  __syncthreads();
}

DEV void r3_item(const Params& p, int item, char* smem, bool dry) {
  const int tid = threadIdx.x, lane = tid & 63, w = tid >> 6, wr = w >> 1, wc = w & 1, l16 = lane & 15, quad = lane >> 4;
  const int bh = item / NCH, c = item - bh * NCH; const int b = bh >> 3, h = bh & 7;
  bfu* sQ = (bfu*)smem; bfu* sK = sQ + 128 * 72; bfu* sP = sK + 128 * 72; float* sRed = (float*)(sP + 128 * 136);
  const size_t row0 = (size_t)b * SEQ + c * RC;
  const bfu* Q = (const bfu*)(p.ws + OFF_QT) + row0 * 512 + h * 64;
  const bfu* Kk = (const bfu*)(p.ws + OFF_KT) + row0 * 512 + h * 64;
  const bfu* vT = (const bfu*)(p.ws + OFF_VT) + (size_t)bh * 128 * SEQ + c * RC;
  const bfu* ST = (const bfu*)(p.ws + OFF_SST) + (size_t)item * 8192;
  u32x4 ra[4], rb[4];
  g2r<128>(Q, 512, ra); g2r<128>(Kk, 512, rb);
  __syncthreads();
  r2s<128>(sQ, ra); r2s<128>(sK, rb);
  __syncthreads();
  g2r<128>(vT, SEQ, rb);
  f32x4 acc[4][4];
#pragma unroll
  for (int i = 0; i < 4; i++)
#pragma unroll
    for (int j = 0; j < 4; j++) acc[i][j] = f32x4{0.f, 0.f, 0.f, 0.f};
  mma64<4, 4>(sQ, 72, sK, 72, acc);
#pragma unroll
  for (int mi = 0; mi < 4; mi++)
#pragma unroll
    for (int ni = 0; ni < 4; ni++)
#pragma unroll
      for (int j = 0; j < 4; j++) {
        int row = wr * 64 + mi * 16 + quad * 4 + j, col = wc * 64 + ni * 16 + l16;
        sP[row * 136 + col] = (col <= row) ? f2bf(acc[mi][ni][j]) : (bfu)0;
      }
#pragma unroll
  for (int i = 0; i < 4; i++)
#pragma unroll
    for (int j = 0; j < 4; j++) acc[i][j] = f32x4{0.f, 0.f, 0.f, 0.f};
  __syncthreads();
  r2s<128>(sK, rb);
  __syncthreads();
  g2r<128>(vT + 64, SEQ, rb);
  mma64<4, 4>(sP, 136, sK, 72, acc);
  __syncthreads();
  r2s<128>(sK, rb);
  __syncthreads();
  g2r<128>(ST, 64, rb);
  mma64<4, 4>(sP + 64, 136, sK, 72, acc);
  __syncthreads();
  r2s<128>(sK, rb);
  __syncthreads();
  mma64<4, 4>(sQ, 72, sK, 72, acc);
  float ssq[4][4];
#pragma unroll
  for (int mi = 0; mi < 4; mi++)
#pragma unroll
    for (int j = 0; j < 4; j++) { float s = 0.f;
#pragma unroll
      for (int ni = 0; ni < 4; ni++) s += acc[mi][ni][j] * acc[mi][ni][j];
      s = sum16(s); ssq[mi][j] = s;
      if (l16 == 0) sRed[(wr * 64 + mi * 16 + quad * 4 + j) * 2 + wc] = s; }
  __syncthreads();
  bfu* RG = (bfu*)(p.ws + OFF_RG);
  float gg[4];
#pragma unroll
  for (int ni = 0; ni < 4; ni++) gg[ni] = p.gn_g[h * 128 + wc * 64 + ni * 16 + l16];
  float* sw = (float*)smem + w * EPI_WAVE;
#pragma unroll
  for (int mi = 0; mi < 4; mi++) {
    f32x4 tv[4];
#pragma unroll
    for (int j = 0; j < 4; j++) {
      int row = wr * 64 + mi * 16 + quad * 4 + j;
      float tot = sRed[row * 2] + sRed[row * 2 + 1];
      float r = rsqrtf(tot * (1.f / 128.f) + EPSN);
#pragma unroll
      for (int ni = 0; ni < 4; ni++) tv[ni][j] = acc[mi][ni][j] * r * gg[ni];
    }
    float rw[16], g[16]; to_rows(tv, rw, sw, lane);
    int rr_ = lane >> 2; asm volatile("" : "+v"(rr_));
    const size_t o = (row0 + wr * 64 + mi * 16 + rr_) * DM + h * 128 + wc * 64 + (lane & 3) * 16;
    ld_bf16x16(RG + o, g);
#pragma unroll
    for (int e = 0; e < 16; e++) rw[e] *= g[e] * sigmoidf_(g[e]);
    st_bf16x16(dry ? (bfu*)(p.ws + OFF_XB) + (o & 0xffffff) : RG + o, rw);
  }
  __syncthreads();
}

DEV void phase4(const Params& p, int bid, int nb, char* smem, bool dry = false) {
  float gq = 0.f, gk = 0.f;
  for (int i = 0; i < 64; i++) { gq = fmaxf(gq, fabsf(p.fq_g[i])); gk = fmaxf(gk, fabsf(p.fk_g[i])); }
  const float thr = 2.f * (8.f * gq * gk * 1.03f * LOG2E) + 44.f;
  for (int it = bid; it < 2048 + 16 * NCH; it += nb) {
    if (it < 2048) attn_item(p, it, smem, thr, dry); else r3_item(p, it - 2048, smem, dry);
  }
}

DEV void phase5(const Params& p, int bid, int nb, char* smem) {
  const int tid = threadIdx.x, lane = tid & 63, w = tid >> 6, wr = w >> 1, wc = w & 1, l16 = lane & 15, quad = lane >> 4;
  bfu* sA = (bfu*)smem; bfu* sB = sA + 128 * 72;
  const bfu* G = (const bfu*)(p.ws + OFF_RG); const bfu* FO = (const bfu*)(p.ws + OFF_FQ);
  const bfu* WR = (const bfu*)(p.ws + OFF_WRT); const bfu* WF = (const bfu*)(p.ws + OFF_WFT);
  bfu* MX = (bfu*)(p.ws + OFF_XB);
  constexpr int NG = (TT / 128) * 8, NCV = 8192;
  const int xcd = bid & 7, slot = bid >> 3, nslots = (nb + 7 - xcd) >> 3;
  const int n_p = slot < 128 ? (128 - slot + nslots - 1) / nslots : 0;
  for (int i_ = 0; i_ < n_p; i_++) {
    int q = slot + i_ * nslots; int mt = xcd * 16 + (q >> 3), nt = q & 7;
    int m0 = mt * 256, n0 = nt * 128;
    int tid2 = threadIdx.x; asm volatile("" : "+v"(tid2));
    const int lane2 = tid2 & 63, w2 = tid2 >> 6, wr2 = w2 >> 1, wc2 = w2 & 1, l162 = lane2 & 15, quad2 = lane2 >> 4;
    f32x4 a1[8][4];
#pragma unroll
    for (int i = 0; i < 8; i++)
#pragma unroll
      for (int j = 0; j < 4; j++) a1[i][j] = f32x4{0.f, 0.f, 0.f, 0.f};
    gemm_loop_sb<8, 4>(G + (size_t)m0 * DM, DM, WR + (size_t)n0 * DM, DM, DM, a1, sA);
    const bfu* ga = (const bfu*)(p.out + O_YP); const bfu* gb = ga + (size_t)TP * DM;
    float* sw = (float*)(smem + EPI_OFF) + w2 * EPI_WAVE;
    const int rr = lane2 >> 2, c0 = wc2 * 64 + (lane2 & 3) * 16;
#pragma unroll
    for (int mi = 0; mi < 8; mi++) {
      float r[16], g[16]; to_rows(a1[mi], r, sw, lane2);
      int rr_ = rr; asm volatile("" : "+v"(rr_));
      const size_t o = (size_t)(m0 + wr2 * 128 + mi * 16 + rr_) * DM + n0 + c0;
      ld_bf16x16(ga + o, g);
#pragma unroll
      for (int e = 0; e < 16; e++) r[e] *= sigmoidf_(g[e]);
      st_bf16x16(MX + o, r);
#pragma unroll
      for (int ni = 0; ni < 4; ni++) a1[mi][ni] = f32x4{0.f, 0.f, 0.f, 0.f};
    }
    gemm_loop_sb<8, 4>(FO + (size_t)m0 * 512, 512, WF + (size_t)n0 * 512, 512, 512, a1, sA);
#pragma unroll
    for (int mi = 0; mi < 8; mi++) {
      float r[16], g[16], m[16]; to_rows(a1[mi], r, sw, lane2);
      int rr_ = rr; asm volatile("" : "+v"(rr_));
      const size_t o = (size_t)(m0 + wr2 * 128 + mi * 16 + rr_) * DM + n0 + c0;
      ld_bf16x16(gb + o, g); ld_bf16x16(MX + o, m);
#pragma unroll
      for (int e = 0; e < 16; e++) r[e] = m[e] + sigmoidf_(g[e]) * r[e];
      st_bf16x16(MX + o, r);
    }
  }
  if (bid < 128) {
    int nt = bid & 7;
    int m0 = TP + (bid >> 3) * 32, n0 = nt * 128;
    f32x4 a1[1][4];
#pragma unroll
    for (int j = 0; j < 4; j++) a1[0][j] = f32x4{0.f, 0.f, 0.f, 0.f};
    gemm_loop<1, 4>(G + (size_t)m0 * DM, DM, WR + (size_t)n0 * DM, DM, DM, a1, sA);
    const bfu* ga = (const bfu*)(p.out + O_YS) + (size_t)(m0 - TP) * DM + n0; const bfu* gb = ga + (size_t)TS * DM;
    bfu* mxT = MX + (size_t)m0 * DM + n0;
    unsigned loff = (unsigned)((wr * 16 + quad * 4) * DM + wc * 64 + l16); asm volatile("" : "+v"(loff));
#pragma unroll
    for (int ni = 0; ni < 4; ni++) {
#pragma unroll
      for (int j = 0; j < 4; j++) { unsigned o = loff + (unsigned)(j * DM + ni * 16);
        mxT[o] = f2bf(sigmoidf_(bf2f(ga[o])) * a1[0][ni][j]); }
      a1[0][ni] = f32x4{0.f, 0.f, 0.f, 0.f};
    }
    gemm_loop<1, 4>(FO + (size_t)m0 * 512, 512, WF + (size_t)n0 * 512, 512, 512, a1, sA);
    unsigned loff2 = loff; asm volatile("" : "+v"(loff2));
#pragma unroll
    for (int ni = 0; ni < 4; ni++) {
#pragma unroll
      for (int j = 0; j < 4; j++) { unsigned o = loff2 + (unsigned)(j * DM + ni * 16);
        mxT[o] = f2bf(bf2f(mxT[o]) + sigmoidf_(bf2f(gb[o])) * a1[0][ni][j]); }
    }
  }
}

DEV void phase6(const Params& p, int bid, int nb, char* smem) {
  bfu* sA = (bfu*)smem;
  const bfu* MX = (const bfu*)(p.ws + OFF_XB); const bfu* WO = (const bfu*)(p.ws + OFF_WOT);
  bfu* X1B = (bfu*)(p.ws + OFF_X1B); float* SSQ2 = (float*)(p.ws + OFF_SSQ2);
  const int xcd = bid & 7, slot = bid >> 3, nslots = (nb + 7 - xcd) >> 3;
  const int n_p = slot < 128 ? (128 - slot + nslots - 1) / nslots : 0;
  for (int i_ = 0; i_ < n_p; i_++) {
    int q = slot + i_ * nslots; int mt = xcd * 16 + (q >> 3), nt = q & 7;
    int m0 = mt * 256, n0 = nt * 128;
    int tid = threadIdx.x; asm volatile("" : "+v"(tid));
    const int lane = tid & 63, w = tid >> 6, wr = w >> 1, wc = w & 1, l16 = lane & 15, quad = lane >> 4;
    f32x4 acc[8][4];
#pragma unroll
    for (int i = 0; i < 8; i++)
#pragma unroll
      for (int j = 0; j < 4; j++) acc[i][j] = f32x4{0.f, 0.f, 0.f, 0.f};
    gemm_loop_sb<8, 4>(MX + (size_t)m0 * DM, DM, WO + (size_t)n0 * DM, DM, DM, acc, sA);
    float* sw = (float*)(smem + EPI_OFF) + w * EPI_WAVE;
    const int rr = lane >> 2, c0 = wc * 64 + (lane & 3) * 16;
#pragma unroll
    for (int mi = 0; mi < 8; mi++) {
      float r[16]; to_rows(acc[mi], r, sw, lane);
      int rr_ = rr; asm volatile("" : "+v"(rr_));
      const size_t o = (size_t)(m0 + wr * 128 + mi * 16 + rr_) * DM + n0 + c0;
      const float* xp = (m0 < TP ? p.x_p : p.x_s - (size_t)TP * DM) + o;
      float ss = 0.f;
#pragma unroll
      for (int c = 0; c < 4; c++) { f32x4 xv = *(const f32x4*)(xp + 4 * c);
#pragma unroll
        for (int e = 0; e < 4; e++) { r[4 * c + e] += xv[e]; ss += r[4 * c + e] * r[4 * c + e]; } }
      st_f32x16(p.out + O_YP + o, r);
      st_bf16x16(X1B + o, r);
      ss += __shfl_xor(ss, 1); ss += __shfl_xor(ss, 2);
      if ((lane & 3) == 0) SSQ2[(size_t)(m0 + wr * 128 + mi * 16 + rr) * 16 + nt * 2 + wc] = ss;
    }
  }
  if (bid < 128) {
    const int tid = threadIdx.x, lane = tid & 63, w = tid >> 6, wr = w >> 1, wc = w & 1, l16 = lane & 15, quad = lane >> 4;
    int nt = bid & 7;
    int m0 = TP + (bid >> 3) * 32, n0 = nt * 128;
    f32x4 acc[1][4];
#pragma unroll
    for (int j = 0; j < 4; j++) acc[0][j] = f32x4{0.f, 0.f, 0.f, 0.f};
    gemm_loop<1, 4>(MX + (size_t)m0 * DM, DM, WO + (size_t)n0 * DM, DM, DM, acc, sA);
    const float* xin = p.x_s + (size_t)(m0 - TP) * DM + n0;
    float* y = p.out + O_YS + (size_t)(m0 - TP) * DM + n0;
    bfu* xb1 = X1B + (size_t)m0 * DM + n0;
    unsigned loff = (unsigned)((wr * 16 + quad * 4) * DM + wc * 64 + l16); asm volatile("" : "+v"(loff));
#pragma unroll
    for (int j = 0; j < 4; j++) {
      int lr = wr * 16 + quad * 4 + j; float ss = 0.f;
#pragma unroll
      for (int ni = 0; ni < 4; ni++) {
        unsigned o = loff + (unsigned)(j * DM + ni * 16);
        float v = xin[o] + acc[0][ni][j];
        y[o] = v; xb1[o] = f2bf(v); ss += v * v;
      }
      ss = sum16(ss);
      if (l16 == 0) (SSQ2 + (size_t)m0 * 16 + nt * 2)[(unsigned)(lr * 16 + wc)] = ss;
    }
  }
}

DEV int fkey(float x, int idx, int mask) { int b = __float_as_int(x); b ^= (b >> 31) & 0x7fffffff; return (b & ~mask) | idx; }
DEV void ins16(int (&t)[16], int v) {
#pragma unroll
  for (int s = 0; s < 16; s++) { int hi = max(t[s], v); v = min(t[s], v); t[s] = hi; }
}

DEV void phase7(const Params& p, int bid, int nb, char* smem) {
  const int tid = threadIdx.x, lane = tid & 63, w = tid >> 6, wr = w >> 1, wc = w & 1, l16 = lane & 15, quad = lane >> 4;
  bfu* sA = (bfu*)smem;
  float* sS = (float*)smem;
  int* sL = (int*)(smem + 33024);
  float* sTV = (float*)(smem + 55296);
  int* sTI = (int*)(sTV + 2 * 64 * 17);
  const bfu* X1B = (const bfu*)(p.ws + OFF_X1B); const bfu* MT = (const bfu*)(p.ws + OFF_MT);
  const float* SSQ2 = (const float*)(p.ws + OFF_SSQ2);
  int2* ROUTE = (int2*)(p.ws + OFF_ROUTE);
  constexpr int NI7 = (TT / 64) * 8;
  const int xcd = bid & 7, slot = bid >> 3, nslots = (nb + 7 - xcd) >> 3;
  for (int q = slot; q < 520; q += nslots) {
    int hg = q / 260, q2 = q - hg * 260; int mt = xcd * 65 + (q2 >> 2), h = hg * 4 + (q2 & 3); int m0 = mt * 64;
    for (int half = 0; half < 2; half++) {
      f32x4 acc[2][4];
#pragma unroll
      for (int i = 0; i < 2; i++)
#pragma unroll
        for (int j = 0; j < 4; j++) acc[i][j] = f32x4{0.f, 0.f, 0.f, 0.f};
      gemm_loop<2, 4>(X1B + (size_t)m0 * DM, DM, MT + (size_t)(h * 256 + half * 128) * DM, DM, DM, acc, sA);
      __syncthreads();
#pragma unroll
      for (int mi = 0; mi < 2; mi++)
#pragma unroll
        for (int j = 0; j < 4; j++) {
          int lr = wr * 32 + mi * 16 + quad * 4 + j;
          const float* sp = SSQ2 + (size_t)(m0 + lr) * 16; float tot = 0.f;
#pragma unroll
          for (int i = 0; i < 16; i++) tot += sp[i];
          float rs = rsqrtf(tot * (1.f / DM) + EPSN);
#pragma unroll
          for (int ni = 0; ni < 4; ni++) sS[lr * 129 + wc * 64 + ni * 16 + l16] = acc[mi][ni][j] * rs;
        }
      __syncthreads();
      { int row = tid & 63, q = tid >> 6; int t[16];
#pragma unroll
        for (int s = 0; s < 16; s++) t[s] = (int)0x80000000;
#pragma unroll 8
        for (int i = 0; i < 32; i++) { int idx = q * 32 + i; ins16(t, fkey(sS[row * 129 + idx], idx, 127)); }
#pragma unroll
        for (int s = 0; s < 16; s++) sL[row * 65 + q * 16 + s] = t[s]; }
      __syncthreads();
      if (tid < 64) { int row = tid; int p0 = 0, p1 = 0, p2 = 0, p3 = 0; const int* L = sL + row * 65;
        for (int r = 0; r < 16; r++) {
          int a0 = L[p0], a1 = L[16 + p1], a2 = L[32 + p2], a3 = L[48 + p3];
          int mx = max(max(a0, a1), max(a2, a3));
          if (mx == a0) p0++; else if (mx == a1) p1++; else if (mx == a2) p2++; else p3++;
          int idx = mx & 127;
          sTV[(half * 64 + row) * 17 + r] = sS[row * 129 + idx]; sTI[(half * 64 + row) * 17 + r] = idx; } }
      __syncthreads();
    }
    if (tid < 64) {
      int row = tid; float v1[16], v2[16];
#pragma unroll
      for (int i = 0; i < 16; i++) { v1[i] = sTV[row * 17 + i]; v2[i] = sTV[(64 + row) * 17 + i]; }
      int t[16];
#pragma unroll
      for (int s = 0; s < 16; s++) t[s] = (int)0x80000000;
#pragma unroll
      for (int i = 0; i < 16; i++)
#pragma unroll
        for (int j = 0; j < 16; j++)
          if ((i + 1) * (j + 1) <= 16) ins16(t, fkey(v1[i] + v2[j], i * 16 + j, 255));
      float es[16]; int ei[16]; float mx = 0.f, sum = 0.f;
#pragma unroll
      for (int r = 0; r < 16; r++) { int c = t[r] & 255; int i = c >> 4, j = c & 15;
        float s = sTV[row * 17 + i] + sTV[(64 + row) * 17 + j];
        ei[r] = sTI[row * 17 + i] * 128 + sTI[(64 + row) * 17 + j];
        if (r == 0) mx = s;
        es[r] = __expf(s - mx); sum += es[r]; }
      float inv = 1.f / sum;
      int2* ro = ROUTE + ((size_t)(m0 + row) * 8 + h) * 16;
#pragma unroll
      for (int r = 0; r < 16; r++) ro[r] = make_int2(ei[r], __float_as_int(es[r] * inv));
    }
    __syncthreads();
  }
}

#define FP4PK(w_, sel_) __builtin_amdgcn_cvt_scalef32_pk_f32_fp4((w_), 1.0f, (sel_))
DEV float dot16_fp8(const u32x2& u, const f32x2 (&xn)[8]) {
  f32x2 s = FP4PK(u[0], 0) * xn[0];
  s = FP4PK(u[0], 1) * xn[1] + s;
  s = FP4PK(u[0], 2) * xn[2] + s;
  s = FP4PK(u[0], 3) * xn[3] + s;
  s = FP4PK(u[1], 0) * xn[4] + s;
  s = FP4PK(u[1], 1) * xn[5] + s;
  s = FP4PK(u[1], 2) * xn[6] + s;
  s = FP4PK(u[1], 3) * xn[7] + s;
  return s[0] + s[1];
}
DEV void axpy16_fp8(const u32x2& u, float wj, f32x2 (&acc)[8]) {
  const f32x2 w2 = {wj, wj};
  acc[0] = FP4PK(u[0], 0) * w2 + acc[0];
  acc[1] = FP4PK(u[0], 1) * w2 + acc[1];
  acc[2] = FP4PK(u[0], 2) * w2 + acc[2];
  acc[3] = FP4PK(u[0], 3) * w2 + acc[3];
  acc[4] = FP4PK(u[1], 0) * w2 + acc[4];
  acc[5] = FP4PK(u[1], 1) * w2 + acc[5];
  acc[6] = FP4PK(u[1], 2) * w2 + acc[6];
  acc[7] = FP4PK(u[1], 3) * w2 + acc[7];
}
template <int S>
DEV void red_step(float (&pp)[16], int lane) {
  const bool up = (lane & S) != 0;
#pragma unroll
  for (int i = 0; i < S; i++) {
    float send = up ? pp[i] : pp[i + S];
    float keep = up ? pp[i + S] : pp[i];
    pp[i] = keep + __shfl_xor(send, S);
  }
}
DEV float reduce16(float (&pp)[16], int lane) {
  red_step<8>(pp, lane); red_step<4>(pp, lane); red_step<2>(pp, lane); red_step<1>(pp, lane);
  float v = pp[0];
  v += __shfl_xor(v, 16); v += __shfl_xor(v, 32);
  return v;
}

DEV void phase8(const Params& p, int bid, int nb, char* smem, bool dry = false) {
  const int tid = threadIdx.x, lane = tid & 63, w = __builtin_amdgcn_readfirstlane(tid >> 6);
  const u32x2* PUB = (const u32x2*)(p.ws + OFF_PUB); const u32x2* PVB = (const u32x2*)(p.ws + OFF_PVB);
  const float* PSC = (const float*)(p.ws + OFF_PSC);
  const float* SSQ2 = (const float*)(p.ws + OFF_SSQ2); const int2* ROUTE = (const int2*)(p.ws + OFF_ROUTE);
  for (int it = bid; it < TT / 4; it += nb) {
    int tok = it * 4 + w;
    float* y = tok < TP ? p.out + O_YP + (size_t)tok * DM : p.out + O_YS + (size_t)(tok - TP) * DM;
    float x[16]; f32x2 xn[8];
    { float4 a0 = *(const float4*)(y + lane * 16), a1 = *(const float4*)(y + lane * 16 + 4), b0 = *(const float4*)(y + lane * 16 + 8), b1 = *(const float4*)(y + lane * 16 + 12);
      x[0] = a0.x; x[1] = a0.y; x[2] = a0.z; x[3] = a0.w; x[4] = a1.x; x[5] = a1.y; x[6] = a1.z; x[7] = a1.w;
      x[8] = b0.x; x[9] = b0.y; x[10] = b0.z; x[11] = b0.w; x[12] = b1.x; x[13] = b1.y; x[14] = b1.z; x[15] = b1.w; }
    float tot = 0.f;
    { const float* sp = SSQ2 + (size_t)tok * 16;
#pragma unroll
      for (int i = 0; i < 16; i++) tot += sp[i]; }
    float rs = rsqrtf(tot * (1.f / DM) + EPSN);
#pragma unroll
    for (int i = 0; i < 8; i++) { xn[i][0] = x[2 * i] * rs * p.norm2_g[lane * 16 + 2 * i]; xn[i][1] = x[2 * i + 1] * rs * p.norm2_g[lane * 16 + 2 * i + 1]; }
    const int2* rt = ROUTE + (size_t)tok * 128;
    int2 r0 = rt[lane], r1 = rt[lane + 64];
    float d0 = 0.f, d1 = 0.f, w0 = 0.f, w1 = 0.f;
    f32x2 acc[8];
#pragma unroll
    for (int i = 0; i < 8; i++) acc[i] = f32x2{0.f, 0.f};
#define P8_LOAD(buf, tb_, gi_) do { const int rx_ = ((gi_) & 4) ? r1.x : r0.x; \
      _Pragma("unroll") for (int jj = 0; jj < 16; jj++) { int e = __builtin_amdgcn_readlane(rx_, ((gi_) & 3) * 16 + jj); buf[jj] = tb_[(size_t)e * 64 + lane]; } } while (0)
#define P8_COMPU(buf, gi_) do { float pp[16]; \
      _Pragma("unroll") for (int jj = 0; jj < 16; jj++) pp[jj] = dot16_fp8(buf[jj], xn); \
      float v_ = reduce16(pp, lane); \
      if ((lane >> 4) == ((gi_) & 3)) { if ((gi_) < 4) d0 = v_; else d1 = v_; } } while (0)
#define P8_COMPV(buf, gi_) do { const int wx_ = __float_as_int(((gi_) & 4) ? w1 : w0); \
      _Pragma("unroll") for (int jj = 0; jj < 16; jj++) { float wj = __int_as_float(__builtin_amdgcn_readlane(wx_, ((gi_) & 3) * 16 + jj)); axpy16_fp8(buf[jj], wj, acc); } } while (0)
#define P8_SB() __builtin_amdgcn_sched_barrier(0)
    {
      u32x2 ua[16], ub[16];
      P8_LOAD(ua, PUB, 0);
#pragma unroll 1
      for (int gi = 0; gi < 6; gi += 2) {
        P8_LOAD(ub, PUB, gi + 1); P8_SB();
        P8_COMPU(ua, gi); P8_SB();
        P8_LOAD(ua, PUB, gi + 2); P8_SB();
        P8_COMPU(ub, gi + 1); P8_SB();
      }
      P8_LOAD(ub, PUB, 7); P8_SB();
      P8_COMPU(ua, 6); P8_SB();
      P8_LOAD(ua, PVB, 0); P8_SB();
      P8_COMPU(ub, 7); P8_SB();
      d0 *= PSC[r0.x]; d1 *= PSC[r1.x];
      w0 = 0.5f * d0 * (1.f + erff(d0 * 0.70710678118654752f)) * __int_as_float(r0.y) * PSC[16384 + r0.x];
      w1 = 0.5f * d1 * (1.f + erff(d1 * 0.70710678118654752f)) * __int_as_float(r1.y) * PSC[16384 + r1.x];
      P8_SB();
#pragma unroll 1
      for (int gi = 0; gi < 6; gi += 2) {
        P8_LOAD(ub, PVB, gi + 1); P8_SB();
        P8_COMPV(ua, gi); P8_SB();
        P8_LOAD(ua, PVB, gi + 2); P8_SB();
        P8_COMPV(ub, gi + 1); P8_SB();
      }
      P8_LOAD(ub, PVB, 7); P8_SB();
      P8_COMPV(ua, 6); P8_SB();
      P8_COMPV(ub, 7);
    }
    if (dry) y = (float*)(p.ws + OFF_XB) + (size_t)(tok & 8191) * DM;
    *(float4*)(y + lane * 16) = make_float4(x[0] + acc[0][0], x[1] + acc[0][1], x[2] + acc[1][0], x[3] + acc[1][1]);
    *(float4*)(y + lane * 16 + 4) = make_float4(x[4] + acc[2][0], x[5] + acc[2][1], x[6] + acc[3][0], x[7] + acc[3][1]);
    *(float4*)(y + lane * 16 + 8) = make_float4(x[8] + acc[4][0], x[9] + acc[4][1], x[10] + acc[5][0], x[11] + acc[5][1]);
    *(float4*)(y + lane * 16 + 12) = make_float4(x[12] + acc[6][0], x[13] + acc[6][1], x[14] + acc[7][0], x[15] + acc[7][1]);
  }
}

#define XB_TMO      128
#define XB_XCNT(j)  (256  + 64 * (j))
#define XB_XSUB(j)  (1280 + 64 * (j))
#define XB_XGEN(j)  (2304 + 64 * (j))
#define XB_TOP      3328
#define XB_TOPGEN   3392
#define XCD_BAR_WORDS 3456
#define XB_SPIN_CAP (1u << 18)
#define LAS __attribute__((address_space(3)))

__device__ __forceinline__ unsigned xb_ld(unsigned* p)              { return __hip_atomic_load(p, __ATOMIC_RELAXED, __HIP_MEMORY_SCOPE_AGENT); }
__device__ __forceinline__ unsigned xb_add(unsigned* p, unsigned v) { return __hip_atomic_fetch_add(p, v, __ATOMIC_RELAXED, __HIP_MEMORY_SCOPE_AGENT); }
__device__ __forceinline__ unsigned xb_xcc_id() { return (unsigned)__builtin_amdgcn_s_getreg((3 << 11) | 20) & 0xFu; }
#define XB_SPIN(cond, bar) do { unsigned _sp = 0; while (cond) { __builtin_amdgcn_s_sleep(1); \
    if ((++_sp & 255u) == 0u) { if (xb_ld(&(bar)[XB_TMO])) break; if (_sp > XB_SPIN_CAP) { atomicAdd(&(bar)[XB_TMO], 1u); break; } } } } while (0)

struct XcdBarrier {
    unsigned* bar; unsigned x;
    volatile LAS unsigned* st;
};

__device__ __forceinline__ XcdBarrier xcd_barrier_post(unsigned* bar, volatile LAS unsigned* st) {
    XcdBarrier b; b.bar = bar; b.x = xb_xcc_id(); b.st = st;
    if (threadIdx.x == 0) (void)xb_add(&bar[XB_XCNT(b.x)], 1u);
    return b;
}
__device__ __forceinline__ void xcd_barrier_complete(unsigned* bar, unsigned x, unsigned& nloc, unsigned& nx) {
    const unsigned G = gridDim.x * gridDim.y * gridDim.z;
    unsigned sum, cnt, mine, sp = 0u;
    for (;;) {
        sum = 0u; cnt = 0u; mine = 0u;
#pragma unroll
        for (unsigned j = 0; j < 16; ++j) { const unsigned c = xb_ld(&bar[XB_XCNT(j)]); sum += c; cnt += (c > 0u) ? 1u : 0u; mine = (j == x) ? c : mine; }
        if (sum == G) break;
        __builtin_amdgcn_s_sleep(1);
        if ((++sp & 255u) == 0u) { if (xb_ld(&bar[XB_TMO])) break; if (sp > XB_SPIN_CAP) { atomicAdd(&bar[XB_TMO], 1u); break; } }
    }
    nloc = mine > 0u ? mine : 1u; nx = cnt > 0u ? cnt : 1u;
}

__device__ __forceinline__ void xcd_barrier(const XcdBarrier& b) {
    asm volatile("s_waitcnt vmcnt(0)" ::: "memory");
    __syncthreads();
    if (threadIdx.x == 0) {
        unsigned* bar = b.bar;
        __builtin_amdgcn_s_waitcnt(0);
        unsigned nloc = b.st[0], nx = b.st[1];
        if (nloc == 0u) { xcd_barrier_complete(bar, b.x, nloc, nx); b.st[0] = nloc; b.st[1] = nx; }
        const unsigned old = xb_add(&bar[XB_XSUB(b.x)], 1u);
        const unsigned gen = old / nloc;
        if (old + 1u == (gen + 1u) * nloc) {
            __builtin_amdgcn_fence(__ATOMIC_RELEASE, "agent");
            asm volatile("s_waitcnt vmcnt(0)" ::: "memory");
            const unsigned og = xb_add(&bar[XB_TOP], 1u);
            const unsigned tg = og / nx;
            if (og + 1u == (tg + 1u) * nx) xb_add(&bar[XB_TOPGEN], 1u);
            else XB_SPIN(xb_ld(&bar[XB_TOPGEN]) == tg, bar);
            __builtin_amdgcn_fence(__ATOMIC_ACQUIRE, "agent");
            xb_add(&bar[XB_XGEN(b.x)], 1u);
            asm volatile("s_waitcnt vmcnt(0)" ::: "memory");
        } else {
            XB_SPIN(xb_ld(&bar[XB_XGEN(b.x)]) == gen, bar);
            __builtin_amdgcn_fence(__ATOMIC_ACQUIRE, "agent");
            asm volatile("s_waitcnt vmcnt(0)" ::: "memory");
        }
    }
    __syncthreads();
}


__global__ void __launch_bounds__(256, 2) fwd_kernel(Params p, int ph_lo, int ph_hi, int coop) {
  __shared__ __attribute__((aligned(16))) char smem[SMEM_BYTES];
  const int bid = blockIdx.x, nb = gridDim.x;
  __shared__ uint4 xb_words;
  if (threadIdx.x == 0) xb_words = make_uint4(0u, 0u, 0u, 0u);
  __syncthreads();
  XcdBarrier xb; xb.bar = (unsigned*)(p.ws + OFF_BAR); xb.x = 0; xb.st = (volatile LAS unsigned*)&xb_words;
  if (coop) xb = xcd_barrier_post((unsigned*)(p.ws + OFF_BAR), (volatile LAS unsigned*)&xb_words);
#ifndef REPS
#define REPS {1,1,1,1,1,1,1,1,1}
#endif
  constexpr int REP[9] = REPS;
#define RUN_PHASE(N) if (ph_lo <= N && N <= ph_hi) { for (int r_ = 0; r_ < REP[N]; r_++) phase##N(p, bid, nb, smem); if (coop && N < ph_hi) { if (N == 0) cg::this_grid().sync(); else xcd_barrier(xb); } }
#define RUN_PHASE_DRY(N) if (ph_lo <= N && N <= ph_hi) { for (int r_ = 1; r_ < REP[N]; r_++) phase##N(p, bid, nb, smem, true); phase##N(p, bid, nb, smem, false); if (coop && N < ph_hi) xcd_barrier(xb); }
  RUN_PHASE(0) RUN_PHASE_DRY(1) RUN_PHASE(2) RUN_PHASE(3) RUN_PHASE_DRY(4) RUN_PHASE(5) RUN_PHASE(6) RUN_PHASE(7) RUN_PHASE_DRY(8)
}

extern "C" void kernel_launch(void* const* d_in, const int* in_sizes, int n_in, void* d_out, int out_size,
                              void* d_ws, size_t ws_size, hipStream_t stream) {
  if (ws_size < WS_NEED) { fprintf(stderr, "workspace too small\n"); return; }
  static int grid_blocks = 0;
  if (!grid_blocks) {
    int dev = 0, cus = 0, per_cu = 0;
    hipGetDevice(&dev);
    hipDeviceGetAttribute(&cus, hipDeviceAttributeMultiprocessorCount, dev);
    hipOccupancyMaxActiveBlocksPerMultiprocessor(&per_cu, fwd_kernel, 256, 0);
    if (per_cu < 1) per_cu = 1;
    if (per_cu > 2) per_cu = 2;
    grid_blocks = cus * per_cu;
  }
  Params p{};
  const float* const* in = (const float* const*)d_in;
  p.x_p = in[0]; p.x_s = in[1]; p.state_ret = in[2]; p.ck = in[3]; p.cv = in[4]; p.clogf = in[5]; p.norm1_g = in[6];
  p.w_in = in[7]; p.b_f = in[8]; p.fq_g = in[9]; p.fk_g = in[10]; p.gn_g = in[11]; p.w_ret_out = in[12]; p.w_fox_out = in[13];
  p.w_o = in[14]; p.norm2_g = in[15]; p.peer_wq = in[16]; p.k1 = in[17]; p.k2 = in[18]; p.peer_u = in[19]; p.peer_v = in[20];
  p.out = (float*)d_out; p.ws = (char*)d_ws;
#ifndef MULTI_LAUNCH
#define MULTI_LAUNCH 0
#endif
#if MULTI_LAUNCH
  for (int ph = 0; ph <= 8; ph++) fwd_kernel<<<grid_blocks, 256, 0, stream>>>(p, ph, ph, 0);
#else
  hipMemsetAsync((char*)d_ws + OFF_BAR, 0, XCD_BAR_WORDS * sizeof(unsigned), stream);
  int lo = 0, hi = 8, coop = 1;
  void* args[] = {&p, &lo, &hi, &coop};
  hipError_t e = hipLaunchCooperativeKernel((void*)fwd_kernel, dim3(grid_blocks), dim3(256), args, 0, stream);
  if (e != hipSuccess) fprintf(stderr, "cooperative launch failed: %s (grid %d)\n", hipGetErrorString(e), grid_blocks);
#endif
}
```

```cpp
#include <hip/hip_runtime.h>
#include <hip/hip_cooperative_groups.h>
#include <stdint.h>
#include <stdio.h>
namespace cg = cooperative_groups;

#define DEV __device__ __forceinline__
typedef unsigned short bfu;
typedef __attribute__((ext_vector_type(8))) short bf16x8;
typedef __attribute__((ext_vector_type(4))) short bf16x4;
typedef __attribute__((ext_vector_type(4))) float f32x4;
typedef __attribute__((ext_vector_type(16))) float f32x16;
typedef __attribute__((ext_vector_type(4))) unsigned u32x4;
typedef __attribute__((ext_vector_type(2))) float f32x2;
typedef __attribute__((ext_vector_type(2))) unsigned u32x2;

constexpr int DM = 1024, SEQ = 16384, TP = 32768, TS = 512, TT = 33280;
constexpr int NWP = 6784;
constexpr int RC = 128;
constexpr int NCH = SEQ / RC;
constexpr float LOG2E = 1.4426950408889634f;
constexpr float EPSN = 1e-6f;

constexpr size_t O_YP = 0, O_YS = 33554432, O_SP = 34078720, O_FKP = 34209792, O_FVP = 50987008,
                 O_LFP = 67764224, O_SS = 68026368, O_FKS = 70123520, O_FVS = 70385664, O_LFS = 70647808;
constexpr size_t MiB = 1u << 20;
constexpr size_t OFF_XB = 0;
constexpr size_t OFF_WINT = 66 * MiB, OFF_WRT = 80 * MiB, OFF_WFT = 82 * MiB, OFF_WOT = 83 * MiB, OFF_MT = 85 * MiB;
constexpr size_t OFF_RSTD1 = 89 * MiB, OFF_C2 = 90 * MiB, OFF_HS = 91 * MiB;
constexpr size_t OFF_QT = 105 * MiB, OFF_KT = 137 * MiB, OFF_KTT = 169 * MiB, OFF_VT = 201 * MiB;
constexpr size_t OFF_X1B = OFF_HS;
constexpr size_t OFF_RG = 265 * MiB, OFF_FQ = 331 * MiB, OFF_FKB = 364 * MiB, OFF_FVT = 396 * MiB;
constexpr size_t OFF_PUB = OFF_KTT, OFF_PVB = OFF_KTT + 16 * MiB;
constexpr size_t OFF_ROUTE = OFF_FKB, OFF_SSQ2 = OFF_FKB + 33 * MiB;
constexpr size_t OFF_BAR = OFF_RSTD1 + 768 * 1024;
constexpr size_t OFF_PSC = OFF_RSTD1 + 512 * 1024;
constexpr size_t OFF_SST = 428 * MiB;
constexpr size_t WS_NEED = 460 * MiB;

constexpr int SMEM_BYTES = 75776;

struct Params {
  const float *x_p, *x_s, *state_ret, *ck, *cv, *clogf, *norm1_g, *w_in, *b_f, *fq_g, *fk_g, *gn_g,
      *w_ret_out, *w_fox_out, *w_o, *norm2_g, *peer_wq, *k1, *k2, *peer_u, *peer_v;
  float* out;
  char* ws;
};

DEV bfu f2bf(float f) { unsigned u = __float_as_uint(f); u += 0x7fffu + ((u >> 16) & 1u); return (bfu)(u >> 16); }
DEV float bf2f(bfu b) { return __uint_as_float(((unsigned)b) << 16); }
DEV unsigned pack2(float a, float b) { return (unsigned)f2bf(a) | ((unsigned)f2bf(b) << 16); }
DEV float bflo(unsigned u) { return __uint_as_float(u << 16); }
DEV float bfhi(unsigned u) { return __uint_as_float(u & 0xffff0000u); }
DEV float sigmoidf_(float z) { return 1.f / (1.f + __expf(-z)); }
DEV float l2gamma(int h) { return log2f(1.f - exp2f(-5.f - (float)h)); }
DEV float wave_sum(float v) {
#pragma unroll
  for (int o = 32; o >= 1; o >>= 1) v += __shfl_xor(v, o);
  return v;
}
DEV float sum16(float v) {
  v += __shfl_xor(v, 1); v += __shfl_xor(v, 2); v += __shfl_xor(v, 4); v += __shfl_xor(v, 8);
  return v;
}

template <int ROWS>
DEV void g2r(const bfu* g, int ld, u32x4 (&r)[ROWS / 32], int tid_ = threadIdx.x) {
#pragma unroll
  for (int i = 0; i < ROWS / 32; i++) {
    int id = tid_ + i * 256; int row = id >> 3, ch = id & 7;
    const unsigned off = (unsigned)(row * ld + ch * 8);
    r[i] = *(const u32x4*)(g + off);
  }
}
template <int ROWS>
DEV void r2s(bfu* s, const u32x4 (&r)[ROWS / 32], int tid_ = threadIdx.x) {
#pragma unroll
  for (int i = 0; i < ROWS / 32; i++) {
    int id = tid_ + i * 256; int row = id >> 3, ch = id & 7;
    *(u32x4*)(s + row * 72 + ch * 8) = r[i];
  }
}
template <int MI, int NI>
DEV void mma64(const bfu* sA, int sldA, const bfu* sB, int sldB, f32x4 (&acc)[MI][NI]) {
  const int lane = threadIdx.x & 63, w = threadIdx.x >> 6, wr = w >> 1, wc = w & 1, l16 = lane & 15, quad = lane >> 4;
#pragma unroll
  for (int kk = 0; kk < 2; kk++) {
    bf16x8 a[MI], b[NI];
#pragma unroll
    for (int mi = 0; mi < MI; mi++) a[mi] = *(const bf16x8*)(sA + (wr * MI * 16 + mi * 16 + l16) * sldA + kk * 32 + quad * 8);
#pragma unroll
    for (int ni = 0; ni < NI; ni++) b[ni] = *(const bf16x8*)(sB + (wc * NI * 16 + ni * 16 + l16) * sldB + kk * 32 + quad * 8);
#pragma unroll
    for (int mi = 0; mi < MI; mi++)
#pragma unroll
      for (int ni = 0; ni < NI; ni++) acc[mi][ni] = __builtin_amdgcn_mfma_f32_16x16x32_bf16(a[mi], b[ni], acc[mi][ni], 0, 0, 0);
  }
}
template <int ROWS>
DEV void r2sw(bfu* s, const u32x4 (&r)[ROWS / 32], int tid_) {
#pragma unroll
  for (int i = 0; i < ROWS / 32; i++) {
    int id = tid_ + i * 256; int row = id >> 3, ch = id & 7;
    int byte = (((row >> 4) * 2 + (ch >> 2)) << 10) + ((((row & 15) << 6) + ((ch & 3) << 4)) ^ (((row >> 3) & 1) << 5));
    *(u32x4*)((char*)s + byte) = r[i];
  }
}
template <int MI, int NI>
DEV void mma64w(const bfu* sA, const bfu* sB, f32x4 (&acc)[MI][NI]) {
  const int lane = threadIdx.x & 63, w = threadIdx.x >> 6, wr = w >> 1, wc = w & 1, l16 = lane & 15, quad = lane >> 4;
  const int lo = ((l16 << 6) + (quad << 4)) ^ (((l16 >> 3) & 1) << 5);
#pragma unroll
  for (int kk = 0; kk < 2; kk++) {
    bf16x8 a[MI], b[NI];
#pragma unroll
    for (int mi = 0; mi < MI; mi++) a[mi] = *(const bf16x8*)((const char*)sA + (((wr * MI + mi) * 2 + kk) << 10) + lo);
#pragma unroll
    for (int ni = 0; ni < NI; ni++) b[ni] = *(const bf16x8*)((const char*)sB + (((wc * NI + ni) * 2 + kk) << 10) + lo);
#pragma unroll
    for (int mi = 0; mi < MI; mi++)
#pragma unroll
      for (int ni = 0; ni < NI; ni++) acc[mi][ni] = __builtin_amdgcn_mfma_f32_16x16x32_bf16(a[mi], b[ni], acc[mi][ni], 0, 0, 0);
  }
}
template <int MI, int NI>
DEV void mma64w_big(const bfu* sA, const bfu* sB, f32x4 (&acc)[MI][NI]) {
  const int lane = threadIdx.x & 63, w = threadIdx.x >> 6, wr = w >> 1, wc = w & 1, l16 = lane & 15, quad = lane >> 4;
  const int lo = ((l16 << 6) + (quad << 4)) ^ (((l16 >> 3) & 1) << 5);
#pragma unroll
  for (int kk = 0; kk < 2; kk++) {
    bf16x8 b[NI];
#pragma unroll
    for (int ni = 0; ni < NI; ni++) b[ni] = *(const bf16x8*)((const char*)sB + (((wc * NI + ni) * 2 + kk) << 10) + lo);
#pragma unroll
    for (int mi = 0; mi < MI; mi++) {
      bf16x8 a = *(const bf16x8*)((const char*)sA + (((wr * MI + mi) * 2 + kk) << 10) + lo);
#pragma unroll
      for (int ni = 0; ni < NI; ni++) acc[mi][ni] = __builtin_amdgcn_mfma_f32_16x16x32_bf16(a, b[ni], acc[mi][ni], 0, 0, 0);
    }
  }
}
template <int MI, int NI>
DEV void gemm_loop_sb(const bfu* A, int lda, const bfu* B, int ldb, int K, f32x4 (&acc)[MI][NI], bfu* sbuf) {
  constexpr int BM = 32 * MI, BN = 32 * NI;
  bfu* sA = sbuf; bfu* sB = sA + BM * 64;
  const int nk = K >> 6;
  int t_ = threadIdx.x; asm volatile("" : "+v"(t_));
  u32x4 ra[BM / 32], rb[BN / 32];
  g2r<BM>(A, lda, ra, t_); g2r<BN>(B, ldb, rb, t_);
#pragma unroll 1
  for (int k = 0; k < nk; k++) {
    __syncthreads();
    r2sw<BM>(sA, ra, t_); r2sw<BN>(sB, rb, t_);
    __syncthreads();
    if (k + 1 < nk) { g2r<BM>(A + (k + 1) * 64, lda, ra, t_); g2r<BN>(B + (k + 1) * 64, ldb, rb, t_); }
    mma64w_big<MI, NI>(sA, sB, acc);
  }
}

template <int MI, int NI>
DEV void gemm_loop(const bfu* A, int lda, const bfu* B, int ldb, int K, f32x4 (&acc)[MI][NI], bfu* sbuf) {
  constexpr int BM = 32 * MI, BN = 32 * NI;
  bfu* sA0 = sbuf; bfu* sB0 = sA0 + BM * 64; bfu* sA1 = sB0 + BN * 64; bfu* sB1 = sA1 + BM * 64;
  const int nk = K >> 6;
  int t_ = threadIdx.x; asm volatile("" : "+v"(t_));
  u32x4 ra0[BM / 32], rb0[BN / 32], ra1[BM / 32], rb1[BN / 32];
  g2r<BM>(A, lda, ra0, t_); g2r<BN>(B, ldb, rb0, t_);
  if (nk > 1) { g2r<BM>(A + 64, lda, ra1, t_); g2r<BN>(B + 64, ldb, rb1, t_); }
  __syncthreads();
  r2sw<BM>(sA0, ra0, t_); r2sw<BN>(sB0, rb0, t_);
  if (nk > 2) { g2r<BM>(A + 128, lda, ra0, t_); g2r<BN>(B + 128, ldb, rb0, t_); }
  __syncthreads();
  for (int k = 0; k < nk; k += 2) {
    if (k + 1 < nk) { r2sw<BM>(sA1, ra1, t_); r2sw<BN>(sB1, rb1, t_); }
    if (k + 3 < nk) { g2r<BM>(A + (k + 3) * 64, lda, ra1, t_); g2r<BN>(B + (k + 3) * 64, ldb, rb1, t_); }
    mma64w<MI, NI>(sA0, sB0, acc);
    __syncthreads();
    if (k + 1 >= nk) break;
    if (k + 2 < nk) { r2sw<BM>(sA0, ra0, t_); r2sw<BN>(sB0, rb0, t_); }
    if (k + 4 < nk) { g2r<BM>(A + (k + 4) * 64, lda, ra0, t_); g2r<BN>(B + (k + 4) * 64, ldb, rb0, t_); }
    mma64w<MI, NI>(sA1, sB1, acc);
    __syncthreads();
  }
}

constexpr int EPI_OFF = 49152, EPI_WAVE = 16 * 68;
DEV void to_rows(const f32x4 (&v)[4], float (&r)[16], float* sw, int lane) {
  const int l16 = lane & 15, quad = lane >> 4;
  __builtin_amdgcn_wave_barrier();
#pragma unroll
  for (int ni = 0; ni < 4; ni++)
#pragma unroll
    for (int j = 0; j < 4; j++) sw[(quad * 4 + j) * 68 + ni * 16 + l16] = v[ni][j];
  __builtin_amdgcn_wave_barrier();
  const f32x4* rp = (const f32x4*)(sw + (lane >> 2) * 68 + (lane & 3) * 16);
#pragma unroll
  for (int c = 0; c < 4; c++) { f32x4 t = rp[c]; r[4 * c] = t[0]; r[4 * c + 1] = t[1]; r[4 * c + 2] = t[2]; r[4 * c + 3] = t[3]; }
}
DEV void st_bf16x16(bfu* dst, const float (&r)[16]) {
  u32x4 a = {pack2(r[0], r[1]), pack2(r[2], r[3]), pack2(r[4], r[5]), pack2(r[6], r[7])};
  u32x4 b = {pack2(r[8], r[9]), pack2(r[10], r[11]), pack2(r[12], r[13]), pack2(r[14], r[15])};
  *(u32x4*)dst = a; *(u32x4*)(dst + 8) = b;
}
DEV void ld_bf16x16(const bfu* src, float (&r)[16]) {
  u32x4 a = *(const u32x4*)src, b = *(const u32x4*)(src + 8);
#pragma unroll
  for (int i = 0; i < 4; i++) { r[2 * i] = bflo(a[i]); r[2 * i + 1] = bfhi(a[i]); r[8 + 2 * i] = bflo(b[i]); r[9 + 2 * i] = bfhi(b[i]); }
}
DEV void st_f32x16(float* dst, const float (&r)[16]) {
#pragma unroll
  for (int c = 0; c < 4; c++) *(f32x4*)(dst + 4 * c) = f32x4{r[4 * c], r[4 * c + 1], r[4 * c + 2], r[4 * c + 3]};
}

DEV void transpose_tile(const float* src, int ldsrc, int srccol0, int validcols, const float* scale,
                        bfu* dst, int lddst, int n0, int k0, float* sT) {
  const int tid = threadIdx.x;
  __syncthreads();
#pragma unroll
  for (int i = 0; i < 4; i++) {
    int kk = (tid >> 4) + i * 16, c = (tid & 15) * 4;
    float4 v = make_float4(0.f, 0.f, 0.f, 0.f);
    if (c < validcols) v = *(const float4*)(src + (size_t)(k0 + kk) * ldsrc + srccol0 + c);
    float s = scale ? scale[k0 + kk] : 1.f;
    sT[kk * 65 + c] = v.x * s; sT[kk * 65 + c + 1] = v.y * s; sT[kk * 65 + c + 2] = v.z * s; sT[kk * 65 + c + 3] = v.w * s;
  }
  __syncthreads();
  int n = tid >> 2, kc = (tid & 3) * 16;
  unsigned o[8];
#pragma unroll
  for (int e = 0; e < 8; e++) o[e] = pack2(sT[(kc + 2 * e) * 65 + n], sT[(kc + 2 * e + 1) * 65 + n]);
  uint4* d = (uint4*)(dst + (size_t)(n0 + n) * lddst + k0 + kc);
  d[0] = make_uint4(o[0], o[1], o[2], o[3]); d[1] = make_uint4(o[4], o[5], o[6], o[7]);
}

DEV void phase0(const Params& p, int bid, int nb, char* smem) {
  const int tid = threadIdx.x, lane = tid & 63, w = tid >> 6;
  constexpr int N_X = TT / 4, N_TW = 106 * 16, N_TR = 256, N_TF = 128, N_TO = 256, N_MT = 512;
  constexpr int B1 = N_X, B2 = B1 + N_TW, B3 = B2 + N_TR, B4 = B3 + N_TF, B5 = B4 + N_TO, TOT = B5 + N_MT;
  bfu* xb = (bfu*)(p.ws + OFF_XB); float* rstd1 = (float*)(p.ws + OFF_RSTD1);
  for (int it = bid; it < TOT; it += nb) {
    if (it < B1) {
      int row = it * 4 + w;
      const float* src = row < TP ? p.x_p + (size_t)row * DM : p.x_s + (size_t)(row - TP) * DM;
      float4 a0 = *(const float4*)(src + lane * 8), a1 = *(const float4*)(src + lane * 8 + 4);
      float4 b0 = *(const float4*)(src + 512 + lane * 8), b1 = *(const float4*)(src + 512 + lane * 8 + 4);
      float ss = a0.x * a0.x + a0.y * a0.y + a0.z * a0.z + a0.w * a0.w + a1.x * a1.x + a1.y * a1.y + a1.z * a1.z + a1.w * a1.w +
                 b0.x * b0.x + b0.y * b0.y + b0.z * b0.z + b0.w * b0.w + b1.x * b1.x + b1.y * b1.y + b1.z * b1.z + b1.w * b1.w;
      ss = wave_sum(ss);
      if (lane == 0) rstd1[row] = rsqrtf(ss * (1.f / DM) + EPSN);
      *(uint4*)(xb + (size_t)row * DM + lane * 8) = make_uint4(pack2(a0.x, a0.y), pack2(a0.z, a0.w), pack2(a1.x, a1.y), pack2(a1.z, a1.w));
      *(uint4*)(xb + (size_t)row * DM + 512 + lane * 8) = make_uint4(pack2(b0.x, b0.y), pack2(b0.z, b0.w), pack2(b1.x, b1.y), pack2(b1.z, b1.w));
    } else if (it < B2) {
      int j = it - B1; int nt = j >> 4, kt = j & 15; int n0 = nt * 64;
      int sc0, vc;
      if (n0 < 4608) { sc0 = n0; vc = 64; } else if (n0 < 6656) { sc0 = n0 + 8; vc = 64; } else if (n0 == 6656) { sc0 = 4608; vc = 8; } else { sc0 = 0; vc = 0; }
      transpose_tile(p.w_in, 6664, sc0, vc, p.norm1_g, (bfu*)(p.ws + OFF_WINT), DM, n0, kt * 64, (float*)smem);
    } else if (it < B3) {
      int j = it - B2; transpose_tile(p.w_ret_out, 1024, (j >> 4) * 64, 64, nullptr, (bfu*)(p.ws + OFF_WRT), 1024, (j >> 4) * 64, (j & 15) * 64, (float*)smem);
    } else if (it < B4) {
      int j = it - B3; transpose_tile(p.w_fox_out, 1024, (j >> 3) * 64, 64, nullptr, (bfu*)(p.ws + OFF_WFT), 512, (j >> 3) * 64, (j & 7) * 64, (float*)smem);
    } else if (it < B5) {
      int j = it - B4; transpose_tile(p.w_o, 1024, (j >> 4) * 64, 64, nullptr, (bfu*)(p.ws + OFF_WOT), 1024, (j >> 4) * 64, (j & 15) * 64, (float*)smem);
    } else {
      int j = it - B5; int hh = j >> 5, kt = (j >> 4) & 1, dt = j & 15;
      float* sW = (float*)smem; float* sK = sW + 64 * 129;
      const float* ksub = (hh & 1) ? p.k2 : p.k1;
      __syncthreads();
#pragma unroll
      for (int i = 0; i < 8; i++) {
        int id = tid + i * 256; int row = id >> 5, c4 = (id & 31) * 4;
        float4 v = *(const float4*)(p.peer_wq + (size_t)(dt * 64 + row) * 2048 + hh * 128 + c4);
        sW[row * 129 + c4] = v.x; sW[row * 129 + c4 + 1] = v.y; sW[row * 129 + c4 + 2] = v.z; sW[row * 129 + c4 + 3] = v.w;
        float4 u = *(const float4*)(ksub + (size_t)(kt * 64 + row) * 128 + c4);
        sK[row * 129 + c4] = u.x; sK[row * 129 + c4 + 1] = u.y; sK[row * 129 + c4 + 2] = u.z; sK[row * 129 + c4 + 3] = u.w;
      }
      __syncthreads();
      int ky = (tid >> 4) * 4, dd = (tid & 15) * 4;
      float a[4][4];
#pragma unroll
      for (int i = 0; i < 4; i++)
#pragma unroll
        for (int jj = 0; jj < 4; jj++) a[i][jj] = 0.f;
      for (int c = 0; c < 128; c++) {
        float kv[4], wv[4];
#pragma unroll
        for (int i = 0; i < 4; i++) { kv[i] = sK[(ky + i) * 129 + c]; wv[i] = sW[(dd + i) * 129 + c]; }
#pragma unroll
        for (int i = 0; i < 4; i++)
#pragma unroll
          for (int jj = 0; jj < 4; jj++) a[i][jj] += kv[i] * wv[jj];
      }
      bfu* MT = (bfu*)(p.ws + OFF_MT);
      float g0 = p.norm2_g[dt * 64 + dd], g1 = p.norm2_g[dt * 64 + dd + 1], g2 = p.norm2_g[dt * 64 + dd + 2], g3 = p.norm2_g[dt * 64 + dd + 3];
#pragma unroll
      for (int i = 0; i < 4; i++)
        *(uint2*)(MT + (size_t)(hh * 128 + kt * 64 + ky + i) * DM + dt * 64 + dd) = make_uint2(pack2(a[i][0] * g0, a[i][1] * g1), pack2(a[i][2] * g2, a[i][3] * g3));
    }
  }
}

DEV void rot_angle(int pos, int d, float& cs, float& sn) {
  float inv = exp2f(-(float)d * (13.287712379549449f / 32.f));
  float ang = (float)pos * inv;
  float rev = ang * 0.15915494309189535f;
  rev = rev - floorf(rev);
  sn = __builtin_amdgcn_sinf(rev); cs = __builtin_amdgcn_cosf(rev);
}

DEV void phase1(const Params& p, int bid, int nb, char* smem, bool noepi = false) {
  bfu* sA = (bfu*)smem; bfu* sB = sA + 128 * 72;
  const bfu* XB = (const bfu*)(p.ws + OFF_XB); const bfu* WT = (const bfu*)(p.ws + OFF_WINT);
  const float* rstd1 = (const float*)(p.ws + OFF_RSTD1);
  constexpr int NT = NWP / 128;
  const int xcd = bid & 7, slot = bid >> 3, nslots = (nb + 7 - xcd) >> 3;
  constexpr int MI1 = 8;
  const int nprompt = 16 * NT;
  const int n_p = slot < nprompt ? (nprompt - slot + nslots - 1) / nslots : 0;
  const int n_s = bid < 2 * NT ? (2 * NT - bid + nb - 1) / nb : 0;
  for (int i_ = 0; i_ < n_p + n_s; i_++) {
    int mt, nt;
    if (i_ < n_p) { int q = slot + i_ * nslots; int sub = q / (8 * NT), rem = q - sub * (8 * NT); nt = rem >> 3; mt = xcd * 16 + sub * 8 + (rem & 7); }
    else { int it = bid + (i_ - n_p) * nb; mt = 128 + it / NT; nt = it - (it / NT) * NT; }
    int m0 = mt * 256, n0 = nt * 128;
    int tid = threadIdx.x; asm volatile("" : "+v"(tid));
    const int lane = tid & 63, w = tid >> 6, wr = w >> 1, wc = w & 1, l16 = lane & 15, quad = lane >> 4;
    f32x4 acc[MI1][4];
#pragma unroll
    for (int i = 0; i < MI1; i++)
#pragma unroll
      for (int j = 0; j < 4; j++) acc[i][j] = f32x4{0.f, 0.f, 0.f, 0.f};
    gemm_loop_sb<MI1, 4>(XB + (size_t)m0 * DM, DM, WT + (size_t)n0 * DM, DM, DM, acc, sA);
    if (noepi) { float t_ = 0.f;
#pragma unroll
      for (int i = 0; i < MI1; i++)
#pragma unroll
        for (int j = 0; j < 4; j++) t_ += acc[i][j][0] + acc[i][j][1] + acc[i][j][2] + acc[i][j][3];
      if (t_ == 12345.678f) p.out[0] = 1.f; continue; }
    const int rbase = m0 + wr * (MI1 * 16) + quad * 4;
    const int cbase = n0 + wc * 64 + l16;
    if (m0 >= TP) {
      float* hs = (float*)(p.ws + OFF_HS);
      bfu* gaS = (bfu*)(p.out + O_YS); bfu* gbS = gaS + (size_t)TS * DM;
#pragma unroll
      for (int mi = 0; mi < MI1; mi++)
#pragma unroll
        for (int j = 0; j < 4; j++) {
          int row = rbase + mi * 16 + j; float rs = rstd1[row]; int sr = row - TP;
#pragma unroll
          for (int ni = 0; ni < 4; ni++) {
            int col = cbase + ni * 16; float v = acc[mi][ni][j] * rs;
            if (n0 >= 4608 && n0 < 5632) gaS[(size_t)sr * DM + col - 4608] = f2bf(v);
            else if (n0 >= 5632 && n0 < 6656) gbS[(size_t)sr * DM + col - 5632] = f2bf(v);
            else hs[(size_t)sr * NWP + col] = v;
          }
        }
      continue;
    }
    const int b = m0 >> 14;
    float* sw = (float*)(smem + EPI_OFF) + w * EPI_WAVE;
    const int rrow = m0 + wr * (MI1 * 16) + (lane >> 2);
    const int rcol = (lane & 3) * 16;
    if (n0 < 1024) {
      const int isK = n0 >= 512; const int head = ((n0 & 511) >> 6) + wc;
      const float l2g = l2gamma(head);
      bfu* dst = (bfu*)(p.ws + (isK ? OFF_KT : OFF_QT));
      bfu* ktT = (bfu*)(p.ws + OFF_KTT);
#pragma unroll
      for (int mi = 0; mi < MI1; mi++) {
        f32x4 tv[4];
#pragma unroll
        for (int ni = 0; ni < 2; ni++) {
          int d = ni * 16 + l16;
          float y1[4], y2[4];
#pragma unroll
          for (int j = 0; j < 4; j++) {
            int row = rbase + mi * 16 + j; int t = row & (SEQ - 1); int l = t & (RC - 1);
            float rs = rstd1[row];
            float dec = exp2f((float)(l + 1) * l2g);
            float sc = isK ? 0.125f / dec : dec;
            float cs, sn; rot_angle(t, d, cs, sn);
            float x1 = acc[mi][ni][j] * rs, x2 = acc[mi][ni + 2][j] * rs;
            y1[j] = (x1 * cs - x2 * sn) * sc; y2[j] = (x2 * cs + x1 * sn) * sc;
            tv[ni][j] = y1[j]; tv[ni + 2][j] = y2[j];
          }
          if (isK) {
            int t0 = (rbase + mi * 16) & (SEQ - 1);
            *(uint2*)(ktT + ((size_t)((b * 8 + head) * 64 + d)) * SEQ + t0) = make_uint2(pack2(y1[0], y1[1]), pack2(y1[2], y1[3]));
            *(uint2*)(ktT + ((size_t)((b * 8 + head) * 64 + d + 32)) * SEQ + t0) = make_uint2(pack2(y2[0], y2[1]), pack2(y2[2], y2[3]));
          }
        }
        { float r[16]; to_rows(tv, r, sw, lane); int rr_ = rrow; asm volatile("" : "+v"(rr_));
          st_bf16x16(dst + (size_t)(rr_ + mi * 16) * 512 + head * 64 + rcol, r); }
      }
    } else if (n0 < 2048) {
      const int head = (n0 - 1024) >> 7;
      bfu* vT = (bfu*)(p.ws + OFF_VT);
#pragma unroll
      for (int mi = 0; mi < MI1; mi++) {
        int row0 = rbase + mi * 16; int t0 = row0 & (SEQ - 1);
        float r0 = rstd1[row0], r1 = rstd1[row0 + 1], r2 = rstd1[row0 + 2], r3 = rstd1[row0 + 3];
#pragma unroll
        for (int ni = 0; ni < 4; ni++) {
          int dv = wc * 64 + ni * 16 + l16;
          *(uint2*)(vT + ((size_t)((b * 8 + head) * 128 + dv)) * SEQ + t0) =
              make_uint2(pack2(acc[mi][ni][0] * r0, acc[mi][ni][1] * r1), pack2(acc[mi][ni][2] * r2, acc[mi][ni][3] * r3));
        }
      }
    } else if (n0 < 3072 || (n0 >= 4608 && n0 < 6656)) {
      bfu* dst; int c0;
      if (n0 < 3072) { dst = (bfu*)(p.ws + OFF_RG); c0 = 2048; }
      else if (n0 < 5632) { dst = (bfu*)(p.out + O_YP); c0 = 4608; }
      else { dst = (bfu*)(p.out + O_YP) + (size_t)TP * DM; c0 = 5632; }
#pragma unroll
      for (int mi = 0; mi < MI1; mi++) {
        f32x4 tv[4];
#pragma unroll
        for (int j = 0; j < 4; j++) {
          int row = rbase + mi * 16 + j; float rs = rstd1[row];
#pragma unroll
          for (int ni = 0; ni < 4; ni++) tv[ni][j] = acc[mi][ni][j] * rs;
        }
        float r[16]; to_rows(tv, r, sw, lane); int rr_ = rrow; asm volatile("" : "+v"(rr_));
        st_bf16x16(dst + (size_t)(rr_ + mi * 16) * DM + (n0 - c0) + wc * 64 + rcol, r);
      }
    } else if (n0 < 4096) {
      const int isK = n0 >= 3584; const int head = (((n0 - 3072) & 511) >> 6) + wc;
      const float* g = isK ? p.fk_g : p.fq_g;
      float gv[4];
#pragma unroll
      for (int ni = 0; ni < 4; ni++) gv[ni] = g[ni * 16 + l16];
      bfu* fq = (bfu*)(p.ws + OFF_FQ); bfu* fkb = (bfu*)(p.ws + OFF_FKB);
#pragma unroll
      for (int mi = 0; mi < MI1; mi++) {
        f32x4 tv[4];
#pragma unroll
        for (int j = 0; j < 4; j++) {
          int row = rbase + mi * 16 + j; float rs = rstd1[row];
          float v[4]; float ss = 0.f;
#pragma unroll
          for (int ni = 0; ni < 4; ni++) { v[ni] = acc[mi][ni][j] * rs; ss += v[ni] * v[ni]; }
          ss = sum16(ss);
          float r = rsqrtf(ss * (1.f / 64.f) + EPSN) * (isK ? 1.f : 0.125f * LOG2E);
#pragma unroll
          for (int ni = 0; ni < 4; ni++) tv[ni][j] = v[ni] * r * gv[ni];
        }
        float r[16]; to_rows(tv, r, sw, lane); int rr_ = rrow; asm volatile("" : "+v"(rr_));
        const size_t o = (size_t)(rr_ + mi * 16) * 512 + head * 64 + rcol;
        if (isK) { st_f32x16(p.out + O_FKP + o, r); st_bf16x16(fkb + o, r); }
        else st_bf16x16(fq + o, r);
      }
    } else if (n0 < 4608) {
      const int head = ((n0 - 4096) >> 6) + wc;
      bfu* fvT = (bfu*)(p.ws + OFF_FVT);
#pragma unroll
      for (int mi = 0; mi < MI1; mi++) {
        int row0 = rbase + mi * 16; int t0 = row0 & (SEQ - 1);
        float r[4] = {rstd1[row0], rstd1[row0 + 1], rstd1[row0 + 2], rstd1[row0 + 3]};
        f32x4 tv[4];
#pragma unroll
        for (int ni = 0; ni < 4; ni++) {
          int d = ni * 16 + l16; float v[4];
#pragma unroll
          for (int j = 0; j < 4; j++) { v[j] = acc[mi][ni][j] * r[j]; tv[ni][j] = v[j]; }
          *(uint2*)(fvT + ((size_t)((b * 8 + head) * 64 + d)) * SEQ + t0) = make_uint2(pack2(v[0], v[1]), pack2(v[2], v[3]));
        }
        { float rw[16]; to_rows(tv, rw, sw, lane); int rr_ = rrow; asm volatile("" : "+v"(rr_));
          st_f32x16(p.out + O_FVP + (size_t)(rr_ + mi * 16) * 512 + head * 64 + rcol, rw); }
      }
    } else {
      if (wc == 0 && l16 < 8) {
        float bf = p.b_f[l16];
#pragma unroll
        for (int mi = 0; mi < MI1; mi++)
#pragma unroll
          for (int j = 0; j < 4; j++) {
            int row = rbase + mi * 16 + j;
            float z = acc[mi][0][j] * rstd1[row] + bf;
            p.out[O_LFP + (size_t)row * 8 + l16] = fminf(z, 0.f) - log1pf(__expf(-fabsf(z)));
          }
      }
    }
  }
}

DEV void phase2(const Params& p, int bid, int nb, char* smem) {
  const int tid = threadIdx.x, lane = tid & 63, w = tid >> 6, wr = w >> 1, wc = w & 1, l16 = lane & 15, quad = lane >> 4;
  bfu* sA = (bfu*)smem; bfu* sB = sA + 128 * 72;
  const bfu* vT = (const bfu*)(p.ws + OFF_VT); const bfu* ktT = (const bfu*)(p.ws + OFF_KTT);
  float* U = (float*)(p.ws + OFF_XB);
  constexpr int NR1 = 16 * NCH;
  for (int it = bid; it < NR1 + 16; it += nb) {
    if (it < 16) {
      int bh = it, b = bh >> 3, h = bh & 7;
      double* sd = (double*)smem;
      const float* lf = p.out + O_LFP + (size_t)b * SEQ * 8 + h;
      float part = 0.f;
      for (int i = 0; i < 64; i++) part += lf[(size_t)(tid * 64 + i) * 8];
      __syncthreads();
      sd[tid] = (double)part;
      __syncthreads();
      if (tid == 0) { double run = 0.0; for (int i = 0; i < 256; i++) { double v = sd[i]; sd[i] = run; run += v; } }
      __syncthreads();
      double run = sd[tid];
      float* c2 = (float*)(p.ws + OFF_C2) + (size_t)bh * SEQ;
      for (int i = 0; i < 64; i++) { run += (double)lf[(size_t)(tid * 64 + i) * 8]; c2[tid * 64 + i] = (float)(run * (double)LOG2E); }
      __syncthreads();
    } else {
      int j = it - 16; int bh = j / NCH, c = j - bh * NCH;
      f32x4 acc[4][2];
#pragma unroll
      for (int i = 0; i < 4; i++) { acc[i][0] = f32x4{0.f, 0.f, 0.f, 0.f}; acc[i][1] = f32x4{0.f, 0.f, 0.f, 0.f}; }
      gemm_loop<4, 2>(vT + (size_t)bh * 128 * SEQ + c * RC, SEQ, ktT + (size_t)bh * 64 * SEQ + c * RC, SEQ, RC, acc, sA);
      float gC = exp2f((float)RC * l2gamma(bh & 7));
      float* Uo = U + (size_t)j * 8192;
#pragma unroll
      for (int mi = 0; mi < 4; mi++)
#pragma unroll
        for (int ni = 0; ni < 2; ni++)
#pragma unroll
          for (int jj = 0; jj < 4; jj++) {
            int dv = wr * 64 + mi * 16 + quad * 4 + jj, dk = wc * 32 + ni * 16 + l16;
            Uo[dv * 64 + dk] = acc[mi][ni][jj] * gC;
          }
    }
  }
}

DEV void sample_item(const Params& p, int item, char* smem) {
  int tid = threadIdx.x; asm volatile("" : "+v"(tid));
  const int b = item >> 3, h = item & 7;
  float* sq = (float*)smem;
  float* sk = sq + 1024;
  float* sv = sk + 1024;
  float* sP = sv + 2048;
  float* so = sP + 256;
  float* sr = so + 2048;
  float* sc = (float*)smem;
  float* fq = (float*)(smem + 34816);
  float* fk = fq + 1024;
  float* cn = fk + 1024;
  float* suf = cn + 16;
  float* red = suf + 1024;
  float* sL = red + 256;
  float* pvr = sL + 16;
  const float* hs = (const float*)(p.ws + OFF_HS) + (size_t)b * 16 * NWP;
  const float l2g = l2gamma(h);
  __syncthreads();
  for (int i = tid; i < 512; i += 256) {
    int l = i >> 5, d = i & 31; float cs, sn; rot_angle(1024 + l, d, cs, sn);
    float dec = exp2f((float)(l + 1) * l2g);
    const float* r = hs + (size_t)l * NWP;
    float x1 = r[h * 64 + d], x2 = r[h * 64 + d + 32];
    sq[l * 64 + d] = (x1 * cs - x2 * sn) * dec; sq[l * 64 + d + 32] = (x2 * cs + x1 * sn) * dec;
    x1 = r[512 + h * 64 + d]; x2 = r[512 + h * 64 + d + 32];
    float sc_ = 0.125f / dec;
    sk[l * 64 + d] = (x1 * cs - x2 * sn) * sc_; sk[l * 64 + d + 32] = (x2 * cs + x1 * sn) * sc_;
  }
  for (int i = tid; i < 2048; i += 256) { int l = i >> 7, dv = i & 127; sv[i] = hs[(size_t)l * NWP + 1024 + h * 128 + dv]; }
  __syncthreads();
  { int l = tid >> 4, m = tid & 15; float a = 0.f;
    if (l >= m) for (int d = 0; d < 64; d++) a += sq[l * 64 + d] * sk[m * 64 + d];
    sP[tid] = a; }
  __syncthreads();
  const float* S = p.state_ret + (size_t)(b * 8 + h) * 8192;
  { int dv = tid & 127, lh = tid >> 7; float o[8];
#pragma unroll
    for (int i = 0; i < 8; i++) o[i] = 0.f;
#pragma unroll 16
    for (int dk = 0; dk < 64; dk++) { float s = S[dk * 128 + dv];
#pragma unroll
      for (int i = 0; i < 8; i++) o[i] += sq[(lh * 8 + i) * 64 + dk] * s; }
    for (int m = 0; m < 16; m++) { float v = sv[m * 128 + dv];
#pragma unroll
      for (int i = 0; i < 8; i++) o[i] += sP[(lh * 8 + i) * 16 + m] * v; }
#pragma unroll
    for (int i = 0; i < 8; i++) so[(lh * 8 + i) * 128 + dv] = o[i];
    float g16 = exp2f(16.f * l2g);
    float* So = p.out + O_SS + (size_t)(b * 8 + h) * 8192;
#pragma unroll 8
    for (int i = 0; i < 32; i++) { int dk = lh * 32 + i; float a = S[dk * 128 + dv];
      for (int m = 0; m < 16; m++) a += sk[m * 64 + dk] * sv[m * 128 + dv];
      So[dk * 128 + dv] = a * g16; }
  }
  __syncthreads();
  if (tid < 16) { float ss = 0.f; for (int i = 0; i < 128; i++) { float v = so[tid * 128 + i]; ss += v * v; } sr[tid] = rsqrtf(ss * (1.f / 128.f) + EPSN); }
  __syncthreads();
  { int dv = tid & 127, lh = tid >> 7; bfu* gated = (bfu*)(p.ws + OFF_RG);
    float gg = p.gn_g[h * 128 + dv];
    for (int i = 0; i < 8; i++) { int l = lh * 8 + i; float rgv = hs[(size_t)l * NWP + 2048 + h * 128 + dv];
      float v = so[l * 128 + dv] * sr[l] * gg * (rgv * sigmoidf_(rgv));
      gated[(size_t)(TP + b * 16 + l) * DM + h * 128 + dv] = f2bf(v); } }
  {
    int l = tid >> 4, dl = tid & 15; const float* r = hs + (size_t)l * NWP;
    float qv[4], kv[4]; float sq_ = 0.f, sk_ = 0.f;
#pragma unroll
    for (int i = 0; i < 4; i++) { qv[i] = r[3072 + h * 64 + dl * 4 + i]; kv[i] = r[3584 + h * 64 + dl * 4 + i]; sq_ += qv[i] * qv[i]; sk_ += kv[i] * kv[i]; }
    sq_ = sum16(sq_); sk_ = sum16(sk_);
    float rq = rsqrtf(sq_ * (1.f / 64.f) + EPSN), rk = rsqrtf(sk_ * (1.f / 64.f) + EPSN);
#pragma unroll
    for (int i = 0; i < 4; i++) { int d = dl * 4 + i;
      fq[l * 64 + d] = qv[i] * rq * p.fq_g[d] * 0.125f;
      float kk = kv[i] * rk * p.fk_g[d]; fk[l * 64 + d] = kk;
      p.out[O_FKS + (size_t)((b * 16 + l) * 8 + h) * 64 + d] = kk;
      p.out[O_FVS + (size_t)((b * 16 + l) * 8 + h) * 64 + d] = r[4096 + h * 64 + d]; }
  }
  if (tid < 16) { float z = hs[(size_t)tid * NWP + 6656 + h] + p.b_f[h]; float lf = fminf(z, 0.f) - log1pf(__expf(-fabsf(z)));
    p.out[O_LFS + (size_t)(b * 16 + tid) * 8 + h] = lf; cn[tid] = lf; }
  { const float* cl = p.clogf + (size_t)b * 1024 * 8 + h; float v[4]; float part = 0.f;
#pragma unroll
    for (int i = 0; i < 4; i++) { v[i] = cl[(size_t)(tid * 4 + i) * 8]; part += v[i]; }
    float inc = part;
#pragma unroll
    for (int o = 1; o < 64; o <<= 1) { float t = __shfl_down(inc, o); if ((tid & 63) + o < 64) inc += t; }
    if ((tid & 63) == 0) red[tid >> 6] = inc;
    __syncthreads();
    if (tid == 0) { float c = 0.f; for (int i = 0; i < 16; i++) { c += cn[i]; cn[i] = c; } }
    float later = 0.f;
    for (int ww = (tid >> 6) + 1; ww < 4; ww++) later += red[ww];
    __syncthreads();
    float run = inc - part + later;
    for (int i = 3; i >= 0; i--) { suf[tid * 4 + i] = run; run += v[i]; }
  }
  __syncthreads();
  const float* CK = p.ck + (size_t)b * 1024 * 512 + h * 64; const float* CV = p.cv + (size_t)b * 1024 * 512 + h * 64;
  for (int pass = 0; pass < 2; pass++) {
    __syncthreads();
    for (int j = tid; j < 1040; j += 256) {
      float a[8];
#pragma unroll
      for (int qi = 0; qi < 8; qi++) a[qi] = 0.f;
      if (j < 1024) {
        const f32x4* kp = (const f32x4*)(CK + (size_t)j * 512);
        f32x4 tt[16];
#pragma unroll
        for (int i = 0; i < 16; i++) tt[i] = kp[i];
#pragma unroll
        for (int i = 0; i < 16; i++) { f32x4 t = tt[i];
#pragma unroll
          for (int qi = 0; qi < 8; qi++) { const float* qq = fq + (pass * 8 + qi) * 64 + i * 4; a[qi] += qq[0] * t[0] + qq[1] * t[1] + qq[2] * t[2] + qq[3] * t[3]; } }
      } else {
        const float* kp = fk + (j - 1024) * 64;
#pragma unroll 4
        for (int i = 0; i < 64; i++) { float t = kp[i];
#pragma unroll
          for (int qi = 0; qi < 8; qi++) a[qi] += fq[(pass * 8 + qi) * 64 + i] * t; }
      }
#pragma unroll
      for (int qi = 0; qi < 8; qi++) { int q = pass * 8 + qi;
        float bias;
        if (j < 1024) bias = suf[j] + cn[q]; else { int m = j - 1024; bias = (m <= q) ? (cn[q] - cn[m]) : -INFINITY; }
        sc[qi * 1040 + j] = a[qi] + bias; }
    }
    __syncthreads();
    { int qi = tid >> 5, l32 = tid & 31; float m = -INFINITY;
      for (int j = l32; j < 1040; j += 32) m = fmaxf(m, sc[qi * 1040 + j]);
#pragma unroll
      for (int o = 16; o >= 1; o >>= 1) m = fmaxf(m, __shfl_xor(m, o));
      float s = 0.f;
      for (int j = l32; j < 1040; j += 32) { float e = __expf(sc[qi * 1040 + j] - m); sc[qi * 1040 + j] = e; s += e; }
#pragma unroll
      for (int o = 16; o >= 1; o >>= 1) s += __shfl_xor(s, o);
      if (l32 == 0) sL[qi] = s; }
    __syncthreads();
    {
      const int kg = tid >> 4, d4 = (tid & 15) * 4;
      float ac[8][4];
#pragma unroll
      for (int qi = 0; qi < 8; qi++) { ac[qi][0] = 0.f; ac[qi][1] = 0.f; ac[qi][2] = 0.f; ac[qi][3] = 0.f; }
#pragma unroll 8
      for (int i = 0; i < 64; i++) { int j = kg + 16 * i;
        float4 v = *(const float4*)(CV + (size_t)j * 512 + d4);
#pragma unroll
        for (int qi = 0; qi < 8; qi++) { float pj = sc[qi * 1040 + j]; ac[qi][0] += pj * v.x; ac[qi][1] += pj * v.y; ac[qi][2] += pj * v.z; ac[qi][3] += pj * v.w; } }
      { const float* r = hs + (size_t)kg * NWP + 4096 + h * 64 + d4;
#pragma unroll
        for (int qi = 0; qi < 8; qi++) { float pj = sc[qi * 1040 + 1024 + kg]; ac[qi][0] += pj * r[0]; ac[qi][1] += pj * r[1]; ac[qi][2] += pj * r[2]; ac[qi][3] += pj * r[3]; } }
#pragma unroll
      for (int qi = 0; qi < 8; qi++)
#pragma unroll
        for (int c = 0; c < 4; c++) { float t = ac[qi][c]; t += __shfl_xor(t, 16); t += __shfl_xor(t, 32); ac[qi][c] = t; }
      if ((tid & 63) < 16) {
#pragma unroll
        for (int qi = 0; qi < 8; qi++)
#pragma unroll
          for (int c = 0; c < 4; c++) pvr[((tid >> 6) * 8 + qi) * 64 + d4 + c] = ac[qi][c];
      }
      __syncthreads();
      int qi = tid >> 5, d2 = (tid & 31) * 2;
      float a0 = pvr[(0 * 8 + qi) * 64 + d2] + pvr[(1 * 8 + qi) * 64 + d2] + pvr[(2 * 8 + qi) * 64 + d2] + pvr[(3 * 8 + qi) * 64 + d2];
      float a1 = pvr[(0 * 8 + qi) * 64 + d2 + 1] + pvr[(1 * 8 + qi) * 64 + d2 + 1] + pvr[(2 * 8 + qi) * 64 + d2 + 1] + pvr[(3 * 8 + qi) * 64 + d2 + 1];
      float inv = 1.f / sL[qi]; bfu* fo = (bfu*)(p.ws + OFF_FQ);
      *(unsigned*)(fo + (size_t)(TP + b * 16 + pass * 8 + qi) * 512 + h * 64 + d2) = pack2(a0 * inv, a1 * inv); }
  }
  __syncthreads();
}

DEV void peer_convert_item(const Params& p, int item) {
  const int tid = threadIdx.x, lane = tid & 63, w = tid >> 6;
  constexpr int NG = 0; const int it = item;
    {
      int r = (it - NG) * 4 + w;
      const float* src = r < 16384 ? p.peer_u + (size_t)r * DM : p.peer_v + (size_t)(r - 16384) * DM;
      float4 v0 = *(const float4*)(src + lane * 16), v1 = *(const float4*)(src + lane * 16 + 4), v2 = *(const float4*)(src + lane * 16 + 8), v3 = *(const float4*)(src + lane * 16 + 12);
      float am = fmaxf(fmaxf(fmaxf(fabsf(v0.x), fabsf(v0.y)), fmaxf(fabsf(v0.z), fabsf(v0.w))), fmaxf(fmaxf(fabsf(v1.x), fabsf(v1.y)), fmaxf(fabsf(v1.z), fabsf(v1.w))));
      am = fmaxf(am, fmaxf(fmaxf(fmaxf(fabsf(v2.x), fabsf(v2.y)), fmaxf(fabsf(v2.z), fabsf(v2.w))), fmaxf(fmaxf(fabsf(v3.x), fabsf(v3.y)), fmaxf(fabsf(v3.z), fabsf(v3.w)))));
#pragma unroll
      for (int o = 32; o >= 1; o >>= 1) am = fmaxf(am, __shfl_xor(am, o));
      float sc = am > 0.f ? 6.f / am : 1.f;
      unsigned w0 = 0, w1 = 0;
      w0 = __builtin_amdgcn_cvt_scalef32_pk_fp4_f32(w0, v0.x * sc, v0.y * sc, 1.0f, 0);
      w0 = __builtin_amdgcn_cvt_scalef32_pk_fp4_f32(w0, v0.z * sc, v0.w * sc, 1.0f, 1);
      w0 = __builtin_amdgcn_cvt_scalef32_pk_fp4_f32(w0, v1.x * sc, v1.y * sc, 1.0f, 2);
      w0 = __builtin_amdgcn_cvt_scalef32_pk_fp4_f32(w0, v1.z * sc, v1.w * sc, 1.0f, 3);
      w1 = __builtin_amdgcn_cvt_scalef32_pk_fp4_f32(w1, v2.x * sc, v2.y * sc, 1.0f, 0);
      w1 = __builtin_amdgcn_cvt_scalef32_pk_fp4_f32(w1, v2.z * sc, v2.w * sc, 1.0f, 1);
      w1 = __builtin_amdgcn_cvt_scalef32_pk_fp4_f32(w1, v3.x * sc, v3.y * sc, 1.0f, 2);
      w1 = __builtin_amdgcn_cvt_scalef32_pk_fp4_f32(w1, v3.z * sc, v3.w * sc, 1.0f, 3);
      u32x2* dst = (u32x2*)(p.ws + (r < 16384 ? OFF_PUB : OFF_PVB)) + (size_t)(r & 16383) * 64 + lane;
      *dst = u32x2{w0, w1};
      if (lane == 0) ((float*)(p.ws + OFF_PSC))[r] = am > 0.f ? am / 6.f : 1.f;
    }
}

DEV void phase3(const Params& p, int bid, int nb, char* smem) {
  const int tid = threadIdx.x;
  const float* U = (const float*)(p.ws + OFF_XB); bfu* SST = (bfu*)(p.ws + OFF_SST);
  { const int c0 = nb > 256 ? bid - 256 : bid, cs = nb > 256 ? nb - 256 : nb;
    if (c0 >= 0) for (int it = c0; it < 8192; it += cs) peer_convert_item(p, it); }
  for (int it = bid; it < 256 + 512; it += nb) {
    if (it < 256) { sample_item(p, it, smem); continue; }
    int g = (it - 256) * 256 + tid; int bh = g >> 13, e = g & 8191;
    float G = exp2f((float)RC * l2gamma(bh & 7));
    float s = 0.f;
    const float* Up = U + (size_t)bh * NCH * 8192 + e; bfu* Sp = SST + (size_t)bh * NCH * 8192 + e;
    Sp[0] = 0;
    for (int c0 = 0; c0 < NCH; c0 += 8) {
      float u[8];
#pragma unroll
      for (int i = 0; i < 8; i++) u[i] = Up[(size_t)(c0 + i) * 8192];
#pragma unroll
      for (int i = 0; i < 8; i++) { s = s * G + u[i]; if (c0 + i + 1 < NCH) Sp[(size_t)(c0 + i + 1) * 8192] = f2bf(s); }
    }
    int dv = e >> 6, dk = e & 63;
    p.out[O_SP + (size_t)bh * 8192 + dk * 128 + dv] = s;
  }
}

DEV void attn_item(const Params& p, int item, char* smem, float thr, bool dry) {
  const int tid = threadIdx.x, lane = tid & 63, w = tid >> 6, r32 = lane & 31, hi = lane >> 5;
  const int bh = item >> 7, qt = 127 - (item & 127);
  const int b = bh >> 3, h = bh & 7;
  const int q0 = qt * 128;
  bfu* sK = (bfu*)smem;
  bfu* sV = sK + 64 * 72;
  float* sC = (float*)(sV + 64 * 72);
  const float* c2 = (const float*)(p.ws + OFF_C2) + (size_t)bh * SEQ;
  bfu* FQ = (bfu*)(p.ws + OFF_FQ);
  const bfu* FKB = (const bfu*)(p.ws + OFF_FKB) + (size_t)b * SEQ * 512 + h * 64;
  const bfu* FVT = (const bfu*)(p.ws + OFF_FVT) + (size_t)bh * 64 * SEQ;
  const int jd0 = q0 >> 6;
  int pred = 0;
  if (tid < jd0) pred = (c2[q0] - c2[tid * 64 + 63]) < -thr;
  const int jstart = __syncthreads_count(pred);
  const int qrow = q0 + w * 32 + r32;
  bf16x8 qf[4];
  const bfu* qp = FQ + (size_t)(b * SEQ + qrow) * 512 + h * 64 + hi * 8;
#pragma unroll
  for (int d0 = 0; d0 < 4; d0++) qf[d0] = *(const bf16x8*)(qp + d0 * 16);
  const float cq = c2[qrow];
  float m = -INFINITY, lsum = 0.f;
  f32x16 o0, o1;
#pragma unroll
  for (int r = 0; r < 16; r++) { o0[r] = 0.f; o1[r] = 0.f; }
  u32x4 rk0, rk1, rv0, rv1; float rc = 0.f;
  const int srow = tid >> 3, sch = tid & 7;
#define ATT_GLOAD(j_) do { \
    rk0 = *(const u32x4*)(FKB + (size_t)((j_) * 64 + srow) * 512 + sch * 8); \
    rk1 = *(const u32x4*)(FKB + (size_t)((j_) * 64 + srow + 32) * 512 + sch * 8); \
    rv0 = *(const u32x4*)(FVT + (size_t)srow * SEQ + (j_) * 64 + sch * 8); \
    rv1 = *(const u32x4*)(FVT + (size_t)(srow + 32) * SEQ + (j_) * 64 + sch * 8); \
    if (tid < 64) rc = c2[(j_) * 64 + tid]; } while (0)
  ATT_GLOAD(jstart);
  for (int j = jstart; j <= jd0 + 1; j++) {
    __syncthreads();
    *(u32x4*)(sK + srow * 72 + sch * 8) = rk0; *(u32x4*)(sK + (srow + 32) * 72 + sch * 8) = rk1;
    *(u32x4*)(sV + srow * 72 + sch * 8) = rv0; *(u32x4*)(sV + (srow + 32) * 72 + sch * 8) = rv1;
    if (tid < 64) sC[tid] = rc;
    __syncthreads();
    if (j < jd0 + 1) ATT_GLOAD(j + 1);
    if (j * 64 > q0 + w * 32 + 31) continue;
    f32x16 s0, s1;
#pragma unroll
    for (int r = 0; r < 16; r++) { s0[r] = 0.f; s1[r] = 0.f; }
#pragma unroll
    for (int d0 = 0; d0 < 4; d0++) {
      bf16x8 k0 = *(const bf16x8*)(sK + r32 * 72 + d0 * 16 + hi * 8);
      bf16x8 k1 = *(const bf16x8*)(sK + (32 + r32) * 72 + d0 * 16 + hi * 8);
      s0 = __builtin_amdgcn_mfma_f32_32x32x16_bf16(k0, qf[d0], s0, 0, 0, 0);
      s1 = __builtin_amdgcn_mfma_f32_32x32x16_bf16(k1, qf[d0], s1, 0, 0, 0);
    }
    const bool diag = (j >= jd0);
    const int kbase = j * 64 + 4 * hi;
    float mloc = -INFINITY;
#pragma unroll
    for (int g = 0; g < 4; g++) {
      float4 c0 = *(const float4*)(sC + 8 * g + 4 * hi), c1 = *(const float4*)(sC + 32 + 8 * g + 4 * hi);
      float cc0[4] = {c0.x, c0.y, c0.z, c0.w}, cc1[4] = {c1.x, c1.y, c1.z, c1.w};
#pragma unroll
      for (int e = 0; e < 4; e++) {
        int r = g * 4 + e;
        float a = s0[r] + (cq - cc0[e]), bb = s1[r] + (cq - cc1[e]);
        if (diag) { int key = kbase + 8 * g + e; if (key > qrow) a = -INFINITY; if (key + 32 > qrow) bb = -INFINITY; }
        s0[r] = a; s1[r] = bb; mloc = fmaxf(mloc, fmaxf(a, bb));
      }
    }
    mloc = fmaxf(mloc, __shfl_xor(mloc, 32));
    float mn = fmaxf(m, mloc);
    float alpha = __builtin_amdgcn_exp2f(m - mn);
    m = mn;
    float ps = 0.f;
#pragma unroll
    for (int r = 0; r < 16; r++) { s0[r] = __builtin_amdgcn_exp2f(s0[r] - mn); s1[r] = __builtin_amdgcn_exp2f(s1[r] - mn); ps += s0[r] + s1[r]; }
    lsum = lsum * alpha + ps;
#pragma unroll
    for (int r = 0; r < 16; r++) { o0[r] *= alpha; o1[r] *= alpha; }
#pragma unroll
    for (int ks = 0; ks < 4; ks++) {
      union { bf16x8 v; unsigned u[4]; } pf;
#pragma unroll
      for (int e = 0; e < 4; e++) {
        int r = (ks & 1) * 8 + 2 * e;
        pf.u[e] = (ks < 2) ? pack2(s0[r], s0[r + 1]) : pack2(s1[r], s1[r + 1]);
      }
#pragma unroll
      for (int db = 0; db < 2; db++) {
        const bfu* vp = sV + (db * 32 + r32) * 72 + ks * 16 + 4 * hi;
        union { bf16x8 v; uint2 u[2]; } vf;
        vf.u[0] = *(const uint2*)vp; vf.u[1] = *(const uint2*)(vp + 8);
        if (db == 0) o0 = __builtin_amdgcn_mfma_f32_32x32x16_bf16(vf.v, pf.v, o0, 0, 0, 0);
        else o1 = __builtin_amdgcn_mfma_f32_32x32x16_bf16(vf.v, pf.v, o1, 0, 0, 0);
      }
    }
  }
  float lt = lsum + __shfl_xor(lsum, 32);
  float inv = 1.f / lt;
  bfu* op = (dry ? (bfu*)(p.ws + OFF_XB) : FQ) + (size_t)(b * SEQ + qrow) * 512 + h * 64;
#pragma unroll
  for (int g = 0; g < 4; g++) {
    *(uint2*)(op + 8 * g + 4 * hi) = make_uint2(pack2(o0[g * 4] * inv, o0[g * 4 + 1] * inv), pack2(o0[g * 4 + 2] * inv, o0[g * 4 + 3] * inv));
    *(uint2*)(op + 32 + 8 * g + 4 * hi) = make_uint2(pack2(o1[g * 4] * inv, o1[g * 4 + 1] * inv), pack2(o1[g * 4 + 2] * inv, o1[g * 4 + 3] * inv));
  }
  __syncthreads();
}

DEV void r3_item(const Params& p, int item, char* smem, bool dry) {
  const int tid = threadIdx.x, lane = tid & 63, w = tid >> 6, wr = w >> 1, wc = w & 1, l16 = lane & 15, quad = lane >> 4;
  const int bh = item / NCH, c = item - bh * NCH; const int b = bh >> 3, h = bh & 7;
  bfu* sQ = (bfu*)smem; bfu* sK = sQ + 128 * 72; bfu* sP = sK + 128 * 72; float* sRed = (float*)(sP + 128 * 136);
  const size_t row0 = (size_t)b * SEQ + c * RC;
  const bfu* Q = (const bfu*)(p.ws + OFF_QT) + row0 * 512 + h * 64;
  const bfu* Kk = (const bfu*)(p.ws + OFF_KT) + row0 * 512 + h * 64;
  const bfu* vT = (const bfu*)(p.ws + OFF_VT) + (size_t)bh * 128 * SEQ + c * RC;
  const bfu* ST = (const bfu*)(p.ws + OFF_SST) + (size_t)item * 8192;
  u32x4 ra[4], rb[4];
  g2r<128>(Q, 512, ra); g2r<128>(Kk, 512, rb);
  __syncthreads();
  r2s<128>(sQ, ra); r2s<128>(sK, rb);
  __syncthreads();
  g2r<128>(vT, SEQ, rb);
  f32x4 acc[4][4];
#pragma unroll
  for (int i = 0; i < 4; i++)
#pragma unroll
    for (int j = 0; j < 4; j++) acc[i][j] = f32x4{0.f, 0.f, 0.f, 0.f};
  mma64<4, 4>(sQ, 72, sK, 72, acc);
#pragma unroll
  for (int mi = 0; mi < 4; mi++)
#pragma unroll
    for (int ni = 0; ni < 4; ni++)
#pragma unroll
      for (int j = 0; j < 4; j++) {
        int row = wr * 64 + mi * 16 + quad * 4 + j, col = wc * 64 + ni * 16 + l16;
        sP[row * 136 + col] = (col <= row) ? f2bf(acc[mi][ni][j]) : (bfu)0;
      }
#pragma unroll
  for (int i = 0; i < 4; i++)
#pragma unroll
    for (int j = 0; j < 4; j++) acc[i][j] = f32x4{0.f, 0.f, 0.f, 0.f};
  __syncthreads();
  r2s<128>(sK, rb);
  __syncthreads();
  g2r<128>(vT + 64, SEQ, rb);
  mma64<4, 4>(sP, 136, sK, 72, acc);
  __syncthreads();
  r2s<128>(sK, rb);
  __syncthreads();
  g2r<128>(ST, 64, rb);
  mma64<4, 4>(sP + 64, 136, sK, 72, acc);
  __syncthreads();
  r2s<128>(sK, rb);
  __syncthreads();
  mma64<4, 4>(sQ, 72, sK, 72, acc);
  float ssq[4][4];
#pragma unroll
  for (int mi = 0; mi < 4; mi++)
#pragma unroll
    for (int j = 0; j < 4; j++) { float s = 0.f;
#pragma unroll
      for (int ni = 0; ni < 4; ni++) s += acc[mi][ni][j] * acc[mi][ni][j];
      s = sum16(s); ssq[mi][j] = s;
      if (l16 == 0) sRed[(wr * 64 + mi * 16 + quad * 4 + j) * 2 + wc] = s; }
  __syncthreads();
  bfu* RG = (bfu*)(p.ws + OFF_RG);
  float gg[4];
#pragma unroll
  for (int ni = 0; ni < 4; ni++) gg[ni] = p.gn_g[h * 128 + wc * 64 + ni * 16 + l16];
  float* sw = (float*)smem + w * EPI_WAVE;
#pragma unroll
  for (int mi = 0; mi < 4; mi++) {
    f32x4 tv[4];
#pragma unroll
    for (int j = 0; j < 4; j++) {
      int row = wr * 64 + mi * 16 + quad * 4 + j;
      float tot = sRed[row * 2] + sRed[row * 2 + 1];
      float r = rsqrtf(tot * (1.f / 128.f) + EPSN);
#pragma unroll
      for (int ni = 0; ni < 4; ni++) tv[ni][j] = acc[mi][ni][j] * r * gg[ni];
    }
    float rw[16], g[16]; to_rows(tv, rw, sw, lane);
    int rr_ = lane >> 2; asm volatile("" : "+v"(rr_));
    const size_t o = (row0 + wr * 64 + mi * 16 + rr_) * DM + h * 128 + wc * 64 + (lane & 3) * 16;
    ld_bf16x16(RG + o, g);
#pragma unroll
    for (int e = 0; e < 16; e++) rw[e] *= g[e] * sigmoidf_(g[e]);
    st_bf16x16(dry ? (bfu*)(p.ws + OFF_XB) + (o & 0xffffff) : RG + o, rw);
  }
  __syncthreads();
}

DEV void phase4(const Params& p, int bid, int nb, char* smem, bool dry = false) {
  float gq = 0.f, gk = 0.f;
  for (int i = 0; i < 64; i++) { gq = fmaxf(gq, fabsf(p.fq_g[i])); gk = fmaxf(gk, fabsf(p.fk_g[i])); }
  const float thr = 2.f * (8.f * gq * gk * 1.03f * LOG2E) + 44.f;
  for (int it = bid; it < 2048 + 16 * NCH; it += nb) {
    if (it < 2048) attn_item(p, it, smem, thr, dry); else r3_item(p, it - 2048, smem, dry);
  }
}

DEV void phase5(const Params& p, int bid, int nb, char* smem) {
  const int tid = threadIdx.x, lane = tid & 63, w = tid >> 6, wr = w >> 1, wc = w & 1, l16 = lane & 15, quad = lane >> 4;
  bfu* sA = (bfu*)smem; bfu* sB = sA + 128 * 72;
  const bfu* G = (const bfu*)(p.ws + OFF_RG); const bfu* FO = (const bfu*)(p.ws + OFF_FQ);
  const bfu* WR = (const bfu*)(p.ws + OFF_WRT); const bfu* WF = (const bfu*)(p.ws + OFF_WFT);
  bfu* MX = (bfu*)(p.ws + OFF_XB);
  constexpr int NG = (TT / 128) * 8, NCV = 8192;
  const int xcd = bid & 7, slot = bid >> 3, nslots = (nb + 7 - xcd) >> 3;
  const int n_p = slot < 128 ? (128 - slot + nslots - 1) / nslots : 0;
  for (int i_ = 0; i_ < n_p; i_++) {
    int q = slot + i_ * nslots; int mt = xcd * 16 + (q >> 3), nt = q & 7;
    int m0 = mt * 256, n0 = nt * 128;
    int tid2 = threadIdx.x; asm volatile("" : "+v"(tid2));
    const int lane2 = tid2 & 63, w2 = tid2 >> 6, wr2 = w2 >> 1, wc2 = w2 & 1, l162 = lane2 & 15, quad2 = lane2 >> 4;
    f32x4 a1[8][4];
#pragma unroll
    for (int i = 0; i < 8; i++)
#pragma unroll
      for (int j = 0; j < 4; j++) a1[i][j] = f32x4{0.f, 0.f, 0.f, 0.f};
    gemm_loop_sb<8, 4>(G + (size_t)m0 * DM, DM, WR + (size_t)n0 * DM, DM, DM, a1, sA);
    const bfu* ga = (const bfu*)(p.out + O_YP); const bfu* gb = ga + (size_t)TP * DM;
    float* sw = (float*)(smem + EPI_OFF) + w2 * EPI_WAVE;
    const int rr = lane2 >> 2, c0 = wc2 * 64 + (lane2 & 3) * 16;
#pragma unroll
    for (int mi = 0; mi < 8; mi++) {
      float r[16], g[16]; to_rows(a1[mi], r, sw, lane2);
      int rr_ = rr; asm volatile("" : "+v"(rr_));
      const size_t o = (size_t)(m0 + wr2 * 128 + mi * 16 + rr_) * DM + n0 + c0;
      ld_bf16x16(ga + o, g);
#pragma unroll
      for (int e = 0; e < 16; e++) r[e] *= sigmoidf_(g[e]);
      st_bf16x16(MX + o, r);
#pragma unroll
      for (int ni = 0; ni < 4; ni++) a1[mi][ni] = f32x4{0.f, 0.f, 0.f, 0.f};
    }
    gemm_loop_sb<8, 4>(FO + (size_t)m0 * 512, 512, WF + (size_t)n0 * 512, 512, 512, a1, sA);
#pragma unroll
    for (int mi = 0; mi < 8; mi++) {
      float r[16], g[16], m[16]; to_rows(a1[mi], r, sw, lane2);
      int rr_ = rr; asm volatile("" : "+v"(rr_));
      const size_t o = (size_t)(m0 + wr2 * 128 + mi * 16 + rr_) * DM + n0 + c0;
      ld_bf16x16(gb + o, g); ld_bf16x16(MX + o, m);
#pragma unroll
      for (int e = 0; e < 16; e++) r[e] = m[e] + sigmoidf_(g[e]) * r[e];
      st_bf16x16(MX + o, r);
    }
  }
  if (bid < 128) {
    int nt = bid & 7;
    int m0 = TP + (bid >> 3) * 32, n0 = nt * 128;
    f32x4 a1[1][4];
#pragma unroll
    for (int j = 0; j < 4; j++) a1[0][j] = f32x4{0.f, 0.f, 0.f, 0.f};
    gemm_loop<1, 4>(G + (size_t)m0 * DM, DM, WR + (size_t)n0 * DM, DM, DM, a1, sA);
    const bfu* ga = (const bfu*)(p.out + O_YS) + (size_t)(m0 - TP) * DM + n0; const bfu* gb = ga + (size_t)TS * DM;
    bfu* mxT = MX + (size_t)m0 * DM + n0;
    unsigned loff = (unsigned)((wr * 16 + quad * 4) * DM + wc * 64 + l16); asm volatile("" : "+v"(loff));
#pragma unroll
    for (int ni = 0; ni < 4; ni++) {
#pragma unroll
      for (int j = 0; j < 4; j++) { unsigned o = loff + (unsigned)(j * DM + ni * 16);
        mxT[o] = f2bf(sigmoidf_(bf2f(ga[o])) * a1[0][ni][j]); }
      a1[0][ni] = f32x4{0.f, 0.f, 0.f, 0.f};
    }
    gemm_loop<1, 4>(FO + (size_t)m0 * 512, 512, WF + (size_t)n0 * 512, 512, 512, a1, sA);
    unsigned loff2 = loff; asm volatile("" : "+v"(loff2));
#pragma unroll
    for (int ni = 0; ni < 4; ni++) {
#pragma unroll
      for (int j = 0; j < 4; j++) { unsigned o = loff2 + (unsigned)(j * DM + ni * 16);
        mxT[o] = f2bf(bf2f(mxT[o]) + sigmoidf_(bf2f(gb[o])) * a1[0][ni][j]); }
    }
  }
}

DEV void phase6(const Params& p, int bid, int nb, char* smem) {
  bfu* sA = (bfu*)smem;
  const bfu* MX = (const bfu*)(p.ws + OFF_XB); const bfu* WO = (const bfu*)(p.ws + OFF_WOT);
  bfu* X1B = (bfu*)(p.ws + OFF_X1B); float* SSQ2 = (float*)(p.ws + OFF_SSQ2);
  const int xcd = bid & 7, slot = bid >> 3, nslots = (nb + 7 - xcd) >> 3;
  const int n_p = slot < 128 ? (128 - slot + nslots - 1) / nslots : 0;
  for (int i_ = 0; i_ < n_p; i_++) {
    int q = slot + i_ * nslots; int mt = xcd * 16 + (q >> 3), nt = q & 7;
    int m0 = mt * 256, n0 = nt * 128;
    int tid = threadIdx.x; asm volatile("" : "+v"(tid));
    const int lane = tid & 63, w = tid >> 6, wr = w >> 1, wc = w & 1, l16 = lane & 15, quad = lane >> 4;
    f32x4 acc[8][4];
#pragma unroll
    for (int i = 0; i < 8; i++)
#pragma unroll
      for (int j = 0; j < 4; j++) acc[i][j] = f32x4{0.f, 0.f, 0.f, 0.f};
    gemm_loop_sb<8, 4>(MX + (size_t)m0 * DM, DM, WO + (size_t)n0 * DM, DM, DM, acc, sA);
    float* sw = (float*)(smem + EPI_OFF) + w * EPI_WAVE;
    const int rr = lane >> 2, c0 = wc * 64 + (lane & 3) * 16;
#pragma unroll
    for (int mi = 0; mi < 8; mi++) {
      float r[16]; to_rows(acc[mi], r, sw, lane);
      int rr_ = rr; asm volatile("" : "+v"(rr_));
      const size_t o = (size_t)(m0 + wr * 128 + mi * 16 + rr_) * DM + n0 + c0;
      const float* xp = (m0 < TP ? p.x_p : p.x_s - (size_t)TP * DM) + o;
      float ss = 0.f;
#pragma unroll
      for (int c = 0; c < 4; c++) { f32x4 xv = *(const f32x4*)(xp + 4 * c);
#pragma unroll
        for (int e = 0; e < 4; e++) { r[4 * c + e] += xv[e]; ss += r[4 * c + e] * r[4 * c + e]; } }
      st_f32x16(p.out + O_YP + o, r);
      st_bf16x16(X1B + o, r);
      ss += __shfl_xor(ss, 1); ss += __shfl_xor(ss, 2);
      if ((lane & 3) == 0) SSQ2[(size_t)(m0 + wr * 128 + mi * 16 + rr) * 16 + nt * 2 + wc] = ss;
    }
  }
  if (bid < 128) {
    const int tid = threadIdx.x, lane = tid & 63, w = tid >> 6, wr = w >> 1, wc = w & 1, l16 = lane & 15, quad = lane >> 4;
    int nt = bid & 7;
    int m0 = TP + (bid >> 3) * 32, n0 = nt * 128;
    f32x4 acc[1][4];
#pragma unroll
    for (int j = 0; j < 4; j++) acc[0][j] = f32x4{0.f, 0.f, 0.f, 0.f};
    gemm_loop<1, 4>(MX + (size_t)m0 * DM, DM, WO + (size_t)n0 * DM, DM, DM, acc, sA);
    const float* xin = p.x_s + (size_t)(m0 - TP) * DM + n0;
    float* y = p.out + O_YS + (size_t)(m0 - TP) * DM + n0;
    bfu* xb1 = X1B + (size_t)m0 * DM + n0;
    unsigned loff = (unsigned)((wr * 16 + quad * 4) * DM + wc * 64 + l16); asm volatile("" : "+v"(loff));
#pragma unroll
    for (int j = 0; j < 4; j++) {
      int lr = wr * 16 + quad * 4 + j; float ss = 0.f;
#pragma unroll
      for (int ni = 0; ni < 4; ni++) {
        unsigned o = loff + (unsigned)(j * DM + ni * 16);
        float v = xin[o] + acc[0][ni][j];
        y[o] = v; xb1[o] = f2bf(v); ss += v * v;
      }
      ss = sum16(ss);
      if (l16 == 0) (SSQ2 + (size_t)m0 * 16 + nt * 2)[(unsigned)(lr * 16 + wc)] = ss;
    }
  }
}

DEV int fkey(float x, int idx, int mask) { int b = __float_as_int(x); b ^= (b >> 31) & 0x7fffffff; return (b & ~mask) | idx; }
DEV void ins16(int (&t)[16], int v) {
#pragma unroll
  for (int s = 0; s < 16; s++) { int hi = max(t[s], v); v = min(t[s], v); t[s] = hi; }
}

DEV void phase7(const Params& p, int bid, int nb, char* smem) {
  const int tid = threadIdx.x, lane = tid & 63, w = tid >> 6, wr = w >> 1, wc = w & 1, l16 = lane & 15, quad = lane >> 4;
  bfu* sA = (bfu*)smem;
  float* sS = (float*)smem;
  int* sL = (int*)(smem + 33024);
  float* sTV = (float*)(smem + 55296);
  int* sTI = (int*)(sTV + 2 * 64 * 17);
  const bfu* X1B = (const bfu*)(p.ws + OFF_X1B); const bfu* MT = (const bfu*)(p.ws + OFF_MT);
  const float* SSQ2 = (const float*)(p.ws + OFF_SSQ2);
  int2* ROUTE = (int2*)(p.ws + OFF_ROUTE);
  constexpr int NI7 = (TT / 64) * 8;
  const int xcd = bid & 7, slot = bid >> 3, nslots = (nb + 7 - xcd) >> 3;
  for (int q = slot; q < 520; q += nslots) {
    int hg = q / 260, q2 = q - hg * 260; int mt = xcd * 65 + (q2 >> 2), h = hg * 4 + (q2 & 3); int m0 = mt * 64;
    for (int half = 0; half < 2; half++) {
      f32x4 acc[2][4];
#pragma unroll
      for (int i = 0; i < 2; i++)
#pragma unroll
        for (int j = 0; j < 4; j++) acc[i][j] = f32x4{0.f, 0.f, 0.f, 0.f};
      gemm_loop<2, 4>(X1B + (size_t)m0 * DM, DM, MT + (size_t)(h * 256 + half * 128) * DM, DM, DM, acc, sA);
      __syncthreads();
#pragma unroll
      for (int mi = 0; mi < 2; mi++)
#pragma unroll
        for (int j = 0; j < 4; j++) {
          int lr = wr * 32 + mi * 16 + quad * 4 + j;
          const float* sp = SSQ2 + (size_t)(m0 + lr) * 16; float tot = 0.f;
#pragma unroll
          for (int i = 0; i < 16; i++) tot += sp[i];
          float rs = rsqrtf(tot * (1.f / DM) + EPSN);
#pragma unroll
          for (int ni = 0; ni < 4; ni++) sS[lr * 129 + wc * 64 + ni * 16 + l16] = acc[mi][ni][j] * rs;
        }
      __syncthreads();
      { int row = tid & 63, q = tid >> 6; int t[16];
#pragma unroll
        for (int s = 0; s < 16; s++) t[s] = (int)0x80000000;
#pragma unroll 8
        for (int i = 0; i < 32; i++) { int idx = q * 32 + i; ins16(t, fkey(sS[row * 129 + idx], idx, 127)); }
#pragma unroll
        for (int s = 0; s < 16; s++) sL[row * 65 + q * 16 + s] = t[s]; }
      __syncthreads();
      if (tid < 64) { int row = tid; int p0 = 0, p1 = 0, p2 = 0, p3 = 0; const int* L = sL + row * 65;
        for (int r = 0; r < 16; r++) {
          int a0 = L[p0], a1 = L[16 + p1], a2 = L[32 + p2], a3 = L[48 + p3];
          int mx = max(max(a0, a1), max(a2, a3));
          if (mx == a0) p0++; else if (mx == a1) p1++; else if (mx == a2) p2++; else p3++;
          int idx = mx & 127;
          sTV[(half * 64 + row) * 17 + r] = sS[row * 129 + idx]; sTI[(half * 64 + row) * 17 + r] = idx; } }
      __syncthreads();
    }
    if (tid < 64) {
      int row = tid; float v1[16], v2[16];
#pragma unroll
      for (int i = 0; i < 16; i++) { v1[i] = sTV[row * 17 + i]; v2[i] = sTV[(64 + row) * 17 + i]; }
      int t[16];
#pragma unroll
      for (int s = 0; s < 16; s++) t[s] = (int)0x80000000;
#pragma unroll
      for (int i = 0; i < 16; i++)
#pragma unroll
        for (int j = 0; j < 16; j++)
          if ((i + 1) * (j + 1) <= 16) ins16(t, fkey(v1[i] + v2[j], i * 16 + j, 255));
      float es[16]; int ei[16]; float mx = 0.f, sum = 0.f;
#pragma unroll
      for (int r = 0; r < 16; r++) { int c = t[r] & 255; int i = c >> 4, j = c & 15;
        float s = sTV[row * 17 + i] + sTV[(64 + row) * 17 + j];
        ei[r] = sTI[row * 17 + i] * 128 + sTI[(64 + row) * 17 + j];
        if (r == 0) mx = s;
        es[r] = __expf(s - mx); sum += es[r]; }
      float inv = 1.f / sum;
      int2* ro = ROUTE + ((size_t)(m0 + row) * 8 + h) * 16;
#pragma unroll
      for (int r = 0; r < 16; r++) ro[r] = make_int2(ei[r], __float_as_int(es[r] * inv));
    }
    __syncthreads();
  }
}

#define FP4PK(w_, sel_) __builtin_amdgcn_cvt_scalef32_pk_f32_fp4((w_), 1.0f, (sel_))
DEV float dot16_fp8(const u32x2& u, const f32x2 (&xn)[8]) {
  f32x2 s = FP4PK(u[0], 0) * xn[0];
  s = FP4PK(u[0], 1) * xn[1] + s;
  s = FP4PK(u[0], 2) * xn[2] + s;
  s = FP4PK(u[0], 3) * xn[3] + s;
  s = FP4PK(u[1], 0) * xn[4] + s;
  s = FP4PK(u[1], 1) * xn[5] + s;
  s = FP4PK(u[1], 2) * xn[6] + s;
  s = FP4PK(u[1], 3) * xn[7] + s;
  return s[0] + s[1];
}
DEV void axpy16_fp8(const u32x2& u, float wj, f32x2 (&acc)[8]) {
  const f32x2 w2 = {wj, wj};
  acc[0] = FP4PK(u[0], 0) * w2 + acc[0];
  acc[1] = FP4PK(u[0], 1) * w2 + acc[1];
  acc[2] = FP4PK(u[0], 2) * w2 + acc[2];
  acc[3] = FP4PK(u[0], 3) * w2 + acc[3];
  acc[4] = FP4PK(u[1], 0) * w2 + acc[4];
  acc[5] = FP4PK(u[1], 1) * w2 + acc[5];
  acc[6] = FP4PK(u[1], 2) * w2 + acc[6];
  acc[7] = FP4PK(u[1], 3) * w2 + acc[7];
}
template <int S>
DEV void red_step(float (&pp)[16], int lane) {
  const bool up = (lane & S) != 0;
#pragma unroll
  for (int i = 0; i < S; i++) {
    float send = up ? pp[i] : pp[i + S];
    float keep = up ? pp[i + S] : pp[i];
    pp[i] = keep + __shfl_xor(send, S);
  }
}
DEV float reduce16(float (&pp)[16], int lane) {
  red_step<8>(pp, lane); red_step<4>(pp, lane); red_step<2>(pp, lane); red_step<1>(pp, lane);
  float v = pp[0];
  v += __shfl_xor(v, 16); v += __shfl_xor(v, 32);
  return v;
}

DEV void phase8(const Params& p, int bid, int nb, char* smem, bool dry = false) {
  const int tid = threadIdx.x, lane = tid & 63, w = __builtin_amdgcn_readfirstlane(tid >> 6);
  const u32x2* PUB = (const u32x2*)(p.ws + OFF_PUB); const u32x2* PVB = (const u32x2*)(p.ws + OFF_PVB);
  const float* PSC = (const float*)(p.ws + OFF_PSC);
  const float* SSQ2 = (const float*)(p.ws + OFF_SSQ2); const int2* ROUTE = (const int2*)(p.ws + OFF_ROUTE);
  for (int it = bid; it < TT / 4; it += nb) {
    int tok = it * 4 + w;
    float* y = tok < TP ? p.out + O_YP + (size_t)tok * DM : p.out + O_YS + (size_t)(tok - TP) * DM;
    float x[16]; f32x2 xn[8];
    { float4 a0 = *(const float4*)(y + lane * 16), a1 = *(const float4*)(y + lane * 16 + 4), b0 = *(const float4*)(y + lane * 16 + 8), b1 = *(const float4*)(y + lane * 16 + 12);
      x[0] = a0.x; x[1] = a0.y; x[2] = a0.z; x[3] = a0.w; x[4] = a1.x; x[5] = a1.y; x[6] = a1.z; x[7] = a1.w;
      x[8] = b0.x; x[9] = b0.y; x[10] = b0.z; x[11] = b0.w; x[12] = b1.x; x[13] = b1.y; x[14] = b1.z; x[15] = b1.w; }
    float tot = 0.f;
    { const float* sp = SSQ2 + (size_t)tok * 16;
#pragma unroll
      for (int i = 0; i < 16; i++) tot += sp[i]; }
    float rs = rsqrtf(tot * (1.f / DM) + EPSN);
#pragma unroll
    for (int i = 0; i < 8; i++) { xn[i][0] = x[2 * i] * rs * p.norm2_g[lane * 16 + 2 * i]; xn[i][1] = x[2 * i + 1] * rs * p.norm2_g[lane * 16 + 2 * i + 1]; }
    const int2* rt = ROUTE + (size_t)tok * 128;
    int2 r0 = rt[lane], r1 = rt[lane + 64];
    float d0 = 0.f, d1 = 0.f, w0 = 0.f, w1 = 0.f;
    f32x2 acc[8];
#pragma unroll
    for (int i = 0; i < 8; i++) acc[i] = f32x2{0.f, 0.f};
#define P8_LOAD(buf, tb_, gi_) do { const int rx_ = ((gi_) & 4) ? r1.x : r0.x; \
      _Pragma("unroll") for (int jj = 0; jj < 16; jj++) { int e = __builtin_amdgcn_readlane(rx_, ((gi_) & 3) * 16 + jj); buf[jj] = tb_[(size_t)e * 64 + lane]; } } while (0)
#define P8_COMPU(buf, gi_) do { float pp[16]; \
      _Pragma("unroll") for (int jj = 0; jj < 16; jj++) pp[jj] = dot16_fp8(buf[jj], xn); \
      float v_ = reduce16(pp, lane); \
      if ((lane >> 4) == ((gi_) & 3)) { if ((gi_) < 4) d0 = v_; else d1 = v_; } } while (0)
#define P8_COMPV(buf, gi_) do { const int wx_ = __float_as_int(((gi_) & 4) ? w1 : w0); \
      _Pragma("unroll") for (int jj = 0; jj < 16; jj++) { float wj = __int_as_float(__builtin_amdgcn_readlane(wx_, ((gi_) & 3) * 16 + jj)); axpy16_fp8(buf[jj], wj, acc); } } while (0)
#define P8_SB() __builtin_amdgcn_sched_barrier(0)
    {
      u32x2 ua[16], ub[16];
      P8_LOAD(ua, PUB, 0);
#pragma unroll 1
      for (int gi = 0; gi < 6; gi += 2) {
        P8_LOAD(ub, PUB, gi + 1); P8_SB();
        P8_COMPU(ua, gi); P8_SB();
        P8_LOAD(ua, PUB, gi + 2); P8_SB();
        P8_COMPU(ub, gi + 1); P8_SB();
      }
      P8_LOAD(ub, PUB, 7); P8_SB();
      P8_COMPU(ua, 6); P8_SB();
      P8_LOAD(ua, PVB, 0); P8_SB();
      P8_COMPU(ub, 7); P8_SB();
      d0 *= PSC[r0.x]; d1 *= PSC[r1.x];
      w0 = 0.5f * d0 * (1.f + erff(d0 * 0.70710678118654752f)) * __int_as_float(r0.y) * PSC[16384 + r0.x];
      w1 = 0.5f * d1 * (1.f + erff(d1 * 0.70710678118654752f)) * __int_as_float(r1.y) * PSC[16384 + r1.x];
      P8_SB();
#pragma unroll 1
      for (int gi = 0; gi < 6; gi += 2) {
        P8_LOAD(ub, PVB, gi + 1); P8_SB();
        P8_COMPV(ua, gi); P8_SB();
        P8_LOAD(ua, PVB, gi + 2); P8_SB();
        P8_COMPV(ub, gi + 1); P8_SB();
      }
      P8_LOAD(ub, PVB, 7); P8_SB();
      P8_COMPV(ua, 6); P8_SB();
      P8_COMPV(ub, 7);
    }
    if (dry) y = (float*)(p.ws + OFF_XB) + (size_t)(tok & 8191) * DM;
    *(float4*)(y + lane * 16) = make_float4(x[0] + acc[0][0], x[1] + acc[0][1], x[2] + acc[1][0], x[3] + acc[1][1]);
    *(float4*)(y + lane * 16 + 4) = make_float4(x[4] + acc[2][0], x[5] + acc[2][1], x[6] + acc[3][0], x[7] + acc[3][1]);
    *(float4*)(y + lane * 16 + 8) = make_float4(x[8] + acc[4][0], x[9] + acc[4][1], x[10] + acc[5][0], x[11] + acc[5][1]);
    *(float4*)(y + lane * 16 + 12) = make_float4(x[12] + acc[6][0], x[13] + acc[6][1], x[14] + acc[7][0], x[15] + acc[7][1]);
  }
}

#define XB_TMO      128
#define XB_XCNT(j)  (256  + 64 * (j))
#define XB_XSUB(j)  (1280 + 64 * (j))
#define XB_XGEN(j)  (2304 + 64 * (j))
#define XB_TOP      3328
#define XB_TOPGEN   3392
#define XCD_BAR_WORDS 3456
#define XB_SPIN_CAP (1u << 18)
#define LAS __attribute__((address_space(3)))

__device__ __forceinline__ unsigned xb_ld(unsigned* p)              { return __hip_atomic_load(p, __ATOMIC_RELAXED, __HIP_MEMORY_SCOPE_AGENT); }
__device__ __forceinline__ unsigned xb_add(unsigned* p, unsigned v) { return __hip_atomic_fetch_add(p, v, __ATOMIC_RELAXED, __HIP_MEMORY_SCOPE_AGENT); }
__device__ __forceinline__ unsigned xb_xcc_id() { return (unsigned)__builtin_amdgcn_s_getreg((3 << 11) | 20) & 0xFu; }
#define XB_SPIN(cond, bar) do { unsigned _sp = 0; while (cond) { __builtin_amdgcn_s_sleep(1); \
    if ((++_sp & 255u) == 0u) { if (xb_ld(&(bar)[XB_TMO])) break; if (_sp > XB_SPIN_CAP) { atomicAdd(&(bar)[XB_TMO], 1u); break; } } } } while (0)

struct XcdBarrier {
    unsigned* bar; unsigned x;
    volatile LAS unsigned* st;
};

__device__ __forceinline__ XcdBarrier xcd_barrier_post(unsigned* bar, volatile LAS unsigned* st) {
    XcdBarrier b; b.bar = bar; b.x = xb_xcc_id(); b.st = st;
    if (threadIdx.x == 0) (void)xb_add(&bar[XB_XCNT(b.x)], 1u);
    return b;
}
__device__ __forceinline__ void xcd_barrier_complete(unsigned* bar, unsigned x, unsigned& nloc, unsigned& nx) {
    const unsigned G = gridDim.x * gridDim.y * gridDim.z;
    unsigned sum, cnt, mine, sp = 0u;
    for (;;) {
        sum = 0u; cnt = 0u; mine = 0u;
#pragma unroll
        for (unsigned j = 0; j < 16; ++j) { const unsigned c = xb_ld(&bar[XB_XCNT(j)]); sum += c; cnt += (c > 0u) ? 1u : 0u; mine = (j == x) ? c : mine; }
        if (sum == G) break;
        __builtin_amdgcn_s_sleep(1);
        if ((++sp & 255u) == 0u) { if (xb_ld(&bar[XB_TMO])) break; if (sp > XB_SPIN_CAP) { atomicAdd(&bar[XB_TMO], 1u); break; } }
    }
    nloc = mine > 0u ? mine : 1u; nx = cnt > 0u ? cnt : 1u;
}

__device__ __forceinline__ void xcd_barrier(const XcdBarrier& b) {
    asm volatile("s_waitcnt vmcnt(0)" ::: "memory");
    __syncthreads();
    if (threadIdx.x == 0) {
        unsigned* bar = b.bar;
        __builtin_amdgcn_s_waitcnt(0);
        unsigned nloc = b.st[0], nx = b.st[1];
        if (nloc == 0u) { xcd_barrier_complete(bar, b.x, nloc, nx); b.st[0] = nloc; b.st[1] = nx; }
        const unsigned old = xb_add(&bar[XB_XSUB(b.x)], 1u);
        const unsigned gen = old / nloc;
        if (old + 1u == (gen + 1u) * nloc) {
            __builtin_amdgcn_fence(__ATOMIC_RELEASE, "agent");
            asm volatile("s_waitcnt vmcnt(0)" ::: "memory");
            const unsigned og = xb_add(&bar[XB_TOP], 1u);
            const unsigned tg = og / nx;
            if (og + 1u == (tg + 1u) * nx) xb_add(&bar[XB_TOPGEN], 1u);
            else XB_SPIN(xb_ld(&bar[XB_TOPGEN]) == tg, bar);
            __builtin_amdgcn_fence(__ATOMIC_ACQUIRE, "agent");
            xb_add(&bar[XB_XGEN(b.x)], 1u);
            asm volatile("s_waitcnt vmcnt(0)" ::: "memory");
        } else {
            XB_SPIN(xb_ld(&bar[XB_XGEN(b.x)]) == gen, bar);
            __builtin_amdgcn_fence(__ATOMIC_ACQUIRE, "agent");
            asm volatile("s_waitcnt vmcnt(0)" ::: "memory");
        }
    }
    __syncthreads();
}


__global__ void __launch_bounds__(256, 2) fwd_kernel(Params p, int ph_lo, int ph_hi, int coop) {
  __shared__ __attribute__((aligned(16))) char smem[SMEM_BYTES];
  const int bid = blockIdx.x, nb = gridDim.x;
  __shared__ uint4 xb_words;
  if (threadIdx.x == 0) xb_words = make_uint4(0u, 0u, 0u, 0u);
  __syncthreads();
  XcdBarrier xb; xb.bar = (unsigned*)(p.ws + OFF_BAR); xb.x = 0; xb.st = (volatile LAS unsigned*)&xb_words;
  if (coop) xb = xcd_barrier_post((unsigned*)(p.ws + OFF_BAR), (volatile LAS unsigned*)&xb_words);
#ifndef REPS
#define REPS {1,1,1,1,1,1,1,1,1}
#endif
  constexpr int REP[9] = REPS;
#define RUN_PHASE(N) if (ph_lo <= N && N <= ph_hi) { for (int r_ = 0; r_ < REP[N]; r_++) phase##N(p, bid, nb, smem); if (coop && N < ph_hi) { if (ph_lo == 0x7fffffff) cg::this_grid().sync();   xcd_barrier(xb); } }
#define RUN_PHASE_DRY(N) if (ph_lo <= N && N <= ph_hi) { for (int r_ = 1; r_ < REP[N]; r_++) phase##N(p, bid, nb, smem, true); phase##N(p, bid, nb, smem, false); if (coop && N < ph_hi) xcd_barrier(xb); }
  RUN_PHASE(0) RUN_PHASE_DRY(1) RUN_PHASE(2) RUN_PHASE(3) RUN_PHASE_DRY(4) RUN_PHASE(5) RUN_PHASE(6) RUN_PHASE(7) RUN_PHASE_DRY(8)
}

extern "C" void kernel_launch(void* const* d_in, const int* in_sizes, int n_in, void* d_out, int out_size,
                              void* d_ws, size_t ws_size, hipStream_t stream) {
  if (ws_size < WS_NEED) { fprintf(stderr, "workspace too small\n"); return; }
  static int grid_blocks = 0;
  if (!grid_blocks) {
    int dev = 0, cus = 0, per_cu = 0;
    hipGetDevice(&dev);
    hipDeviceGetAttribute(&cus, hipDeviceAttributeMultiprocessorCount, dev);
    hipOccupancyMaxActiveBlocksPerMultiprocessor(&per_cu, fwd_kernel, 256, 0);
    if (per_cu < 1) per_cu = 1;
    if (per_cu > 2) per_cu = 2;
    grid_blocks = cus * per_cu;
  }
  Params p{};
  const float* const* in = (const float* const*)d_in;
  p.x_p = in[0]; p.x_s = in[1]; p.state_ret = in[2]; p.ck = in[3]; p.cv = in[4]; p.clogf = in[5]; p.norm1_g = in[6];
  p.w_in = in[7]; p.b_f = in[8]; p.fq_g = in[9]; p.fk_g = in[10]; p.gn_g = in[11]; p.w_ret_out = in[12]; p.w_fox_out = in[13];
  p.w_o = in[14]; p.norm2_g = in[15]; p.peer_wq = in[16]; p.k1 = in[17]; p.k2 = in[18]; p.peer_u = in[19]; p.peer_v = in[20];
  p.out = (float*)d_out; p.ws = (char*)d_ws;
#ifndef MULTI_LAUNCH
#define MULTI_LAUNCH 0
#endif
#if MULTI_LAUNCH
  for (int ph = 0; ph <= 8; ph++) fwd_kernel<<<grid_blocks, 256, 0, stream>>>(p, ph, ph, 0);
#else
  hipMemsetAsync((char*)d_ws + OFF_BAR, 0, XCD_BAR_WORDS * sizeof(unsigned), stream);
  int lo = 0, hi = 8, coop = 1;
  void* args[] = {&p, &lo, &hi, &coop};
  hipError_t e = hipLaunchCooperativeKernel((void*)fwd_kernel, dim3(grid_blocks), dim3(256), args, 0, stream);
  if (e != hipSuccess) fprintf(stderr, "cooperative launch failed: %s (grid %d)\n", hipGetErrorString(e), grid_blocks);
#endif
}
```

```cpp
#include <hip/hip_runtime.h>
#include <hip/hip_cooperative_groups.h>
#include <stdint.h>
#include <stdio.h>
namespace cg = cooperative_groups;

#define DEV __device__ __forceinline__
typedef unsigned short bfu;
typedef __attribute__((ext_vector_type(8))) short bf16x8;
typedef __attribute__((ext_vector_type(4))) short bf16x4;
typedef __attribute__((ext_vector_type(4))) float f32x4;
typedef __attribute__((ext_vector_type(16))) float f32x16;
typedef __attribute__((ext_vector_type(4))) unsigned u32x4;
typedef __attribute__((ext_vector_type(2))) float f32x2;
typedef __attribute__((ext_vector_type(2))) unsigned u32x2;

constexpr int DM = 1024, SEQ = 16384, TP = 32768, TS = 512, TT = 33280;
constexpr int NWP = 6784;
constexpr int RC = 128;
constexpr int NCH = SEQ / RC;
constexpr float LOG2E = 1.4426950408889634f;
constexpr float EPSN = 1e-6f;

constexpr size_t O_YP = 0, O_YS = 33554432, O_SP = 34078720, O_FKP = 34209792, O_FVP = 50987008,
                 O_LFP = 67764224, O_SS = 68026368, O_FKS = 70123520, O_FVS = 70385664, O_LFS = 70647808;
constexpr size_t MiB = 1u << 20;
constexpr size_t OFF_XB = 0;
constexpr size_t OFF_WINT = 66 * MiB, OFF_WRT = 80 * MiB, OFF_WFT = 82 * MiB, OFF_WOT = 83 * MiB, OFF_MT = 85 * MiB;
constexpr size_t OFF_RSTD1 = 89 * MiB, OFF_C2 = 90 * MiB, OFF_HS = 91 * MiB;
constexpr size_t OFF_QT = 105 * MiB, OFF_KT = 137 * MiB, OFF_KTT = 169 * MiB, OFF_VT = 201 * MiB;
constexpr size_t OFF_X1B = OFF_HS;
constexpr size_t OFF_RG = 265 * MiB, OFF_FQ = 331 * MiB, OFF_FKB = 364 * MiB, OFF_FVT = 396 * MiB;
constexpr size_t OFF_PUB = OFF_KTT, OFF_PVB = OFF_KTT + 16 * MiB;
constexpr size_t OFF_ROUTE = OFF_FKB, OFF_SSQ2 = OFF_FKB + 33 * MiB;
constexpr size_t OFF_BAR = OFF_RSTD1 + 768 * 1024;
constexpr size_t OFF_PSC = OFF_RSTD1 + 512 * 1024;
constexpr size_t OFF_SST = 428 * MiB;
constexpr size_t WS_NEED = 460 * MiB;

constexpr int SMEM_BYTES = 75776;

struct Params {
  const float *x_p, *x_s, *state_ret, *ck, *cv, *clogf, *norm1_g, *w_in, *b_f, *fq_g, *fk_g, *gn_g,
      *w_ret_out, *w_fox_out, *w_o, *norm2_g, *peer_wq, *k1, *k2, *peer_u, *peer_v;
  float* out;
  char* ws;
};

DEV bfu f2bf(float f) { unsigned u = __float_as_uint(f); u += 0x7fffu + ((u >> 16) & 1u); return (bfu)(u >> 16); }
DEV float bf2f(bfu b) { return __uint_as_float(((unsigned)b) << 16); }
DEV unsigned pack2(float a, float b) { return (unsigned)f2bf(a) | ((unsigned)f2bf(b) << 16); }
DEV float bflo(unsigned u) { return __uint_as_float(u << 16); }
DEV float bfhi(unsigned u) { return __uint_as_float(u & 0xffff0000u); }
DEV float sigmoidf_(float z) { return 1.f / (1.f + __expf(-z)); }
DEV float l2gamma(int h) { return log2f(1.f - exp2f(-5.f - (float)h)); }
DEV float wave_sum(float v) {
#pragma unroll
  for (int o = 32; o >= 1; o >>= 1) v += __shfl_xor(v, o);
  return v;
}
DEV float sum16(float v) {
  v += __shfl_xor(v, 1); v += __shfl_xor(v, 2); v += __shfl_xor(v, 4); v += __shfl_xor(v, 8);
  return v;
}

template <int ROWS>
DEV void g2r(const bfu* g, int ld, u32x4 (&r)[ROWS / 32], int tid_ = threadIdx.x) {
#pragma unroll
  for (int i = 0; i < ROWS / 32; i++) {
    int id = tid_ + i * 256; int row = id >> 3, ch = id & 7;
    const unsigned off = (unsigned)(row * ld + ch * 8);
    r[i] = *(const u32x4*)(g + off);
  }
}
template <int ROWS>
DEV void r2s(bfu* s, const u32x4 (&r)[ROWS / 32], int tid_ = threadIdx.x) {
#pragma unroll
  for (int i = 0; i < ROWS / 32; i++) {
    int id = tid_ + i * 256; int row = id >> 3, ch = id & 7;
    *(u32x4*)(s + row * 72 + ch * 8) = r[i];
  }
}
template <int MI, int NI>
DEV void mma64(const bfu* sA, int sldA, const bfu* sB, int sldB, f32x4 (&acc)[MI][NI]) {
  const int lane = threadIdx.x & 63, w = threadIdx.x >> 6, wr = w >> 1, wc = w & 1, l16 = lane & 15, quad = lane >> 4;
#pragma unroll
  for (int kk = 0; kk < 2; kk++) {
    bf16x8 a[MI], b[NI];
#pragma unroll
    for (int mi = 0; mi < MI; mi++) a[mi] = *(const bf16x8*)(sA + (wr * MI * 16 + mi * 16 + l16) * sldA + kk * 32 + quad * 8);
#pragma unroll
    for (int ni = 0; ni < NI; ni++) b[ni] = *(const bf16x8*)(sB + (wc * NI * 16 + ni * 16 + l16) * sldB + kk * 32 + quad * 8);
#pragma unroll
    for (int mi = 0; mi < MI; mi++)
#pragma unroll
      for (int ni = 0; ni < NI; ni++) acc[mi][ni] = __builtin_amdgcn_mfma_f32_16x16x32_bf16(a[mi], b[ni], acc[mi][ni], 0, 0, 0);
  }
}
template <int ROWS>
DEV void r2sw(bfu* s, const u32x4 (&r)[ROWS / 32], int tid_) {
#pragma unroll
  for (int i = 0; i < ROWS / 32; i++) {
    int id = tid_ + i * 256; int row = id >> 3, ch = id & 7;
    int byte = (((row >> 4) * 2 + (ch >> 2)) << 10) + ((((row & 15) << 6) + ((ch & 3) << 4)) ^ (((row >> 3) & 1) << 5));
    *(u32x4*)((char*)s + byte) = r[i];
  }
}
template <int MI, int NI>
DEV void mma64w(const bfu* sA, const bfu* sB, f32x4 (&acc)[MI][NI]) {
  const int lane = threadIdx.x & 63, w = threadIdx.x >> 6, wr = w >> 1, wc = w & 1, l16 = lane & 15, quad = lane >> 4;
  const int lo = ((l16 << 6) + (quad << 4)) ^ (((l16 >> 3) & 1) << 5);
#pragma unroll
  for (int kk = 0; kk < 2; kk++) {
    bf16x8 a[MI], b[NI];
#pragma unroll
    for (int mi = 0; mi < MI; mi++) a[mi] = *(const bf16x8*)((const char*)sA + (((wr * MI + mi) * 2 + kk) << 10) + lo);
#pragma unroll
    for (int ni = 0; ni < NI; ni++) b[ni] = *(const bf16x8*)((const char*)sB + (((wc * NI + ni) * 2 + kk) << 10) + lo);
#pragma unroll
    for (int mi = 0; mi < MI; mi++)
#pragma unroll
      for (int ni = 0; ni < NI; ni++) acc[mi][ni] = __builtin_amdgcn_mfma_f32_16x16x32_bf16(a[mi], b[ni], acc[mi][ni], 0, 0, 0);
  }
}
template <int MI, int NI>
DEV void mma64w_big(const bfu* sA, const bfu* sB, f32x4 (&acc)[MI][NI]) {
  const int lane = threadIdx.x & 63, w = threadIdx.x >> 6, wr = w >> 1, wc = w & 1, l16 = lane & 15, quad = lane >> 4;
  const int lo = ((l16 << 6) + (quad << 4)) ^ (((l16 >> 3) & 1) << 5);
#pragma unroll
  for (int kk = 0; kk < 2; kk++) {
    bf16x8 b[NI];
#pragma unroll
    for (int ni = 0; ni < NI; ni++) b[ni] = *(const bf16x8*)((const char*)sB + (((wc * NI + ni) * 2 + kk) << 10) + lo);
#pragma unroll
    for (int mi = 0; mi < MI; mi++) {
      bf16x8 a = *(const bf16x8*)((const char*)sA + (((wr * MI + mi) * 2 + kk) << 10) + lo);
#pragma unroll
      for (int ni = 0; ni < NI; ni++) acc[mi][ni] = __builtin_amdgcn_mfma_f32_16x16x32_bf16(a, b[ni], acc[mi][ni], 0, 0, 0);
    }
  }
}
template <int MI, int NI>
DEV void gemm_loop_sb(const bfu* A, int lda, const bfu* B, int ldb, int K, f32x4 (&acc)[MI][NI], bfu* sbuf) {
  constexpr int BM = 32 * MI, BN = 32 * NI;
  bfu* sA = sbuf; bfu* sB = sA + BM * 64;
  const int nk = K >> 6;
  int t_ = threadIdx.x; asm volatile("" : "+v"(t_));
  u32x4 ra[BM / 32], rb[BN / 32];
  g2r<BM>(A, lda, ra, t_); g2r<BN>(B, ldb, rb, t_);
#pragma unroll 1
  for (int k = 0; k < nk; k++) {
    __syncthreads();
    r2sw<BM>(sA, ra, t_); r2sw<BN>(sB, rb, t_);
    __syncthreads();
    if (k + 1 < nk) { g2r<BM>(A + (k + 1) * 64, lda, ra, t_); g2r<BN>(B + (k + 1) * 64, ldb, rb, t_); }
    mma64w_big<MI, NI>(sA, sB, acc);
  }
}

template <int MI, int NI>
DEV void gemm_loop(const bfu* A, int lda, const bfu* B, int ldb, int K, f32x4 (&acc)[MI][NI], bfu* sbuf) {
  constexpr int BM = 32 * MI, BN = 32 * NI;
  bfu* sA0 = sbuf; bfu* sB0 = sA0 + BM * 64; bfu* sA1 = sB0 + BN * 64; bfu* sB1 = sA1 + BM * 64;
  const int nk = K >> 6;
  int t_ = threadIdx.x; asm volatile("" : "+v"(t_));
  u32x4 ra0[BM / 32], rb0[BN / 32], ra1[BM / 32], rb1[BN / 32];
  g2r<BM>(A, lda, ra0, t_); g2r<BN>(B, ldb, rb0, t_);
  if (nk > 1) { g2r<BM>(A + 64, lda, ra1, t_); g2r<BN>(B + 64, ldb, rb1, t_); }
  __syncthreads();
  r2sw<BM>(sA0, ra0, t_); r2sw<BN>(sB0, rb0, t_);
  if (nk > 2) { g2r<BM>(A + 128, lda, ra0, t_); g2r<BN>(B + 128, ldb, rb0, t_); }
  __syncthreads();
  for (int k = 0; k < nk; k += 2) {
    if (k + 1 < nk) { r2sw<BM>(sA1, ra1, t_); r2sw<BN>(sB1, rb1, t_); }
    if (k + 3 < nk) { g2r<BM>(A + (k + 3) * 64, lda, ra1, t_); g2r<BN>(B + (k + 3) * 64, ldb, rb1, t_); }
    mma64w<MI, NI>(sA0, sB0, acc);
    __syncthreads();
    if (k + 1 >= nk) break;
    if (k + 2 < nk) { r2sw<BM>(sA0, ra0, t_); r2sw<BN>(sB0, rb0, t_); }
    if (k + 4 < nk) { g2r<BM>(A + (k + 4) * 64, lda, ra0, t_); g2r<BN>(B + (k + 4) * 64, ldb, rb0, t_); }
    mma64w<MI, NI>(sA1, sB1, acc);
    __syncthreads();
  }
}

constexpr int EPI_OFF = 49152, EPI_WAVE = 16 * 68;
DEV void to_rows(const f32x4 (&v)[4], float (&r)[16], float* sw, int lane) {
  const int l16 = lane & 15, quad = lane >> 4;
  __builtin_amdgcn_wave_barrier();
#pragma unroll
  for (int ni = 0; ni < 4; ni++)
#pragma unroll
    for (int j = 0; j < 4; j++) sw[(quad * 4 + j) * 68 + ni * 16 + l16] = v[ni][j];
  __builtin_amdgcn_wave_barrier();
  const f32x4* rp = (const f32x4*)(sw + (lane >> 2) * 68 + (lane & 3) * 16);
#pragma unroll
  for (int c = 0; c < 4; c++) { f32x4 t = rp[c]; r[4 * c] = t[0]; r[4 * c + 1] = t[1]; r[4 * c + 2] = t[2]; r[4 * c + 3] = t[3]; }
}
DEV void st_bf16x16(bfu* dst, const float (&r)[16]) {
  u32x4 a = {pack2(r[0], r[1]), pack2(r[2], r[3]), pack2(r[4], r[5]), pack2(r[6], r[7])};
  u32x4 b = {pack2(r[8], r[9]), pack2(r[10], r[11]), pack2(r[12], r[13]), pack2(r[14], r[15])};
  *(u32x4*)dst = a; *(u32x4*)(dst + 8) = b;
}
DEV void ld_bf16x16(const bfu* src, float (&r)[16]) {
  u32x4 a = *(const u32x4*)src, b = *(const u32x4*)(src + 8);
#pragma unroll
  for (int i = 0; i < 4; i++) { r[2 * i] = bflo(a[i]); r[2 * i + 1] = bfhi(a[i]); r[8 + 2 * i] = bflo(b[i]); r[9 + 2 * i] = bfhi(b[i]); }
}
DEV void st_f32x16(float* dst, const float (&r)[16]) {
#pragma unroll
  for (int c = 0; c < 4; c++) *(f32x4*)(dst + 4 * c) = f32x4{r[4 * c], r[4 * c + 1], r[4 * c + 2], r[4 * c + 3]};
}

DEV void transpose_tile(const float* src, int ldsrc, int srccol0, int validcols, const float* scale,
                        bfu* dst, int lddst, int n0, int k0, float* sT) {
  const int tid = threadIdx.x;
  __syncthreads();
#pragma unroll
  for (int i = 0; i < 4; i++) {
    int kk = (tid >> 4) + i * 16, c = (tid & 15) * 4;
    float4 v = make_float4(0.f, 0.f, 0.f, 0.f);
    if (c < validcols) v = *(const float4*)(src + (size_t)(k0 + kk) * ldsrc + srccol0 + c);
    float s = scale ? scale[k0 + kk] : 1.f;
    sT[kk * 65 + c] = v.x * s; sT[kk * 65 + c + 1] = v.y * s; sT[kk * 65 + c + 2] = v.z * s; sT[kk * 65 + c + 3] = v.w * s;
  }
  __syncthreads();
  int n = tid >> 2, kc = (tid & 3) * 16;
  unsigned o[8];
#pragma unroll
  for (int e = 0; e < 8; e++) o[e] = pack2(sT[(kc + 2 * e) * 65 + n], sT[(kc + 2 * e + 1) * 65 + n]);
  uint4* d = (uint4*)(dst + (size_t)(n0 + n) * lddst + k0 + kc);
  d[0] = make_uint4(o[0], o[1], o[2], o[3]); d[1] = make_uint4(o[4], o[5], o[6], o[7]);
}

DEV void phase0(const Params& p, int bid, int nb, char* smem) {
  const int tid = threadIdx.x, lane = tid & 63, w = tid >> 6;
  constexpr int N_X = TT / 4, N_TW = 106 * 16, N_TR = 256, N_TF = 128, N_TO = 256, N_MT = 512;
  constexpr int B1 = N_X, B2 = B1 + N_TW, B3 = B2 + N_TR, B4 = B3 + N_TF, B5 = B4 + N_TO, TOT = B5 + N_MT;
  bfu* xb = (bfu*)(p.ws + OFF_XB); float* rstd1 = (float*)(p.ws + OFF_RSTD1);
  for (int it = bid; it < TOT; it += nb) {
    if (it < B1) {
      int row = it * 4 + w;
      const float* src = row < TP ? p.x_p + (size_t)row * DM : p.x_s + (size_t)(row - TP) * DM;
      float4 a0 = *(const float4*)(src + lane * 8), a1 = *(const float4*)(src + lane * 8 + 4);
      float4 b0 = *(const float4*)(src + 512 + lane * 8), b1 = *(const float4*)(src + 512 + lane * 8 + 4);
      float ss = a0.x * a0.x + a0.y * a0.y + a0.z * a0.z + a0.w * a0.w + a1.x * a1.x + a1.y * a1.y + a1.z * a1.z + a1.w * a1.w +
                 b0.x * b0.x + b0.y * b0.y + b0.z * b0.z + b0.w * b0.w + b1.x * b1.x + b1.y * b1.y + b1.z * b1.z + b1.w * b1.w;
      ss = wave_sum(ss);
      if (lane == 0) rstd1[row] = rsqrtf(ss * (1.f / DM) + EPSN);
      *(uint4*)(xb + (size_t)row * DM + lane * 8) = make_uint4(pack2(a0.x, a0.y), pack2(a0.z, a0.w), pack2(a1.x, a1.y), pack2(a1.z, a1.w));
      *(uint4*)(xb + (size_t)row * DM + 512 + lane * 8) = make_uint4(pack2(b0.x, b0.y), pack2(b0.z, b0.w), pack2(b1.x, b1.y), pack2(b1.z, b1.w));
    } else if (it < B2) {
      int j = it - B1; int nt = j >> 4, kt = j & 15; int n0 = nt * 64;
      int sc0, vc;
      if (n0 < 4608) { sc0 = n0; vc = 64; } else if (n0 < 6656) { sc0 = n0 + 8; vc = 64; } else if (n0 == 6656) { sc0 = 4608; vc = 8; } else { sc0 = 0; vc = 0; }
      transpose_tile(p.w_in, 6664, sc0, vc, p.norm1_g, (bfu*)(p.ws + OFF_WINT), DM, n0, kt * 64, (float*)smem);
    } else if (it < B3) {
      int j = it - B2; transpose_tile(p.w_ret_out, 1024, (j >> 4) * 64, 64, nullptr, (bfu*)(p.ws + OFF_WRT), 1024, (j >> 4) * 64, (j & 15) * 64, (float*)smem);
    } else if (it < B4) {
      int j = it - B3; transpose_tile(p.w_fox_out, 1024, (j >> 3) * 64, 64, nullptr, (bfu*)(p.ws + OFF_WFT), 512, (j >> 3) * 64, (j & 7) * 64, (float*)smem);
    } else if (it < B5) {
      int j = it - B4; transpose_tile(p.w_o, 1024, (j >> 4) * 64, 64, nullptr, (bfu*)(p.ws + OFF_WOT), 1024, (j >> 4) * 64, (j & 15) * 64, (float*)smem);
    } else {
      int j = it - B5; int hh = j >> 5, kt = (j >> 4) & 1, dt = j & 15;
      float* sW = (float*)smem; float* sK = sW + 64 * 129;
      const float* ksub = (hh & 1) ? p.k2 : p.k1;
      __syncthreads();
#pragma unroll
      for (int i = 0; i < 8; i++) {
        int id = tid + i * 256; int row = id >> 5, c4 = (id & 31) * 4;
        float4 v = *(const float4*)(p.peer_wq + (size_t)(dt * 64 + row) * 2048 + hh * 128 + c4);
        sW[row * 129 + c4] = v.x; sW[row * 129 + c4 + 1] = v.y; sW[row * 129 + c4 + 2] = v.z; sW[row * 129 + c4 + 3] = v.w;
        float4 u = *(const float4*)(ksub + (size_t)(kt * 64 + row) * 128 + c4);
        sK[row * 129 + c4] = u.x; sK[row * 129 + c4 + 1] = u.y; sK[row * 129 + c4 + 2] = u.z; sK[row * 129 + c4 + 3] = u.w;
      }
      __syncthreads();
      int ky = (tid >> 4) * 4, dd = (tid & 15) * 4;
      float a[4][4];
#pragma unroll
      for (int i = 0; i < 4; i++)
#pragma unroll
        for (int jj = 0; jj < 4; jj++) a[i][jj] = 0.f;
      for (int c = 0; c < 128; c++) {
        float kv[4], wv[4];
#pragma unroll
        for (int i = 0; i < 4; i++) { kv[i] = sK[(ky + i) * 129 + c]; wv[i] = sW[(dd + i) * 129 + c]; }
#pragma unroll
        for (int i = 0; i < 4; i++)
#pragma unroll
          for (int jj = 0; jj < 4; jj++) a[i][jj] += kv[i] * wv[jj];
      }
      bfu* MT = (bfu*)(p.ws + OFF_MT);
      float g0 = p.norm2_g[dt * 64 + dd], g1 = p.norm2_g[dt * 64 + dd + 1], g2 = p.norm2_g[dt * 64 + dd + 2], g3 = p.norm2_g[dt * 64 + dd + 3];
#pragma unroll
      for (int i = 0; i < 4; i++)
        *(uint2*)(MT + (size_t)(hh * 128 + kt * 64 + ky + i) * DM + dt * 64 + dd) = make_uint2(pack2(a[i][0] * g0, a[i][1] * g1), pack2(a[i][2] * g2, a[i][3] * g3));
    }
  }
}

DEV void rot_angle(int pos, int d, float& cs, float& sn) {
  float inv = exp2f(-(float)d * (13.287712379549449f / 32.f));
  float ang = (float)pos * inv;
  float rev = ang * 0.15915494309189535f;
  rev = rev - floorf(rev);
  sn = __builtin_amdgcn_sinf(rev); cs = __builtin_amdgcn_cosf(rev);
}

DEV void phase1(const Params& p, int bid, int nb, char* smem, bool noepi = false) {
  bfu* sA = (bfu*)smem; bfu* sB = sA + 128 * 72;
  const bfu* XB = (const bfu*)(p.ws + OFF_XB); const bfu* WT = (const bfu*)(p.ws + OFF_WINT);
  const float* rstd1 = (const float*)(p.ws + OFF_RSTD1);
  constexpr int NT = NWP / 128;
  const int xcd = bid & 7, slot = bid >> 3, nslots = (nb + 7 - xcd) >> 3;
  constexpr int MI1 = 8;
  const int nprompt = 16 * NT;
  const int n_p = slot < nprompt ? (nprompt - slot + nslots - 1) / nslots : 0;
  const int n_s = bid < 2 * NT ? (2 * NT - bid + nb - 1) / nb : 0;
  for (int i_ = 0; i_ < n_p + n_s; i_++) {
    int mt, nt;
    if (i_ < n_p) { int q = slot + i_ * nslots; int sub = q / (8 * NT), rem = q - sub * (8 * NT); nt = rem >> 3; mt = xcd * 16 + sub * 8 + (rem & 7); }
    else { int it = bid + (i_ - n_p) * nb; mt = 128 + it / NT; nt = it - (it / NT) * NT; }
    int m0 = mt * 256, n0 = nt * 128;
    int tid = threadIdx.x; asm volatile("" : "+v"(tid));
    const int lane = tid & 63, w = tid >> 6, wr = w >> 1, wc = w & 1, l16 = lane & 15, quad = lane >> 4;
    f32x4 acc[MI1][4];
#pragma unroll
    for (int i = 0; i < MI1; i++)
#pragma unroll
      for (int j = 0; j < 4; j++) acc[i][j] = f32x4{0.f, 0.f, 0.f, 0.f};
    gemm_loop_sb<MI1, 4>(XB + (size_t)m0 * DM, DM, WT + (size_t)n0 * DM, DM, DM, acc, sA);
    if (noepi) { float t_ = 0.f;
#pragma unroll
      for (int i = 0; i < MI1; i++)
#pragma unroll
        for (int j = 0; j < 4; j++) t_ += acc[i][j][0] + acc[i][j][1] + acc[i][j][2] + acc[i][j][3];
      if (t_ == 12345.678f) p.out[0] = 1.f; continue; }
    const int rbase = m0 + wr * (MI1 * 16) + quad * 4;
    const int cbase = n0 + wc * 64 + l16;
    if (m0 >= TP) {
      float* hs = (float*)(p.ws + OFF_HS);
      bfu* gaS = (bfu*)(p.out + O_YS); bfu* gbS = gaS + (size_t)TS * DM;
#pragma unroll
      for (int mi = 0; mi < MI1; mi++)
#pragma unroll
        for (int j = 0; j < 4; j++) {
          int row = rbase + mi * 16 + j; float rs = rstd1[row]; int sr = row - TP;
#pragma unroll
          for (int ni = 0; ni < 4; ni++) {
            int col = cbase + ni * 16; float v = acc[mi][ni][j] * rs;
            if (n0 >= 4608 && n0 < 5632) gaS[(size_t)sr * DM + col - 4608] = f2bf(v);
            else if (n0 >= 5632 && n0 < 6656) gbS[(size_t)sr * DM + col - 5632] = f2bf(v);
            else hs[(size_t)sr * NWP + col] = v;
          }
        }
      continue;
    }
    const int b = m0 >> 14;
    float* sw = (float*)(smem + EPI_OFF) + w * EPI_WAVE;
    const int rrow = m0 + wr * (MI1 * 16) + (lane >> 2);
    const int rcol = (lane & 3) * 16;
    if (n0 < 1024) {
      const int isK = n0 >= 512; const int head = ((n0 & 511) >> 6) + wc;
      const float l2g = l2gamma(head);
      bfu* dst = (bfu*)(p.ws + (isK ? OFF_KT : OFF_QT));
      bfu* ktT = (bfu*)(p.ws + OFF_KTT);
#pragma unroll
      for (int mi = 0; mi < MI1; mi++) {
        f32x4 tv[4];
#pragma unroll
        for (int ni = 0; ni < 2; ni++) {
          int d = ni * 16 + l16;
          float y1[4], y2[4];
#pragma unroll
          for (int j = 0; j < 4; j++) {
            int row = rbase + mi * 16 + j; int t = row & (SEQ - 1); int l = t & (RC - 1);
            float rs = rstd1[row];
            float dec = exp2f((float)(l + 1) * l2g);
            float sc = isK ? 0.125f / dec : dec;
            float cs, sn; rot_angle(t, d, cs, sn);
            float x1 = acc[mi][ni][j] * rs, x2 = acc[mi][ni + 2][j] * rs;
            y1[j] = (x1 * cs - x2 * sn) * sc; y2[j] = (x2 * cs + x1 * sn) * sc;
            tv[ni][j] = y1[j]; tv[ni + 2][j] = y2[j];
          }
          if (isK) {
            int t0 = (rbase + mi * 16) & (SEQ - 1);
            *(uint2*)(ktT + ((size_t)((b * 8 + head) * 64 + d)) * SEQ + t0) = make_uint2(pack2(y1[0], y1[1]), pack2(y1[2], y1[3]));
            *(uint2*)(ktT + ((size_t)((b * 8 + head) * 64 + d + 32)) * SEQ + t0) = make_uint2(pack2(y2[0], y2[1]), pack2(y2[2], y2[3]));
          }
        }
        { float r[16]; to_rows(tv, r, sw, lane); int rr_ = rrow; asm volatile("" : "+v"(rr_));
          st_bf16x16(dst + (size_t)(rr_ + mi * 16) * 512 + head * 64 + rcol, r); }
      }
    } else if (n0 < 2048) {
      const int head = (n0 - 1024) >> 7;
      bfu* vT = (bfu*)(p.ws + OFF_VT);
#pragma unroll
      for (int mi = 0; mi < MI1; mi++) {
        int row0 = rbase + mi * 16; int t0 = row0 & (SEQ - 1);
        float r0 = rstd1[row0], r1 = rstd1[row0 + 1], r2 = rstd1[row0 + 2], r3 = rstd1[row0 + 3];
#pragma unroll
        for (int ni = 0; ni < 4; ni++) {
          int dv = wc * 64 + ni * 16 + l16;
          *(uint2*)(vT + ((size_t)((b * 8 + head) * 128 + dv)) * SEQ + t0) =
              make_uint2(pack2(acc[mi][ni][0] * r0, acc[mi][ni][1] * r1), pack2(acc[mi][ni][2] * r2, acc[mi][ni][3] * r3));
        }
      }
    } else if (n0 < 3072 || (n0 >= 4608 && n0 < 6656)) {
      bfu* dst; int c0;
      if (n0 < 3072) { dst = (bfu*)(p.ws + OFF_RG); c0 = 2048; }
      else if (n0 < 5632) { dst = (bfu*)(p.out + O_YP); c0 = 4608; }
      else { dst = (bfu*)(p.out + O_YP) + (size_t)TP * DM; c0 = 5632; }
#pragma unroll
      for (int mi = 0; mi < MI1; mi++) {
        f32x4 tv[4];
#pragma unroll
        for (int j = 0; j < 4; j++) {
          int row = rbase + mi * 16 + j; float rs = rstd1[row];
#pragma unroll
          for (int ni = 0; ni < 4; ni++) tv[ni][j] = acc[mi][ni][j] * rs;
        }
        float r[16]; to_rows(tv, r, sw, lane); int rr_ = rrow; asm volatile("" : "+v"(rr_));
        st_bf16x16(dst + (size_t)(rr_ + mi * 16) * DM + (n0 - c0) + wc * 64 + rcol, r);
      }
    } else if (n0 < 4096) {
      const int isK = n0 >= 3584; const int head = (((n0 - 3072) & 511) >> 6) + wc;
      const float* g = isK ? p.fk_g : p.fq_g;
      float gv[4];
#pragma unroll
      for (int ni = 0; ni < 4; ni++) gv[ni] = g[ni * 16 + l16];
      bfu* fq = (bfu*)(p.ws + OFF_FQ); bfu* fkb = (bfu*)(p.ws + OFF_FKB);
#pragma unroll
      for (int mi = 0; mi < MI1; mi++) {
        f32x4 tv[4];
#pragma unroll
        for (int j = 0; j < 4; j++) {
          int row = rbase + mi * 16 + j; float rs = rstd1[row];
          float v[4]; float ss = 0.f;
#pragma unroll
          for (int ni = 0; ni < 4; ni++) { v[ni] = acc[mi][ni][j] * rs; ss += v[ni] * v[ni]; }
          ss = sum16(ss);
          float r = rsqrtf(ss * (1.f / 64.f) + EPSN) * (isK ? 1.f : 0.125f * LOG2E);
#pragma unroll
          for (int ni = 0; ni < 4; ni++) tv[ni][j] = v[ni] * r * gv[ni];
        }
        float r[16]; to_rows(tv, r, sw, lane); int rr_ = rrow; asm volatile("" : "+v"(rr_));
        const size_t o = (size_t)(rr_ + mi * 16) * 512 + head * 64 + rcol;
        if (isK) { st_f32x16(p.out + O_FKP + o, r); st_bf16x16(fkb + o, r); }
        else st_bf16x16(fq + o, r);
      }
    } else if (n0 < 4608) {
      const int head = ((n0 - 4096) >> 6) + wc;
      bfu* fvT = (bfu*)(p.ws + OFF_FVT);
#pragma unroll
      for (int mi = 0; mi < MI1; mi++) {
        int row0 = rbase + mi * 16; int t0 = row0 & (SEQ - 1);
        float r[4] = {rstd1[row0], rstd1[row0 + 1], rstd1[row0 + 2], rstd1[row0 + 3]};
        f32x4 tv[4];
#pragma unroll
        for (int ni = 0; ni < 4; ni++) {
          int d = ni * 16 + l16; float v[4];
#pragma unroll
          for (int j = 0; j < 4; j++) { v[j] = acc[mi][ni][j] * r[j]; tv[ni][j] = v[j]; }
          *(uint2*)(fvT + ((size_t)((b * 8 + head) * 64 + d)) * SEQ + t0) = make_uint2(pack2(v[0], v[1]), pack2(v[2], v[3]));
        }
        { float rw[16]; to_rows(tv, rw, sw, lane); int rr_ = rrow; asm volatile("" : "+v"(rr_));
          st_f32x16(p.out + O_FVP + (size_t)(rr_ + mi * 16) * 512 + head * 64 + rcol, rw); }
      }
    } else {
      if (wc == 0 && l16 < 8) {
        float bf = p.b_f[l16];
#pragma unroll
        for (int mi = 0; mi < MI1; mi++)
#pragma unroll
          for (int j = 0; j < 4; j++) {
            int row = rbase + mi * 16 + j;
            float z = acc[mi][0][j] * rstd1[row] + bf;
            p.out[O_LFP + (size_t)row * 8 + l16] = fminf(z, 0.f) - log1pf(__expf(-fabsf(z)));
          }
      }
    }
  }
}

DEV void phase2(const Params& p, int bid, int nb, char* smem) {
  const int tid = threadIdx.x, lane = tid & 63, w = tid >> 6, wr = w >> 1, wc = w & 1, l16 = lane & 15, quad = lane >> 4;
  bfu* sA = (bfu*)smem; bfu* sB = sA + 128 * 72;
  const bfu* vT = (const bfu*)(p.ws + OFF_VT); const bfu* ktT = (const bfu*)(p.ws + OFF_KTT);
  float* U = (float*)(p.ws + OFF_XB);
  constexpr int NR1 = 16 * NCH;
  for (int it = bid; it < NR1 + 16; it += nb) {
    if (it < 16) {
      int bh = it, b = bh >> 3, h = bh & 7;
      double* sd = (double*)smem;
      const float* lf = p.out + O_LFP + (size_t)b * SEQ * 8 + h;
      float part = 0.f;
      for (int i = 0; i < 64; i++) part += lf[(size_t)(tid * 64 + i) * 8];
      __syncthreads();
      sd[tid] = (double)part;
      __syncthreads();
      if (tid == 0) { double run = 0.0; for (int i = 0; i < 256; i++) { double v = sd[i]; sd[i] = run; run += v; } }
      __syncthreads();
      double run = sd[tid];
      float* c2 = (float*)(p.ws + OFF_C2) + (size_t)bh * SEQ;
      for (int i = 0; i < 64; i++) { run += (double)lf[(size_t)(tid * 64 + i) * 8]; c2[tid * 64 + i] = (float)(run * (double)LOG2E); }
      __syncthreads();
    } else {
      int j = it - 16; int bh = j / NCH, c = j - bh * NCH;
      f32x4 acc[4][2];
#pragma unroll
      for (int i = 0; i < 4; i++) { acc[i][0] = f32x4{0.f, 0.f, 0.f, 0.f}; acc[i][1] = f32x4{0.f, 0.f, 0.f, 0.f}; }
      gemm_loop<4, 2>(vT + (size_t)bh * 128 * SEQ + c * RC, SEQ, ktT + (size_t)bh * 64 * SEQ + c * RC, SEQ, RC, acc, sA);
      float gC = exp2f((float)RC * l2gamma(bh & 7));
      float* Uo = U + (size_t)j * 8192;
#pragma unroll
      for (int mi = 0; mi < 4; mi++)
#pragma unroll
        for (int ni = 0; ni < 2; ni++)
#pragma unroll
          for (int jj = 0; jj < 4; jj++) {
            int dv = wr * 64 + mi * 16 + quad * 4 + jj, dk = wc * 32 + ni * 16 + l16;
            Uo[dv * 64 + dk] = acc[mi][ni][jj] * gC;
          }
    }
  }
}

DEV void sample_item(const Params& p, int item, char* smem) {
  int tid = threadIdx.x; asm volatile("" : "+v"(tid));
  const int pass_sel = item & 1; const int b = item >> 4, h = (item >> 1) & 7;
  float* sq = (float*)smem;
  float* sk = sq + 1024;
  float* sv = sk + 1024;
  float* sP = sv + 2048;
  float* so = sP + 256;
  float* sr = so + 2048;
  float* sc = (float*)smem;
  float* fq = (float*)(smem + 34816);
  float* fk = fq + 1024;
  float* cn = fk + 1024;
  float* suf = cn + 16;
  float* red = suf + 1024;
  float* sL = red + 256;
  float* pvr = sL + 16;
  const float* hs = (const float*)(p.ws + OFF_HS) + (size_t)b * 16 * NWP;
  const float l2g = l2gamma(h);
  __syncthreads();
  if (pass_sel == 0) {
  for (int i = tid; i < 512; i += 256) {
    int l = i >> 5, d = i & 31; float cs, sn; rot_angle(1024 + l, d, cs, sn);
    float dec = exp2f((float)(l + 1) * l2g);
    const float* r = hs + (size_t)l * NWP;
    float x1 = r[h * 64 + d], x2 = r[h * 64 + d + 32];
    sq[l * 64 + d] = (x1 * cs - x2 * sn) * dec; sq[l * 64 + d + 32] = (x2 * cs + x1 * sn) * dec;
    x1 = r[512 + h * 64 + d]; x2 = r[512 + h * 64 + d + 32];
    float sc_ = 0.125f / dec;
    sk[l * 64 + d] = (x1 * cs - x2 * sn) * sc_; sk[l * 64 + d + 32] = (x2 * cs + x1 * sn) * sc_;
  }
  for (int i = tid; i < 2048; i += 256) { int l = i >> 7, dv = i & 127; sv[i] = hs[(size_t)l * NWP + 1024 + h * 128 + dv]; }
  __syncthreads();
  { int l = tid >> 4, m = tid & 15; float a = 0.f;
    if (l >= m) for (int d = 0; d < 64; d++) a += sq[l * 64 + d] * sk[m * 64 + d];
    sP[tid] = a; }
  __syncthreads();
  const float* S = p.state_ret + (size_t)(b * 8 + h) * 8192;
  { int dv = tid & 127, lh = tid >> 7; float o[8];
#pragma unroll
    for (int i = 0; i < 8; i++) o[i] = 0.f;
#pragma unroll 16
    for (int dk = 0; dk < 64; dk++) { float s = S[dk * 128 + dv];
#pragma unroll
      for (int i = 0; i < 8; i++) o[i] += sq[(lh * 8 + i) * 64 + dk] * s; }
    for (int m = 0; m < 16; m++) { float v = sv[m * 128 + dv];
#pragma unroll
      for (int i = 0; i < 8; i++) o[i] += sP[(lh * 8 + i) * 16 + m] * v; }
#pragma unroll
    for (int i = 0; i < 8; i++) so[(lh * 8 + i) * 128 + dv] = o[i];
    float g16 = exp2f(16.f * l2g);
    float* So = p.out + O_SS + (size_t)(b * 8 + h) * 8192;
#pragma unroll 8
    for (int i = 0; i < 32; i++) { int dk = lh * 32 + i; float a = S[dk * 128 + dv];
      for (int m = 0; m < 16; m++) a += sk[m * 64 + dk] * sv[m * 128 + dv];
      So[dk * 128 + dv] = a * g16; }
  }
  __syncthreads();
  if (tid < 16) { float ss = 0.f; for (int i = 0; i < 128; i++) { float v = so[tid * 128 + i]; ss += v * v; } sr[tid] = rsqrtf(ss * (1.f / 128.f) + EPSN); }
  __syncthreads();
  { int dv = tid & 127, lh = tid >> 7; bfu* gated = (bfu*)(p.ws + OFF_RG);
    float gg = p.gn_g[h * 128 + dv];
    for (int i = 0; i < 8; i++) { int l = lh * 8 + i; float rgv = hs[(size_t)l * NWP + 2048 + h * 128 + dv];
      float v = so[l * 128 + dv] * sr[l] * gg * (rgv * sigmoidf_(rgv));
      gated[(size_t)(TP + b * 16 + l) * DM + h * 128 + dv] = f2bf(v); } }
  }
  __syncthreads();
  {
    int l = tid >> 4, dl = tid & 15; const float* r = hs + (size_t)l * NWP;
    float qv[4], kv[4]; float sq_ = 0.f, sk_ = 0.f;
#pragma unroll
    for (int i = 0; i < 4; i++) { qv[i] = r[3072 + h * 64 + dl * 4 + i]; kv[i] = r[3584 + h * 64 + dl * 4 + i]; sq_ += qv[i] * qv[i]; sk_ += kv[i] * kv[i]; }
    sq_ = sum16(sq_); sk_ = sum16(sk_);
    float rq = rsqrtf(sq_ * (1.f / 64.f) + EPSN), rk = rsqrtf(sk_ * (1.f / 64.f) + EPSN);
#pragma unroll
    for (int i = 0; i < 4; i++) { int d = dl * 4 + i;
      fq[l * 64 + d] = qv[i] * rq * p.fq_g[d] * 0.125f;
      float kk = kv[i] * rk * p.fk_g[d]; fk[l * 64 + d] = kk;
      p.out[O_FKS + (size_t)((b * 16 + l) * 8 + h) * 64 + d] = kk;
      p.out[O_FVS + (size_t)((b * 16 + l) * 8 + h) * 64 + d] = r[4096 + h * 64 + d]; }
  }
  if (tid < 16) { float z = hs[(size_t)tid * NWP + 6656 + h] + p.b_f[h]; float lf = fminf(z, 0.f) - log1pf(__expf(-fabsf(z)));
    p.out[O_LFS + (size_t)(b * 16 + tid) * 8 + h] = lf; cn[tid] = lf; }
  { const float* cl = p.clogf + (size_t)b * 1024 * 8 + h; float v[4]; float part = 0.f;
#pragma unroll
    for (int i = 0; i < 4; i++) { v[i] = cl[(size_t)(tid * 4 + i) * 8]; part += v[i]; }
    float inc = part;
#pragma unroll
    for (int o = 1; o < 64; o <<= 1) { float t = __shfl_down(inc, o); if ((tid & 63) + o < 64) inc += t; }
    if ((tid & 63) == 0) red[tid >> 6] = inc;
    __syncthreads();
    if (tid == 0) { float c = 0.f; for (int i = 0; i < 16; i++) { c += cn[i]; cn[i] = c; } }
    float later = 0.f;
    for (int ww = (tid >> 6) + 1; ww < 4; ww++) later += red[ww];
    __syncthreads();
    float run = inc - part + later;
    for (int i = 3; i >= 0; i--) { suf[tid * 4 + i] = run; run += v[i]; }
  }
  __syncthreads();
  const float* CK = p.ck + (size_t)b * 1024 * 512 + h * 64; const float* CV = p.cv + (size_t)b * 1024 * 512 + h * 64;
  int p_start = 0;
  { float gqm = 0.f, gkm = 0.f;
    for (int i = 0; i < 64; i++) { gqm = fmaxf(gqm, fabsf(p.fq_g[i])); gkm = fmaxf(gkm, fabsf(p.fk_g[i])); }
    const float thr_ln = 30.f + 2.f * 8.f * gqm * gkm * 1.03f;
#pragma unroll
    for (int i = 0; i < 4; i++) p_start += __syncthreads_count(suf[tid * 4 + i] < -thr_ln); }
  for (int pass = pass_sel; pass <= pass_sel; pass++) {
    __syncthreads();
    for (int j = p_start + tid; j < 1040; j += 256) {
      float a[8];
#pragma unroll
      for (int qi = 0; qi < 8; qi++) a[qi] = 0.f;
      if (j < 1024) {
        const f32x4* kp = (const f32x4*)(CK + (size_t)j * 512);
        f32x4 tt[16];
#pragma unroll
        for (int i = 0; i < 16; i++) tt[i] = kp[i];
#pragma unroll
        for (int i = 0; i < 16; i++) { f32x4 t = tt[i];
#pragma unroll
          for (int qi = 0; qi < 8; qi++) { const float* qq = fq + (pass * 8 + qi) * 64 + i * 4; a[qi] += qq[0] * t[0] + qq[1] * t[1] + qq[2] * t[2] + qq[3] * t[3]; } }
      } else {
        const float* kp = fk + (j - 1024) * 64;
#pragma unroll 4
        for (int i = 0; i < 64; i++) { float t = kp[i];
#pragma unroll
          for (int qi = 0; qi < 8; qi++) a[qi] += fq[(pass * 8 + qi) * 64 + i] * t; }
      }
#pragma unroll
      for (int qi = 0; qi < 8; qi++) { int q = pass * 8 + qi;
        float bias;
        if (j < 1024) bias = suf[j] + cn[q]; else { int m = j - 1024; bias = (m <= q) ? (cn[q] - cn[m]) : -INFINITY; }
        sc[qi * 1040 + j] = a[qi] + bias; }
    }
    __syncthreads();
    { int qi = tid >> 5, l32 = tid & 31; float m = -INFINITY;
      for (int j = p_start + l32; j < 1040; j += 32) m = fmaxf(m, sc[qi * 1040 + j]);
#pragma unroll
      for (int o = 16; o >= 1; o >>= 1) m = fmaxf(m, __shfl_xor(m, o));
      float s = 0.f;
      for (int j = p_start + l32; j < 1040; j += 32) { float e = __expf(sc[qi * 1040 + j] - m); sc[qi * 1040 + j] = e; s += e; }
#pragma unroll
      for (int o = 16; o >= 1; o >>= 1) s += __shfl_xor(s, o);
      if (l32 == 0) sL[qi] = s; }
    __syncthreads();
    {
      const int kg = tid >> 4, d4 = (tid & 15) * 4;
      float ac[8][4];
#pragma unroll
      for (int qi = 0; qi < 8; qi++) { ac[qi][0] = 0.f; ac[qi][1] = 0.f; ac[qi][2] = 0.f; ac[qi][3] = 0.f; }
#pragma unroll 8
      for (int j = p_start + kg; j < 1024; j += 16) {
        float4 v = *(const float4*)(CV + (size_t)j * 512 + d4);
#pragma unroll
        for (int qi = 0; qi < 8; qi++) { float pj = sc[qi * 1040 + j]; ac[qi][0] += pj * v.x; ac[qi][1] += pj * v.y; ac[qi][2] += pj * v.z; ac[qi][3] += pj * v.w; } }
      { const float* r = hs + (size_t)kg * NWP + 4096 + h * 64 + d4;
#pragma unroll
        for (int qi = 0; qi < 8; qi++) { float pj = sc[qi * 1040 + 1024 + kg]; ac[qi][0] += pj * r[0]; ac[qi][1] += pj * r[1]; ac[qi][2] += pj * r[2]; ac[qi][3] += pj * r[3]; } }
#pragma unroll
      for (int qi = 0; qi < 8; qi++)
#pragma unroll
        for (int c = 0; c < 4; c++) { float t = ac[qi][c]; t += __shfl_xor(t, 16); t += __shfl_xor(t, 32); ac[qi][c] = t; }
      if ((tid & 63) < 16) {
#pragma unroll
        for (int qi = 0; qi < 8; qi++)
#pragma unroll
          for (int c = 0; c < 4; c++) pvr[((tid >> 6) * 8 + qi) * 64 + d4 + c] = ac[qi][c];
      }
      __syncthreads();
      int qi = tid >> 5, d2 = (tid & 31) * 2;
      float a0 = pvr[(0 * 8 + qi) * 64 + d2] + pvr[(1 * 8 + qi) * 64 + d2] + pvr[(2 * 8 + qi) * 64 + d2] + pvr[(3 * 8 + qi) * 64 + d2];
      float a1 = pvr[(0 * 8 + qi) * 64 + d2 + 1] + pvr[(1 * 8 + qi) * 64 + d2 + 1] + pvr[(2 * 8 + qi) * 64 + d2 + 1] + pvr[(3 * 8 + qi) * 64 + d2 + 1];
      float inv = 1.f / sL[qi]; bfu* fo = (bfu*)(p.ws + OFF_FQ);
      *(unsigned*)(fo + (size_t)(TP + b * 16 + pass * 8 + qi) * 512 + h * 64 + d2) = pack2(a0 * inv, a1 * inv); }
  }
  __syncthreads();
}

DEV void peer_convert_item(const Params& p, int item) {
  const int tid = threadIdx.x, lane = tid & 63, w = tid >> 6;
  f32x4 v[4][4];
#pragma unroll
  for (int k = 0; k < 4; k++) {
    const int r = item * 16 + w * 4 + k;
    const float* src = r < 16384 ? p.peer_u + (size_t)r * DM : p.peer_v + (size_t)(r - 16384) * DM;
#pragma unroll
    for (int c = 0; c < 4; c++) v[k][c] = *(const f32x4*)(src + lane * 16 + c * 4);
  }
#pragma unroll
  for (int k = 0; k < 4; k++) {
    const int r = item * 16 + w * 4 + k;
    float am = 0.f;
#pragma unroll
    for (int c = 0; c < 4; c++)
#pragma unroll
      for (int e = 0; e < 4; e++) am = fmaxf(am, fabsf(v[k][c][e]));
#pragma unroll
    for (int o = 32; o >= 1; o >>= 1) am = fmaxf(am, __shfl_xor(am, o));
    const float sc = am > 0.f ? 6.f / am : 1.f;
    unsigned w0 = 0, w1 = 0;
    w0 = __builtin_amdgcn_cvt_scalef32_pk_fp4_f32(w0, v[k][0][0] * sc, v[k][0][1] * sc, 1.0f, 0);
    w0 = __builtin_amdgcn_cvt_scalef32_pk_fp4_f32(w0, v[k][0][2] * sc, v[k][0][3] * sc, 1.0f, 1);
    w0 = __builtin_amdgcn_cvt_scalef32_pk_fp4_f32(w0, v[k][1][0] * sc, v[k][1][1] * sc, 1.0f, 2);
    w0 = __builtin_amdgcn_cvt_scalef32_pk_fp4_f32(w0, v[k][1][2] * sc, v[k][1][3] * sc, 1.0f, 3);
    w1 = __builtin_amdgcn_cvt_scalef32_pk_fp4_f32(w1, v[k][2][0] * sc, v[k][2][1] * sc, 1.0f, 0);
    w1 = __builtin_amdgcn_cvt_scalef32_pk_fp4_f32(w1, v[k][2][2] * sc, v[k][2][3] * sc, 1.0f, 1);
    w1 = __builtin_amdgcn_cvt_scalef32_pk_fp4_f32(w1, v[k][3][0] * sc, v[k][3][1] * sc, 1.0f, 2);
    w1 = __builtin_amdgcn_cvt_scalef32_pk_fp4_f32(w1, v[k][3][2] * sc, v[k][3][3] * sc, 1.0f, 3);
    u32x2* dst = (u32x2*)(p.ws + (r < 16384 ? OFF_PUB : OFF_PVB)) + (size_t)(r & 16383) * 64 + lane;
    *dst = u32x2{w0, w1};
    if (lane == 0) ((float*)(p.ws + OFF_PSC))[r] = am > 0.f ? am / 6.f : 1.f;
  }
}

DEV void phase3(const Params& p, int bid, int nb, char* smem) {
  const int tid = threadIdx.x;
  const float* U = (const float*)(p.ws + OFF_XB); bfu* SST = (bfu*)(p.ws + OFF_SST);
  for (int it = bid; it < 2048; it += nb) peer_convert_item(p, it);
  for (int it = bid; it < 512 + 512; it += nb) {
    if (it < 512) { sample_item(p, it, smem); continue; }
    int g = (it - 512) * 256 + tid; int bh = g >> 13, e = g & 8191;
    float G = exp2f((float)RC * l2gamma(bh & 7));
    float s = 0.f;
    const float* Up = U + (size_t)bh * NCH * 8192 + e; bfu* Sp = SST + (size_t)bh * NCH * 8192 + e;
    Sp[0] = 0;
    for (int c0 = 0; c0 < NCH; c0 += 8) {
      float u[8];
#pragma unroll
      for (int i = 0; i < 8; i++) u[i] = Up[(size_t)(c0 + i) * 8192];
#pragma unroll
      for (int i = 0; i < 8; i++) { s = s * G + u[i]; if (c0 + i + 1 < NCH) Sp[(size_t)(c0 + i + 1) * 8192] = f2bf(s); }
    }
    int dv = e >> 6, dk = e & 63;
    p.out[O_SP + (size_t)bh * 8192 + dk * 128 + dv] = s;
  }
}

DEV void attn_item(const Params& p, int item, char* smem, float thr, bool dry) {
  const int tid = threadIdx.x, lane = tid & 63, w = tid >> 6, r32 = lane & 31, hi = lane >> 5;
  const int bh = item >> 7, qt = 127 - (item & 127);
  const int b = bh >> 3, h = bh & 7;
  const int q0 = qt * 128;
  bfu* sK = (bfu*)smem;
  bfu* sV = sK + 64 * 72;
  float* sC = (float*)(sV + 64 * 72);
  const float* c2 = (const float*)(p.ws + OFF_C2) + (size_t)bh * SEQ;
  bfu* FQ = (bfu*)(p.ws + OFF_FQ);
  const bfu* FKB = (const bfu*)(p.ws + OFF_FKB) + (size_t)b * SEQ * 512 + h * 64;
  const bfu* FVT = (const bfu*)(p.ws + OFF_FVT) + (size_t)bh * 64 * SEQ;
  const int jd0 = q0 >> 6;
  int pred = 0;
  if (tid < jd0) pred = (c2[q0] - c2[tid * 64 + 63]) < -thr;
  const int jstart = __syncthreads_count(pred);
  const int qrow = q0 + w * 32 + r32;
  bf16x8 qf[4];
  const bfu* qp = FQ + (size_t)(b * SEQ + qrow) * 512 + h * 64 + hi * 8;
#pragma unroll
  for (int d0 = 0; d0 < 4; d0++) qf[d0] = *(const bf16x8*)(qp + d0 * 16);
  const float cq = c2[qrow];
  float m = -INFINITY, lsum = 0.f;
  f32x16 o0, o1;
#pragma unroll
  for (int r = 0; r < 16; r++) { o0[r] = 0.f; o1[r] = 0.f; }
  u32x4 rk0, rk1, rv0, rv1; float rc = 0.f;
  const int srow = tid >> 3, sch = tid & 7;
#define ATT_GLOAD(j_) do { \
    rk0 = *(const u32x4*)(FKB + (size_t)((j_) * 64 + srow) * 512 + sch * 8); \
    rk1 = *(const u32x4*)(FKB + (size_t)((j_) * 64 + srow + 32) * 512 + sch * 8); \
    rv0 = *(const u32x4*)(FVT + (size_t)srow * SEQ + (j_) * 64 + sch * 8); \
    rv1 = *(const u32x4*)(FVT + (size_t)(srow + 32) * SEQ + (j_) * 64 + sch * 8); \
    if (tid < 64) rc = c2[(j_) * 64 + tid]; } while (0)
  ATT_GLOAD(jstart);
  for (int j = jstart; j <= jd0 + 1; j++) {
    __syncthreads();
    *(u32x4*)(sK + srow * 72 + sch * 8) = rk0; *(u32x4*)(sK + (srow + 32) * 72 + sch * 8) = rk1;
    *(u32x4*)(sV + srow * 72 + sch * 8) = rv0; *(u32x4*)(sV + (srow + 32) * 72 + sch * 8) = rv1;
    if (tid < 64) sC[tid] = rc;
    __syncthreads();
    if (j < jd0 + 1) ATT_GLOAD(j + 1);
    if (j * 64 > q0 + w * 32 + 31) continue;
    f32x16 s0, s1;
#pragma unroll
    for (int r = 0; r < 16; r++) { s0[r] = 0.f; s1[r] = 0.f; }
#pragma unroll
    for (int d0 = 0; d0 < 4; d0++) {
      bf16x8 k0 = *(const bf16x8*)(sK + r32 * 72 + d0 * 16 + hi * 8);
      bf16x8 k1 = *(const bf16x8*)(sK + (32 + r32) * 72 + d0 * 16 + hi * 8);
      s0 = __builtin_amdgcn_mfma_f32_32x32x16_bf16(k0, qf[d0], s0, 0, 0, 0);
      s1 = __builtin_amdgcn_mfma_f32_32x32x16_bf16(k1, qf[d0], s1, 0, 0, 0);
    }
    const bool diag = (j >= jd0);
    const int kbase = j * 64 + 4 * hi;
    float mloc = -INFINITY;
#pragma unroll
    for (int g = 0; g < 4; g++) {
      float4 c0 = *(const float4*)(sC + 8 * g + 4 * hi), c1 = *(const float4*)(sC + 32 + 8 * g + 4 * hi);
      float cc0[4] = {c0.x, c0.y, c0.z, c0.w}, cc1[4] = {c1.x, c1.y, c1.z, c1.w};
#pragma unroll
      for (int e = 0; e < 4; e++) {
        int r = g * 4 + e;
        float a = s0[r] + (cq - cc0[e]), bb = s1[r] + (cq - cc1[e]);
        if (diag) { int key = kbase + 8 * g + e; if (key > qrow) a = -INFINITY; if (key + 32 > qrow) bb = -INFINITY; }
        s0[r] = a; s1[r] = bb; mloc = fmaxf(mloc, fmaxf(a, bb));
      }
    }
    mloc = fmaxf(mloc, __shfl_xor(mloc, 32));
    float mn = fmaxf(m, mloc);
    float alpha = __builtin_amdgcn_exp2f(m - mn);
    m = mn;
    float ps = 0.f;
#pragma unroll
    for (int r = 0; r < 16; r++) { s0[r] = __builtin_amdgcn_exp2f(s0[r] - mn); s1[r] = __builtin_amdgcn_exp2f(s1[r] - mn); ps += s0[r] + s1[r]; }
    lsum = lsum * alpha + ps;
#pragma unroll
    for (int r = 0; r < 16; r++) { o0[r] *= alpha; o1[r] *= alpha; }
#pragma unroll
    for (int ks = 0; ks < 4; ks++) {
      union { bf16x8 v; unsigned u[4]; } pf;
#pragma unroll
      for (int e = 0; e < 4; e++) {
        int r = (ks & 1) * 8 + 2 * e;
        pf.u[e] = (ks < 2) ? pack2(s0[r], s0[r + 1]) : pack2(s1[r], s1[r + 1]);
      }
#pragma unroll
      for (int db = 0; db < 2; db++) {
        const bfu* vp = sV + (db * 32 + r32) * 72 + ks * 16 + 4 * hi;
        union { bf16x8 v; uint2 u[2]; } vf;
        vf.u[0] = *(const uint2*)vp; vf.u[1] = *(const uint2*)(vp + 8);
        if (db == 0) o0 = __builtin_amdgcn_mfma_f32_32x32x16_bf16(vf.v, pf.v, o0, 0, 0, 0);
        else o1 = __builtin_amdgcn_mfma_f32_32x32x16_bf16(vf.v, pf.v, o1, 0, 0, 0);
      }
    }
  }
  float lt = lsum + __shfl_xor(lsum, 32);
  float inv = 1.f / lt;
  bfu* op = (dry ? (bfu*)(p.ws + OFF_XB) : FQ) + (size_t)(b * SEQ + qrow) * 512 + h * 64;
#pragma unroll
  for (int g = 0; g < 4; g++) {
    *(uint2*)(op + 8 * g + 4 * hi) = make_uint2(pack2(o0[g * 4] * inv, o0[g * 4 + 1] * inv), pack2(o0[g * 4 + 2] * inv, o0[g * 4 + 3] * inv));
    *(uint2*)(op + 32 + 8 * g + 4 * hi) = make_uint2(pack2(o1[g * 4] * inv, o1[g * 4 + 1] * inv), pack2(o1[g * 4 + 2] * inv, o1[g * 4 + 3] * inv));
  }
  __syncthreads();
}

DEV void r3_item(const Params& p, int item, char* smem, bool dry) {
  const int tid = threadIdx.x, lane = tid & 63, w = tid >> 6, wr = w >> 1, wc = w & 1, l16 = lane & 15, quad = lane >> 4;
  const int bh = item / NCH, c = item - bh * NCH; const int b = bh >> 3, h = bh & 7;
  bfu* sQ = (bfu*)smem; bfu* sK = sQ + 128 * 72; bfu* sP = sK + 128 * 72; float* sRed = (float*)(sP + 128 * 136);
  const size_t row0 = (size_t)b * SEQ + c * RC;
  const bfu* Q = (const bfu*)(p.ws + OFF_QT) + row0 * 512 + h * 64;
  const bfu* Kk = (const bfu*)(p.ws + OFF_KT) + row0 * 512 + h * 64;
  const bfu* vT = (const bfu*)(p.ws + OFF_VT) + (size_t)bh * 128 * SEQ + c * RC;
  const bfu* ST = (const bfu*)(p.ws + OFF_SST) + (size_t)item * 8192;
  u32x4 ra[4], rb[4];
  g2r<128>(Q, 512, ra); g2r<128>(Kk, 512, rb);
  __syncthreads();
  r2s<128>(sQ, ra); r2s<128>(sK, rb);
  __syncthreads();
  g2r<128>(vT, SEQ, rb);
  f32x4 acc[4][4];
#pragma unroll
  for (int i = 0; i < 4; i++)
#pragma unroll
    for (int j = 0; j < 4; j++) acc[i][j] = f32x4{0.f, 0.f, 0.f, 0.f};
  mma64<4, 4>(sQ, 72, sK, 72, acc);
#pragma unroll
  for (int mi = 0; mi < 4; mi++)
#pragma unroll
    for (int ni = 0; ni < 4; ni++)
#pragma unroll
      for (int j = 0; j < 4; j++) {
        int row = wr * 64 + mi * 16 + quad * 4 + j, col = wc * 64 + ni * 16 + l16;
        sP[row * 136 + col] = (col <= row) ? f2bf(acc[mi][ni][j]) : (bfu)0;
      }
#pragma unroll
  for (int i = 0; i < 4; i++)
#pragma unroll
    for (int j = 0; j < 4; j++) acc[i][j] = f32x4{0.f, 0.f, 0.f, 0.f};
  __syncthreads();
  r2s<128>(sK, rb);
  __syncthreads();
  g2r<128>(vT + 64, SEQ, rb);
  mma64<4, 4>(sP, 136, sK, 72, acc);
  __syncthreads();
  r2s<128>(sK, rb);
  __syncthreads();
  g2r<128>(ST, 64, rb);
  mma64<4, 4>(sP + 64, 136, sK, 72, acc);
  __syncthreads();
  r2s<128>(sK, rb);
  __syncthreads();
  mma64<4, 4>(sQ, 72, sK, 72, acc);
  float ssq[4][4];
#pragma unroll
  for (int mi = 0; mi < 4; mi++)
#pragma unroll
    for (int j = 0; j < 4; j++) { float s = 0.f;
#pragma unroll
      for (int ni = 0; ni < 4; ni++) s += acc[mi][ni][j] * acc[mi][ni][j];
      s = sum16(s); ssq[mi][j] = s;
      if (l16 == 0) sRed[(wr * 64 + mi * 16 + quad * 4 + j) * 2 + wc] = s; }
  __syncthreads();
  bfu* RG = (bfu*)(p.ws + OFF_RG);
  float gg[4];
#pragma unroll
  for (int ni = 0; ni < 4; ni++) gg[ni] = p.gn_g[h * 128 + wc * 64 + ni * 16 + l16];
  float* sw = (float*)smem + w * EPI_WAVE;
#pragma unroll
  for (int mi = 0; mi < 4; mi++) {
    f32x4 tv[4];
#pragma unroll
    for (int j = 0; j < 4; j++) {
      int row = wr * 64 + mi * 16 + quad * 4 + j;
      float tot = sRed[row * 2] + sRed[row * 2 + 1];
      float r = rsqrtf(tot * (1.f / 128.f) + EPSN);
#pragma unroll
      for (int ni = 0; ni < 4; ni++) tv[ni][j] = acc[mi][ni][j] * r * gg[ni];
    }
    float rw[16], g[16]; to_rows(tv, rw, sw, lane);
    int rr_ = lane >> 2; asm volatile("" : "+v"(rr_));
    const size_t o = (row0 + wr * 64 + mi * 16 + rr_) * DM + h * 128 + wc * 64 + (lane & 3) * 16;
    ld_bf16x16(RG + o, g);
#pragma unroll
    for (int e = 0; e < 16; e++) rw[e] *= g[e] * sigmoidf_(g[e]);
    st_bf16x16(dry ? (bfu*)(p.ws + OFF_XB) + (o & 0xffffff) : RG + o, rw);
  }
  __syncthreads();
}

DEV void phase4(const Params& p, int bid, int nb, char* smem, bool dry = false) {
  float gq = 0.f, gk = 0.f;
  for (int i = 0; i < 64; i++) { gq = fmaxf(gq, fabsf(p.fq_g[i])); gk = fmaxf(gk, fabsf(p.fk_g[i])); }
  const float thr = 2.f * (8.f * gq * gk * 1.03f * LOG2E) + 44.f;
  for (int it = bid; it < 2048 + 16 * NCH; it += nb) {
    if (it < 2048) attn_item(p, it, smem, thr, dry); else r3_item(p, it - 2048, smem, dry);
  }
}

DEV void phase5(const Params& p, int bid, int nb, char* smem) {
  const int tid = threadIdx.x, lane = tid & 63, w = tid >> 6, wr = w >> 1, wc = w & 1, l16 = lane & 15, quad = lane >> 4;
  bfu* sA = (bfu*)smem; bfu* sB = sA + 128 * 72;
  const bfu* G = (const bfu*)(p.ws + OFF_RG); const bfu* FO = (const bfu*)(p.ws + OFF_FQ);
  const bfu* WR = (const bfu*)(p.ws + OFF_WRT); const bfu* WF = (const bfu*)(p.ws + OFF_WFT);
  bfu* MX = (bfu*)(p.ws + OFF_XB);
  constexpr int NG = (TT / 128) * 8, NCV = 8192;
  const int xcd = bid & 7, slot = bid >> 3, nslots = (nb + 7 - xcd) >> 3;
  const int n_p = slot < 128 ? (128 - slot + nslots - 1) / nslots : 0;
  for (int i_ = 0; i_ < n_p; i_++) {
    int q = slot + i_ * nslots; int mt = xcd * 16 + (q >> 3), nt = q & 7;
    int m0 = mt * 256, n0 = nt * 128;
    int tid2 = threadIdx.x; asm volatile("" : "+v"(tid2));
    const int lane2 = tid2 & 63, w2 = tid2 >> 6, wr2 = w2 >> 1, wc2 = w2 & 1, l162 = lane2 & 15, quad2 = lane2 >> 4;
    f32x4 a1[8][4];
#pragma unroll
    for (int i = 0; i < 8; i++)
#pragma unroll
      for (int j = 0; j < 4; j++) a1[i][j] = f32x4{0.f, 0.f, 0.f, 0.f};
    gemm_loop_sb<8, 4>(G + (size_t)m0 * DM, DM, WR + (size_t)n0 * DM, DM, DM, a1, sA);
    const bfu* ga = (const bfu*)(p.out + O_YP); const bfu* gb = ga + (size_t)TP * DM;
    float* sw = (float*)(smem + EPI_OFF) + w2 * EPI_WAVE;
    const int rr = lane2 >> 2, c0 = wc2 * 64 + (lane2 & 3) * 16;
#pragma unroll
    for (int mi = 0; mi < 8; mi++) {
      float r[16], g[16]; to_rows(a1[mi], r, sw, lane2);
      int rr_ = rr; asm volatile("" : "+v"(rr_));
      const size_t o = (size_t)(m0 + wr2 * 128 + mi * 16 + rr_) * DM + n0 + c0;
      ld_bf16x16(ga + o, g);
#pragma unroll
      for (int e = 0; e < 16; e++) r[e] *= sigmoidf_(g[e]);
      st_bf16x16(MX + o, r);
#pragma unroll
      for (int ni = 0; ni < 4; ni++) a1[mi][ni] = f32x4{0.f, 0.f, 0.f, 0.f};
    }
    gemm_loop_sb<8, 4>(FO + (size_t)m0 * 512, 512, WF + (size_t)n0 * 512, 512, 512, a1, sA);
#pragma unroll
    for (int mi = 0; mi < 8; mi++) {
      float r[16], g[16], m[16]; to_rows(a1[mi], r, sw, lane2);
      int rr_ = rr; asm volatile("" : "+v"(rr_));
      const size_t o = (size_t)(m0 + wr2 * 128 + mi * 16 + rr_) * DM + n0 + c0;
      ld_bf16x16(gb + o, g); ld_bf16x16(MX + o, m);
#pragma unroll
      for (int e = 0; e < 16; e++) r[e] = m[e] + sigmoidf_(g[e]) * r[e];
      st_bf16x16(MX + o, r);
    }
  }
  if (bid < 128) {
    int nt = bid & 7;
    int m0 = TP + (bid >> 3) * 32, n0 = nt * 128;
    f32x4 a1[1][4];
#pragma unroll
    for (int j = 0; j < 4; j++) a1[0][j] = f32x4{0.f, 0.f, 0.f, 0.f};
    gemm_loop<1, 4>(G + (size_t)m0 * DM, DM, WR + (size_t)n0 * DM, DM, DM, a1, sA);
    const bfu* ga = (const bfu*)(p.out + O_YS) + (size_t)(m0 - TP) * DM + n0; const bfu* gb = ga + (size_t)TS * DM;
    bfu* mxT = MX + (size_t)m0 * DM + n0;
    unsigned loff = (unsigned)((wr * 16 + quad * 4) * DM + wc * 64 + l16); asm volatile("" : "+v"(loff));
#pragma unroll
    for (int ni = 0; ni < 4; ni++) {
#pragma unroll
      for (int j = 0; j < 4; j++) { unsigned o = loff + (unsigned)(j * DM + ni * 16);
        mxT[o] = f2bf(sigmoidf_(bf2f(ga[o])) * a1[0][ni][j]); }
      a1[0][ni] = f32x4{0.f, 0.f, 0.f, 0.f};
    }
    gemm_loop<1, 4>(FO + (size_t)m0 * 512, 512, WF + (size_t)n0 * 512, 512, 512, a1, sA);
    unsigned loff2 = loff; asm volatile("" : "+v"(loff2));
#pragma unroll
    for (int ni = 0; ni < 4; ni++) {
#pragma unroll
      for (int j = 0; j < 4; j++) { unsigned o = loff2 + (unsigned)(j * DM + ni * 16);
        mxT[o] = f2bf(bf2f(mxT[o]) + sigmoidf_(bf2f(gb[o])) * a1[0][ni][j]); }
    }
  }
}

DEV void phase6(const Params& p, int bid, int nb, char* smem) {
  bfu* sA = (bfu*)smem;
  const bfu* MX = (const bfu*)(p.ws + OFF_XB); const bfu* WO = (const bfu*)(p.ws + OFF_WOT);
  bfu* X1B = (bfu*)(p.ws + OFF_X1B); float* SSQ2 = (float*)(p.ws + OFF_SSQ2);
  const int xcd = bid & 7, slot = bid >> 3, nslots = (nb + 7 - xcd) >> 3;
  const int n_p = slot < 128 ? (128 - slot + nslots - 1) / nslots : 0;
  for (int i_ = 0; i_ < n_p; i_++) {
    int q = slot + i_ * nslots; int mt = xcd * 16 + (q >> 3), nt = q & 7;
    int m0 = mt * 256, n0 = nt * 128;
    int tid = threadIdx.x; asm volatile("" : "+v"(tid));
    const int lane = tid & 63, w = tid >> 6, wr = w >> 1, wc = w & 1, l16 = lane & 15, quad = lane >> 4;
    f32x4 acc[8][4];
#pragma unroll
    for (int i = 0; i < 8; i++)
#pragma unroll
      for (int j = 0; j < 4; j++) acc[i][j] = f32x4{0.f, 0.f, 0.f, 0.f};
    gemm_loop_sb<8, 4>(MX + (size_t)m0 * DM, DM, WO + (size_t)n0 * DM, DM, DM, acc, sA);
    float* sw = (float*)(smem + EPI_OFF) + w * EPI_WAVE;
    const int rr = lane >> 2, c0 = wc * 64 + (lane & 3) * 16;
#pragma unroll
    for (int mi = 0; mi < 8; mi++) {
      float r[16]; to_rows(acc[mi], r, sw, lane);
      int rr_ = rr; asm volatile("" : "+v"(rr_));
      const size_t o = (size_t)(m0 + wr * 128 + mi * 16 + rr_) * DM + n0 + c0;
      const float* xp = (m0 < TP ? p.x_p : p.x_s - (size_t)TP * DM) + o;
      float ss = 0.f;
#pragma unroll
      for (int c = 0; c < 4; c++) { f32x4 xv = *(const f32x4*)(xp + 4 * c);
#pragma unroll
        for (int e = 0; e < 4; e++) { r[4 * c + e] += xv[e]; ss += r[4 * c + e] * r[4 * c + e]; } }
      st_f32x16(p.out + O_YP + o, r);
      st_bf16x16(X1B + o, r);
      ss += __shfl_xor(ss, 1); ss += __shfl_xor(ss, 2);
      if ((lane & 3) == 0) SSQ2[(size_t)(m0 + wr * 128 + mi * 16 + rr) * 16 + nt * 2 + wc] = ss;
    }
  }
  if (bid < 128) {
    const int tid = threadIdx.x, lane = tid & 63, w = tid >> 6, wr = w >> 1, wc = w & 1, l16 = lane & 15, quad = lane >> 4;
    int nt = bid & 7;
    int m0 = TP + (bid >> 3) * 32, n0 = nt * 128;
    f32x4 acc[1][4];
#pragma unroll
    for (int j = 0; j < 4; j++) acc[0][j] = f32x4{0.f, 0.f, 0.f, 0.f};
    gemm_loop<1, 4>(MX + (size_t)m0 * DM, DM, WO + (size_t)n0 * DM, DM, DM, acc, sA);
    const float* xin = p.x_s + (size_t)(m0 - TP) * DM + n0;
    float* y = p.out + O_YS + (size_t)(m0 - TP) * DM + n0;
    bfu* xb1 = X1B + (size_t)m0 * DM + n0;
    unsigned loff = (unsigned)((wr * 16 + quad * 4) * DM + wc * 64 + l16); asm volatile("" : "+v"(loff));
#pragma unroll
    for (int j = 0; j < 4; j++) {
      int lr = wr * 16 + quad * 4 + j; float ss = 0.f;
#pragma unroll
      for (int ni = 0; ni < 4; ni++) {
        unsigned o = loff + (unsigned)(j * DM + ni * 16);
        float v = xin[o] + acc[0][ni][j];
        y[o] = v; xb1[o] = f2bf(v); ss += v * v;
      }
      ss = sum16(ss);
      if (l16 == 0) (SSQ2 + (size_t)m0 * 16 + nt * 2)[(unsigned)(lr * 16 + wc)] = ss;
    }
  }
}

DEV int fkey(float x, int idx, int mask) { int b = __float_as_int(x); b ^= (b >> 31) & 0x7fffffff; return (b & ~mask) | idx; }
DEV void ins16(int (&t)[16], int v) {
#pragma unroll
  for (int s = 0; s < 16; s++) { int hi = max(t[s], v); v = min(t[s], v); t[s] = hi; }
}

DEV void phase7(const Params& p, int bid, int nb, char* smem) {
  const int tid = threadIdx.x, lane = tid & 63, w = tid >> 6, wr = w >> 1, wc = w & 1, l16 = lane & 15, quad = lane >> 4;
  bfu* sA = (bfu*)smem;
  float* sS = (float*)smem;
  int* sL = (int*)(smem + 33024);
  float* sTV = (float*)(smem + 55296);
  int* sTI = (int*)(sTV + 2 * 64 * 17);
  const bfu* X1B = (const bfu*)(p.ws + OFF_X1B); const bfu* MT = (const bfu*)(p.ws + OFF_MT);
  const float* SSQ2 = (const float*)(p.ws + OFF_SSQ2);
  int2* ROUTE = (int2*)(p.ws + OFF_ROUTE);
  constexpr int NI7 = (TT / 64) * 8;
  const int xcd = bid & 7, slot = bid >> 3, nslots = (nb + 7 - xcd) >> 3;
  for (int q = slot; q < 520; q += nslots) {
    int hg = q / 260, q2 = q - hg * 260; int mt = xcd * 65 + (q2 >> 2), h = hg * 4 + (q2 & 3); int m0 = mt * 64;
    for (int half = 0; half < 2; half++) {
      f32x4 acc[2][4];
#pragma unroll
      for (int i = 0; i < 2; i++)
#pragma unroll
        for (int j = 0; j < 4; j++) acc[i][j] = f32x4{0.f, 0.f, 0.f, 0.f};
      gemm_loop<2, 4>(X1B + (size_t)m0 * DM, DM, MT + (size_t)(h * 256 + half * 128) * DM, DM, DM, acc, sA);
      __syncthreads();
#pragma unroll
      for (int mi = 0; mi < 2; mi++)
#pragma unroll
        for (int j = 0; j < 4; j++) {
          int lr = wr * 32 + mi * 16 + quad * 4 + j;
          const float* sp = SSQ2 + (size_t)(m0 + lr) * 16; float tot = 0.f;
#pragma unroll
          for (int i = 0; i < 16; i++) tot += sp[i];
          float rs = rsqrtf(tot * (1.f / DM) + EPSN);
#pragma unroll
          for (int ni = 0; ni < 4; ni++) sS[lr * 129 + wc * 64 + ni * 16 + l16] = acc[mi][ni][j] * rs;
        }
      __syncthreads();
      { int row = tid & 63, q = tid >> 6; int t[16];
#pragma unroll
        for (int s = 0; s < 16; s++) t[s] = (int)0x80000000;
#pragma unroll 8
        for (int i = 0; i < 32; i++) { int idx = q * 32 + i; ins16(t, fkey(sS[row * 129 + idx], idx, 127)); }
#pragma unroll
        for (int s = 0; s < 16; s++) sL[row * 65 + q * 16 + s] = t[s]; }
      __syncthreads();
      if (tid < 64) { int row = tid; int p0 = 0, p1 = 0, p2 = 0, p3 = 0; const int* L = sL + row * 65;
        for (int r = 0; r < 16; r++) {
          int a0 = L[p0], a1 = L[16 + p1], a2 = L[32 + p2], a3 = L[48 + p3];
          int mx = max(max(a0, a1), max(a2, a3));
          if (mx == a0) p0++; else if (mx == a1) p1++; else if (mx == a2) p2++; else p3++;
          int idx = mx & 127;
          sTV[(half * 64 + row) * 17 + r] = sS[row * 129 + idx]; sTI[(half * 64 + row) * 17 + r] = idx; } }
      __syncthreads();
    }
    if (tid < 64) {
      int row = tid; float v1[16], v2[16];
#pragma unroll
      for (int i = 0; i < 16; i++) { v1[i] = sTV[row * 17 + i]; v2[i] = sTV[(64 + row) * 17 + i]; }
      int t[16];
#pragma unroll
      for (int s = 0; s < 16; s++) t[s] = (int)0x80000000;
#pragma unroll
      for (int i = 0; i < 16; i++)
#pragma unroll
        for (int j = 0; j < 16; j++)
          if ((i + 1) * (j + 1) <= 16) ins16(t, fkey(v1[i] + v2[j], i * 16 + j, 255));
      float es[16]; int ei[16]; float mx = 0.f, sum = 0.f;
#pragma unroll
      for (int r = 0; r < 16; r++) { int c = t[r] & 255; int i = c >> 4, j = c & 15;
        float s = sTV[row * 17 + i] + sTV[(64 + row) * 17 + j];
        ei[r] = sTI[row * 17 + i] * 128 + sTI[(64 + row) * 17 + j];
        if (r == 0) mx = s;
        es[r] = __expf(s - mx); sum += es[r]; }
      float inv = 1.f / sum;
      int2* ro = ROUTE + ((size_t)(m0 + row) * 8 + h) * 16;
#pragma unroll
      for (int r = 0; r < 16; r++) ro[r] = make_int2(ei[r], __float_as_int(es[r] * inv));
    }
    __syncthreads();
  }
}

#define FP4PK(w_, sel_) __builtin_amdgcn_cvt_scalef32_pk_f32_fp4((w_), 1.0f, (sel_))
DEV float dot16_fp8(const u32x2& u, const f32x2 (&xn)[8]) {
  f32x2 s = FP4PK(u[0], 0) * xn[0];
  s = FP4PK(u[0], 1) * xn[1] + s;
  s = FP4PK(u[0], 2) * xn[2] + s;
  s = FP4PK(u[0], 3) * xn[3] + s;
  s = FP4PK(u[1], 0) * xn[4] + s;
  s = FP4PK(u[1], 1) * xn[5] + s;
  s = FP4PK(u[1], 2) * xn[6] + s;
  s = FP4PK(u[1], 3) * xn[7] + s;
  return s[0] + s[1];
}
DEV void axpy16_fp8(const u32x2& u, float wj, f32x2 (&acc)[8]) {
  const f32x2 w2 = {wj, wj};
  acc[0] = FP4PK(u[0], 0) * w2 + acc[0];
  acc[1] = FP4PK(u[0], 1) * w2 + acc[1];
  acc[2] = FP4PK(u[0], 2) * w2 + acc[2];
  acc[3] = FP4PK(u[0], 3) * w2 + acc[3];
  acc[4] = FP4PK(u[1], 0) * w2 + acc[4];
  acc[5] = FP4PK(u[1], 1) * w2 + acc[5];
  acc[6] = FP4PK(u[1], 2) * w2 + acc[6];
  acc[7] = FP4PK(u[1], 3) * w2 + acc[7];
}
template <int S>
DEV void red_step(float (&pp)[16], int lane) {
  const bool up = (lane & S) != 0;
#pragma unroll
  for (int i = 0; i < S; i++) {
    float send = up ? pp[i] : pp[i + S];
    float keep = up ? pp[i + S] : pp[i];
    pp[i] = keep + __shfl_xor(send, S);
  }
}
DEV float reduce16(float (&pp)[16], int lane) {
  red_step<8>(pp, lane); red_step<4>(pp, lane); red_step<2>(pp, lane); red_step<1>(pp, lane);
  float v = pp[0];
  v += __shfl_xor(v, 16); v += __shfl_xor(v, 32);
  return v;
}

DEV void phase8(const Params& p, int bid, int nb, char* smem, bool dry = false) {
  const int tid = threadIdx.x, lane = tid & 63, w = __builtin_amdgcn_readfirstlane(tid >> 6);
  const u32x2* PUB = (const u32x2*)(p.ws + OFF_PUB); const u32x2* PVB = (const u32x2*)(p.ws + OFF_PVB);
  const float* PSC = (const float*)(p.ws + OFF_PSC);
  const float* SSQ2 = (const float*)(p.ws + OFF_SSQ2); const int2* ROUTE = (const int2*)(p.ws + OFF_ROUTE);
  for (int it = bid; it < TT / 4; it += nb) {
    int tok = it * 4 + w;
    float* y = tok < TP ? p.out + O_YP + (size_t)tok * DM : p.out + O_YS + (size_t)(tok - TP) * DM;
    float x[16]; f32x2 xn[8];
    { float4 a0 = *(const float4*)(y + lane * 16), a1 = *(const float4*)(y + lane * 16 + 4), b0 = *(const float4*)(y + lane * 16 + 8), b1 = *(const float4*)(y + lane * 16 + 12);
      x[0] = a0.x; x[1] = a0.y; x[2] = a0.z; x[3] = a0.w; x[4] = a1.x; x[5] = a1.y; x[6] = a1.z; x[7] = a1.w;
      x[8] = b0.x; x[9] = b0.y; x[10] = b0.z; x[11] = b0.w; x[12] = b1.x; x[13] = b1.y; x[14] = b1.z; x[15] = b1.w; }
    float tot = 0.f;
    { const float* sp = SSQ2 + (size_t)tok * 16;
#pragma unroll
      for (int i = 0; i < 16; i++) tot += sp[i]; }
    float rs = rsqrtf(tot * (1.f / DM) + EPSN);
#pragma unroll
    for (int i = 0; i < 8; i++) { xn[i][0] = x[2 * i] * rs * p.norm2_g[lane * 16 + 2 * i]; xn[i][1] = x[2 * i + 1] * rs * p.norm2_g[lane * 16 + 2 * i + 1]; }
    const int2* rt = ROUTE + (size_t)tok * 128;
    int2 r0 = rt[lane], r1 = rt[lane + 64];
    float d0 = 0.f, d1 = 0.f, w0 = 0.f, w1 = 0.f;
    f32x2 acc[8];
#pragma unroll
    for (int i = 0; i < 8; i++) acc[i] = f32x2{0.f, 0.f};
#define P8_LOAD(buf, tb_, gi_) do { const int rx_ = ((gi_) & 4) ? r1.x : r0.x; \
      _Pragma("unroll") for (int jj = 0; jj < 16; jj++) { int e = __builtin_amdgcn_readlane(rx_, ((gi_) & 3) * 16 + jj); buf[jj] = tb_[(size_t)e * 64 + lane]; } } while (0)
#define P8_COMPU(buf, gi_) do { float pp[16]; \
      _Pragma("unroll") for (int jj = 0; jj < 16; jj++) pp[jj] = dot16_fp8(buf[jj], xn); \
      float v_ = reduce16(pp, lane); \
      if ((lane >> 4) == ((gi_) & 3)) { if ((gi_) < 4) d0 = v_; else d1 = v_; } } while (0)
#define P8_COMPV(buf, gi_) do { const int wx_ = __float_as_int(((gi_) & 4) ? w1 : w0); \
      _Pragma("unroll") for (int jj = 0; jj < 16; jj++) { float wj = __int_as_float(__builtin_amdgcn_readlane(wx_, ((gi_) & 3) * 16 + jj)); axpy16_fp8(buf[jj], wj, acc); } } while (0)
#define P8_SB() __builtin_amdgcn_sched_barrier(0)
    {
      u32x2 ua[16], ub[16];
      P8_LOAD(ua, PUB, 0);
#pragma unroll 1
      for (int gi = 0; gi < 6; gi += 2) {
        P8_LOAD(ub, PUB, gi + 1); P8_SB();
        P8_COMPU(ua, gi); P8_SB();
        P8_LOAD(ua, PUB, gi + 2); P8_SB();
        P8_COMPU(ub, gi + 1); P8_SB();
      }
      P8_LOAD(ub, PUB, 7); P8_SB();
      P8_COMPU(ua, 6); P8_SB();
      P8_LOAD(ua, PVB, 0); P8_SB();
      P8_COMPU(ub, 7); P8_SB();
      d0 *= PSC[r0.x]; d1 *= PSC[r1.x];
      w0 = 0.5f * d0 * (1.f + erff(d0 * 0.70710678118654752f)) * __int_as_float(r0.y) * PSC[16384 + r0.x];
      w1 = 0.5f * d1 * (1.f + erff(d1 * 0.70710678118654752f)) * __int_as_float(r1.y) * PSC[16384 + r1.x];
      P8_SB();
#pragma unroll 1
      for (int gi = 0; gi < 6; gi += 2) {
        P8_LOAD(ub, PVB, gi + 1); P8_SB();
        P8_COMPV(ua, gi); P8_SB();
        P8_LOAD(ua, PVB, gi + 2); P8_SB();
        P8_COMPV(ub, gi + 1); P8_SB();
      }
      P8_LOAD(ub, PVB, 7); P8_SB();
      P8_COMPV(ua, 6); P8_SB();
      P8_COMPV(ub, 7);
    }
    if (dry) y = (float*)(p.ws + OFF_XB) + (size_t)(tok & 8191) * DM;
    *(float4*)(y + lane * 16) = make_float4(x[0] + acc[0][0], x[1] + acc[0][1], x[2] + acc[1][0], x[3] + acc[1][1]);
    *(float4*)(y + lane * 16 + 4) = make_float4(x[4] + acc[2][0], x[5] + acc[2][1], x[6] + acc[3][0], x[7] + acc[3][1]);
    *(float4*)(y + lane * 16 + 8) = make_float4(x[8] + acc[4][0], x[9] + acc[4][1], x[10] + acc[5][0], x[11] + acc[5][1]);
    *(float4*)(y + lane * 16 + 12) = make_float4(x[12] + acc[6][0], x[13] + acc[6][1], x[14] + acc[7][0], x[15] + acc[7][1]);
  }
}

#define XB_TMO      128
#define XB_XCNT(j)  (256  + 64 * (j))
#define XB_XSUB(j)  (1280 + 64 * (j))
#define XB_XGEN(j)  (2304 + 64 * (j))
#define XB_TOP      3328
#define XB_TOPGEN   3392
#define XCD_BAR_WORDS 3456
#define XB_SPIN_CAP (1u << 18)
#define LAS __attribute__((address_space(3)))

__device__ __forceinline__ unsigned xb_ld(unsigned* p)              { return __hip_atomic_load(p, __ATOMIC_RELAXED, __HIP_MEMORY_SCOPE_AGENT); }
__device__ __forceinline__ unsigned xb_add(unsigned* p, unsigned v) { return __hip_atomic_fetch_add(p, v, __ATOMIC_RELAXED, __HIP_MEMORY_SCOPE_AGENT); }
__device__ __forceinline__ unsigned xb_xcc_id() { return (unsigned)__builtin_amdgcn_s_getreg((3 << 11) | 20) & 0xFu; }
#define XB_SPIN(cond, bar) do { unsigned _sp = 0; while (cond) { __builtin_amdgcn_s_sleep(1); \
    if ((++_sp & 255u) == 0u) { if (xb_ld(&(bar)[XB_TMO])) break; if (_sp > XB_SPIN_CAP) { atomicAdd(&(bar)[XB_TMO], 1u); break; } } } } while (0)

struct XcdBarrier {
    unsigned* bar; unsigned x;
    volatile LAS unsigned* st;
};

__device__ __forceinline__ XcdBarrier xcd_barrier_post(unsigned* bar, volatile LAS unsigned* st) {
    XcdBarrier b; b.bar = bar; b.x = xb_xcc_id(); b.st = st;
    if (threadIdx.x == 0) (void)xb_add(&bar[XB_XCNT(b.x)], 1u);
    return b;
}
__device__ __forceinline__ void xcd_barrier_complete(unsigned* bar, unsigned x, unsigned& nloc, unsigned& nx) {
    const unsigned G = gridDim.x * gridDim.y * gridDim.z;
    unsigned sum, cnt, mine, sp = 0u;
    for (;;) {
        sum = 0u; cnt = 0u; mine = 0u;
#pragma unroll
        for (unsigned j = 0; j < 16; ++j) { const unsigned c = xb_ld(&bar[XB_XCNT(j)]); sum += c; cnt += (c > 0u) ? 1u : 0u; mine = (j == x) ? c : mine; }
        if (sum == G) break;
        __builtin_amdgcn_s_sleep(1);
        if ((++sp & 255u) == 0u) { if (xb_ld(&bar[XB_TMO])) break; if (sp > XB_SPIN_CAP) { atomicAdd(&bar[XB_TMO], 1u); break; } }
    }
    nloc = mine > 0u ? mine : 1u; nx = cnt > 0u ? cnt : 1u;
}

__device__ __forceinline__ void xcd_barrier(const XcdBarrier& b) {
    asm volatile("s_waitcnt vmcnt(0)" ::: "memory");
    __syncthreads();
    if (threadIdx.x == 0) {
        unsigned* bar = b.bar;
        __builtin_amdgcn_s_waitcnt(0);
        unsigned nloc = b.st[0], nx = b.st[1];
        if (nloc == 0u) { xcd_barrier_complete(bar, b.x, nloc, nx); b.st[0] = nloc; b.st[1] = nx; }
        const unsigned old = xb_add(&bar[XB_XSUB(b.x)], 1u);
        const unsigned gen = old / nloc;
        if (old + 1u == (gen + 1u) * nloc) {
            __builtin_amdgcn_fence(__ATOMIC_RELEASE, "agent");
            asm volatile("s_waitcnt vmcnt(0)" ::: "memory");
            const unsigned og = xb_add(&bar[XB_TOP], 1u);
            const unsigned tg = og / nx;
            if (og + 1u == (tg + 1u) * nx) xb_add(&bar[XB_TOPGEN], 1u);
            else XB_SPIN(xb_ld(&bar[XB_TOPGEN]) == tg, bar);
            __builtin_amdgcn_fence(__ATOMIC_ACQUIRE, "agent");
            xb_add(&bar[XB_XGEN(b.x)], 1u);
            asm volatile("s_waitcnt vmcnt(0)" ::: "memory");
        } else {
            XB_SPIN(xb_ld(&bar[XB_XGEN(b.x)]) == gen, bar);
            __builtin_amdgcn_fence(__ATOMIC_ACQUIRE, "agent");
            asm volatile("s_waitcnt vmcnt(0)" ::: "memory");
        }
    }
    __syncthreads();
}


__global__ void __launch_bounds__(256, 2) fwd_kernel(Params p, int ph_lo, int ph_hi, int coop) {
  __shared__ __attribute__((aligned(16))) char smem[SMEM_BYTES];
  const int bid = blockIdx.x, nb = gridDim.x;
  __shared__ uint4 xb_words;
  if (threadIdx.x == 0) xb_words = make_uint4(0u, 0u, 0u, 0u);
  __syncthreads();
  XcdBarrier xb; xb.bar = (unsigned*)(p.ws + OFF_BAR); xb.x = 0; xb.st = (volatile LAS unsigned*)&xb_words;
  if (coop) xb = xcd_barrier_post((unsigned*)(p.ws + OFF_BAR), (volatile LAS unsigned*)&xb_words);
#ifndef REPS
#define REPS {1,1,1,1,1,1,1,1,1}
#endif
  constexpr int REP[9] = REPS;
#define RUN_PHASE(N) if (ph_lo <= N && N <= ph_hi) { for (int r_ = 0; r_ < REP[N]; r_++) phase##N(p, bid, nb, smem); if (coop && N < ph_hi) { if (ph_lo == 0x7fffffff) cg::this_grid().sync();   xcd_barrier(xb); } }
#define RUN_PHASE_DRY(N) if (ph_lo <= N && N <= ph_hi) { for (int r_ = 1; r_ < REP[N]; r_++) phase##N(p, bid, nb, smem, true); phase##N(p, bid, nb, smem, false); if (coop && N < ph_hi) xcd_barrier(xb); }
  RUN_PHASE(0) RUN_PHASE_DRY(1) RUN_PHASE(2) RUN_PHASE(3) RUN_PHASE_DRY(4) RUN_PHASE(5) RUN_PHASE(6) RUN_PHASE(7) RUN_PHASE_DRY(8)
}

extern "C" void kernel_launch(void* const* d_in, const int* in_sizes, int n_in, void* d_out, int out_size,
                              void* d_ws, size_t ws_size, hipStream_t stream) {
  if (ws_size < WS_NEED) { fprintf(stderr, "workspace too small\n"); return; }
  static int grid_blocks = 0;
  if (!grid_blocks) {
    int dev = 0, cus = 0, per_cu = 0;
    hipGetDevice(&dev);
    hipDeviceGetAttribute(&cus, hipDeviceAttributeMultiprocessorCount, dev);
    hipOccupancyMaxActiveBlocksPerMultiprocessor(&per_cu, fwd_kernel, 256, 0);
    if (per_cu < 1) per_cu = 1;
    if (per_cu > 2) per_cu = 2;
    grid_blocks = cus * per_cu;
  }
  Params p{};
  const float* const* in = (const float* const*)d_in;
  p.x_p = in[0]; p.x_s = in[1]; p.state_ret = in[2]; p.ck = in[3]; p.cv = in[4]; p.clogf = in[5]; p.norm1_g = in[6];
  p.w_in = in[7]; p.b_f = in[8]; p.fq_g = in[9]; p.fk_g = in[10]; p.gn_g = in[11]; p.w_ret_out = in[12]; p.w_fox_out = in[13];
  p.w_o = in[14]; p.norm2_g = in[15]; p.peer_wq = in[16]; p.k1 = in[17]; p.k2 = in[18]; p.peer_u = in[19]; p.peer_v = in[20];
  p.out = (float*)d_out; p.ws = (char*)d_ws;
#ifndef MULTI_LAUNCH
#define MULTI_LAUNCH 0
#endif
#if MULTI_LAUNCH
  for (int ph = 0; ph <= 8; ph++) fwd_kernel<<<grid_blocks, 256, 0, stream>>>(p, ph, ph, 0);
#else
  hipMemsetAsync((char*)d_ws + OFF_BAR, 0, XCD_BAR_WORDS * sizeof(unsigned), stream);
  int lo = 0, hi = 8, coop = 1;
  void* args[] = {&p, &lo, &hi, &coop};
  hipError_t e = hipLaunchCooperativeKernel((void*)fwd_kernel, dim3(grid_blocks), dim3(256), args, 0, stream);
  if (e != hipSuccess) fprintf(stderr, "cooperative launch failed: %s (grid %d)\n", hipGetErrorString(e), grid_blocks);
#endif
}
```

```cpp
#include <hip/hip_runtime.h>
#include <hip/hip_cooperative_groups.h>
#include <stdint.h>
#include <stdio.h>
namespace cg = cooperative_groups;

#define DEV __device__ __forceinline__
typedef unsigned short bfu;
typedef __attribute__((ext_vector_type(8))) short bf16x8;
typedef __attribute__((ext_vector_type(4))) short bf16x4;
typedef __attribute__((ext_vector_type(4))) float f32x4;
typedef __attribute__((ext_vector_type(16))) float f32x16;
typedef __attribute__((ext_vector_type(4))) unsigned u32x4;
typedef __attribute__((ext_vector_type(2))) float f32x2;
typedef __attribute__((ext_vector_type(2))) unsigned u32x2;

constexpr int DM = 1024, SEQ = 16384, TP = 32768, TS = 512, TT = 33280;
constexpr int NWP = 6784;
constexpr int RC = 128;
constexpr int NCH = SEQ / RC;
constexpr float LOG2E = 1.4426950408889634f;
constexpr float EPSN = 1e-6f;

constexpr size_t O_YP = 0, O_YS = 33554432, O_SP = 34078720, O_FKP = 34209792, O_FVP = 50987008,
                 O_LFP = 67764224, O_SS = 68026368, O_FKS = 70123520, O_FVS = 70385664, O_LFS = 70647808;
constexpr size_t MiB = 1u << 20;
constexpr size_t OFF_XB = 0;
constexpr size_t OFF_WINT = 66 * MiB, OFF_WRT = 80 * MiB, OFF_WFT = 82 * MiB, OFF_WOT = 83 * MiB, OFF_MT = 85 * MiB;
constexpr size_t OFF_RSTD1 = 89 * MiB, OFF_C2 = 90 * MiB, OFF_HS = 91 * MiB;
constexpr size_t OFF_QT = 105 * MiB, OFF_KT = 137 * MiB, OFF_KTT = 169 * MiB, OFF_VT = 201 * MiB;
constexpr size_t OFF_X1B = OFF_HS;
constexpr size_t OFF_RG = 265 * MiB, OFF_FQ = 331 * MiB, OFF_FKB = 364 * MiB, OFF_FVT = 396 * MiB;
constexpr size_t OFF_PUB = OFF_KTT, OFF_PVB = OFF_KTT + 16 * MiB;
constexpr size_t OFF_ROUTE = OFF_FKB, OFF_SSQ2 = OFF_FKB + 33 * MiB;
constexpr size_t OFF_BAR = OFF_RSTD1 + 768 * 1024;
constexpr size_t OFF_PSC = OFF_RSTD1 + 512 * 1024;
constexpr size_t OFF_SST = 428 * MiB;
constexpr size_t WS_NEED = 460 * MiB;

constexpr int SMEM_BYTES = 75776;

struct Params {
  const float *x_p, *x_s, *state_ret, *ck, *cv, *clogf, *norm1_g, *w_in, *b_f, *fq_g, *fk_g, *gn_g,
      *w_ret_out, *w_fox_out, *w_o, *norm2_g, *peer_wq, *k1, *k2, *peer_u, *peer_v;
  float* out;
  char* ws;
};

DEV bfu f2bf(float f) { unsigned u = __float_as_uint(f); u += 0x7fffu + ((u >> 16) & 1u); return (bfu)(u >> 16); }
DEV float bf2f(bfu b) { return __uint_as_float(((unsigned)b) << 16); }
DEV unsigned pack2(float a, float b) { return (unsigned)f2bf(a) | ((unsigned)f2bf(b) << 16); }
DEV float bflo(unsigned u) { return __uint_as_float(u << 16); }
DEV float bfhi(unsigned u) { return __uint_as_float(u & 0xffff0000u); }
DEV float sigmoidf_(float z) { return 1.f / (1.f + __expf(-z)); }
DEV float l2gamma(int h) { return log2f(1.f - exp2f(-5.f - (float)h)); }
DEV float wave_sum(float v) {
#pragma unroll
  for (int o = 32; o >= 1; o >>= 1) v += __shfl_xor(v, o);
  return v;
}
DEV float sum16(float v) {
  v += __shfl_xor(v, 1); v += __shfl_xor(v, 2); v += __shfl_xor(v, 4); v += __shfl_xor(v, 8);
  return v;
}

template <int ROWS>
DEV void g2r(const bfu* g, int ld, u32x4 (&r)[ROWS / 32], int tid_ = threadIdx.x) {
#pragma unroll
  for (int i = 0; i < ROWS / 32; i++) {
    int id = tid_ + i * 256; int row = id >> 3, ch = id & 7;
    const unsigned off = (unsigned)(row * ld + ch * 8);
    r[i] = *(const u32x4*)(g + off);
  }
}
template <int ROWS>
DEV void r2s(bfu* s, const u32x4 (&r)[ROWS / 32], int tid_ = threadIdx.x) {
#pragma unroll
  for (int i = 0; i < ROWS / 32; i++) {
    int id = tid_ + i * 256; int row = id >> 3, ch = id & 7;
    *(u32x4*)(s + row * 72 + ch * 8) = r[i];
  }
}
template <int MI, int NI>
DEV void mma64(const bfu* sA, int sldA, const bfu* sB, int sldB, f32x4 (&acc)[MI][NI]) {
  const int lane = threadIdx.x & 63, w = threadIdx.x >> 6, wr = w >> 1, wc = w & 1, l16 = lane & 15, quad = lane >> 4;
#pragma unroll
  for (int kk = 0; kk < 2; kk++) {
    bf16x8 a[MI], b[NI];
#pragma unroll
    for (int mi = 0; mi < MI; mi++) a[mi] = *(const bf16x8*)(sA + (wr * MI * 16 + mi * 16 + l16) * sldA + kk * 32 + quad * 8);
#pragma unroll
    for (int ni = 0; ni < NI; ni++) b[ni] = *(const bf16x8*)(sB + (wc * NI * 16 + ni * 16 + l16) * sldB + kk * 32 + quad * 8);
#pragma unroll
    for (int mi = 0; mi < MI; mi++)
#pragma unroll
      for (int ni = 0; ni < NI; ni++) acc[mi][ni] = __builtin_amdgcn_mfma_f32_16x16x32_bf16(a[mi], b[ni], acc[mi][ni], 0, 0, 0);
  }
}
template <int ROWS>
DEV void r2sw(bfu* s, const u32x4 (&r)[ROWS / 32], int tid_) {
#pragma unroll
  for (int i = 0; i < ROWS / 32; i++) {
    int id = tid_ + i * 256; int row = id >> 3, ch = id & 7;
    int byte = (((row >> 4) * 2 + (ch >> 2)) << 10) + ((((row & 15) << 6) + ((ch & 3) << 4)) ^ (((row >> 3) & 1) << 5));
    *(u32x4*)((char*)s + byte) = r[i];
  }
}
template <int MI, int NI>
DEV void mma64w(const bfu* sA, const bfu* sB, f32x4 (&acc)[MI][NI]) {
  const int lane = threadIdx.x & 63, w = threadIdx.x >> 6, wr = w >> 1, wc = w & 1, l16 = lane & 15, quad = lane >> 4;
  const int lo = ((l16 << 6) + (quad << 4)) ^ (((l16 >> 3) & 1) << 5);
#pragma unroll
  for (int kk = 0; kk < 2; kk++) {
    bf16x8 a[MI], b[NI];
#pragma unroll
    for (int mi = 0; mi < MI; mi++) a[mi] = *(const bf16x8*)((const char*)sA + (((wr * MI + mi) * 2 + kk) << 10) + lo);
#pragma unroll
    for (int ni = 0; ni < NI; ni++) b[ni] = *(const bf16x8*)((const char*)sB + (((wc * NI + ni) * 2 + kk) << 10) + lo);
#pragma unroll
    for (int mi = 0; mi < MI; mi++)
#pragma unroll
      for (int ni = 0; ni < NI; ni++) acc[mi][ni] = __builtin_amdgcn_mfma_f32_16x16x32_bf16(a[mi], b[ni], acc[mi][ni], 0, 0, 0);
  }
}
template <int MI, int NI>
DEV void mma64w_big(const bfu* sA, const bfu* sB, f32x4 (&acc)[MI][NI]) {
  const int lane = threadIdx.x & 63, w = threadIdx.x >> 6, wr = w >> 1, wc = w & 1, l16 = lane & 15, quad = lane >> 4;
  const int lo = ((l16 << 6) + (quad << 4)) ^ (((l16 >> 3) & 1) << 5);
#pragma unroll
  for (int kk = 0; kk < 2; kk++) {
    bf16x8 b[NI];
#pragma unroll
    for (int ni = 0; ni < NI; ni++) b[ni] = *(const bf16x8*)((const char*)sB + (((wc * NI + ni) * 2 + kk) << 10) + lo);
#pragma unroll
    for (int mi = 0; mi < MI; mi++) {
      bf16x8 a = *(const bf16x8*)((const char*)sA + (((wr * MI + mi) * 2 + kk) << 10) + lo);
#pragma unroll
      for (int ni = 0; ni < NI; ni++) acc[mi][ni] = __builtin_amdgcn_mfma_f32_16x16x32_bf16(a, b[ni], acc[mi][ni], 0, 0, 0);
    }
  }
}
template <int MI, int NI>
DEV void gemm_loop_sb(const bfu* A, int lda, const bfu* B, int ldb, int K, f32x4 (&acc)[MI][NI], bfu* sbuf) {
  constexpr int BM = 32 * MI, BN = 32 * NI;
  bfu* sA = sbuf; bfu* sB = sA + BM * 64;
  const int nk = K >> 6;
  int t_ = threadIdx.x; asm volatile("" : "+v"(t_));
  u32x4 ra[BM / 32], rb[BN / 32];
  g2r<BM>(A, lda, ra, t_); g2r<BN>(B, ldb, rb, t_);
#pragma unroll 1
  for (int k = 0; k < nk; k++) {
    __syncthreads();
    r2sw<BM>(sA, ra, t_); r2sw<BN>(sB, rb, t_);
    if (k + 1 < nk) { g2r<BM>(A + (k + 1) * 64, lda, ra, t_); g2r<BN>(B + (k + 1) * 64, ldb, rb, t_); }
    __syncthreads();
    mma64w_big<MI, NI>(sA, sB, acc);
  }
}

template <int MI, int NI>
DEV void gemm_loop(const bfu* A, int lda, const bfu* B, int ldb, int K, f32x4 (&acc)[MI][NI], bfu* sbuf) {
  constexpr int BM = 32 * MI, BN = 32 * NI;
  bfu* sA0 = sbuf; bfu* sB0 = sA0 + BM * 64; bfu* sA1 = sB0 + BN * 64; bfu* sB1 = sA1 + BM * 64;
  const int nk = K >> 6;
  int t_ = threadIdx.x; asm volatile("" : "+v"(t_));
  u32x4 ra0[BM / 32], rb0[BN / 32], ra1[BM / 32], rb1[BN / 32];
  g2r<BM>(A, lda, ra0, t_); g2r<BN>(B, ldb, rb0, t_);
  if (nk > 1) { g2r<BM>(A + 64, lda, ra1, t_); g2r<BN>(B + 64, ldb, rb1, t_); }
  __syncthreads();
  r2sw<BM>(sA0, ra0, t_); r2sw<BN>(sB0, rb0, t_);
  if (nk > 2) { g2r<BM>(A + 128, lda, ra0, t_); g2r<BN>(B + 128, ldb, rb0, t_); }
  __syncthreads();
  for (int k = 0; k < nk; k += 2) {
    if (k + 1 < nk) { r2sw<BM>(sA1, ra1, t_); r2sw<BN>(sB1, rb1, t_); }
    if (k + 3 < nk) { g2r<BM>(A + (k + 3) * 64, lda, ra1, t_); g2r<BN>(B + (k + 3) * 64, ldb, rb1, t_); }
    mma64w<MI, NI>(sA0, sB0, acc);
    __syncthreads();
    if (k + 1 >= nk) break;
    if (k + 2 < nk) { r2sw<BM>(sA0, ra0, t_); r2sw<BN>(sB0, rb0, t_); }
    if (k + 4 < nk) { g2r<BM>(A + (k + 4) * 64, lda, ra0, t_); g2r<BN>(B + (k + 4) * 64, ldb, rb0, t_); }
    mma64w<MI, NI>(sA1, sB1, acc);
    __syncthreads();
  }
}

constexpr int EPI_OFF = 49152, EPI_WAVE = 16 * 68;
DEV void to_rows(const f32x4 (&v)[4], float (&r)[16], float* sw, int lane) {
  const int l16 = lane & 15, quad = lane >> 4;
  __builtin_amdgcn_wave_barrier();
#pragma unroll
  for (int ni = 0; ni < 4; ni++)
#pragma unroll
    for (int j = 0; j < 4; j++) sw[(quad * 4 + j) * 68 + ni * 16 + l16] = v[ni][j];
  __builtin_amdgcn_wave_barrier();
  const f32x4* rp = (const f32x4*)(sw + (lane >> 2) * 68 + (lane & 3) * 16);
#pragma unroll
  for (int c = 0; c < 4; c++) { f32x4 t = rp[c]; r[4 * c] = t[0]; r[4 * c + 1] = t[1]; r[4 * c + 2] = t[2]; r[4 * c + 3] = t[3]; }
}
DEV void st_bf16x16(bfu* dst, const float (&r)[16]) {
  u32x4 a = {pack2(r[0], r[1]), pack2(r[2], r[3]), pack2(r[4], r[5]), pack2(r[6], r[7])};
  u32x4 b = {pack2(r[8], r[9]), pack2(r[10], r[11]), pack2(r[12], r[13]), pack2(r[14], r[15])};
  *(u32x4*)dst = a; *(u32x4*)(dst + 8) = b;
}
DEV void ld_bf16x16(const bfu* src, float (&r)[16]) {
  u32x4 a = *(const u32x4*)src, b = *(const u32x4*)(src + 8);
#pragma unroll
  for (int i = 0; i < 4; i++) { r[2 * i] = bflo(a[i]); r[2 * i + 1] = bfhi(a[i]); r[8 + 2 * i] = bflo(b[i]); r[9 + 2 * i] = bfhi(b[i]); }
}
DEV void st_f32x16(float* dst, const float (&r)[16]) {
#pragma unroll
  for (int c = 0; c < 4; c++) *(f32x4*)(dst + 4 * c) = f32x4{r[4 * c], r[4 * c + 1], r[4 * c + 2], r[4 * c + 3]};
}

DEV void transpose_tile(const float* src, int ldsrc, int srccol0, int validcols, const float* scale,
                        bfu* dst, int lddst, int n0, int k0, float* sT) {
  const int tid = threadIdx.x;
  __syncthreads();
#pragma unroll
  for (int i = 0; i < 4; i++) {
    int kk = (tid >> 4) + i * 16, c = (tid & 15) * 4;
    float4 v = make_float4(0.f, 0.f, 0.f, 0.f);
    if (c < validcols) v = *(const float4*)(src + (size_t)(k0 + kk) * ldsrc + srccol0 + c);
    float s = scale ? scale[k0 + kk] : 1.f;
    sT[kk * 65 + c] = v.x * s; sT[kk * 65 + c + 1] = v.y * s; sT[kk * 65 + c + 2] = v.z * s; sT[kk * 65 + c + 3] = v.w * s;
  }
  __syncthreads();
  int n = tid >> 2, kc = (tid & 3) * 16;
  unsigned o[8];
#pragma unroll
  for (int e = 0; e < 8; e++) o[e] = pack2(sT[(kc + 2 * e) * 65 + n], sT[(kc + 2 * e + 1) * 65 + n]);
  uint4* d = (uint4*)(dst + (size_t)(n0 + n) * lddst + k0 + kc);
  d[0] = make_uint4(o[0], o[1], o[2], o[3]); d[1] = make_uint4(o[4], o[5], o[6], o[7]);
}

DEV void phase0(const Params& p, int bid, int nb, char* smem) {
  const int tid = threadIdx.x, lane = tid & 63, w = tid >> 6;
  constexpr int N_X = TT / 4, N_TW = 106 * 16, N_TR = 256, N_TF = 128, N_TO = 256, N_MT = 512;
  constexpr int B1 = N_X, B2 = B1 + N_TW, B3 = B2 + N_TR, B4 = B3 + N_TF, B5 = B4 + N_TO, TOT = B5 + N_MT;
  bfu* xb = (bfu*)(p.ws + OFF_XB); float* rstd1 = (float*)(p.ws + OFF_RSTD1);
  for (int it = bid; it < TOT; it += nb) {
    if (it < B1) {
      int row = it * 4 + w;
      const float* src = row < TP ? p.x_p + (size_t)row * DM : p.x_s + (size_t)(row - TP) * DM;
      float4 a0 = *(const float4*)(src + lane * 8), a1 = *(const float4*)(src + lane * 8 + 4);
      float4 b0 = *(const float4*)(src + 512 + lane * 8), b1 = *(const float4*)(src + 512 + lane * 8 + 4);
      float ss = a0.x * a0.x + a0.y * a0.y + a0.z * a0.z + a0.w * a0.w + a1.x * a1.x + a1.y * a1.y + a1.z * a1.z + a1.w * a1.w +
                 b0.x * b0.x + b0.y * b0.y + b0.z * b0.z + b0.w * b0.w + b1.x * b1.x + b1.y * b1.y + b1.z * b1.z + b1.w * b1.w;
      ss = wave_sum(ss);
      if (lane == 0) rstd1[row] = rsqrtf(ss * (1.f / DM) + EPSN);
      *(uint4*)(xb + (size_t)row * DM + lane * 8) = make_uint4(pack2(a0.x, a0.y), pack2(a0.z, a0.w), pack2(a1.x, a1.y), pack2(a1.z, a1.w));
      *(uint4*)(xb + (size_t)row * DM + 512 + lane * 8) = make_uint4(pack2(b0.x, b0.y), pack2(b0.z, b0.w), pack2(b1.x, b1.y), pack2(b1.z, b1.w));
    } else if (it < B2) {
      int j = it - B1; int nt = j >> 4, kt = j & 15; int n0 = nt * 64;
      int sc0, vc;
      if (n0 < 4608) { sc0 = n0; vc = 64; } else if (n0 < 6656) { sc0 = n0 + 8; vc = 64; } else if (n0 == 6656) { sc0 = 4608; vc = 8; } else { sc0 = 0; vc = 0; }
      transpose_tile(p.w_in, 6664, sc0, vc, p.norm1_g, (bfu*)(p.ws + OFF_WINT), DM, n0, kt * 64, (float*)smem);
    } else if (it < B3) {
      int j = it - B2; transpose_tile(p.w_ret_out, 1024, (j >> 4) * 64, 64, nullptr, (bfu*)(p.ws + OFF_WRT), 1024, (j >> 4) * 64, (j & 15) * 64, (float*)smem);
    } else if (it < B4) {
      int j = it - B3; transpose_tile(p.w_fox_out, 1024, (j >> 3) * 64, 64, nullptr, (bfu*)(p.ws + OFF_WFT), 512, (j >> 3) * 64, (j & 7) * 64, (float*)smem);
    } else if (it < B5) {
      int j = it - B4; transpose_tile(p.w_o, 1024, (j >> 4) * 64, 64, nullptr, (bfu*)(p.ws + OFF_WOT), 1024, (j >> 4) * 64, (j & 15) * 64, (float*)smem);
    } else {
      int j = it - B5; int hh = j >> 5, kt = (j >> 4) & 1, dt = j & 15;
      float* sW = (float*)smem; float* sK = sW + 64 * 129;
      const float* ksub = (hh & 1) ? p.k2 : p.k1;
      __syncthreads();
#pragma unroll
      for (int i = 0; i < 8; i++) {
        int id = tid + i * 256; int row = id >> 5, c4 = (id & 31) * 4;
        float4 v = *(const float4*)(p.peer_wq + (size_t)(dt * 64 + row) * 2048 + hh * 128 + c4);
        sW[row * 129 + c4] = v.x; sW[row * 129 + c4 + 1] = v.y; sW[row * 129 + c4 + 2] = v.z; sW[row * 129 + c4 + 3] = v.w;
        float4 u = *(const float4*)(ksub + (size_t)(kt * 64 + row) * 128 + c4);
        sK[row * 129 + c4] = u.x; sK[row * 129 + c4 + 1] = u.y; sK[row * 129 + c4 + 2] = u.z; sK[row * 129 + c4 + 3] = u.w;
      }
      __syncthreads();
      int ky = (tid >> 4) * 4, dd = (tid & 15) * 4;
      float a[4][4];
#pragma unroll
      for (int i = 0; i < 4; i++)
#pragma unroll
        for (int jj = 0; jj < 4; jj++) a[i][jj] = 0.f;
      for (int c = 0; c < 128; c++) {
        float kv[4], wv[4];
#pragma unroll
        for (int i = 0; i < 4; i++) { kv[i] = sK[(ky + i) * 129 + c]; wv[i] = sW[(dd + i) * 129 + c]; }
#pragma unroll
        for (int i = 0; i < 4; i++)
#pragma unroll
          for (int jj = 0; jj < 4; jj++) a[i][jj] += kv[i] * wv[jj];
      }
      bfu* MT = (bfu*)(p.ws + OFF_MT);
      float g0 = p.norm2_g[dt * 64 + dd], g1 = p.norm2_g[dt * 64 + dd + 1], g2 = p.norm2_g[dt * 64 + dd + 2], g3 = p.norm2_g[dt * 64 + dd + 3];
#pragma unroll
      for (int i = 0; i < 4; i++)
        *(uint2*)(MT + (size_t)(hh * 128 + kt * 64 + ky + i) * DM + dt * 64 + dd) = make_uint2(pack2(a[i][0] * g0, a[i][1] * g1), pack2(a[i][2] * g2, a[i][3] * g3));
    }
  }
}

DEV void rot_angle(int pos, int d, float& cs, float& sn) {
  float inv = exp2f(-(float)d * (13.287712379549449f / 32.f));
  float ang = (float)pos * inv;
  float rev = ang * 0.15915494309189535f;
  rev = rev - floorf(rev);
  sn = __builtin_amdgcn_sinf(rev); cs = __builtin_amdgcn_cosf(rev);
}

DEV void phase1(const Params& p, int bid, int nb, char* smem, bool noepi = false) {
  bfu* sA = (bfu*)smem; bfu* sB = sA + 128 * 72;
  const bfu* XB = (const bfu*)(p.ws + OFF_XB); const bfu* WT = (const bfu*)(p.ws + OFF_WINT);
  const float* rstd1 = (const float*)(p.ws + OFF_RSTD1);
  constexpr int NT = NWP / 128;
  const int xcd = bid & 7, slot = bid >> 3, nslots = (nb + 7 - xcd) >> 3;
  constexpr int MI1 = 8;
  const int nprompt = 16 * NT;
  const int n_p = slot < nprompt ? (nprompt - slot + nslots - 1) / nslots : 0;
  const int n_s = bid < 2 * NT ? (2 * NT - bid + nb - 1) / nb : 0;
  for (int i_ = 0; i_ < n_p + n_s; i_++) {
    int mt, nt;
    if (i_ < n_p) { int q = slot + i_ * nslots; int sub = q / (8 * NT), rem = q - sub * (8 * NT); nt = rem >> 3; mt = xcd * 16 + sub * 8 + (rem & 7); }
    else { int it = bid + (i_ - n_p) * nb; mt = 128 + it / NT; nt = it - (it / NT) * NT; }
    int m0 = mt * 256, n0 = nt * 128;
    int tid = threadIdx.x; asm volatile("" : "+v"(tid));
    const int lane = tid & 63, w = tid >> 6, wr = w >> 1, wc = w & 1, l16 = lane & 15, quad = lane >> 4;
    f32x4 acc[MI1][4];
#pragma unroll
    for (int i = 0; i < MI1; i++)
#pragma unroll
      for (int j = 0; j < 4; j++) acc[i][j] = f32x4{0.f, 0.f, 0.f, 0.f};
    gemm_loop_sb<MI1, 4>(XB + (size_t)m0 * DM, DM, WT + (size_t)n0 * DM, DM, DM, acc, sA);
    if (noepi) { float t_ = 0.f;
#pragma unroll
      for (int i = 0; i < MI1; i++)
#pragma unroll
        for (int j = 0; j < 4; j++) t_ += acc[i][j][0] + acc[i][j][1] + acc[i][j][2] + acc[i][j][3];
      if (t_ == 12345.678f) p.out[0] = 1.f; continue; }
    const int rbase = m0 + wr * (MI1 * 16) + quad * 4;
    const int cbase = n0 + wc * 64 + l16;
    if (m0 >= TP) {
      float* hs = (float*)(p.ws + OFF_HS);
      bfu* gaS = (bfu*)(p.out + O_YS); bfu* gbS = gaS + (size_t)TS * DM;
#pragma unroll
      for (int mi = 0; mi < MI1; mi++)
#pragma unroll
        for (int j = 0; j < 4; j++) {
          int row = rbase + mi * 16 + j; float rs = rstd1[row]; int sr = row - TP;
#pragma unroll
          for (int ni = 0; ni < 4; ni++) {
            int col = cbase + ni * 16; float v = acc[mi][ni][j] * rs;
            if (n0 >= 4608 && n0 < 5632) gaS[(size_t)sr * DM + col - 4608] = f2bf(v);
            else if (n0 >= 5632 && n0 < 6656) gbS[(size_t)sr * DM + col - 5632] = f2bf(v);
            else hs[(size_t)sr * NWP + col] = v;
          }
        }
      continue;
    }
    const int b = m0 >> 14;
    float* sw = (float*)(smem + EPI_OFF) + w * EPI_WAVE;
    const int rrow = m0 + wr * (MI1 * 16) + (lane >> 2);
    const int rcol = (lane & 3) * 16;
    if (n0 < 1024) {
      const int isK = n0 >= 512; const int head = ((n0 & 511) >> 6) + wc;
      const float l2g = l2gamma(head);
      bfu* dst = (bfu*)(p.ws + (isK ? OFF_KT : OFF_QT));
      bfu* ktT = (bfu*)(p.ws + OFF_KTT);
#pragma unroll
      for (int mi = 0; mi < MI1; mi++) {
        f32x4 tv[4];
#pragma unroll
        for (int ni = 0; ni < 2; ni++) {
          int d = ni * 16 + l16;
          float y1[4], y2[4];
#pragma unroll
          for (int j = 0; j < 4; j++) {
            int row = rbase + mi * 16 + j; int t = row & (SEQ - 1); int l = t & (RC - 1);
            float rs = rstd1[row];
            float dec = exp2f((float)(l + 1) * l2g);
            float sc = isK ? 0.125f / dec : dec;
            float cs, sn; rot_angle(t, d, cs, sn);
            float x1 = acc[mi][ni][j] * rs, x2 = acc[mi][ni + 2][j] * rs;
            y1[j] = (x1 * cs - x2 * sn) * sc; y2[j] = (x2 * cs + x1 * sn) * sc;
            tv[ni][j] = y1[j]; tv[ni + 2][j] = y2[j];
          }
          if (isK) {
            int t0 = (rbase + mi * 16) & (SEQ - 1);
            *(uint2*)(ktT + ((size_t)((b * 8 + head) * 64 + d)) * SEQ + t0) = make_uint2(pack2(y1[0], y1[1]), pack2(y1[2], y1[3]));
            *(uint2*)(ktT + ((size_t)((b * 8 + head) * 64 + d + 32)) * SEQ + t0) = make_uint2(pack2(y2[0], y2[1]), pack2(y2[2], y2[3]));
          }
        }
        { float r[16]; to_rows(tv, r, sw, lane); int rr_ = rrow; asm volatile("" : "+v"(rr_));
          st_bf16x16(dst + (size_t)(rr_ + mi * 16) * 512 + head * 64 + rcol, r); }
      }
    } else if (n0 < 2048) {
      const int head = (n0 - 1024) >> 7;
      bfu* vT = (bfu*)(p.ws + OFF_VT);
#pragma unroll
      for (int mi = 0; mi < MI1; mi++) {
        int row0 = rbase + mi * 16; int t0 = row0 & (SEQ - 1);
        float r0 = rstd1[row0], r1 = rstd1[row0 + 1], r2 = rstd1[row0 + 2], r3 = rstd1[row0 + 3];
#pragma unroll
        for (int ni = 0; ni < 4; ni++) {
          int dv = wc * 64 + ni * 16 + l16;
          *(uint2*)(vT + ((size_t)((b * 8 + head) * 128 + dv)) * SEQ + t0) =
              make_uint2(pack2(acc[mi][ni][0] * r0, acc[mi][ni][1] * r1), pack2(acc[mi][ni][2] * r2, acc[mi][ni][3] * r3));
        }
      }
    } else if (n0 < 3072 || (n0 >= 4608 && n0 < 6656)) {
      bfu* dst; int c0;
      if (n0 < 3072) { dst = (bfu*)(p.ws + OFF_RG); c0 = 2048; }
      else if (n0 < 5632) { dst = (bfu*)(p.out + O_YP); c0 = 4608; }
      else { dst = (bfu*)(p.out + O_YP) + (size_t)TP * DM; c0 = 5632; }
#pragma unroll
      for (int mi = 0; mi < MI1; mi++) {
        f32x4 tv[4];
#pragma unroll
        for (int j = 0; j < 4; j++) {
          int row = rbase + mi * 16 + j; float rs = rstd1[row];
#pragma unroll
          for (int ni = 0; ni < 4; ni++) tv[ni][j] = acc[mi][ni][j] * rs;
        }
        float r[16]; to_rows(tv, r, sw, lane); int rr_ = rrow; asm volatile("" : "+v"(rr_));
        st_bf16x16(dst + (size_t)(rr_ + mi * 16) * DM + (n0 - c0) + wc * 64 + rcol, r);
      }
    } else if (n0 < 4096) {
      const int isK = n0 >= 3584; const int head = (((n0 - 3072) & 511) >> 6) + wc;
      const float* g = isK ? p.fk_g : p.fq_g;
      float gv[4];
#pragma unroll
      for (int ni = 0; ni < 4; ni++) gv[ni] = g[ni * 16 + l16];
      bfu* fq = (bfu*)(p.ws + OFF_FQ); bfu* fkb = (bfu*)(p.ws + OFF_FKB);
#pragma unroll
      for (int mi = 0; mi < MI1; mi++) {
        f32x4 tv[4];
#pragma unroll
        for (int j = 0; j < 4; j++) {
          int row = rbase + mi * 16 + j; float rs = rstd1[row];
          float v[4]; float ss = 0.f;
#pragma unroll
          for (int ni = 0; ni < 4; ni++) { v[ni] = acc[mi][ni][j] * rs; ss += v[ni] * v[ni]; }
          ss = sum16(ss);
          float r = rsqrtf(ss * (1.f / 64.f) + EPSN) * (isK ? 1.f : 0.125f * LOG2E);
#pragma unroll
          for (int ni = 0; ni < 4; ni++) tv[ni][j] = v[ni] * r * gv[ni];
        }
        float r[16]; to_rows(tv, r, sw, lane); int rr_ = rrow; asm volatile("" : "+v"(rr_));
        const size_t o = (size_t)(rr_ + mi * 16) * 512 + head * 64 + rcol;
        if (isK) { st_f32x16(p.out + O_FKP + o, r); st_bf16x16(fkb + o, r); }
        else st_bf16x16(fq + o, r);
      }
    } else if (n0 < 4608) {
      const int head = ((n0 - 4096) >> 6) + wc;
      bfu* fvT = (bfu*)(p.ws + OFF_FVT);
#pragma unroll
      for (int mi = 0; mi < MI1; mi++) {
        int row0 = rbase + mi * 16; int t0 = row0 & (SEQ - 1);
        float r[4] = {rstd1[row0], rstd1[row0 + 1], rstd1[row0 + 2], rstd1[row0 + 3]};
        f32x4 tv[4];
#pragma unroll
        for (int ni = 0; ni < 4; ni++) {
          int d = ni * 16 + l16; float v[4];
#pragma unroll
          for (int j = 0; j < 4; j++) { v[j] = acc[mi][ni][j] * r[j]; tv[ni][j] = v[j]; }
          *(uint2*)(fvT + ((size_t)((b * 8 + head) * 64 + d)) * SEQ + t0) = make_uint2(pack2(v[0], v[1]), pack2(v[2], v[3]));
        }
        { float rw[16]; to_rows(tv, rw, sw, lane); int rr_ = rrow; asm volatile("" : "+v"(rr_));
          st_f32x16(p.out + O_FVP + (size_t)(rr_ + mi * 16) * 512 + head * 64 + rcol, rw); }
      }
    } else {
      if (wc == 0 && l16 < 8) {
        float bf = p.b_f[l16];
#pragma unroll
        for (int mi = 0; mi < MI1; mi++)
#pragma unroll
          for (int j = 0; j < 4; j++) {
            int row = rbase + mi * 16 + j;
            float z = acc[mi][0][j] * rstd1[row] + bf;
            p.out[O_LFP + (size_t)row * 8 + l16] = fminf(z, 0.f) - log1pf(__expf(-fabsf(z)));
          }
      }
    }
  }
}

DEV void phase2(const Params& p, int bid, int nb, char* smem) {
  const int tid = threadIdx.x, lane = tid & 63, w = tid >> 6, wr = w >> 1, wc = w & 1, l16 = lane & 15, quad = lane >> 4;
  bfu* sA = (bfu*)smem; bfu* sB = sA + 128 * 72;
  const bfu* vT = (const bfu*)(p.ws + OFF_VT); const bfu* ktT = (const bfu*)(p.ws + OFF_KTT);
  float* U = (float*)(p.ws + OFF_XB);
  constexpr int NR1 = 16 * NCH;
  for (int it = bid; it < NR1 + 16; it += nb) {
    if (it < 16) {
      int bh = it, b = bh >> 3, h = bh & 7;
      double* sd = (double*)smem;
      const float* lf = p.out + O_LFP + (size_t)b * SEQ * 8 + h;
      float part = 0.f;
      for (int i = 0; i < 64; i++) part += lf[(size_t)(tid * 64 + i) * 8];
      __syncthreads();
      sd[tid] = (double)part;
      __syncthreads();
      if (tid == 0) { double run = 0.0; for (int i = 0; i < 256; i++) { double v = sd[i]; sd[i] = run; run += v; } }
      __syncthreads();
      double run = sd[tid];
      float* c2 = (float*)(p.ws + OFF_C2) + (size_t)bh * SEQ;
      for (int i = 0; i < 64; i++) { run += (double)lf[(size_t)(tid * 64 + i) * 8]; c2[tid * 64 + i] = (float)(run * (double)LOG2E); }
      __syncthreads();
    } else {
      int j = it - 16; int bh = j / NCH, c = j - bh * NCH;
      f32x4 acc[4][2];
#pragma unroll
      for (int i = 0; i < 4; i++) { acc[i][0] = f32x4{0.f, 0.f, 0.f, 0.f}; acc[i][1] = f32x4{0.f, 0.f, 0.f, 0.f}; }
      gemm_loop<4, 2>(vT + (size_t)bh * 128 * SEQ + c * RC, SEQ, ktT + (size_t)bh * 64 * SEQ + c * RC, SEQ, RC, acc, sA);
      float gC = exp2f((float)RC * l2gamma(bh & 7));
      float* Uo = U + (size_t)j * 8192;
#pragma unroll
      for (int mi = 0; mi < 4; mi++)
#pragma unroll
        for (int ni = 0; ni < 2; ni++)
#pragma unroll
          for (int jj = 0; jj < 4; jj++) {
            int dv = wr * 64 + mi * 16 + quad * 4 + jj, dk = wc * 32 + ni * 16 + l16;
            Uo[dv * 64 + dk] = acc[mi][ni][jj] * gC;
          }
    }
  }
}

DEV void sample_item(const Params& p, int item, char* smem) {
  int tid = threadIdx.x; asm volatile("" : "+v"(tid));
  const int pass_sel = item & 1; const int b = item >> 4, h = (item >> 1) & 7;
  float* sq = (float*)smem;
  float* sk = sq + 1024;
  float* sv = sk + 1024;
  float* sP = sv + 2048;
  float* so = sP + 256;
  float* sr = so + 2048;
  float* sc = (float*)smem;
  float* fq = (float*)(smem + 34816);
  float* fk = fq + 1024;
  float* cn = fk + 1024;
  float* suf = cn + 16;
  float* red = suf + 1024;
  float* sL = red + 256;
  float* pvr = sL + 16;
  const float* hs = (const float*)(p.ws + OFF_HS) + (size_t)b * 16 * NWP;
  const float l2g = l2gamma(h);
  __syncthreads();
  if (pass_sel == 0) {
  for (int i = tid; i < 512; i += 256) {
    int l = i >> 5, d = i & 31; float cs, sn; rot_angle(1024 + l, d, cs, sn);
    float dec = exp2f((float)(l + 1) * l2g);
    const float* r = hs + (size_t)l * NWP;
    float x1 = r[h * 64 + d], x2 = r[h * 64 + d + 32];
    sq[l * 64 + d] = (x1 * cs - x2 * sn) * dec; sq[l * 64 + d + 32] = (x2 * cs + x1 * sn) * dec;
    x1 = r[512 + h * 64 + d]; x2 = r[512 + h * 64 + d + 32];
    float sc_ = 0.125f / dec;
    sk[l * 64 + d] = (x1 * cs - x2 * sn) * sc_; sk[l * 64 + d + 32] = (x2 * cs + x1 * sn) * sc_;
  }
  for (int i = tid; i < 2048; i += 256) { int l = i >> 7, dv = i & 127; sv[i] = hs[(size_t)l * NWP + 1024 + h * 128 + dv]; }
  __syncthreads();
  { int l = tid >> 4, m = tid & 15; float a = 0.f;
    if (l >= m) for (int d = 0; d < 64; d++) a += sq[l * 64 + d] * sk[m * 64 + d];
    sP[tid] = a; }
  __syncthreads();
  const float* S = p.state_ret + (size_t)(b * 8 + h) * 8192;
  { int dv = tid & 127, lh = tid >> 7; float o[8];
#pragma unroll
    for (int i = 0; i < 8; i++) o[i] = 0.f;
#pragma unroll 16
    for (int dk = 0; dk < 64; dk++) { float s = S[dk * 128 + dv];
#pragma unroll
      for (int i = 0; i < 8; i++) o[i] += sq[(lh * 8 + i) * 64 + dk] * s; }
    for (int m = 0; m < 16; m++) { float v = sv[m * 128 + dv];
#pragma unroll
      for (int i = 0; i < 8; i++) o[i] += sP[(lh * 8 + i) * 16 + m] * v; }
#pragma unroll
    for (int i = 0; i < 8; i++) so[(lh * 8 + i) * 128 + dv] = o[i];
    float g16 = exp2f(16.f * l2g);
    float* So = p.out + O_SS + (size_t)(b * 8 + h) * 8192;
#pragma unroll 8
    for (int i = 0; i < 32; i++) { int dk = lh * 32 + i; float a = S[dk * 128 + dv];
      for (int m = 0; m < 16; m++) a += sk[m * 64 + dk] * sv[m * 128 + dv];
      So[dk * 128 + dv] = a * g16; }
  }
  __syncthreads();
  if (tid < 16) { float ss = 0.f; for (int i = 0; i < 128; i++) { float v = so[tid * 128 + i]; ss += v * v; } sr[tid] = rsqrtf(ss * (1.f / 128.f) + EPSN); }
  __syncthreads();
  { int dv = tid & 127, lh = tid >> 7; bfu* gated = (bfu*)(p.ws + OFF_RG);
    float gg = p.gn_g[h * 128 + dv];
    for (int i = 0; i < 8; i++) { int l = lh * 8 + i; float rgv = hs[(size_t)l * NWP + 2048 + h * 128 + dv];
      float v = so[l * 128 + dv] * sr[l] * gg * (rgv * sigmoidf_(rgv));
      gated[(size_t)(TP + b * 16 + l) * DM + h * 128 + dv] = f2bf(v); } }
  }
  __syncthreads();
  {
    int l = tid >> 4, dl = tid & 15; const float* r = hs + (size_t)l * NWP;
    float qv[4], kv[4]; float sq_ = 0.f, sk_ = 0.f;
#pragma unroll
    for (int i = 0; i < 4; i++) { qv[i] = r[3072 + h * 64 + dl * 4 + i]; kv[i] = r[3584 + h * 64 + dl * 4 + i]; sq_ += qv[i] * qv[i]; sk_ += kv[i] * kv[i]; }
    sq_ = sum16(sq_); sk_ = sum16(sk_);
    float rq = rsqrtf(sq_ * (1.f / 64.f) + EPSN), rk = rsqrtf(sk_ * (1.f / 64.f) + EPSN);
#pragma unroll
    for (int i = 0; i < 4; i++) { int d = dl * 4 + i;
      fq[l * 64 + d] = qv[i] * rq * p.fq_g[d] * 0.125f;
      float kk = kv[i] * rk * p.fk_g[d]; fk[l * 64 + d] = kk;
      p.out[O_FKS + (size_t)((b * 16 + l) * 8 + h) * 64 + d] = kk;
      p.out[O_FVS + (size_t)((b * 16 + l) * 8 + h) * 64 + d] = r[4096 + h * 64 + d]; }
  }
  if (tid < 16) { float z = hs[(size_t)tid * NWP + 6656 + h] + p.b_f[h]; float lf = fminf(z, 0.f) - log1pf(__expf(-fabsf(z)));
    p.out[O_LFS + (size_t)(b * 16 + tid) * 8 + h] = lf; cn[tid] = lf; }
  { const float* cl = p.clogf + (size_t)b * 1024 * 8 + h; float v[4]; float part = 0.f;
#pragma unroll
    for (int i = 0; i < 4; i++) { v[i] = cl[(size_t)(tid * 4 + i) * 8]; part += v[i]; }
    float inc = part;
#pragma unroll
    for (int o = 1; o < 64; o <<= 1) { float t = __shfl_down(inc, o); if ((tid & 63) + o < 64) inc += t; }
    if ((tid & 63) == 0) red[tid >> 6] = inc;
    __syncthreads();
    if (tid == 0) { float c = 0.f; for (int i = 0; i < 16; i++) { c += cn[i]; cn[i] = c; } }
    float later = 0.f;
    for (int ww = (tid >> 6) + 1; ww < 4; ww++) later += red[ww];
    __syncthreads();
    float run = inc - part + later;
    for (int i = 3; i >= 0; i--) { suf[tid * 4 + i] = run; run += v[i]; }
  }
  __syncthreads();
  const float* CK = p.ck + (size_t)b * 1024 * 512 + h * 64; const float* CV = p.cv + (size_t)b * 1024 * 512 + h * 64;
  int p_start = 0;
  { float gqm = 0.f, gkm = 0.f;
    for (int i = 0; i < 64; i++) { gqm = fmaxf(gqm, fabsf(p.fq_g[i])); gkm = fmaxf(gkm, fabsf(p.fk_g[i])); }
    const float thr_ln = 30.f + 2.f * 8.f * gqm * gkm * 1.03f;
#pragma unroll
    for (int i = 0; i < 4; i++) p_start += __syncthreads_count(suf[tid * 4 + i] < -thr_ln); }
  for (int pass = pass_sel; pass <= pass_sel; pass++) {
    __syncthreads();
    for (int j = p_start + tid; j < 1040; j += 256) {
      float a[8];
#pragma unroll
      for (int qi = 0; qi < 8; qi++) a[qi] = 0.f;
      if (j < 1024) {
        const f32x4* kp = (const f32x4*)(CK + (size_t)j * 512);
        f32x4 tt[16];
#pragma unroll
        for (int i = 0; i < 16; i++) tt[i] = kp[i];
#pragma unroll
        for (int i = 0; i < 16; i++) { f32x4 t = tt[i];
#pragma unroll
          for (int qi = 0; qi < 8; qi++) { const float* qq = fq + (pass * 8 + qi) * 64 + i * 4; a[qi] += qq[0] * t[0] + qq[1] * t[1] + qq[2] * t[2] + qq[3] * t[3]; } }
      } else {
        const float* kp = fk + (j - 1024) * 64;
#pragma unroll 4
        for (int i = 0; i < 64; i++) { float t = kp[i];
#pragma unroll
          for (int qi = 0; qi < 8; qi++) a[qi] += fq[(pass * 8 + qi) * 64 + i] * t; }
      }
#pragma unroll
      for (int qi = 0; qi < 8; qi++) { int q = pass * 8 + qi;
        float bias;
        if (j < 1024) bias = suf[j] + cn[q]; else { int m = j - 1024; bias = (m <= q) ? (cn[q] - cn[m]) : -INFINITY; }
        sc[qi * 1040 + j] = a[qi] + bias; }
    }
    __syncthreads();
    { int qi = tid >> 5, l32 = tid & 31; float m = -INFINITY;
      for (int j = p_start + l32; j < 1040; j += 32) m = fmaxf(m, sc[qi * 1040 + j]);
#pragma unroll
      for (int o = 16; o >= 1; o >>= 1) m = fmaxf(m, __shfl_xor(m, o));
      float s = 0.f;
      for (int j = p_start + l32; j < 1040; j += 32) { float e = __expf(sc[qi * 1040 + j] - m); sc[qi * 1040 + j] = e; s += e; }
#pragma unroll
      for (int o = 16; o >= 1; o >>= 1) s += __shfl_xor(s, o);
      if (l32 == 0) sL[qi] = s; }
    __syncthreads();
    {
      const int kg = tid >> 4, d4 = (tid & 15) * 4;
      float ac[8][4];
#pragma unroll
      for (int qi = 0; qi < 8; qi++) { ac[qi][0] = 0.f; ac[qi][1] = 0.f; ac[qi][2] = 0.f; ac[qi][3] = 0.f; }
#pragma unroll 8
      for (int j = p_start + kg; j < 1024; j += 16) {
        float4 v = *(const float4*)(CV + (size_t)j * 512 + d4);
#pragma unroll
        for (int qi = 0; qi < 8; qi++) { float pj = sc[qi * 1040 + j]; ac[qi][0] += pj * v.x; ac[qi][1] += pj * v.y; ac[qi][2] += pj * v.z; ac[qi][3] += pj * v.w; } }
      { const float* r = hs + (size_t)kg * NWP + 4096 + h * 64 + d4;
#pragma unroll
        for (int qi = 0; qi < 8; qi++) { float pj = sc[qi * 1040 + 1024 + kg]; ac[qi][0] += pj * r[0]; ac[qi][1] += pj * r[1]; ac[qi][2] += pj * r[2]; ac[qi][3] += pj * r[3]; } }
#pragma unroll
      for (int qi = 0; qi < 8; qi++)
#pragma unroll
        for (int c = 0; c < 4; c++) { float t = ac[qi][c]; t += __shfl_xor(t, 16); t += __shfl_xor(t, 32); ac[qi][c] = t; }
      if ((tid & 63) < 16) {
#pragma unroll
        for (int qi = 0; qi < 8; qi++)
#pragma unroll
          for (int c = 0; c < 4; c++) pvr[((tid >> 6) * 8 + qi) * 64 + d4 + c] = ac[qi][c];
      }
      __syncthreads();
      int qi = tid >> 5, d2 = (tid & 31) * 2;
      float a0 = pvr[(0 * 8 + qi) * 64 + d2] + pvr[(1 * 8 + qi) * 64 + d2] + pvr[(2 * 8 + qi) * 64 + d2] + pvr[(3 * 8 + qi) * 64 + d2];
      float a1 = pvr[(0 * 8 + qi) * 64 + d2 + 1] + pvr[(1 * 8 + qi) * 64 + d2 + 1] + pvr[(2 * 8 + qi) * 64 + d2 + 1] + pvr[(3 * 8 + qi) * 64 + d2 + 1];
      float inv = 1.f / sL[qi]; bfu* fo = (bfu*)(p.ws + OFF_FQ);
      *(unsigned*)(fo + (size_t)(TP + b * 16 + pass * 8 + qi) * 512 + h * 64 + d2) = pack2(a0 * inv, a1 * inv); }
  }
  __syncthreads();
}

DEV void peer_convert_item(const Params& p, int item) {
  const int tid = threadIdx.x, lane = tid & 63, w = tid >> 6;
  f32x4 v[4][4];
#pragma unroll
  for (int k = 0; k < 4; k++) {
    const int r = item * 16 + w * 4 + k;
    const float* src = r < 16384 ? p.peer_u + (size_t)r * DM : p.peer_v + (size_t)(r - 16384) * DM;
#pragma unroll
    for (int c = 0; c < 4; c++) v[k][c] = *(const f32x4*)(src + lane * 16 + c * 4);
  }
#pragma unroll
  for (int k = 0; k < 4; k++) {
    const int r = item * 16 + w * 4 + k;
    float am = 0.f;
#pragma unroll
    for (int c = 0; c < 4; c++)
#pragma unroll
      for (int e = 0; e < 4; e++) am = fmaxf(am, fabsf(v[k][c][e]));
#pragma unroll
    for (int o = 32; o >= 1; o >>= 1) am = fmaxf(am, __shfl_xor(am, o));
    const float sc = am > 0.f ? 6.f / am : 1.f;
    unsigned w0 = 0, w1 = 0;
    w0 = __builtin_amdgcn_cvt_scalef32_pk_fp4_f32(w0, v[k][0][0] * sc, v[k][0][1] * sc, 1.0f, 0);
    w0 = __builtin_amdgcn_cvt_scalef32_pk_fp4_f32(w0, v[k][0][2] * sc, v[k][0][3] * sc, 1.0f, 1);
    w0 = __builtin_amdgcn_cvt_scalef32_pk_fp4_f32(w0, v[k][1][0] * sc, v[k][1][1] * sc, 1.0f, 2);
    w0 = __builtin_amdgcn_cvt_scalef32_pk_fp4_f32(w0, v[k][1][2] * sc, v[k][1][3] * sc, 1.0f, 3);
    w1 = __builtin_amdgcn_cvt_scalef32_pk_fp4_f32(w1, v[k][2][0] * sc, v[k][2][1] * sc, 1.0f, 0);
    w1 = __builtin_amdgcn_cvt_scalef32_pk_fp4_f32(w1, v[k][2][2] * sc, v[k][2][3] * sc, 1.0f, 1);
    w1 = __builtin_amdgcn_cvt_scalef32_pk_fp4_f32(w1, v[k][3][0] * sc, v[k][3][1] * sc, 1.0f, 2);
    w1 = __builtin_amdgcn_cvt_scalef32_pk_fp4_f32(w1, v[k][3][2] * sc, v[k][3][3] * sc, 1.0f, 3);
    u32x2* dst = (u32x2*)(p.ws + (r < 16384 ? OFF_PUB : OFF_PVB)) + (size_t)(r & 16383) * 64 + lane;
    *dst = u32x2{w0, w1};
    if (lane == 0) ((float*)(p.ws + OFF_PSC))[r] = am > 0.f ? am / 6.f : 1.f;
  }
}

DEV void phase3(const Params& p, int bid, int nb, char* smem) {
  const int tid = threadIdx.x;
  const float* U = (const float*)(p.ws + OFF_XB); bfu* SST = (bfu*)(p.ws + OFF_SST);
  for (int it = bid; it < 2048; it += nb) peer_convert_item(p, it);
  for (int it = bid; it < 512 + 512; it += nb) {
    if (it < 512) { sample_item(p, it, smem); continue; }
    int g = (it - 512) * 256 + tid; int bh = g >> 13, e = g & 8191;
    float G = exp2f((float)RC * l2gamma(bh & 7));
    float s = 0.f;
    const float* Up = U + (size_t)bh * NCH * 8192 + e; bfu* Sp = SST + (size_t)bh * NCH * 8192 + e;
    Sp[0] = 0;
    for (int c0 = 0; c0 < NCH; c0 += 8) {
      float u[8];
#pragma unroll
      for (int i = 0; i < 8; i++) u[i] = Up[(size_t)(c0 + i) * 8192];
#pragma unroll
      for (int i = 0; i < 8; i++) { s = s * G + u[i]; if (c0 + i + 1 < NCH) Sp[(size_t)(c0 + i + 1) * 8192] = f2bf(s); }
    }
    int dv = e >> 6, dk = e & 63;
    p.out[O_SP + (size_t)bh * 8192 + dk * 128 + dv] = s;
  }
}

DEV void attn_item(const Params& p, int item, char* smem, float thr, bool dry) {
  const int tid = threadIdx.x, lane = tid & 63, w = tid >> 6, r32 = lane & 31, hi = lane >> 5;
  const int bh = item >> 7, qt = 127 - (item & 127);
  const int b = bh >> 3, h = bh & 7;
  const int q0 = qt * 128;
  bfu* sK = (bfu*)smem;
  bfu* sV = sK + 64 * 72;
  float* sC = (float*)(sV + 64 * 72);
  const float* c2 = (const float*)(p.ws + OFF_C2) + (size_t)bh * SEQ;
  bfu* FQ = (bfu*)(p.ws + OFF_FQ);
  const bfu* FKB = (const bfu*)(p.ws + OFF_FKB) + (size_t)b * SEQ * 512 + h * 64;
  const bfu* FVT = (const bfu*)(p.ws + OFF_FVT) + (size_t)bh * 64 * SEQ;
  const int jd0 = q0 >> 6;
  int pred = 0;
  if (tid < jd0) pred = (c2[q0] - c2[tid * 64 + 63]) < -thr;
  const int jstart = __syncthreads_count(pred);
  const int qrow = q0 + w * 32 + r32;
  bf16x8 qf[4];
  const bfu* qp = FQ + (size_t)(b * SEQ + qrow) * 512 + h * 64 + hi * 8;
#pragma unroll
  for (int d0 = 0; d0 < 4; d0++) qf[d0] = *(const bf16x8*)(qp + d0 * 16);
  const float cq = c2[qrow];
  float m = -INFINITY, lsum = 0.f;
  f32x16 o0, o1;
#pragma unroll
  for (int r = 0; r < 16; r++) { o0[r] = 0.f; o1[r] = 0.f; }
  u32x4 rk0, rk1, rv0, rv1; float rc = 0.f;
  const int srow = tid >> 3, sch = tid & 7;
#define ATT_GLOAD(j_) do { \
    rk0 = *(const u32x4*)(FKB + (size_t)((j_) * 64 + srow) * 512 + sch * 8); \
    rk1 = *(const u32x4*)(FKB + (size_t)((j_) * 64 + srow + 32) * 512 + sch * 8); \
    rv0 = *(const u32x4*)(FVT + (size_t)srow * SEQ + (j_) * 64 + sch * 8); \
    rv1 = *(const u32x4*)(FVT + (size_t)(srow + 32) * SEQ + (j_) * 64 + sch * 8); \
    if (tid < 64) rc = c2[(j_) * 64 + tid]; } while (0)
  ATT_GLOAD(jstart);
  for (int j = jstart; j <= jd0 + 1; j++) {
    __syncthreads();
    *(u32x4*)(sK + srow * 72 + sch * 8) = rk0; *(u32x4*)(sK + (srow + 32) * 72 + sch * 8) = rk1;
    *(u32x4*)(sV + srow * 72 + sch * 8) = rv0; *(u32x4*)(sV + (srow + 32) * 72 + sch * 8) = rv1;
    if (tid < 64) sC[tid] = rc;
    __syncthreads();
    if (j < jd0 + 1) ATT_GLOAD(j + 1);
    if (j * 64 > q0 + w * 32 + 31) continue;
    f32x16 s0, s1;
#pragma unroll
    for (int r = 0; r < 16; r++) { s0[r] = 0.f; s1[r] = 0.f; }
#pragma unroll
    for (int d0 = 0; d0 < 4; d0++) {
      bf16x8 k0 = *(const bf16x8*)(sK + r32 * 72 + d0 * 16 + hi * 8);
      bf16x8 k1 = *(const bf16x8*)(sK + (32 + r32) * 72 + d0 * 16 + hi * 8);
      s0 = __builtin_amdgcn_mfma_f32_32x32x16_bf16(k0, qf[d0], s0, 0, 0, 0);
      s1 = __builtin_amdgcn_mfma_f32_32x32x16_bf16(k1, qf[d0], s1, 0, 0, 0);
    }
    const bool diag = (j >= jd0);
    const int kbase = j * 64 + 4 * hi;
    float mloc = -INFINITY;
#pragma unroll
    for (int g = 0; g < 4; g++) {
      float4 c0 = *(const float4*)(sC + 8 * g + 4 * hi), c1 = *(const float4*)(sC + 32 + 8 * g + 4 * hi);
      float cc0[4] = {c0.x, c0.y, c0.z, c0.w}, cc1[4] = {c1.x, c1.y, c1.z, c1.w};
#pragma unroll
      for (int e = 0; e < 4; e++) {
        int r = g * 4 + e;
        float a = s0[r] + (cq - cc0[e]), bb = s1[r] + (cq - cc1[e]);
        if (diag) { int key = kbase + 8 * g + e; if (key > qrow) a = -INFINITY; if (key + 32 > qrow) bb = -INFINITY; }
        s0[r] = a; s1[r] = bb; mloc = fmaxf(mloc, fmaxf(a, bb));
      }
    }
    mloc = fmaxf(mloc, __shfl_xor(mloc, 32));
    float mn = fmaxf(m, mloc);
    float alpha = __builtin_amdgcn_exp2f(m - mn);
    m = mn;
    float ps = 0.f;
#pragma unroll
    for (int r = 0; r < 16; r++) { s0[r] = __builtin_amdgcn_exp2f(s0[r] - mn); s1[r] = __builtin_amdgcn_exp2f(s1[r] - mn); ps += s0[r] + s1[r]; }
    lsum = lsum * alpha + ps;
#pragma unroll
    for (int r = 0; r < 16; r++) { o0[r] *= alpha; o1[r] *= alpha; }
#pragma unroll
    for (int ks = 0; ks < 4; ks++) {
      union { bf16x8 v; unsigned u[4]; } pf;
#pragma unroll
      for (int e = 0; e < 4; e++) {
        int r = (ks & 1) * 8 + 2 * e;
        pf.u[e] = (ks < 2) ? pack2(s0[r], s0[r + 1]) : pack2(s1[r], s1[r + 1]);
      }
#pragma unroll
      for (int db = 0; db < 2; db++) {
        const bfu* vp = sV + (db * 32 + r32) * 72 + ks * 16 + 4 * hi;
        union { bf16x8 v; uint2 u[2]; } vf;
        vf.u[0] = *(const uint2*)vp; vf.u[1] = *(const uint2*)(vp + 8);
        if (db == 0) o0 = __builtin_amdgcn_mfma_f32_32x32x16_bf16(vf.v, pf.v, o0, 0, 0, 0);
        else o1 = __builtin_amdgcn_mfma_f32_32x32x16_bf16(vf.v, pf.v, o1, 0, 0, 0);
      }
    }
  }
  float lt = lsum + __shfl_xor(lsum, 32);
  float inv = 1.f / lt;
  bfu* op = (dry ? (bfu*)(p.ws + OFF_XB) : FQ) + (size_t)(b * SEQ + qrow) * 512 + h * 64;
#pragma unroll
  for (int g = 0; g < 4; g++) {
    *(uint2*)(op + 8 * g + 4 * hi) = make_uint2(pack2(o0[g * 4] * inv, o0[g * 4 + 1] * inv), pack2(o0[g * 4 + 2] * inv, o0[g * 4 + 3] * inv));
    *(uint2*)(op + 32 + 8 * g + 4 * hi) = make_uint2(pack2(o1[g * 4] * inv, o1[g * 4 + 1] * inv), pack2(o1[g * 4 + 2] * inv, o1[g * 4 + 3] * inv));
  }
  __syncthreads();
}

DEV void r3_item(const Params& p, int item, char* smem, bool dry) {
  const int tid = threadIdx.x, lane = tid & 63, w = tid >> 6, wr = w >> 1, wc = w & 1, l16 = lane & 15, quad = lane >> 4;
  const int bh = item / NCH, c = item - bh * NCH; const int b = bh >> 3, h = bh & 7;
  bfu* sQ = (bfu*)smem; bfu* sK = sQ + 128 * 72; bfu* sP = sK + 128 * 72; float* sRed = (float*)(sP + 128 * 136);
  const size_t row0 = (size_t)b * SEQ + c * RC;
  const bfu* Q = (const bfu*)(p.ws + OFF_QT) + row0 * 512 + h * 64;
  const bfu* Kk = (const bfu*)(p.ws + OFF_KT) + row0 * 512 + h * 64;
  const bfu* vT = (const bfu*)(p.ws + OFF_VT) + (size_t)bh * 128 * SEQ + c * RC;
  const bfu* ST = (const bfu*)(p.ws + OFF_SST) + (size_t)item * 8192;
  u32x4 ra[4], rb[4];
  g2r<128>(Q, 512, ra); g2r<128>(Kk, 512, rb);
  __syncthreads();
  r2s<128>(sQ, ra); r2s<128>(sK, rb);
  __syncthreads();
  g2r<128>(vT, SEQ, rb);
  f32x4 acc[4][4];
#pragma unroll
  for (int i = 0; i < 4; i++)
#pragma unroll
    for (int j = 0; j < 4; j++) acc[i][j] = f32x4{0.f, 0.f, 0.f, 0.f};
  mma64<4, 4>(sQ, 72, sK, 72, acc);
#pragma unroll
  for (int mi = 0; mi < 4; mi++)
#pragma unroll
    for (int ni = 0; ni < 4; ni++)
#pragma unroll
      for (int j = 0; j < 4; j++) {
        int row = wr * 64 + mi * 16 + quad * 4 + j, col = wc * 64 + ni * 16 + l16;
        sP[row * 136 + col] = (col <= row) ? f2bf(acc[mi][ni][j]) : (bfu)0;
      }
#pragma unroll
  for (int i = 0; i < 4; i++)
#pragma unroll
    for (int j = 0; j < 4; j++) acc[i][j] = f32x4{0.f, 0.f, 0.f, 0.f};
  __syncthreads();
  r2s<128>(sK, rb);
  __syncthreads();
  g2r<128>(vT + 64, SEQ, rb);
  mma64<4, 4>(sP, 136, sK, 72, acc);
  __syncthreads();
  r2s<128>(sK, rb);
  __syncthreads();
  g2r<128>(ST, 64, rb);
  mma64<4, 4>(sP + 64, 136, sK, 72, acc);
  __syncthreads();
  r2s<128>(sK, rb);
  __syncthreads();
  mma64<4, 4>(sQ, 72, sK, 72, acc);
  float ssq[4][4];
#pragma unroll
  for (int mi = 0; mi < 4; mi++)
#pragma unroll
    for (int j = 0; j < 4; j++) { float s = 0.f;
#pragma unroll
      for (int ni = 0; ni < 4; ni++) s += acc[mi][ni][j] * acc[mi][ni][j];
      s = sum16(s); ssq[mi][j] = s;
      if (l16 == 0) sRed[(wr * 64 + mi * 16 + quad * 4 + j) * 2 + wc] = s; }
  __syncthreads();
  bfu* RG = (bfu*)(p.ws + OFF_RG);
  float gg[4];
#pragma unroll
  for (int ni = 0; ni < 4; ni++) gg[ni] = p.gn_g[h * 128 + wc * 64 + ni * 16 + l16];
  float* sw = (float*)smem + w * EPI_WAVE;
#pragma unroll
  for (int mi = 0; mi < 4; mi++) {
    f32x4 tv[4];
#pragma unroll
    for (int j = 0; j < 4; j++) {
      int row = wr * 64 + mi * 16 + quad * 4 + j;
      float tot = sRed[row * 2] + sRed[row * 2 + 1];
      float r = rsqrtf(tot * (1.f / 128.f) + EPSN);
#pragma unroll
      for (int ni = 0; ni < 4; ni++) tv[ni][j] = acc[mi][ni][j] * r * gg[ni];
    }
    float rw[16], g[16]; to_rows(tv, rw, sw, lane);
    int rr_ = lane >> 2; asm volatile("" : "+v"(rr_));
    const size_t o = (row0 + wr * 64 + mi * 16 + rr_) * DM + h * 128 + wc * 64 + (lane & 3) * 16;
    ld_bf16x16(RG + o, g);
#pragma unroll
    for (int e = 0; e < 16; e++) rw[e] *= g[e] * sigmoidf_(g[e]);
    st_bf16x16(dry ? (bfu*)(p.ws + OFF_XB) + (o & 0xffffff) : RG + o, rw);
  }
  __syncthreads();
}

DEV void phase4(const Params& p, int bid, int nb, char* smem, bool dry = false) {
  float gq = 0.f, gk = 0.f;
  for (int i = 0; i < 64; i++) { gq = fmaxf(gq, fabsf(p.fq_g[i])); gk = fmaxf(gk, fabsf(p.fk_g[i])); }
  const float thr = 2.f * (8.f * gq * gk * 1.03f * LOG2E) + 44.f;
  for (int it = bid; it < 2048 + 16 * NCH; it += nb) {
    if (it < 2048) attn_item(p, it, smem, thr, dry); else r3_item(p, it - 2048, smem, dry);
  }
}

DEV void phase5(const Params& p, int bid, int nb, char* smem) {
  const int tid = threadIdx.x, lane = tid & 63, w = tid >> 6, wr = w >> 1, wc = w & 1, l16 = lane & 15, quad = lane >> 4;
  bfu* sA = (bfu*)smem; bfu* sB = sA + 128 * 72;
  const bfu* G = (const bfu*)(p.ws + OFF_RG); const bfu* FO = (const bfu*)(p.ws + OFF_FQ);
  const bfu* WR = (const bfu*)(p.ws + OFF_WRT); const bfu* WF = (const bfu*)(p.ws + OFF_WFT);
  bfu* MX = (bfu*)(p.ws + OFF_XB);
  constexpr int NG = (TT / 128) * 8, NCV = 8192;
  const int xcd = bid & 7, slot = bid >> 3, nslots = (nb + 7 - xcd) >> 3;
  const int n_p = slot < 128 ? (128 - slot + nslots - 1) / nslots : 0;
  for (int i_ = 0; i_ < n_p; i_++) {
    int q = slot + i_ * nslots; int mt = xcd * 16 + (q >> 3), nt = q & 7;
    int m0 = mt * 256, n0 = nt * 128;
    int tid2 = threadIdx.x; asm volatile("" : "+v"(tid2));
    const int lane2 = tid2 & 63, w2 = tid2 >> 6, wr2 = w2 >> 1, wc2 = w2 & 1, l162 = lane2 & 15, quad2 = lane2 >> 4;
    f32x4 a1[8][4];
#pragma unroll
    for (int i = 0; i < 8; i++)
#pragma unroll
      for (int j = 0; j < 4; j++) a1[i][j] = f32x4{0.f, 0.f, 0.f, 0.f};
    gemm_loop_sb<8, 4>(G + (size_t)m0 * DM, DM, WR + (size_t)n0 * DM, DM, DM, a1, sA);
    const bfu* ga = (const bfu*)(p.out + O_YP); const bfu* gb = ga + (size_t)TP * DM;
    float* sw = (float*)(smem + EPI_OFF) + w2 * EPI_WAVE;
    const int rr = lane2 >> 2, c0 = wc2 * 64 + (lane2 & 3) * 16;
#pragma unroll
    for (int mi = 0; mi < 8; mi++) {
      float r[16], g[16]; to_rows(a1[mi], r, sw, lane2);
      int rr_ = rr; asm volatile("" : "+v"(rr_));
      const size_t o = (size_t)(m0 + wr2 * 128 + mi * 16 + rr_) * DM + n0 + c0;
      ld_bf16x16(ga + o, g);
#pragma unroll
      for (int e = 0; e < 16; e++) r[e] *= sigmoidf_(g[e]);
      st_bf16x16(MX + o, r);
#pragma unroll
      for (int ni = 0; ni < 4; ni++) a1[mi][ni] = f32x4{0.f, 0.f, 0.f, 0.f};
    }
    gemm_loop_sb<8, 4>(FO + (size_t)m0 * 512, 512, WF + (size_t)n0 * 512, 512, 512, a1, sA);
#pragma unroll
    for (int mi = 0; mi < 8; mi++) {
      float r[16], g[16], m[16]; to_rows(a1[mi], r, sw, lane2);
      int rr_ = rr; asm volatile("" : "+v"(rr_));
      const size_t o = (size_t)(m0 + wr2 * 128 + mi * 16 + rr_) * DM + n0 + c0;
      ld_bf16x16(gb + o, g); ld_bf16x16(MX + o, m);
#pragma unroll
      for (int e = 0; e < 16; e++) r[e] = m[e] + sigmoidf_(g[e]) * r[e];
      st_bf16x16(MX + o, r);
    }
  }
  if (bid < 128) {
    int nt = bid & 7;
    int m0 = TP + (bid >> 3) * 32, n0 = nt * 128;
    f32x4 a1[1][4];
#pragma unroll
    for (int j = 0; j < 4; j++) a1[0][j] = f32x4{0.f, 0.f, 0.f, 0.f};
    gemm_loop<1, 4>(G + (size_t)m0 * DM, DM, WR + (size_t)n0 * DM, DM, DM, a1, sA);
    const bfu* ga = (const bfu*)(p.out + O_YS) + (size_t)(m0 - TP) * DM + n0; const bfu* gb = ga + (size_t)TS * DM;
    bfu* mxT = MX + (size_t)m0 * DM + n0;
    unsigned loff = (unsigned)((wr * 16 + quad * 4) * DM + wc * 64 + l16); asm volatile("" : "+v"(loff));
#pragma unroll
    for (int ni = 0; ni < 4; ni++) {
#pragma unroll
      for (int j = 0; j < 4; j++) { unsigned o = loff + (unsigned)(j * DM + ni * 16);
        mxT[o] = f2bf(sigmoidf_(bf2f(ga[o])) * a1[0][ni][j]); }
      a1[0][ni] = f32x4{0.f, 0.f, 0.f, 0.f};
    }
    gemm_loop<1, 4>(FO + (size_t)m0 * 512, 512, WF + (size_t)n0 * 512, 512, 512, a1, sA);
    unsigned loff2 = loff; asm volatile("" : "+v"(loff2));
#pragma unroll
    for (int ni = 0; ni < 4; ni++) {
#pragma unroll
      for (int j = 0; j < 4; j++) { unsigned o = loff2 + (unsigned)(j * DM + ni * 16);
        mxT[o] = f2bf(bf2f(mxT[o]) + sigmoidf_(bf2f(gb[o])) * a1[0][ni][j]); }
    }
  }
}

DEV void phase6(const Params& p, int bid, int nb, char* smem) {
  bfu* sA = (bfu*)smem;
  const bfu* MX = (const bfu*)(p.ws + OFF_XB); const bfu* WO = (const bfu*)(p.ws + OFF_WOT);
  bfu* X1B = (bfu*)(p.ws + OFF_X1B); float* SSQ2 = (float*)(p.ws + OFF_SSQ2);
  const int xcd = bid & 7, slot = bid >> 3, nslots = (nb + 7 - xcd) >> 3;
  const int n_p = slot < 128 ? (128 - slot + nslots - 1) / nslots : 0;
  for (int i_ = 0; i_ < n_p; i_++) {
    int q = slot + i_ * nslots; int mt = xcd * 16 + (q >> 3), nt = q & 7;
    int m0 = mt * 256, n0 = nt * 128;
    int tid = threadIdx.x; asm volatile("" : "+v"(tid));
    const int lane = tid & 63, w = tid >> 6, wr = w >> 1, wc = w & 1, l16 = lane & 15, quad = lane >> 4;
    f32x4 acc[8][4];
#pragma unroll
    for (int i = 0; i < 8; i++)
#pragma unroll
      for (int j = 0; j < 4; j++) acc[i][j] = f32x4{0.f, 0.f, 0.f, 0.f};
    gemm_loop_sb<8, 4>(MX + (size_t)m0 * DM, DM, WO + (size_t)n0 * DM, DM, DM, acc, sA);
    float* sw = (float*)(smem + EPI_OFF) + w * EPI_WAVE;
    const int rr = lane >> 2, c0 = wc * 64 + (lane & 3) * 16;
#pragma unroll
    for (int mi = 0; mi < 8; mi++) {
      float r[16]; to_rows(acc[mi], r, sw, lane);
      int rr_ = rr; asm volatile("" : "+v"(rr_));
      const size_t o = (size_t)(m0 + wr * 128 + mi * 16 + rr_) * DM + n0 + c0;
      const float* xp = (m0 < TP ? p.x_p : p.x_s - (size_t)TP * DM) + o;
      float ss = 0.f;
#pragma unroll
      for (int c = 0; c < 4; c++) { f32x4 xv = *(const f32x4*)(xp + 4 * c);
#pragma unroll
        for (int e = 0; e < 4; e++) { r[4 * c + e] += xv[e]; ss += r[4 * c + e] * r[4 * c + e]; } }
      st_f32x16(p.out + O_YP + o, r);
      st_bf16x16(X1B + o, r);
      ss += __shfl_xor(ss, 1); ss += __shfl_xor(ss, 2);
      if ((lane & 3) == 0) SSQ2[(size_t)(m0 + wr * 128 + mi * 16 + rr) * 16 + nt * 2 + wc] = ss;
    }
  }
  if (bid < 128) {
    const int tid = threadIdx.x, lane = tid & 63, w = tid >> 6, wr = w >> 1, wc = w & 1, l16 = lane & 15, quad = lane >> 4;
    int nt = bid & 7;
    int m0 = TP + (bid >> 3) * 32, n0 = nt * 128;
    f32x4 acc[1][4];
#pragma unroll
    for (int j = 0; j < 4; j++) acc[0][j] = f32x4{0.f, 0.f, 0.f, 0.f};
    gemm_loop<1, 4>(MX + (size_t)m0 * DM, DM, WO + (size_t)n0 * DM, DM, DM, acc, sA);
    const float* xin = p.x_s + (size_t)(m0 - TP) * DM + n0;
    float* y = p.out + O_YS + (size_t)(m0 - TP) * DM + n0;
    bfu* xb1 = X1B + (size_t)m0 * DM + n0;
    unsigned loff = (unsigned)((wr * 16 + quad * 4) * DM + wc * 64 + l16); asm volatile("" : "+v"(loff));
#pragma unroll
    for (int j = 0; j < 4; j++) {
      int lr = wr * 16 + quad * 4 + j; float ss = 0.f;
#pragma unroll
      for (int ni = 0; ni < 4; ni++) {
        unsigned o = loff + (unsigned)(j * DM + ni * 16);
        float v = xin[o] + acc[0][ni][j];
        y[o] = v; xb1[o] = f2bf(v); ss += v * v;
      }
      ss = sum16(ss);
      if (l16 == 0) (SSQ2 + (size_t)m0 * 16 + nt * 2)[(unsigned)(lr * 16 + wc)] = ss;
    }
  }
}

DEV int fkey(float x, int idx, int mask) { int b = __float_as_int(x); b ^= (b >> 31) & 0x7fffffff; return (b & ~mask) | idx; }
DEV void ins16(int (&t)[16], int v) {
#pragma unroll
  for (int s = 0; s < 16; s++) { int hi = max(t[s], v); v = min(t[s], v); t[s] = hi; }
}

DEV void phase7(const Params& p, int bid, int nb, char* smem) {
  const int tid = threadIdx.x, lane = tid & 63, w = tid >> 6, wr = w >> 1, wc = w & 1, l16 = lane & 15, quad = lane >> 4;
  bfu* sA = (bfu*)smem;
  float* sS = (float*)smem;
  int* sL = (int*)(smem + 33024);
  float* sTV = (float*)(smem + 55296);
  int* sTI = (int*)(sTV + 2 * 64 * 17);
  const bfu* X1B = (const bfu*)(p.ws + OFF_X1B); const bfu* MT = (const bfu*)(p.ws + OFF_MT);
  const float* SSQ2 = (const float*)(p.ws + OFF_SSQ2);
  int2* ROUTE = (int2*)(p.ws + OFF_ROUTE);
  constexpr int NI7 = (TT / 64) * 8;
  const int xcd = bid & 7, slot = bid >> 3, nslots = (nb + 7 - xcd) >> 3;
  for (int q = slot; q < 520; q += nslots) {
    int hg = q / 260, q2 = q - hg * 260; int mt = xcd * 65 + (q2 >> 2), h = hg * 4 + (q2 & 3); int m0 = mt * 64;
    for (int half = 0; half < 2; half++) {
      f32x4 acc[2][4];
#pragma unroll
      for (int i = 0; i < 2; i++)
#pragma unroll
        for (int j = 0; j < 4; j++) acc[i][j] = f32x4{0.f, 0.f, 0.f, 0.f};
      gemm_loop<2, 4>(X1B + (size_t)m0 * DM, DM, MT + (size_t)(h * 256 + half * 128) * DM, DM, DM, acc, sA);
      __syncthreads();
#pragma unroll
      for (int mi = 0; mi < 2; mi++)
#pragma unroll
        for (int j = 0; j < 4; j++) {
          int lr = wr * 32 + mi * 16 + quad * 4 + j;
          const float* sp = SSQ2 + (size_t)(m0 + lr) * 16; float tot = 0.f;
#pragma unroll
          for (int i = 0; i < 16; i++) tot += sp[i];
          float rs = rsqrtf(tot * (1.f / DM) + EPSN);
#pragma unroll
          for (int ni = 0; ni < 4; ni++) sS[lr * 129 + wc * 64 + ni * 16 + l16] = acc[mi][ni][j] * rs;
        }
      __syncthreads();
      { int row = tid & 63, q = tid >> 6; int t[16];
#pragma unroll
        for (int s = 0; s < 16; s++) t[s] = (int)0x80000000;
#pragma unroll 8
        for (int i = 0; i < 32; i++) { int idx = q * 32 + i; ins16(t, fkey(sS[row * 129 + idx], idx, 127)); }
#pragma unroll
        for (int s = 0; s < 16; s++) sL[row * 65 + q * 16 + s] = t[s]; }
      __syncthreads();
      if (tid < 64) { int row = tid; int p0 = 0, p1 = 0, p2 = 0, p3 = 0; const int* L = sL + row * 65;
        for (int r = 0; r < 16; r++) {
          int a0 = L[p0], a1 = L[16 + p1], a2 = L[32 + p2], a3 = L[48 + p3];
          int mx = max(max(a0, a1), max(a2, a3));
          if (mx == a0) p0++; else if (mx == a1) p1++; else if (mx == a2) p2++; else p3++;
          int idx = mx & 127;
          sTV[(half * 64 + row) * 17 + r] = sS[row * 129 + idx]; sTI[(half * 64 + row) * 17 + r] = idx; } }
      __syncthreads();
    }
    if (tid < 64) {
      int row = tid; float v1[16], v2[16];
#pragma unroll
      for (int i = 0; i < 16; i++) { v1[i] = sTV[row * 17 + i]; v2[i] = sTV[(64 + row) * 17 + i]; }
      int t[16];
#pragma unroll
      for (int s = 0; s < 16; s++) t[s] = (int)0x80000000;
#pragma unroll
      for (int i = 0; i < 16; i++)
#pragma unroll
        for (int j = 0; j < 16; j++)
          if ((i + 1) * (j + 1) <= 16) ins16(t, fkey(v1[i] + v2[j], i * 16 + j, 255));
      float es[16]; int ei[16]; float mx = 0.f, sum = 0.f;
#pragma unroll
      for (int r = 0; r < 16; r++) { int c = t[r] & 255; int i = c >> 4, j = c & 15;
        float s = sTV[row * 17 + i] + sTV[(64 + row) * 17 + j];
        ei[r] = sTI[row * 17 + i] * 128 + sTI[(64 + row) * 17 + j];
        if (r == 0) mx = s;
        es[r] = __expf(s - mx); sum += es[r]; }
      float inv = 1.f / sum;
      int2* ro = ROUTE + ((size_t)(m0 + row) * 8 + h) * 16;
#pragma unroll
      for (int r = 0; r < 16; r++) ro[r] = make_int2(ei[r], __float_as_int(es[r] * inv));
    }
    __syncthreads();
  }
}

#define FP4PK(w_, sel_) __builtin_amdgcn_cvt_scalef32_pk_f32_fp4((w_), 1.0f, (sel_))
DEV float dot16_fp8(const u32x2& u, const f32x2 (&xn)[8]) {
  f32x2 s = FP4PK(u[0], 0) * xn[0];
  s = FP4PK(u[0], 1) * xn[1] + s;
  s = FP4PK(u[0], 2) * xn[2] + s;
  s = FP4PK(u[0], 3) * xn[3] + s;
  s = FP4PK(u[1], 0) * xn[4] + s;
  s = FP4PK(u[1], 1) * xn[5] + s;
  s = FP4PK(u[1], 2) * xn[6] + s;
  s = FP4PK(u[1], 3) * xn[7] + s;
  return s[0] + s[1];
}
DEV void axpy16_fp8(const u32x2& u, float wj, f32x2 (&acc)[8]) {
  const f32x2 w2 = {wj, wj};
  acc[0] = FP4PK(u[0], 0) * w2 + acc[0];
  acc[1] = FP4PK(u[0], 1) * w2 + acc[1];
  acc[2] = FP4PK(u[0], 2) * w2 + acc[2];
  acc[3] = FP4PK(u[0], 3) * w2 + acc[3];
  acc[4] = FP4PK(u[1], 0) * w2 + acc[4];
  acc[5] = FP4PK(u[1], 1) * w2 + acc[5];
  acc[6] = FP4PK(u[1], 2) * w2 + acc[6];
  acc[7] = FP4PK(u[1], 3) * w2 + acc[7];
}
template <int S>
DEV void red_step(float (&pp)[16], int lane) {
  const bool up = (lane & S) != 0;
#pragma unroll
  for (int i = 0; i < S; i++) {
    float send = up ? pp[i] : pp[i + S];
    float keep = up ? pp[i + S] : pp[i];
    pp[i] = keep + __shfl_xor(send, S);
  }
}
DEV float reduce16(float (&pp)[16], int lane) {
  red_step<8>(pp, lane); red_step<4>(pp, lane); red_step<2>(pp, lane); red_step<1>(pp, lane);
  float v = pp[0];
  v += __shfl_xor(v, 16); v += __shfl_xor(v, 32);
  return v;
}

DEV void phase8(const Params& p, int bid, int nb, char* smem, bool dry = false) {
  const int tid = threadIdx.x, lane = tid & 63, w = __builtin_amdgcn_readfirstlane(tid >> 6);
  const u32x2* PUB = (const u32x2*)(p.ws + OFF_PUB); const u32x2* PVB = (const u32x2*)(p.ws + OFF_PVB);
  const float* PSC = (const float*)(p.ws + OFF_PSC);
  const float* SSQ2 = (const float*)(p.ws + OFF_SSQ2); const int2* ROUTE = (const int2*)(p.ws + OFF_ROUTE);
  for (int it = bid; it < TT / 4; it += nb) {
    int tok = it * 4 + w;
    float* y = tok < TP ? p.out + O_YP + (size_t)tok * DM : p.out + O_YS + (size_t)(tok - TP) * DM;
    float x[16]; f32x2 xn[8];
    { float4 a0 = *(const float4*)(y + lane * 16), a1 = *(const float4*)(y + lane * 16 + 4), b0 = *(const float4*)(y + lane * 16 + 8), b1 = *(const float4*)(y + lane * 16 + 12);
      x[0] = a0.x; x[1] = a0.y; x[2] = a0.z; x[3] = a0.w; x[4] = a1.x; x[5] = a1.y; x[6] = a1.z; x[7] = a1.w;
      x[8] = b0.x; x[9] = b0.y; x[10] = b0.z; x[11] = b0.w; x[12] = b1.x; x[13] = b1.y; x[14] = b1.z; x[15] = b1.w; }
    float tot = 0.f;
    { const float* sp = SSQ2 + (size_t)tok * 16;
#pragma unroll
      for (int i = 0; i < 16; i++) tot += sp[i]; }
    float rs = rsqrtf(tot * (1.f / DM) + EPSN);
#pragma unroll
    for (int i = 0; i < 8; i++) { xn[i][0] = x[2 * i] * rs * p.norm2_g[lane * 16 + 2 * i]; xn[i][1] = x[2 * i + 1] * rs * p.norm2_g[lane * 16 + 2 * i + 1]; }
    const int2* rt = ROUTE + (size_t)tok * 128;
    int2 r0 = rt[lane], r1 = rt[lane + 64];
    float d0 = 0.f, d1 = 0.f, w0 = 0.f, w1 = 0.f;
    f32x2 acc[8];
#pragma unroll
    for (int i = 0; i < 8; i++) acc[i] = f32x2{0.f, 0.f};
#define P8_LOAD(buf, tb_, gi_) do { const int rx_ = ((gi_) & 4) ? r1.x : r0.x; \
      _Pragma("unroll") for (int jj = 0; jj < 16; jj++) { int e = __builtin_amdgcn_readlane(rx_, ((gi_) & 3) * 16 + jj); buf[jj] = tb_[(size_t)e * 64 + lane]; } } while (0)
#define P8_COMPU(buf, gi_) do { float pp[16]; \
      _Pragma("unroll") for (int jj = 0; jj < 16; jj++) pp[jj] = dot16_fp8(buf[jj], xn); \
      float v_ = reduce16(pp, lane); \
      if ((lane >> 4) == ((gi_) & 3)) { if ((gi_) < 4) d0 = v_; else d1 = v_; } } while (0)
#define P8_COMPV(buf, gi_) do { const int wx_ = __float_as_int(((gi_) & 4) ? w1 : w0); \
      _Pragma("unroll") for (int jj = 0; jj < 16; jj++) { float wj = __int_as_float(__builtin_amdgcn_readlane(wx_, ((gi_) & 3) * 16 + jj)); axpy16_fp8(buf[jj], wj, acc); } } while (0)
#define P8_SB() __builtin_amdgcn_sched_barrier(0)
    {
      u32x2 ua[16], ub[16];
      P8_LOAD(ua, PUB, 0);
#pragma unroll 1
      for (int gi = 0; gi < 6; gi += 2) {
        P8_LOAD(ub, PUB, gi + 1); P8_SB();
        P8_COMPU(ua, gi); P8_SB();
        P8_LOAD(ua, PUB, gi + 2); P8_SB();
        P8_COMPU(ub, gi + 1); P8_SB();
      }
      P8_LOAD(ub, PUB, 7); P8_SB();
      P8_COMPU(ua, 6); P8_SB();
      P8_LOAD(ua, PVB, 0); P8_SB();
      P8_COMPU(ub, 7); P8_SB();
      d0 *= PSC[r0.x]; d1 *= PSC[r1.x];
      w0 = 0.5f * d0 * (1.f + erff(d0 * 0.70710678118654752f)) * __int_as_float(r0.y) * PSC[16384 + r0.x];
      w1 = 0.5f * d1 * (1.f + erff(d1 * 0.70710678118654752f)) * __int_as_float(r1.y) * PSC[16384 + r1.x];
      P8_SB();
#pragma unroll 1
      for (int gi = 0; gi < 6; gi += 2) {
        P8_LOAD(ub, PVB, gi + 1); P8_SB();
        P8_COMPV(ua, gi); P8_SB();
        P8_LOAD(ua, PVB, gi + 2); P8_SB();
        P8_COMPV(ub, gi + 1); P8_SB();
      }
      P8_LOAD(ub, PVB, 7); P8_SB();
      P8_COMPV(ua, 6); P8_SB();
      P8_COMPV(ub, 7);
    }
    if (dry) y = (float*)(p.ws + OFF_XB) + (size_t)(tok & 8191) * DM;
    *(float4*)(y + lane * 16) = make_float4(x[0] + acc[0][0], x[1] + acc[0][1], x[2] + acc[1][0], x[3] + acc[1][1]);
    *(float4*)(y + lane * 16 + 4) = make_float4(x[4] + acc[2][0], x[5] + acc[2][1], x[6] + acc[3][0], x[7] + acc[3][1]);
    *(float4*)(y + lane * 16 + 8) = make_float4(x[8] + acc[4][0], x[9] + acc[4][1], x[10] + acc[5][0], x[11] + acc[5][1]);
    *(float4*)(y + lane * 16 + 12) = make_float4(x[12] + acc[6][0], x[13] + acc[6][1], x[14] + acc[7][0], x[15] + acc[7][1]);
  }
}

#define XB_TMO      128
#define XB_XCNT(j)  (256  + 64 * (j))
#define XB_XSUB(j)  (1280 + 64 * (j))
#define XB_XGEN(j)  (2304 + 64 * (j))
#define XB_TOP      3328
#define XB_TOPGEN   3392
#define XCD_BAR_WORDS 3456
#define XB_SPIN_CAP (1u << 18)
#define LAS __attribute__((address_space(3)))

__device__ __forceinline__ unsigned xb_ld(unsigned* p)              { return __hip_atomic_load(p, __ATOMIC_RELAXED, __HIP_MEMORY_SCOPE_AGENT); }
__device__ __forceinline__ unsigned xb_add(unsigned* p, unsigned v) { return __hip_atomic_fetch_add(p, v, __ATOMIC_RELAXED, __HIP_MEMORY_SCOPE_AGENT); }
__device__ __forceinline__ unsigned xb_xcc_id() { return (unsigned)__builtin_amdgcn_s_getreg((3 << 11) | 20) & 0xFu; }
#define XB_SPIN(cond, bar) do { unsigned _sp = 0; while (cond) { __builtin_amdgcn_s_sleep(1); \
    if ((++_sp & 255u) == 0u) { if (xb_ld(&(bar)[XB_TMO])) break; if (_sp > XB_SPIN_CAP) { atomicAdd(&(bar)[XB_TMO], 1u); break; } } } } while (0)

struct XcdBarrier {
    unsigned* bar; unsigned x;
    volatile LAS unsigned* st;
};

__device__ __forceinline__ XcdBarrier xcd_barrier_post(unsigned* bar, volatile LAS unsigned* st) {
    XcdBarrier b; b.bar = bar; b.x = xb_xcc_id(); b.st = st;
    if (threadIdx.x == 0) (void)xb_add(&bar[XB_XCNT(b.x)], 1u);
    return b;
}
__device__ __forceinline__ void xcd_barrier_complete(unsigned* bar, unsigned x, unsigned& nloc, unsigned& nx) {
    const unsigned G = gridDim.x * gridDim.y * gridDim.z;
    unsigned sum, cnt, mine, sp = 0u;
    for (;;) {
        sum = 0u; cnt = 0u; mine = 0u;
#pragma unroll
        for (unsigned j = 0; j < 16; ++j) { const unsigned c = xb_ld(&bar[XB_XCNT(j)]); sum += c; cnt += (c > 0u) ? 1u : 0u; mine = (j == x) ? c : mine; }
        if (sum == G) break;
        __builtin_amdgcn_s_sleep(1);
        if ((++sp & 255u) == 0u) { if (xb_ld(&bar[XB_TMO])) break; if (sp > XB_SPIN_CAP) { atomicAdd(&bar[XB_TMO], 1u); break; } }
    }
    nloc = mine > 0u ? mine : 1u; nx = cnt > 0u ? cnt : 1u;
}

__device__ __forceinline__ void xcd_barrier(const XcdBarrier& b) {
    asm volatile("s_waitcnt vmcnt(0)" ::: "memory");
    __syncthreads();
    if (threadIdx.x == 0) {
        unsigned* bar = b.bar;
        __builtin_amdgcn_s_waitcnt(0);
        unsigned nloc = b.st[0], nx = b.st[1];
        if (nloc == 0u) { xcd_barrier_complete(bar, b.x, nloc, nx); b.st[0] = nloc; b.st[1] = nx; }
        const unsigned old = xb_add(&bar[XB_XSUB(b.x)], 1u);
        const unsigned gen = old / nloc;
        if (old + 1u == (gen + 1u) * nloc) {
            __builtin_amdgcn_fence(__ATOMIC_RELEASE, "agent");
            asm volatile("s_waitcnt vmcnt(0)" ::: "memory");
            const unsigned og = xb_add(&bar[XB_TOP], 1u);
            const unsigned tg = og / nx;
            if (og + 1u == (tg + 1u) * nx) xb_add(&bar[XB_TOPGEN], 1u);
            else XB_SPIN(xb_ld(&bar[XB_TOPGEN]) == tg, bar);
            __builtin_amdgcn_fence(__ATOMIC_ACQUIRE, "agent");
            xb_add(&bar[XB_XGEN(b.x)], 1u);
            asm volatile("s_waitcnt vmcnt(0)" ::: "memory");
        } else {
            XB_SPIN(xb_ld(&bar[XB_XGEN(b.x)]) == gen, bar);
            __builtin_amdgcn_fence(__ATOMIC_ACQUIRE, "agent");
            asm volatile("s_waitcnt vmcnt(0)" ::: "memory");
        }
    }
    __syncthreads();
}


__global__ void __launch_bounds__(256, 2) fwd_kernel(Params p, int ph_lo, int ph_hi, int coop) {
  __shared__ __attribute__((aligned(16))) char smem[SMEM_BYTES];
  const int bid = blockIdx.x, nb = gridDim.x;
  __shared__ uint4 xb_words;
  if (threadIdx.x == 0) xb_words = make_uint4(0u, 0u, 0u, 0u);
  __syncthreads();
  XcdBarrier xb; xb.bar = (unsigned*)(p.ws + OFF_BAR); xb.x = 0; xb.st = (volatile LAS unsigned*)&xb_words;
  if (coop) xb = xcd_barrier_post((unsigned*)(p.ws + OFF_BAR), (volatile LAS unsigned*)&xb_words);
#ifndef REPS
#define REPS {1,1,1,1,1,1,1,1,1}
#endif
  constexpr int REP[9] = REPS;
#define RUN_PHASE(N) if (ph_lo <= N && N <= ph_hi) { for (int r_ = 0; r_ < REP[N]; r_++) phase##N(p, bid, nb, smem); if (coop && N < ph_hi) { if (ph_lo == 0x7fffffff) cg::this_grid().sync();   xcd_barrier(xb); } }
#define RUN_PHASE_DRY(N) if (ph_lo <= N && N <= ph_hi) { for (int r_ = 1; r_ < REP[N]; r_++) phase##N(p, bid, nb, smem, true); phase##N(p, bid, nb, smem, false); if (coop && N < ph_hi) xcd_barrier(xb); }
  RUN_PHASE(0) RUN_PHASE_DRY(1) RUN_PHASE(2) RUN_PHASE(3) RUN_PHASE_DRY(4) RUN_PHASE(5) RUN_PHASE(6) RUN_PHASE(7) RUN_PHASE_DRY(8)
}

extern "C" void kernel_launch(void* const* d_in, const int* in_sizes, int n_in, void* d_out, int out_size,
                              void* d_ws, size_t ws_size, hipStream_t stream) {
  if (ws_size < WS_NEED) { fprintf(stderr, "workspace too small\n"); return; }
  static int grid_blocks = 0;
  if (!grid_blocks) {
    int dev = 0, cus = 0, per_cu = 0;
    hipGetDevice(&dev);
    hipDeviceGetAttribute(&cus, hipDeviceAttributeMultiprocessorCount, dev);
    hipOccupancyMaxActiveBlocksPerMultiprocessor(&per_cu, fwd_kernel, 256, 0);
    if (per_cu < 1) per_cu = 1;
    if (per_cu > 2) per_cu = 2;
    grid_blocks = cus * per_cu;
  }
  Params p{};
  const float* const* in = (const float* const*)d_in;
  p.x_p = in[0]; p.x_s = in[1]; p.state_ret = in[2]; p.ck = in[3]; p.cv = in[4]; p.clogf = in[5]; p.norm1_g = in[6];
  p.w_in = in[7]; p.b_f = in[8]; p.fq_g = in[9]; p.fk_g = in[10]; p.gn_g = in[11]; p.w_ret_out = in[12]; p.w_fox_out = in[13];
  p.w_o = in[14]; p.norm2_g = in[15]; p.peer_wq = in[16]; p.k1 = in[17]; p.k2 = in[18]; p.peer_u = in[19]; p.peer_v = in[20];
  p.out = (float*)d_out; p.ws = (char*)d_ws;
#ifndef MULTI_LAUNCH
#define MULTI_LAUNCH 0
#endif
#if MULTI_LAUNCH
  for (int ph = 0; ph <= 8; ph++) fwd_kernel<<<grid_blocks, 256, 0, stream>>>(p, ph, ph, 0);
#else
  hipMemsetAsync((char*)d_ws + OFF_BAR, 0, XCD_BAR_WORDS * sizeof(unsigned), stream);
  int lo = 0, hi = 8, coop = 1;
  void* args[] = {&p, &lo, &hi, &coop};
  hipError_t e = hipLaunchCooperativeKernel((void*)fwd_kernel, dim3(grid_blocks), dim3(256), args, 0, stream);
  if (e != hipSuccess) fprintf(stderr, "cooperative launch failed: %s (grid %d)\n", hipGetErrorString(e), grid_blocks);
#endif
}
```
